# Optimizing an MI355X kernel written in HIP

```python
import math
import jax
import jax.numpy as jnp
from jax import lax
import numpy as np


D_MODEL = 1024
BATCH = 1
SEQ = 16384
DEPTH = 2

MEM_LEN = 256
GROUP_WIDTH = D_MODEL // 2
N_GROUPS = 4
MIX_WIDTH = N_GROUPS * GROUP_WIDTH

SWA_HEADS = 8
SWA_KV_HEADS = 2
SWA_HEAD_DIM = GROUP_WIDTH // SWA_HEADS
WINDOW = 128
REL_BUCKETS = 32
REL_MAX_DIST = 128
GDN_HEADS = 4
GDN_HEAD_DIM = GROUP_WIDTH // GDN_HEADS
GDN_CONV = 4
GDN_CHUNK = 64
MLA_HEADS = 4
MLA_NOPE_DIM = 128
MLA_ROPE_DIM = 64
MLA_V_DIM = GROUP_WIDTH // MLA_HEADS
MLA_Q_RANK = D_MODEL // 4
MLA_KV_RANK = D_MODEL // 8
ROPE_THETA = 10000.0
Q_BLOCK = 128
MEM_HEADS = 4
MEM_HEAD_DIM = GROUP_WIDTH // MEM_HEADS

RMS_EPS = 1e-6
NEG_INF = -1e30

IN_SPLITS = (
    SWA_HEADS * SWA_HEAD_DIM,
    SWA_KV_HEADS * SWA_HEAD_DIM,
    SWA_KV_HEADS * SWA_HEAD_DIM,
    GROUP_WIDTH,
    3 * GROUP_WIDTH,
    GDN_HEADS,
    GDN_HEADS,
    GROUP_WIDTH,
    MLA_Q_RANK,
    MLA_KV_RANK,
    MLA_ROPE_DIM,
    GROUP_WIDTH,
    MEM_HEADS * MEM_HEAD_DIM,
    GROUP_WIDTH,
)
D_IN = sum(IN_SPLITS)

kernel_name = 'hybrid_parallel_heads_block'


def rmsnorm(t, gain):
    tf = t.astype(jnp.float32)
    tf = tf * lax.rsqrt(jnp.mean(tf * tf, axis=-1, keepdims=True) + RMS_EPS)
    return (tf * gain.astype(jnp.float32)).astype(t.dtype)


def l2norm(t):
    return t * lax.rsqrt(jnp.sum(t * t, axis=-1, keepdims=True) + 1e-6)


def split_columns(t, sizes):
    offs = np.cumsum(sizes)[:-1].tolist()
    return jnp.split(t, offs, axis=-1)


def t5_bucket(rel):
    n = jnp.maximum(rel, 0)
    max_exact = REL_BUCKETS // 2
    nf = jnp.maximum(n, 1).astype(jnp.float32)
    large = max_exact + (jnp.log(nf / max_exact) / math.log(REL_MAX_DIST / max_exact)
                         * (REL_BUCKETS - max_exact)).astype(jnp.int32)
    large = jnp.minimum(large, REL_BUCKETS - 1)
    return jnp.where(n < max_exact, n, large)


def banded_rel_bias(rel_bias, positions):
    B, S = positions.shape
    nb = S // WINDOW
    pq = positions.reshape(B, nb, WINDOW)
    pprev = jnp.pad(pq, ((0, 0), (1, 0), (0, 0)))[:, :-1]
    pk = jnp.concatenate([pprev, pq], axis=2)
    bucket = t5_bucket(pq[..., :, None] - pk[..., None, :])
    bias = jnp.take(rel_bias.T.astype(jnp.float32), bucket, axis=1)
    bias = bias.reshape(SWA_KV_HEADS, SWA_HEADS // SWA_KV_HEADS, B, nb, WINDOW, 2 * WINDOW)
    return jnp.moveaxis(bias, 2, 0)


def rope_tables(positions):
    inv_freq = 1.0 / (ROPE_THETA ** (jnp.arange(0, MLA_ROPE_DIM, 2, dtype=jnp.float32) / MLA_ROPE_DIM))
    ang = positions.astype(jnp.float32)[..., None] * inv_freq
    return jnp.cos(ang), jnp.sin(ang)


def apply_rope(t, cos, sin):
    half = t.shape[-1] // 2
    t1, t2 = t[..., :half], t[..., half:]
    return jnp.concatenate([t1 * cos - t2 * sin, t1 * sin + t2 * cos], axis=-1)


def swa_sink_attention(q, k, v, sinks, bias):
    B, S, HQ, Dh = q.shape
    HKV = k.shape[2]
    G = HQ // HKV
    W = WINDOW
    nb = S // W
    qb = q.astype(jnp.float32).reshape(B, nb, W, HKV, G, Dh)

    def with_prev(t):
        tb = t.astype(jnp.float32).reshape(B, nb, W, HKV, Dh)
        prev = jnp.pad(tb, ((0, 0), (1, 0), (0, 0), (0, 0), (0, 0)))[:, :-1]
        return jnp.concatenate([prev, tb], axis=2)

    kb, vb = with_prev(k), with_prev(v)
    s = jnp.einsum('bnqhgd,bnkhd->bhgnqk', qb, kb) * (Dh ** -0.5) + bias
    qi = jnp.arange(W)[:, None]
    kj = jnp.arange(2 * W)[None, :]
    band = (kj > qi) & (kj <= qi + W)
    valid = band[None] & ((jnp.arange(nb) > 0)[:, None, None] | (kj >= W)[None])
    s = jnp.where(valid, s, NEG_INF)
    sink = sinks.astype(jnp.float32).reshape(HKV, G)[None, :, :, None, None]
    m = jnp.maximum(jnp.max(s, axis=-1), sink)
    p = jnp.exp(s - m[..., None])
    denom = jnp.sum(p, axis=-1) + jnp.exp(sink - m)
    p = p / denom[..., None]
    o = jnp.einsum('bhgnqk,bnkhd->bnqhgd', p, vb)
    return o.reshape(B, S, HQ * Dh)


def causal_depthwise_conv(t, w):
    K, C = w.shape
    return lax.conv_general_dilated(
        t.astype(jnp.float32), w.astype(jnp.float32)[:, None, :],
        window_strides=(1,), padding=[(K - 1, 0)],
        dimension_numbers=('NWC', 'WIO', 'NWC'), feature_group_count=C)


def gated_delta_rule_chunked(q, k, v, g, beta):
    B, S, H, Dk = q.shape
    Dv = v.shape[-1]
    C = GDN_CHUNK
    N = S // C

    def chunks(t):
        t = t.reshape(B, N, C, H, *t.shape[3:])
        return jnp.moveaxis(t, 3, 1)

    q = chunks(q * (Dk ** -0.5))
    k = chunks(k)
    v = chunks(v)
    beta = chunks(beta)
    g = jnp.cumsum(chunks(g), axis=-1)
    k_beta = k * beta[..., None]
    v_beta = v * beta[..., None]
    incl = jnp.tril(jnp.ones((C, C), bool))
    strict = jnp.tril(jnp.ones((C, C), bool), -1)
    gdiff = g[..., :, None] - g[..., None, :]
    decay = jnp.where(incl, jnp.exp(jnp.where(incl, gdiff, 0.0)), 0.0)
    L = jnp.where(strict, jnp.einsum('bhncd,bhnmd->bhncm', k_beta, k) * decay, 0.0)
    eye = jnp.eye(C, dtype=jnp.float32)
    T = lax.linalg.triangular_solve(eye + L, jnp.broadcast_to(eye, L.shape),
                                    left_side=True, lower=True)
    u = T @ v_beta
    w = T @ (k_beta * jnp.exp(g)[..., None])
    a_qk = jnp.einsum('bhncd,bhnmd->bhncm', q, k) * decay
    qg = q * jnp.exp(g)[..., None]
    g_last = g[..., -1]
    kd = k * jnp.exp(g_last[..., None] - g)[..., None]

    def step(state, inp):
        qg_i, a_i, u_i, w_i, kd_i, gl_i = inp
        v_new = u_i - jnp.einsum('bhcd,bhde->bhce', w_i, state)
        o_i = jnp.einsum('bhcd,bhde->bhce', qg_i, state) + jnp.einsum('bhcm,bhme->bhce', a_i, v_new)
        state = state * jnp.exp(gl_i)[..., None, None] + jnp.einsum('bhcd,bhce->bhde', kd_i, v_new)
        return state, o_i

    xs = tuple(jnp.moveaxis(t, 2, 0) for t in (qg, a_qk, u, w, kd, g_last))
    state0 = jnp.zeros((B, H, Dk, Dv), jnp.float32)
    _, o = lax.scan(step, state0, xs)
    return jnp.transpose(o, (1, 0, 3, 2, 4)).reshape(B, S, H, Dv)


def mla_causal_attention(q_nope, q_rope, k_nope, k_rope, v):
    B, S, H, _ = q_nope.shape
    nb = S // Q_BLOCK
    scale = (MLA_NOPE_DIM + MLA_ROPE_DIM) ** -0.5
    k_idx = jnp.arange(S)

    def to_blocks(t):
        return jnp.moveaxis(t.reshape(B, nb, Q_BLOCK, *t.shape[2:]), 1, 0)

    def block(args):
        qn, qr, start = args
        s = (jnp.einsum('bqhd,bkhd->bhqk', qn, k_nope)
             + jnp.einsum('bqhd,bkd->bhqk', qr, k_rope)) * scale
        q_idx = start + jnp.arange(Q_BLOCK)
        s = jnp.where(k_idx[None, :] <= q_idx[:, None], s, NEG_INF)
        p = jax.nn.softmax(s, axis=-1)
        return jnp.einsum('bhqk,bkhd->bqhd', p, v)

    o = lax.map(block, (to_blocks(q_nope), to_blocks(q_rope), jnp.arange(nb) * Q_BLOCK))
    return jnp.moveaxis(o, 0, 1).reshape(B, S, H * v.shape[-1])


def memory_cross_attention(q, mk, mv):
    B, S, H, D = q.shape
    s = jnp.einsum('bshd,bmhd->bhsm', q, mk) * (D ** -0.5)
    p = jax.nn.softmax(s, axis=-1)
    return jnp.einsum('bhsm,bmhd->bshd', p, mv).reshape(B, S, H * D)


def hybrid_layer(x, mem, cos, sin, bias_blocks, norm_pre, norm_post, w_in, attn_sinks,
                 gdn_conv_w, gdn_a_log, gdn_dt_bias, gdn_norm, mla_q_norm, mla_kv_norm,
                 mla_w_uq, mla_w_ukv, mem_norm, mem_w_kv, w_out):
    B, S, _ = x.shape
    f32 = jnp.float32
    h = rmsnorm(x, norm_pre)
    (a_q, a_k, a_v, a_z, b_qkv, b_a, b_b, b_z,
     c_cq, c_ckv, c_kr, c_z, d_q, d_z) = split_columns(h @ w_in, IN_SPLITS)

    o_a = swa_sink_attention(a_q.reshape(B, S, SWA_HEADS, SWA_HEAD_DIM),
                             a_k.reshape(B, S, SWA_KV_HEADS, SWA_HEAD_DIM),
                             a_v.reshape(B, S, SWA_KV_HEADS, SWA_HEAD_DIM),
                             attn_sinks, bias_blocks)
    o_a = o_a * jax.nn.silu(a_z.astype(f32))

    qkv = jax.nn.silu(causal_depthwise_conv(b_qkv, gdn_conv_w))
    g_q, g_k, g_v = jnp.split(qkv, 3, axis=-1)
    g_q = l2norm(g_q.reshape(B, S, GDN_HEADS, GDN_HEAD_DIM))
    g_k = l2norm(g_k.reshape(B, S, GDN_HEADS, GDN_HEAD_DIM))
    g_v = g_v.reshape(B, S, GDN_HEADS, GDN_HEAD_DIM)
    beta = jax.nn.sigmoid(b_b.astype(f32))
    log_decay = -jnp.exp(gdn_a_log.astype(f32)) * jax.nn.softplus(b_a.astype(f32) + gdn_dt_bias.astype(f32))
    o_b = gated_delta_rule_chunked(g_q, g_k, g_v, log_decay, beta)
    o_b = rmsnorm(o_b, gdn_norm) * jax.nn.silu(b_z.astype(f32).reshape(B, S, GDN_HEADS, GDN_HEAD_DIM))
    o_b = o_b.reshape(B, S, GROUP_WIDTH)

    cq = rmsnorm(c_cq, mla_q_norm)
    qh = (cq @ mla_w_uq).astype(f32).reshape(B, S, MLA_HEADS, MLA_NOPE_DIM + MLA_ROPE_DIM)
    q_nope, q_rope = qh[..., :MLA_NOPE_DIM], qh[..., MLA_NOPE_DIM:]
    q_rope = apply_rope(q_rope, cos[:, :, None, :], sin[:, :, None, :])
    ckv = rmsnorm(c_ckv, mla_kv_norm)
    kv = (ckv @ mla_w_ukv).astype(f32).reshape(B, S, MLA_HEADS, MLA_NOPE_DIM + MLA_V_DIM)
    k_nope, m_v = kv[..., :MLA_NOPE_DIM], kv[..., MLA_NOPE_DIM:]
    k_rope = apply_rope(c_kr.astype(f32), cos, sin)
    o_c = mla_causal_attention(q_nope, q_rope, k_nope, k_rope, m_v)
    o_c = o_c * jax.nn.silu(c_z.astype(f32))

    mkv = (rmsnorm(mem, mem_norm) @ mem_w_kv).astype(f32)
    mk, mv = jnp.split(mkv, 2, axis=-1)
    M = mem.shape[1]
    o_d = memory_cross_attention(d_q.astype(f32).reshape(B, S, MEM_HEADS, MEM_HEAD_DIM),
                                 mk.reshape(B, M, MEM_HEADS, MEM_HEAD_DIM),
                                 mv.reshape(B, M, MEM_HEADS, MEM_HEAD_DIM))
    o_d = o_d * jax.nn.silu(d_z.astype(f32))

    mixed = jnp.concatenate([o_a, o_b, o_c, o_d], axis=-1).astype(x.dtype)
    y = mixed @ w_out
    return x + rmsnorm(y, norm_post)


def setup_inputs(seed: int = 0) -> dict:
    key = jax.random.key(seed)
    ks = jax.random.split(key, 20)

    def nrm(k, shape, scale):
        return jax.random.normal(k, shape, jnp.float32) * scale

    def gain(k, shape):
        return 1.0 + 0.02 * jax.random.normal(k, shape, jnp.float32)

    x = nrm(ks[0], (BATCH, SEQ, D_MODEL), 1.0)
    mem = nrm(ks[1], (BATCH, MEM_LEN, D_MODEL), 1.0)
    offset = jax.random.randint(ks[2], (BATCH, 1), 0, 1024, dtype=jnp.int32)
    positions = offset + jnp.arange(SEQ, dtype=jnp.int32)[None, :]
    rel_bias = nrm(ks[3], (REL_BUCKETS, SWA_HEADS), 0.5)
    norm_pre = gain(ks[4], (DEPTH, D_MODEL))
    norm_post = gain(ks[5], (DEPTH, D_MODEL))
    w_in = nrm(ks[6], (DEPTH, D_MODEL, D_IN), D_MODEL ** -0.5)
    attn_sinks = nrm(ks[7], (DEPTH, SWA_HEADS), 0.5)
    gdn_conv_w = nrm(ks[8], (DEPTH, GDN_CONV, 3 * GROUP_WIDTH), GDN_CONV ** -0.5)
    gdn_a_log = jnp.log(jax.random.uniform(ks[9], (DEPTH, GDN_HEADS), jnp.float32, 1.0, 16.0))
    dt = jnp.exp(jax.random.uniform(ks[10], (DEPTH, GDN_HEADS), jnp.float32,
                                    math.log(1e-3), math.log(1e-1)))
    gdn_dt_bias = jnp.log(jnp.expm1(dt))
    gdn_norm = gain(ks[11], (DEPTH, GDN_HEAD_DIM))
    mla_q_norm = gain(ks[12], (DEPTH, MLA_Q_RANK))
    mla_kv_norm = gain(ks[13], (DEPTH, MLA_KV_RANK))
    mla_w_uq = nrm(ks[14], (DEPTH, MLA_Q_RANK, MLA_HEADS * (MLA_NOPE_DIM + MLA_ROPE_DIM)), MLA_Q_RANK ** -0.5)
    mla_w_ukv = nrm(ks[15], (DEPTH, MLA_KV_RANK, MLA_HEADS * (MLA_NOPE_DIM + MLA_V_DIM)), MLA_KV_RANK ** -0.5)
    mem_norm = gain(ks[16], (DEPTH, D_MODEL))
    mem_w_kv = nrm(ks[17], (DEPTH, D_MODEL, 2 * GROUP_WIDTH), D_MODEL ** -0.5)
    w_out = nrm(ks[18], (DEPTH, MIX_WIDTH, D_MODEL), MIX_WIDTH ** -0.5)
    return {'x': x, 'mem': mem, 'positions': positions, 'rel_bias': rel_bias,
            'norm_pre': norm_pre, 'norm_post': norm_post, 'w_in': w_in,
            'attn_sinks': attn_sinks, 'gdn_conv_w': gdn_conv_w, 'gdn_a_log': gdn_a_log,
            'gdn_dt_bias': gdn_dt_bias, 'gdn_norm': gdn_norm, 'mla_q_norm': mla_q_norm,
            'mla_kv_norm': mla_kv_norm, 'mla_w_uq': mla_w_uq, 'mla_w_ukv': mla_w_ukv,
            'mem_norm': mem_norm, 'mem_w_kv': mem_w_kv, 'w_out': w_out}


def reference(x, mem, positions, rel_bias, norm_pre, norm_post, w_in, attn_sinks,
              gdn_conv_w, gdn_a_log, gdn_dt_bias, gdn_norm, mla_q_norm, mla_kv_norm,
              mla_w_uq, mla_w_ukv, mem_norm, mem_w_kv, w_out):
    bias_blocks = banded_rel_bias(rel_bias, positions)
    cos, sin = rope_tables(positions)
    for l in range(DEPTH):
        x = hybrid_layer(x, mem, cos, sin, bias_blocks, norm_pre[l], norm_post[l], w_in[l],
                         attn_sinks[l], gdn_conv_w[l], gdn_a_log[l], gdn_dt_bias[l], gdn_norm[l],
                         mla_q_norm[l], mla_kv_norm[l], mla_w_uq[l], mla_w_ukv[l],
                         mem_norm[l], mem_w_kv[l], w_out[l])
    return x
```

```cpp
#include <hip/hip_runtime.h>
#include <hip/hip_cooperative_groups.h>
#include <cstdint>
#include <cstdio>
namespace cg = cooperative_groups;

#define LAS __attribute__((address_space(3)))
typedef unsigned short bf16_t;
typedef short bf16x8 __attribute__((ext_vector_type(8)));
typedef short s16x4 __attribute__((ext_vector_type(4)));
typedef float f32x2 __attribute__((ext_vector_type(2)));
typedef float f32x4 __attribute__((ext_vector_type(4)));
typedef float f32x16 __attribute__((ext_vector_type(16)));
typedef unsigned u32x2 __attribute__((ext_vector_type(2)));
typedef unsigned u32x4 __attribute__((ext_vector_type(4)));
typedef __bf16 bf16x2_t __attribute__((ext_vector_type(2)));

constexpr int S = 16384, DM = 1024, MEML = 256, NP = 5376, DEPTH = 2, DIN = 5320, MIXW = 2048;
constexpr int C_Z = 0, C_AQ = 2048, C_AK = 2560, C_AV = 2688, C_DQ = 2816, C_BQKV = 3328, C_CQ = 4864, C_CKV = 5120, C_KR = 5248, C_BA = 5312, C_BB = 5316;
constexpr int C_OLAT = 2048;
constexpr float RMS_EPS = 1e-6f;
constexpr float LOG2E = 1.4426950408889634f;
constexpr int NT_THREADS = 512;

constexpr size_t MiB = 1u << 20;
constexpr size_t WS_CTL = 0, WS_COS = 1 * MiB, WS_SIN = 3 * MiB, WS_MEMKV = 5 * MiB, WS_MISC = 6 * MiB, WS_MEMN = 7 * MiB;
constexpr size_t WS_WIN = 8 * MiB, WS_WOUT = 19 * MiB, WS_WMEM = 23 * MiB, WS_WQ = 27 * MiB, WS_WUV = 28 * MiB, WS_HALO = 29 * MiB;
constexpr size_t WS_AQK = 32 * MiB, WS_U = 40 * MiB, WS_H = 56 * MiB, WS_PROJ = 88 * MiB, WS_END = 256 * MiB;
constexpr size_t WS_QABS = WS_H, WS_KVLAT = WS_H + 24 * MiB, WS_Y = WS_H;
constexpr size_t MISC_BTAB = 0, MISC_RSQ = 8192, MISC_EGL = 8192 + 65536;

constexpr int LDS_BYTES = 147456;

struct Params {
    const float* x; const float* mem; const int* pos; const float* rel_bias;
    const float* norm_pre; const float* norm_post; const float* w_in; const float* sinks;
    const float* conv_w; const float* a_log; const float* dt_bias; const float* gdn_norm;
    const float* q_norm; const float* kv_norm; const float* w_uq; const float* w_ukv;
    const float* mem_norm; const float* w_mem; const float* w_out;
    float* out; unsigned char* ws;
    int ph_lo, ph_hi;
};

__device__ __forceinline__ float bf2f(bf16_t v) { return __uint_as_float((unsigned)v << 16); }
__device__ __forceinline__ unsigned cvtpk(float lo, float hi) { f32x2 v = {lo, hi}; bf16x2_t b = __builtin_convertvector(v, bf16x2_t); return __builtin_bit_cast(unsigned, b); }
__device__ __forceinline__ bf16_t f2bf(float f) { return (bf16_t)(cvtpk(f, 0.f) & 0xffffu); }
__device__ __forceinline__ float lo_bf(unsigned w) { return __uint_as_float(w << 16); }
__device__ __forceinline__ float hi_bf(unsigned w) { return __uint_as_float(w & 0xffff0000u); }
__device__ __forceinline__ float silu_f(float v) { return v / (1.f + __expf(-v)); }
__device__ __forceinline__ float wave_sum(float v) {
#pragma unroll
    for (int o = 1; o < 64; o <<= 1) v += __shfl_xor(v, o);
    return v;
}
__device__ __forceinline__ int crow(int r, int hi) { return (r & 3) + 8 * (r >> 2) + 4 * hi; }
#define MFMA32(a, b, c) __builtin_amdgcn_mfma_f32_32x32x16_bf16((a), (b), (c), 0, 0, 0)
#define SBAR() __builtin_amdgcn_sched_barrier(0)
#define LDS_WAIT() asm volatile("s_waitcnt lgkmcnt(0)" ::: "memory")
__device__ __forceinline__ bf16x8 pack8(const float* v) { u32x4 w = {cvtpk(v[0], v[1]), cvtpk(v[2], v[3]), cvtpk(v[4], v[5]), cvtpk(v[6], v[7])}; return __builtin_bit_cast(bf16x8, w); }
__device__ __forceinline__ bf16x8 pack_step(const f32x16& x, int s) {
    u32x4 w = {cvtpk(x[8 * s + 0], x[8 * s + 1]), cvtpk(x[8 * s + 2], x[8 * s + 3]), cvtpk(x[8 * s + 4], x[8 * s + 5]), cvtpk(x[8 * s + 6], x[8 * s + 7])};
    return __builtin_bit_cast(bf16x8, w);
}

__device__ __forceinline__ int win_src(int n) {
    if (n < 512) return 768 + n;
    if (n < 1024) return 2824 + (n - 512);
    if (n < 1536) return 3784 + (n - 1024);
    if (n < 2048) return 4808 + (n - 1536);
    if (n < 2560) return n - 2048;
    if (n < 2688) return 512 + (n - 2560);
    if (n < 2816) return 640 + (n - 2688);
    if (n < 3328) return 4296 + (n - 2816);
    if (n < 4864) return 1280 + (n - 3328);
    if (n < 5120) return 3336 + (n - 4864);
    if (n < 5248) return 3592 + (n - 5120);
    if (n < 5312) return 3720 + (n - 5248);
    if (n < 5316) return 2816 + (n - 5312);
    if (n < 5320) return 2820 + (n - 5316);
    return -1;
}

__device__ __forceinline__ int t5_bucket(int n) {
    if (n < 16) return n < 0 ? 0 : n;
    if (n >= 128) return 31;
    const float v = __logf((float)n * 0.0625f) * (16.0f / 2.0794415416798357f);
    int b = 16 + (int)v; return b > 31 ? 31 : b;
}
__device__ __forceinline__ float inv_freq(int i) {
    const float t[32] = {1.000000000e+00f, 7.498942018e-01f, 5.623413324e-01f, 4.216965139e-01f, 3.162277639e-01f, 2.371373922e-01f, 1.778279394e-01f, 1.333521456e-01f,
                         1.000000015e-01f, 7.498941571e-02f, 5.623412877e-02f, 4.216964915e-02f, 3.162277862e-02f, 2.371373586e-02f, 1.778279431e-02f, 1.333521493e-02f,
                         9.999999776e-03f, 7.498942316e-03f, 5.623413250e-03f, 4.216964822e-03f, 3.162277862e-03f, 2.371373819e-03f, 1.778279431e-03f, 1.333521446e-03f,
                         1.000000047e-03f, 7.498941850e-04f, 5.623413017e-04f, 4.216965463e-04f, 3.162277862e-04f, 2.371373848e-04f, 1.778279402e-04f, 1.333521504e-04f};
    return t[i];
}
namespace pg8 {
#define PG8_LAS __attribute__((address_space(3)))
constexpr int BM = 256, BK = 64, HALF = 128, HTB = HALF * BK * 2  , STAGE_BYTES = 8 * HTB, NXCD = 8, WGM = 8;
__host__ __device__ __forceinline__ int lds_byte(int r, int c) { const int st = (r >> 4) * 2 + (c >> 5), rr = r & 15, cc = c & 31, ob = rr * 64 + cc * 2; return st * 1024 + (ob ^ (((ob >> 9) & 1) << 5)); }
__host__ __device__ __forceinline__ void stage_rc(int b, int& R, int& C) { const int st = b / 1024, sb = b % 1024, swz = sb ^ (((sb >> 9) & 1) << 5); R = (st >> 1) * 16 + swz / 64; C = (st & 1) * 32 + (swz % 64) / 2; }
__host__ __device__ __forceinline__ int perm32(int rho) { const int n = rho >> 4, i = rho & 15; return 8 * (i >> 2) + 4 * n + (i & 3); }
struct Unit { int pm, pn; };
struct Gemm { const bf16_t* A; const bf16_t* Bt; int M, N, K, lda; };
struct StaticOrder {
    int nM, nN, nwg, G, c;
    __device__ void init(int M, int N, int G_, int c_) { nM = M / BM; nN = N / BM; nwg = nM * nN; G = G_; c = c_; }
    __device__ bool next(int i, Unit& u) const {
        const long L = (long)i * G + c; if (L >= nwg) return false;
        int wgid = (int)L; { const int q = nwg / NXCD, r = nwg % NXCD, xcd = wgid % NXCD, off = wgid / NXCD; wgid = (xcd < r ? xcd * (q + 1) : r * (q + 1) + (xcd - r) * q) + off; }
        const int nig = WGM * nN, gid = wgid / nig, fm = gid * WGM, gsz = (nM - fm) < WGM ? (nM - fm) : WGM;
        u.pm = fm + ((wgid % nig) % gsz); u.pn = (wgid % nig) / gsz; return true;
    }
    __device__ __forceinline__ void a_ready(const Unit&) const {}
    __device__ __forceinline__ void done(const Unit&) const {}
};
struct EpiStore {
    static constexpr bool PERM = true, AFTER_DRAIN = false;
    bf16_t* O; int ldc; bf16_t* halo;
    __device__ __forceinline__ void operator()(const f32x4 (&acc)[2][2][4][2], const Unit& u, int wr, int wc, int fr, int fq) const {
        const int row0 = u.pm * BM + wr * 64 + fr, col0 = u.pn * BM + wc * 32 + 8 * fq;
        const bool hz = halo != nullptr && col0 >= C_BQKV && col0 < C_BQKV + 1536;
#pragma unroll
        for (int ai = 0; ai < 2; ++ai)
#pragma unroll
            for (int m = 0; m < 4; ++m) { const int row = row0 + ai * HALF + m * 16; bf16_t* rowp = O + (size_t)row * ldc + col0;
#pragma unroll
                for (int bj = 0; bj < 2; ++bj) { const f32x4 v0 = acc[ai][bj][m][0], v1 = acc[ai][bj][m][1];
                    u32x4 w; w.x = cvtpk(v0[0], v0[1]); w.y = cvtpk(v0[2], v0[3]); w.z = cvtpk(v1[0], v1[1]); w.w = cvtpk(v1[2], v1[3]);
                    *(u32x4*)(rowp + bj * HALF) = w;
                    if (m == 3 && hz && fr >= 13) *(u32x4*)(halo + ((size_t)(row >> 6) * 3 + (fr - 13)) * 1536 + (col0 + bj * HALF - C_BQKV)) = w; } }
    }
};
struct EpiGate {
    static constexpr bool PERM = true, AFTER_DRAIN = false;
    bf16_t* G; int ldc;
    __device__ __forceinline__ void operator()(const f32x4 (&acc)[2][2][4][2], const Unit& u, int wr, int wc, int fr, int fq) const {
        const int row0 = u.pm * BM + wr * 64 + fr, col0 = u.pn * BM + wc * 32 + 8 * fq;
#pragma unroll
        for (int ai = 0; ai < 2; ++ai)
#pragma unroll
            for (int m = 0; m < 4; ++m) { bf16_t* rowp = G + (size_t)(row0 + ai * HALF + m * 16) * ldc + col0;
#pragma unroll
                for (int bj = 0; bj < 2; ++bj) { const f32x4 v0 = acc[ai][bj][m][0], v1 = acc[ai][bj][m][1];
                    const u32x4 z = *(const u32x4*)(rowp + bj * HALF);
                    u32x4 w; w.x = cvtpk(v0[0] * silu_f(lo_bf(z.x)), v0[1] * silu_f(hi_bf(z.x))); w.y = cvtpk(v0[2] * silu_f(lo_bf(z.y)), v0[3] * silu_f(hi_bf(z.y)));
                    w.z = cvtpk(v1[0] * silu_f(lo_bf(z.z)), v1[1] * silu_f(hi_bf(z.z))); w.w = cvtpk(v1[2] * silu_f(lo_bf(z.w)), v1[3] * silu_f(hi_bf(z.w)));
                    *(u32x4*)(rowp + bj * HALF) = w; } }
    }
};
template <class Epi, class Sched, bool ALIGN_EPI = false, bool SP2 = false>
__device__ __forceinline__ void gemm_phase(PG8_LAS unsigned char* lds, const Gemm g, const Sched& S, const Epi& E) {
    const int tid = threadIdx.x, wid = __builtin_amdgcn_readfirstlane(tid >> 6), lane = tid & 63, wr = wid >> 2, wc = wid & 3, fr = lane & 15, fq = lane >> 4;
    const int K = g.K, nt = K / BK;
    unsigned voffA[2], voffB[2];
#pragma unroll
    for (int i = 0; i < 2; ++i) { int R, C; stage_rc(tid * 16 + i * 8192, R, C); const int Rb = Epi::PERM ? ((R & ~31) + perm32(R & 31)) : R;
        voffA[i] = (unsigned)(R * g.lda + C) * 2u; voffB[i] = (unsigned)(Rb * K + C) * 2u; }
    const size_t kstep = (size_t)(BK * 2);
    const size_t hstepA = (size_t)HALF * g.lda * 2, hstepB = (size_t)HALF * K * 2;
    const size_t tstepA = 2 * hstepA, tstepB = 2 * hstepB;
    const unsigned ldsw = (unsigned)wid * 1024u;
    const int aoff = lds_byte(wr * 64 + fr, fq * 8), boff = lds_byte(wc * 32 + fr, fq * 8);
#define PG8_SA(b, h) (((b) * 2 + (h)) * HTB)
#define PG8_SB(b, h) ((4 + (b) * 2 + (h)) * HTB)
#define PG8_STAGE(bufoff, gbase, voff) do { _Pragma("unroll") for (int _i = 0; _i < 2; ++_i) \
        __builtin_amdgcn_global_load_lds((const unsigned*)((const char*)(gbase) + (voff)[_i]), (PG8_LAS unsigned*)(lds + (bufoff) + ldsw + _i * 8192), 16, 0, 0); } while (0)
#define PG8_LDA(dst, b, h) do { _Pragma("unroll") for (int m = 0; m < 4; ++m) _Pragma("unroll") for (int k = 0; k < 2; ++k) dst[m][k] = *(const PG8_LAS bf16x8*)(lds + PG8_SA(b, h) + aoff + m * 2048 + k * 1024); } while (0)
#define PG8_LDB(dst, b, h) do { _Pragma("unroll") for (int n = 0; n < 2; ++n) _Pragma("unroll") for (int k = 0; k < 2; ++k) dst[n][k] = *(const PG8_LAS bf16x8*)(lds + PG8_SB(b, h) + boff + n * 2048 + k * 1024); } while (0)
#define PG8_MMA(ai, bj, At, Bt) do { __builtin_amdgcn_s_setprio(1); _Pragma("unroll") for (int m = 0; m < 4; ++m) _Pragma("unroll") for (int n = 0; n < 2; ++n) _Pragma("unroll") for (int k = 0; k < 2; ++k) \
        acc[ai][bj][m][n] = __builtin_amdgcn_mfma_f32_16x16x32_bf16(Bt[n][k], At[m][k], acc[ai][bj][m][n], 0, 0, 0); __builtin_amdgcn_s_setprio(0); } while (0)
#define PG8_WAIT_V(n) asm volatile("s_waitcnt vmcnt(" #n ")" ::: "memory")
#define PG8_WAIT_L(n) asm volatile("s_waitcnt lgkmcnt(" #n ")" ::: "memory")
#define PG8_BAR __builtin_amdgcn_s_barrier()
#define PG8_SCHED __builtin_amdgcn_sched_barrier(0)
    Unit cur, nxt; int ui = 0;
    if (!S.next(0, cur)) return;
    f32x4 acc[2][2][4][2];
#pragma unroll
    for (int a = 0; a < 2; ++a)
#pragma unroll
        for (int b = 0; b < 2; ++b)
#pragma unroll
            for (int m = 0; m < 4; ++m)
#pragma unroll
                for (int n = 0; n < 2; ++n) acc[a][b][m][n] = (f32x4){0.f, 0.f, 0.f, 0.f};
    bf16x8 At[4][2], B0[2][2], B1[2][2];
    const char* cA = (const char*)g.A + (size_t)cur.pm * tstepA; const char* cB = (const char*)g.Bt + (size_t)cur.pn * tstepB;
    S.a_ready(cur);
    if constexpr (SP2) {
        PG8_STAGE(PG8_SB(0, 0), cB, voffB); PG8_STAGE(PG8_SB(0, 1), cB + hstepB, voffB); PG8_STAGE(PG8_SA(0, 0), cA, voffA); PG8_STAGE(PG8_SA(0, 1), cA + hstepA, voffA);
        if (wr == 1) PG8_BAR;
        PG8_WAIT_V(2); PG8_BAR;
        PG8_STAGE(PG8_SB(1, 0), cB + kstep, voffB); PG8_STAGE(PG8_SA(1, 0), cA + kstep, voffA); PG8_STAGE(PG8_SB(1, 1), cB + hstepB + kstep, voffB);
        PG8_WAIT_V(6); PG8_BAR;
    } else {
        PG8_STAGE(PG8_SB(0, 0), cB, voffB); PG8_STAGE(PG8_SA(0, 0), cA, voffA); PG8_STAGE(PG8_SB(0, 1), cB + hstepB, voffB); PG8_STAGE(PG8_SA(0, 1), cA + hstepA, voffA);
        if (wr == 1) PG8_BAR;
        PG8_WAIT_V(4); PG8_BAR;
        PG8_STAGE(PG8_SB(1, 0), cB + kstep, voffB); PG8_STAGE(PG8_SA(1, 0), cA + kstep, voffA); PG8_STAGE(PG8_SB(1, 1), cB + hstepB + kstep, voffB);
        PG8_WAIT_V(6); PG8_BAR;
    }
    for (;;) {
        const bool has_next = S.next(ui + 1, nxt);
        const char* nA = has_next ? (const char*)g.A + (size_t)nxt.pm * tstepA : cA; const char* nB = has_next ? (const char*)g.Bt + (size_t)nxt.pn * tstepB : cB;
        for (int t = 0; t < nt; t += 2) {
            const bool last = (t == nt - 2);
            const char* a1 = cA + (size_t)(t + 1) * kstep;
            const char* a2 = last ? nA : cA + (size_t)(t + 2) * kstep; const char* b2 = last ? nB : cB + (size_t)(t + 2) * kstep;
            const char* a3 = a2 + kstep; const char* b3 = b2 + kstep;
            if (last && has_next) S.a_ready(nxt);
            if constexpr (SP2) {
            PG8_LDB(B0, 0, 0); PG8_LDB(B1, 0, 1); PG8_SCHED; PG8_LDA(At, 0, 0); PG8_STAGE(PG8_SA(1, 1), a1 + hstepA, voffA);
            PG8_WAIT_V(8); PG8_WAIT_L(0); PG8_BAR; PG8_MMA(0, 0, At, B0); PG8_MMA(0, 1, At, B1); PG8_BAR; PG8_SCHED;
            PG8_LDA(At, 0, 1); PG8_STAGE(PG8_SB(0, 0), b2, voffB); PG8_STAGE(PG8_SB(0, 1), b2 + hstepB, voffB); PG8_STAGE(PG8_SA(0, 0), a2, voffA);
            PG8_WAIT_V(8); PG8_WAIT_L(0); PG8_BAR; PG8_MMA(1, 0, At, B0); PG8_MMA(1, 1, At, B1); PG8_BAR; PG8_SCHED;
            PG8_LDB(B0, 1, 0); PG8_LDB(B1, 1, 1); PG8_SCHED; PG8_LDA(At, 1, 0); PG8_STAGE(PG8_SA(0, 1), a2 + hstepA, voffA);
            PG8_WAIT_V(8); PG8_WAIT_L(0); PG8_BAR; PG8_MMA(0, 0, At, B0); PG8_MMA(0, 1, At, B1); PG8_BAR; PG8_SCHED;
            PG8_LDA(At, 1, 1); PG8_STAGE(PG8_SB(1, 0), b3, voffB); PG8_STAGE(PG8_SB(1, 1), b3 + hstepB, voffB); PG8_STAGE(PG8_SA(1, 0), a3, voffA);
            PG8_WAIT_V(8); PG8_WAIT_L(0); PG8_BAR; PG8_MMA(1, 0, At, B0); PG8_MMA(1, 1, At, B1); PG8_BAR; PG8_SCHED;
            } else {
            PG8_LDB(B0, 0, 0); PG8_SCHED; PG8_LDA(At, 0, 0); PG8_STAGE(PG8_SA(1, 1), a1 + hstepA, voffA);
            PG8_WAIT_L(8); PG8_BAR; PG8_WAIT_L(0); PG8_MMA(0, 0, At, B0); PG8_BAR; PG8_SCHED;
            PG8_LDB(B1, 0, 1); PG8_STAGE(PG8_SB(0, 0), b2, voffB);
            PG8_BAR; PG8_WAIT_L(0); PG8_MMA(0, 1, At, B1); PG8_BAR;
            PG8_LDA(At, 0, 1); PG8_STAGE(PG8_SA(0, 0), a2, voffA);
            PG8_BAR; PG8_WAIT_L(0); PG8_MMA(1, 0, At, B0); PG8_BAR; PG8_SCHED;
            PG8_STAGE(PG8_SB(0, 1), b2 + hstepB, voffB);
            PG8_WAIT_V(6); PG8_BAR; PG8_MMA(1, 1, At, B1); PG8_BAR;
            PG8_LDB(B0, 1, 0); PG8_SCHED; PG8_LDA(At, 1, 0); PG8_STAGE(PG8_SA(0, 1), a2 + hstepA, voffA);
            PG8_WAIT_L(8); PG8_BAR; PG8_WAIT_L(0); PG8_MMA(0, 0, At, B0); PG8_BAR; PG8_SCHED;
            PG8_LDB(B1, 1, 1); PG8_STAGE(PG8_SB(1, 0), b3, voffB);
            PG8_BAR; PG8_WAIT_L(0); PG8_MMA(0, 1, At, B1); PG8_BAR;
            PG8_LDA(At, 1, 1); PG8_STAGE(PG8_SA(1, 0), a3, voffA);
            PG8_BAR; PG8_WAIT_L(0); PG8_MMA(1, 0, At, B0); PG8_BAR; PG8_SCHED;
            PG8_STAGE(PG8_SB(1, 1), b3 + hstepB, voffB);
            PG8_WAIT_V(6); PG8_BAR; PG8_MMA(1, 1, At, B1); PG8_BAR;
            }
        }
        if constexpr (ALIGN_EPI) { if (wr == 0) PG8_BAR; }
        if constexpr (!Epi::AFTER_DRAIN) { E(acc, cur, wr, wc, fr, fq); S.done(cur); }
        if (!has_next) break;
#pragma unroll
        for (int a = 0; a < 2; ++a)
#pragma unroll
            for (int b = 0; b < 2; ++b)
#pragma unroll
                for (int m = 0; m < 4; ++m)
#pragma unroll
                    for (int n = 0; n < 2; ++n) acc[a][b][m][n] = (f32x4){0.f, 0.f, 0.f, 0.f};
        cur = nxt; cA = nA; cB = nB; ++ui;
        if constexpr (ALIGN_EPI) { if (wr == 1) PG8_BAR; }
    }
    PG8_WAIT_V(0);
    if constexpr (!ALIGN_EPI) { if (wr == 0) PG8_BAR; }
    PG8_BAR;
    if constexpr (Epi::AFTER_DRAIN) { E.fused(acc, cur, wr, wc, fr, fq, lds, wid, lane); S.done(cur); }
#undef PG8_SA
#undef PG8_SB
#undef PG8_STAGE
#undef PG8_LDA
#undef PG8_LDB
#undef PG8_MMA
#undef PG8_WAIT_V
#undef PG8_WAIT_L
#undef PG8_BAR
#undef PG8_SCHED
}
}
namespace att {
constexpr int KVBLK = 64;
constexpr int L_K = 0, L_V = 24576, L_WS = 40960, L_POSK = 43008, L_BTAB = 43264, L_END = 47392;
template <int DV> __device__ __forceinline__ int v_st(int k, int c) { const int kk = (k & ~0xC) | ((k & 4) << 1) | ((k & 8) >> 1); return ((kk >> 3) * (DV / 32) + (c >> 5)) * 512 + ((kk & 7) * 32 + (c & 31)) * 2; }
__device__ __forceinline__ int v_rd_base(int lane) { return ((lane & 3) << 3) | (((lane >> 2) & 3) << 6) | (((lane >> 4) & 1) << 5) | (((lane >> 5) & 1) << 8); }
__device__ __forceinline__ int koff(int row, int colB, int RB) { return row * RB + (colB ^ ((row & 7) << 4)); }

template <int DQK, int DV, int MODE>
__device__ __forceinline__ void attn_core(LAS unsigned char* lds, const bf16_t* qrow, const bf16_t* Kg, int ldk, const bf16_t* Vg, int ldv, int t_lo, int t_hi, float c2,
                                          int qidx, int qlo_wave, int head, const int* pos, const float* rsq, const float* cosT, const float* sinT,
                                          float& m_reg, float& l_reg, f32x16 (&o)[DV / 32]) {
    constexpr int ND = DQK / 16, NV = DV / 32, RB = DQK * 2;
    const int tid = threadIdx.x, lane = tid & 63, r32 = lane & 31, hi = lane >> 5, wid = __builtin_amdgcn_readfirstlane(tid >> 6);
    bf16x8 qr[ND];
#pragma unroll
    for (int d0 = 0; d0 < ND; ++d0) qr[d0] = *(const bf16x8*)(qrow + d0 * 16 + hi * 8);
    if (MODE == 0) {
        const float sc = rsq[qidx] * c2;
#pragma unroll
        for (int d0 = 0; d0 < ND; ++d0) { const u32x4 w = __builtin_bit_cast(u32x4, qr[d0]);
            float v[8] = {lo_bf(w.x) * sc, hi_bf(w.x) * sc, lo_bf(w.y) * sc, hi_bf(w.y) * sc, lo_bf(w.z) * sc, hi_bf(w.z) * sc, lo_bf(w.w) * sc, hi_bf(w.w) * sc};
            if (d0 >= 8) { const int i0 = (d0 - 8) * 8 + hi * 4; const f32x4 c = *(const f32x4*)(cosT + (size_t)qidx * 32 + i0), s = *(const f32x4*)(sinT + (size_t)qidx * 32 + i0);
#pragma unroll
                for (int jj = 0; jj < 4; ++jj) { const float t1 = v[2 * jj], t2 = v[2 * jj + 1]; v[2 * jj] = t1 * c[jj] - t2 * s[jj]; v[2 * jj + 1] = t1 * s[jj] + t2 * c[jj]; } }
            qr[d0] = pack8(v); }
    }
    LAS unsigned char* K_lds = lds + L_K; LAS unsigned char* V_lds = lds + L_V;
    LAS float* al_l = (LAS float*)(lds + L_WS) + wid * 64;
    LAS int* posk = (LAS int*)(lds + L_POSK); LAS float* btab = (LAS float*)(lds + L_BTAB);
    const unsigned vb0 = (unsigned)(uintptr_t)V_lds + (unsigned)v_rd_base(lane);
    int posq = 0; if (MODE == 1) posq = pos[qidx];
    for (int t = t_lo; t < t_hi; ++t) {
        const int kbase = t * KVBLK;
        __syncthreads();
        for (int c = tid; c < 64 * (DQK / 8); c += NT_THREADS) { const int row = c / (DQK / 8), ch = c % (DQK / 8);
            *(LAS bf16x8*)(K_lds + koff(row, ch * 16, RB)) = *(const bf16x8*)(Kg + (size_t)(kbase + row) * ldk + ch * 8); }
        for (int c = tid; c < 64 * (DV / 8); c += NT_THREADS) { const int row = c / (DV / 8), ch = c % (DV / 8);
            *(LAS bf16x8*)(V_lds + v_st<DV>(row, ch * 8)) = *(const bf16x8*)(Vg + (size_t)(kbase + row) * ldv + ch * 8); }
        if (MODE == 1) { if (tid < 64) posk[tid] = pos[kbase + tid]; }
        __syncthreads();
        f32x16 p0 = {}, p1 = {};
#pragma unroll
        for (int d0 = 0; d0 < ND; ++d0) {
            const bf16x8 a0 = *(const LAS bf16x8*)(K_lds + koff(r32, (d0 * 16 + hi * 8) * 2, RB));
            const bf16x8 a1 = *(const LAS bf16x8*)(K_lds + koff(32 + r32, (d0 * 16 + hi * 8) * 2, RB));
            p0 = MFMA32(a0, qr[d0], p0); p1 = MFMA32(a1, qr[d0], p1);
        }
        if (MODE == 0) {
            if (kbase + 63 > qlo_wave) {
#pragma unroll
                for (int r = 0; r < 16; ++r) { const int kk = kbase + crow(r, hi); if (kk > qidx) p0[r] = -__builtin_inff(); if (kk + 32 > qidx) p1[r] = -__builtin_inff(); }
            }
        } else if (MODE == 1) {
#pragma unroll
            for (int r = 0; r < 16; ++r) { const int kl = crow(r, hi);
                { const int kk = kbase + kl; int dist = posq - posk[kl]; dist = dist < 0 ? 0 : (dist > 128 ? 128 : dist);
                  const float b = btab[dist * 8 + head]; p0[r] = ((unsigned)(qidx - kk) < 128u) ? fmaf(p0[r], c2, b) : -__builtin_inff(); }
                { const int kk = kbase + kl + 32; int dist = posq - posk[kl + 32]; dist = dist < 0 ? 0 : (dist > 128 ? 128 : dist);
                  const float b = btab[dist * 8 + head]; p1[r] = ((unsigned)(qidx - kk) < 128u) ? fmaf(p1[r], c2, b) : -__builtin_inff(); } }
        } else {
#pragma unroll
            for (int r = 0; r < 16; ++r) { p0[r] *= c2; p1[r] *= c2; }
        }
        float pmax = p0[0];
#pragma unroll
        for (int r = 1; r < 16; ++r) pmax = fmaxf(pmax, p0[r]);
#pragma unroll
        for (int r = 0; r < 16; ++r) pmax = fmaxf(pmax, p1[r]);
        { auto rr = __builtin_amdgcn_permlane32_swap(__float_as_uint(pmax), __float_as_uint(pmax), false, false); pmax = fmaxf(__uint_as_float(rr[0]), __uint_as_float(rr[1])); }
        const float mn = fmaxf(m_reg, pmax); const float alpha = __builtin_amdgcn_exp2f(m_reg - mn); m_reg = mn;
        float ps = 0.f;
#pragma unroll
        for (int r = 0; r < 16; ++r) { p0[r] = __builtin_amdgcn_exp2f(p0[r] - mn); ps += p0[r]; }
#pragma unroll
        for (int r = 0; r < 16; ++r) { p1[r] = __builtin_amdgcn_exp2f(p1[r] - mn); ps += p1[r]; }
        { auto rr = __builtin_amdgcn_permlane32_swap(__float_as_uint(ps), __float_as_uint(ps), false, false); ps = __uint_as_float(rr[0]) + __uint_as_float(rr[1]); }
        l_reg = l_reg * alpha + ps;
        if (__any(alpha < 1.f)) {
            if (hi == 0) al_l[r32] = alpha;
            LDS_WAIT();
#pragma unroll
            for (int g = 0; g < 4; ++g) { const f32x4 a4 = *(const LAS f32x4*)(al_l + 8 * g + 4 * hi);
#pragma unroll
                for (int d = 0; d < NV; ++d) { o[d][4 * g + 0] *= a4[0]; o[d][4 * g + 1] *= a4[1]; o[d][4 * g + 2] *= a4[2]; o[d][4 * g + 3] *= a4[3]; } }
        }
        bf16x8 pa0, pa1, pa2, pa3;
#define PK4(P, B_, OUT) do { const unsigned a0_ = cvtpk(P[B_ + 0], P[B_ + 1]), a1_ = cvtpk(P[B_ + 2], P[B_ + 3]), b0_ = cvtpk(P[B_ + 4], P[B_ + 5]), b1_ = cvtpk(P[B_ + 6], P[B_ + 7]); \
        auto r0_ = __builtin_amdgcn_permlane32_swap(a0_, b0_, false, false); auto r1_ = __builtin_amdgcn_permlane32_swap(a1_, b1_, false, false); \
        u32x4 w_ = {r0_[0], r1_[0], r0_[1], r1_[1]}; OUT = __builtin_bit_cast(bf16x8, w_); } while (0)
        PK4(p0, 0, pa0); PK4(p0, 8, pa1); PK4(p1, 0, pa2); PK4(p1, 8, pa3);
#undef PK4
#define TRRD(dst, off) asm volatile("ds_read_b64_tr_b16 %0, %1 offset:%2" : "=&v"(dst) : "v"(vb0), "i"(off) : "memory")
#pragma unroll
        for (int d0 = 0; d0 < NV; ++d0) {
            s16x4 l0, l1, l2, l3, h0, h1, h2, h3; constexpr int KS = NV * 1024, HF = NV * 512; const int b_ = d0 * 512;
            if (d0 == 0) { TRRD(l0, 0); TRRD(h0, HF); TRRD(l1, KS); TRRD(h1, KS + HF); TRRD(l2, 2 * KS); TRRD(h2, 2 * KS + HF); TRRD(l3, 3 * KS); TRRD(h3, 3 * KS + HF); }
            else if (d0 == 1) { TRRD(l0, 512); TRRD(h0, 512 + HF); TRRD(l1, 512 + KS); TRRD(h1, 512 + KS + HF); TRRD(l2, 512 + 2 * KS); TRRD(h2, 512 + 2 * KS + HF); TRRD(l3, 512 + 3 * KS); TRRD(h3, 512 + 3 * KS + HF); }
            else if (d0 == 2) { TRRD(l0, 1024); TRRD(h0, 1024 + HF); TRRD(l1, 1024 + KS); TRRD(h1, 1024 + KS + HF); TRRD(l2, 1024 + 2 * KS); TRRD(h2, 1024 + 2 * KS + HF); TRRD(l3, 1024 + 3 * KS); TRRD(h3, 1024 + 3 * KS + HF); }
            else { TRRD(l0, 1536); TRRD(h0, 1536 + HF); TRRD(l1, 1536 + KS); TRRD(h1, 1536 + KS + HF); TRRD(l2, 1536 + 2 * KS); TRRD(h2, 1536 + 2 * KS + HF); TRRD(l3, 1536 + 3 * KS); TRRD(h3, 1536 + 3 * KS + HF); }
            (void)b_;
            asm volatile("s_waitcnt lgkmcnt(0)" ::: "memory"); SBAR();
            o[d0] = MFMA32(pa0, ((bf16x8){l0[0], l0[1], l0[2], l0[3], h0[0], h0[1], h0[2], h0[3]}), o[d0]);
            o[d0] = MFMA32(pa1, ((bf16x8){l1[0], l1[1], l1[2], l1[3], h1[0], h1[1], h1[2], h1[3]}), o[d0]);
            o[d0] = MFMA32(pa2, ((bf16x8){l2[0], l2[1], l2[2], l2[3], h2[0], h2[1], h2[2], h2[3]}), o[d0]);
            o[d0] = MFMA32(pa3, ((bf16x8){l3[0], l3[1], l3[2], l3[3], h3[0], h3[1], h3[2], h3[3]}), o[d0]);
        }
#undef TRRD
    }
}
__device__ __forceinline__ void row_recip(LAS float* li_l, float l_reg, int r32, int hi, float (&rli)[16]) {
    asm volatile("s_waitcnt lgkmcnt(0)" ::: "memory");
    if (hi == 0) li_l[r32] = l_reg;
    asm volatile("s_waitcnt lgkmcnt(0)" ::: "memory");
#pragma unroll
    for (int g = 0; g < 4; ++g) { const f32x4 a4 = *(const LAS f32x4*)(li_l + 8 * g + 4 * hi); rli[4 * g] = 1.f / a4[0]; rli[4 * g + 1] = 1.f / a4[1]; rli[4 * g + 2] = 1.f / a4[2]; rli[4 * g + 3] = 1.f / a4[3]; }
}

__device__ __forceinline__ void mla_unit(LAS unsigned char* lds, int qb, int h, const bf16_t* QABS, const bf16_t* KVLAT, bf16_t* PROJ, const float* rsq, const float* cosT, const float* sinT, float qscale) {
    const int tid = threadIdx.x, lane = tid & 63, r32 = lane & 31, hi = lane >> 5, wid = __builtin_amdgcn_readfirstlane(tid >> 6);
    const int q0 = qb * 256 + wid * 32;
    float m = -1e30f, l = 0.f; f32x16 o[4] = {};
    attn_core<192, 128, 0>(lds, QABS + (size_t)(q0 + r32) * 768 + h * 192, KVLAT, 192, KVLAT, 192, 0, 4 * (qb + 1), qscale, q0 + r32, q0, 0, nullptr, rsq, cosT, sinT, m, l, o);
    LAS float* li_l = (LAS float*)(lds + L_WS) + wid * 64; float rli[16]; row_recip(li_l, l, r32, hi, rli);
#pragma unroll
    for (int r = 0; r < 16; ++r) { bf16_t* op = PROJ + (size_t)(q0 + crow(r, hi)) * NP + C_OLAT + h * 128 + r32;
#pragma unroll
        for (int d0 = 0; d0 < 4; ++d0) op[d0 * 32] = f2bf(o[d0][r] * rli[r]); }
}
__device__ __forceinline__ void swa_unit(LAS unsigned char* lds, int qb, int hk, bf16_t* PROJ, const int* pos, const float* sinks  , const float* btab_g) {
    const int tid = threadIdx.x, lane = tid & 63, r32 = lane & 31, hi = lane >> 5, wid = __builtin_amdgcn_readfirstlane(tid >> 6);
    const int head = hk * 4 + (wid >> 1), q0 = qb * 64 + (wid & 1) * 32;
    __syncthreads();
    for (int i = tid; i < 129 * 8; i += NT_THREADS) ((LAS float*)(lds + L_BTAB))[i] = btab_g[i];
    const float sink = sinks[head] * LOG2E;
    float m = sink, l = 1.f; f32x16 o[2] = {};
    int t_lo = (qb * 64 - 128) / 64; if (t_lo < 0) t_lo = 0;
    attn_core<64, 64, 1>(lds, PROJ + (size_t)(q0 + r32) * NP + C_AQ + head * 64, PROJ + C_AK + hk * 64, NP, PROJ + C_AV + hk * 64, NP, t_lo, qb + 1, 0.125f * LOG2E,
                         q0 + r32, q0, head, pos, nullptr, nullptr, nullptr, m, l, o);
    LAS float* li_l = (LAS float*)(lds + L_WS) + wid * 64; float rli[16]; row_recip(li_l, l, r32, hi, rli);
#pragma unroll
    for (int r = 0; r < 16; ++r) { bf16_t* op = PROJ + (size_t)(q0 + crow(r, hi)) * NP + C_Z + head * 64 + r32;
#pragma unroll
        for (int d0 = 0; d0 < 2; ++d0) { const float z = bf2f(op[d0 * 32]); op[d0 * 32] = f2bf(o[d0][r] * rli[r] * silu_f(z)); } }
}
__device__ __forceinline__ void cross_unit(LAS unsigned char* lds, int qb, int h, bf16_t* PROJ, const bf16_t* MEMKV  ) {
    const int tid = threadIdx.x, lane = tid & 63, r32 = lane & 31, hi = lane >> 5, wid = __builtin_amdgcn_readfirstlane(tid >> 6);
    const int q0 = qb * 256 + wid * 32;
    float m = -1e30f, l = 0.f; f32x16 o[4] = {};
    attn_core<128, 128, 2>(lds, PROJ + (size_t)(q0 + r32) * NP + C_DQ + h * 128, MEMKV + h * 128, 1024, MEMKV + 512 + h * 128, 1024, 0, 4, 0.08838834764831845f * LOG2E,
                           q0 + r32, q0, 0, nullptr, nullptr, nullptr, nullptr, m, l, o);
    LAS float* li_l = (LAS float*)(lds + L_WS) + wid * 64; float rli[16]; row_recip(li_l, l, r32, hi, rli);
#pragma unroll
    for (int r = 0; r < 16; ++r) { bf16_t* op = PROJ + (size_t)(q0 + crow(r, hi)) * NP + C_Z + 1536 + h * 128 + r32;
#pragma unroll
        for (int d0 = 0; d0 < 4; ++d0) { const float z = bf2f(op[d0 * 32]); op[d0 * 32] = f2bf(o[d0][r] * rli[r] * silu_f(z)); } }
}
}
template <class Map>
__device__ __forceinline__ void transpose_tile(const float* W, int ldw, bf16_t* WT, int K, int n0, int k0, LAS float* tile, Map map) {
    const int tid = threadIdx.x;
    { const int n = tid & 63, src = map(n0 + n);
#pragma unroll
      for (int i = 0; i < 8; ++i) { const int k = (tid >> 6) + 8 * i; tile[k * 65 + n] = src >= 0 ? W[(size_t)(k0 + k) * ldw + src] : 0.f; } }
    __syncthreads();
    { const int n = tid >> 3, kc = (tid & 7) * 8; float v[8];
#pragma unroll
      for (int j = 0; j < 8; ++j) v[j] = tile[(kc + j) * 65 + n];
      u32x4 w = {cvtpk(v[0], v[1]), cvtpk(v[2], v[3]), cvtpk(v[4], v[5]), cvtpk(v[6], v[7])};
      *(u32x4*)(WT + (size_t)(n0 + n) * K + k0 + kc) = w; }
    __syncthreads();
}
struct MapWin { __device__ int operator()(int n) const { return win_src(n); } };
struct MapId { __device__ int operator()(int n) const { return n; } };

__device__ __forceinline__ void job_win(const Params& p, int l, int vb, int nb, LAS unsigned char* lds) {
    bf16_t* WT = (bf16_t*)(p.ws + WS_WIN); const float* W = p.w_in + (size_t)l * DM * DIN;
    for (int t = vb; t < (NP / 64) * (DM / 64); t += nb) transpose_tile(W, DIN, WT, DM, (t / (DM / 64)) * 64, (t % (DM / 64)) * 64, (LAS float*)lds, MapWin());
}
__device__ __forceinline__ void job_wout(const Params& p, int l, int vb, int nb, LAS unsigned char* lds) {
    bf16_t* WT = (bf16_t*)(p.ws + WS_WOUT); const float* W = p.w_out + (size_t)l * MIXW * DM;
    for (int t = vb; t < (DM / 64) * (MIXW / 64); t += nb) transpose_tile(W, DM, WT, MIXW, (t / (MIXW / 64)) * 64, (t % (MIXW / 64)) * 64, (LAS float*)lds, MapId());
}
__device__ __forceinline__ void job_wmem(const Params& p, int vb, int nb, LAS unsigned char* lds) {
    for (int t = vb; t < 2 * 16 * 16; t += nb) { const int l = t >> 8, r = t & 255;
        transpose_tile(p.w_mem + (size_t)l * DM * DM, DM, (bf16_t*)(p.ws + WS_WMEM) + (size_t)l * DM * DM, DM, (r >> 4) * 64, (r & 15) * 64, (LAS float*)lds, MapId()); }
}
__device__ __forceinline__ void job_wq(const Params& p, int gtid, int gn) {
    for (int idx = gtid; idx < 2 * 768 * 256; idx += gn) {
        const int l = idx / (768 * 256), r = idx % (768 * 256), n = r / 256, k = r % 256;
        const float* uq = p.w_uq + (size_t)l * 256 * 768 + (size_t)k * 768; const float* ukv = p.w_ukv + (size_t)l * 128 * 1024;
        float v;
        const int h = n / 192, c = n % 192;
        if (c < 128) { float s = 0.f;
            for (int j = 0; j < 128; ++j) s = fmaf(uq[h * 192 + j], ukv[(size_t)c * 1024 + h * 256 + j], s);
            v = s;
        } else { const int w = c - 128, i = w >> 1, which = w & 1; v = uq[h * 192 + 128 + i + 32 * which]; }
        ((bf16_t*)(p.ws + WS_WQ))[idx] = f2bf(v * p.q_norm[l * 256 + k]);
    }
}
__device__ __forceinline__ void job_wuv(const Params& p, int gtid, int gn) {
    for (int idx = gtid; idx < 2 * 512 * 512; idx += gn) {
        const int l = idx / (512 * 512), r = idx % (512 * 512), n = r / 512, k = r % 512, h = n >> 7;
        const float v = (k >> 7) == h ? p.w_ukv[(size_t)l * 128 * 1024 + (size_t)(k & 127) * 1024 + h * 256 + 128 + (n & 127)] : 0.f;
        ((bf16_t*)(p.ws + WS_WUV))[idx] = f2bf(v);
    }
}
__device__ __forceinline__ void job_rope(const Params& p, int gtid, int gn) {
    float* cosT = (float*)(p.ws + WS_COS); float* sinT = (float*)(p.ws + WS_SIN);
    for (int idx = gtid; idx < S * 32; idx += gn) {
        const int s = idx >> 5, i = idx & 31;
        const float angf = (float)p.pos[s] * inv_freq(i);
        const double a = (double)angf; const double kq = __builtin_rint(a * 0.63661977236758134308);
        const double x = (a - kq * 1.5707963267948966192) - kq * 6.123233995736766036e-17;
        const double x2 = x * x;
        const double sn = x * (1.0 + x2 * (-1.0 / 6 + x2 * (1.0 / 120 + x2 * (-1.0 / 5040 + x2 * (1.0 / 362880 + x2 * (-1.0 / 39916800 + x2 * (1.0 / 6227020800.0)))))));
        const double cs = 1.0 + x2 * (-0.5 + x2 * (1.0 / 24 + x2 * (-1.0 / 720 + x2 * (1.0 / 40320 + x2 * (-1.0 / 3628800 + x2 * (1.0 / 479001600.0 + x2 * (-1.0 / 87178291200.0)))))));
        const int q = ((int)kq) & 3;
        const double c = (q == 0) ? cs : (q == 1) ? -sn : (q == 2) ? -cs : sn;
        const double sv = (q == 0) ? sn : (q == 1) ? cs : (q == 2) ? -sn : -cs;
        cosT[idx] = (float)c; sinT[idx] = (float)sv;
    }
}
__device__ __forceinline__ void job_btab(const Params& p, int gtid, int gn) {
    float* bt = (float*)(p.ws + WS_MISC + MISC_BTAB);
    for (int idx = gtid; idx < 129 * 8; idx += gn) { const int d = idx >> 3, h = idx & 7; bt[idx] = p.rel_bias[t5_bucket(d) * 8 + h] * LOG2E; }
}
__device__ __forceinline__ void rms_row_to_bf16(const float* xrow, const float* gain, bf16_t* orow, int lane) {
    f32x4 v[4]; float ss = 0.f;
#pragma unroll
    for (int j = 0; j < 4; ++j) { v[j] = *(const f32x4*)(xrow + 256 * j + 4 * lane); ss += (v[j].x * v[j].x + v[j].y * v[j].y) + (v[j].z * v[j].z + v[j].w * v[j].w); }
    const float rs = rsqrtf(wave_sum(ss) * (1.f / DM) + RMS_EPS);
#pragma unroll
    for (int j = 0; j < 4; ++j) { const f32x4 g = *(const f32x4*)(gain + 256 * j + 4 * lane);
        u32x2 w; w.x = cvtpk(v[j].x * rs * g.x, v[j].y * rs * g.y); w.y = cvtpk(v[j].z * rs * g.z, v[j].w * rs * g.w);
        *(u32x2*)(orow + 256 * j + 4 * lane) = w; }
}
__device__ __forceinline__ void job_memn(const Params& p, int gw, int ngw, int lane) {
    for (int r = gw; r < 2 * MEML; r += ngw) { const int l = r >> 8, m = r & 255;
        rms_row_to_bf16(p.mem + (size_t)m * DM, p.mem_norm + l * DM, (bf16_t*)(p.ws + WS_MEMN) + ((size_t)l * MEML + m) * DM, lane); }
}
__device__ __forceinline__ void job_norm_rows(const Params& p, int mode, int gw, int ngw, int lane) {
    bf16_t* H = (bf16_t*)(p.ws + WS_H); const bf16_t* Y = (const bf16_t*)(p.ws + WS_Y);
    for (int row = gw; row < S; row += ngw) {
        if (mode == 0) { rms_row_to_bf16(p.x + (size_t)row * DM, p.norm_pre, H + (size_t)row * DM, lane); continue; }
        const float* xin = (mode == 1 ? p.x : p.out) + (size_t)row * DM; const float* gpost = p.norm_post + (mode == 1 ? 0 : DM);
        float y[16]; float ss = 0.f;
#pragma unroll
        for (int j = 0; j < 4; ++j) { const u32x2 w = *(const u32x2*)(Y + (size_t)row * DM + 256 * j + 4 * lane);
            y[4 * j] = lo_bf(w.x); y[4 * j + 1] = hi_bf(w.x); y[4 * j + 2] = lo_bf(w.y); y[4 * j + 3] = hi_bf(w.y);
            ss += (y[4 * j] * y[4 * j] + y[4 * j + 1] * y[4 * j + 1]) + (y[4 * j + 2] * y[4 * j + 2] + y[4 * j + 3] * y[4 * j + 3]); }
        const float rs = rsqrtf(wave_sum(ss) * (1.f / DM) + RMS_EPS);
        f32x4 x1[4]; float s2 = 0.f;
#pragma unroll
        for (int j = 0; j < 4; ++j) { const f32x4 xv = *(const f32x4*)(xin + 256 * j + 4 * lane); const f32x4 g = *(const f32x4*)(gpost + 256 * j + 4 * lane);
            x1[j].x = xv.x + y[4 * j] * rs * g.x; x1[j].y = xv.y + y[4 * j + 1] * rs * g.y; x1[j].z = xv.z + y[4 * j + 2] * rs * g.z; x1[j].w = xv.w + y[4 * j + 3] * rs * g.w;
            *(f32x4*)(p.out + (size_t)row * DM + 256 * j + 4 * lane) = x1[j];
            s2 += (x1[j].x * x1[j].x + x1[j].y * x1[j].y) + (x1[j].z * x1[j].z + x1[j].w * x1[j].w); }
        if (mode == 1) { const float r2 = rsqrtf(wave_sum(s2) * (1.f / DM) + RMS_EPS); const float* gpre = p.norm_pre + DM;
#pragma unroll
            for (int j = 0; j < 4; ++j) { const f32x4 g = *(const f32x4*)(gpre + 256 * j + 4 * lane);
                u32x2 w; w.x = cvtpk(x1[j].x * r2 * g.x, x1[j].y * r2 * g.y); w.y = cvtpk(x1[j].z * r2 * g.z, x1[j].w * r2 * g.w);
                *(u32x2*)(H + (size_t)row * DM + 256 * j + 4 * lane) = w; } }
    }
}
__device__ __forceinline__ void job_mla_rows(const Params& p, int l, int gw, int ngw, int lane) {
    const bf16_t* PROJ = (const bf16_t*)(p.ws + WS_PROJ); bf16_t* KV = (bf16_t*)(p.ws + WS_KVLAT); float* RSQ = (float*)(p.ws + WS_MISC + MISC_RSQ);
    const float* cosT = (const float*)(p.ws + WS_COS); const float* sinT = (const float*)(p.ws + WS_SIN);
    for (int row = gw; row < S; row += ngw) {
        const bf16_t* pr = PROJ + (size_t)row * NP;
        { const u32x2 w = *(const u32x2*)(pr + C_CQ + 4 * lane); const float a = lo_bf(w.x), b = hi_bf(w.x), c = lo_bf(w.y), d = hi_bf(w.y);
          const float ss = wave_sum((a * a + b * b) + (c * c + d * d)); if (lane == 0) RSQ[row] = rsqrtf(ss * (1.f / 256.f) + RMS_EPS); }
        { const unsigned w = *(const unsigned*)(pr + C_CKV + 2 * lane); const float a = lo_bf(w), b = hi_bf(w);
          const float rs = rsqrtf(wave_sum(a * a + b * b) * (1.f / 128.f) + RMS_EPS); const float* g = p.kv_norm + l * 128 + 2 * lane;
          *(unsigned*)(KV + (size_t)row * 192 + 2 * lane) = cvtpk(a * rs * g[0], b * rs * g[1]); }
        if (lane < 32) { const float t1 = bf2f(pr[C_KR + lane]), t2 = bf2f(pr[C_KR + 32 + lane]); const float c = cosT[(size_t)row * 32 + lane], s = sinT[(size_t)row * 32 + lane];
          *(unsigned*)(KV + (size_t)row * 192 + 128 + 2 * lane) = cvtpk(t1 * c - t2 * s, t1 * s + t2 * c); }
    }
}
__device__ __forceinline__ void job_gdn_final(const Params& p, int l, int gw, int ngw, int lane) {
    bf16_t* PROJ = (bf16_t*)(p.ws + WS_PROJ); const bf16_t* U = (const bf16_t*)(p.ws + WS_U);
    for (int row = gw; row < S; row += ngw) {
        const u32x4 w = *(const u32x4*)(U + (size_t)row * 512 + 8 * lane);
        float v[8] = {lo_bf(w.x), hi_bf(w.x), lo_bf(w.y), hi_bf(w.y), lo_bf(w.z), hi_bf(w.z), lo_bf(w.w), hi_bf(w.w)};
        float ss = 0.f;
#pragma unroll
        for (int j = 0; j < 8; ++j) ss += v[j] * v[j];
        ss += __shfl_xor(ss, 1); ss += __shfl_xor(ss, 2); ss += __shfl_xor(ss, 4); ss += __shfl_xor(ss, 8);
        const float rs = rsqrtf(ss * (1.f / 128.f) + RMS_EPS);
        bf16_t* zp = PROJ + (size_t)row * NP + C_Z + 512 + 8 * lane; const u32x4 z = *(const u32x4*)zp;
        const float zz[8] = {lo_bf(z.x), hi_bf(z.x), lo_bf(z.y), hi_bf(z.y), lo_bf(z.z), hi_bf(z.z), lo_bf(z.w), hi_bf(z.w)};
        const float* g = p.gdn_norm + l * 128 + (8 * lane & 127); float o[8];
#pragma unroll
        for (int j = 0; j < 8; ++j) o[j] = v[j] * rs * g[j] * silu_f(zz[j]);
        u32x4 ow = {cvtpk(o[0], o[1]), cvtpk(o[2], o[3]), cvtpk(o[4], o[5]), cvtpk(o[6], o[7])};
        *(u32x4*)zp = ow;
    }
}
namespace gdn {
constexpr int L_QH = 0, L_KH = 17408, L_KBGT = 34816, L_KHDT = 53248, L_VBT = 71680, L_LF = 90112, L_TB = 107520, L_GV = 116736, L_END = 118016;
constexpr int QP = 136, TP = 72, LP = 68;
__device__ __forceinline__ bf16_t* frag_ptr(bf16_t* PROJ, int n, int h, int f, int lane) {
    const int seg = 4 * f + (lane >> 4), part = seg >> 6, row = seg & 63;
    return PROJ + (size_t)(n * 64 + row) * NP + C_BQKV + part * 512 + h * 128 + (lane & 15) * 8;
}
__device__ __forceinline__ void prep_item(const Params& p, int l, int n, int h, LAS unsigned char* lds) {
    const int tid = threadIdx.x, lane = tid & 63, r32 = lane & 31, hi = lane >> 5, wid = __builtin_amdgcn_readfirstlane(tid >> 6);
    bf16_t* PROJ = (bf16_t*)(p.ws + WS_PROJ); const bf16_t* HALO = (const bf16_t*)(p.ws + WS_HALO);
    bf16_t* AQKg = (bf16_t*)(p.ws + WS_AQK); bf16_t* Ug = (bf16_t*)(p.ws + WS_U); float* EGL = (float*)(p.ws + WS_MISC + MISC_EGL);
    LAS bf16_t* QH = (LAS bf16_t*)(lds + L_QH); LAS bf16_t* KH = (LAS bf16_t*)(lds + L_KH); LAS bf16_t* KBGT = (LAS bf16_t*)(lds + L_KBGT);
    LAS bf16_t* KHDT = (LAS bf16_t*)(lds + L_KHDT); LAS bf16_t* VBT = (LAS bf16_t*)(lds + L_VBT); LAS float* LF = (LAS float*)(lds + L_LF);
    LAS bf16_t* TB = (LAS bf16_t*)(lds + L_TB); LAS float* GC = (LAS float*)(lds + L_GV); LAS float* BETA = GC + 64; LAS float* EGC = GC + 128; LAS float* EGD = GC + 192;
    const int t0 = n * 64;
    __syncthreads();
    if (wid == 0) {
        const bf16_t* pr = PROJ + (size_t)(t0 + lane) * NP;
        const float xa = bf2f(pr[C_BA + h]) + p.dt_bias[l * 4 + h], xb = bf2f(pr[C_BB + h]);
        const float e = __expf(xa); const float sp = xa > 20.f ? xa : (e < 1e-3f ? e * (1.f - e * (0.5f - e * (1.f / 3.f))) : logf(1.f + e));
        float gc = -__expf(p.a_log[l * 4 + h]) * sp;
#pragma unroll
        for (int o = 1; o < 64; o <<= 1) { const float t_ = __shfl_up(gc, o); if (lane >= o) gc += t_; }
        const float gl = __shfl(gc, 63);
        GC[lane] = gc; BETA[lane] = 1.f / (1.f + __expf(-xb)); EGC[lane] = __expf(gc); EGD[lane] = __expf(gl - gc);
        if (lane == 0) EGL[n * 4 + h] = __expf(gl);
    }
    __syncthreads();
#pragma unroll 1
    for (int it = 0; it < 6; ++it) {
        const int idx = tid + NT_THREADS * it, g16 = idx & 15, pr_ = idx >> 4, part = pr_ >> 6, row = pr_ & 63, cb = part * 512 + h * 128 + g16 * 8;
        float a[8] = {0.f, 0.f, 0.f, 0.f, 0.f, 0.f, 0.f, 0.f};
#pragma unroll
        for (int j = 0; j < 4; ++j) { const int t = t0 + row - 3 + j; u32x4 xw = {0u, 0u, 0u, 0u};
            if (t >= t0) xw = *(const u32x4*)(PROJ + (size_t)t * NP + C_BQKV + cb);
            else if (n > 0) xw = *(const u32x4*)(HALO + ((size_t)(n - 1) * 3 + (t - (t0 - 3))) * 1536 + cb);
            const float* cw = p.conv_w + ((size_t)l * 4 + j) * 1536 + cb; const f32x4 w0 = *(const f32x4*)cw, w1 = *(const f32x4*)(cw + 4);
            a[0] = fmaf(w0[0], lo_bf(xw.x), a[0]); a[1] = fmaf(w0[1], hi_bf(xw.x), a[1]); a[2] = fmaf(w0[2], lo_bf(xw.y), a[2]); a[3] = fmaf(w0[3], hi_bf(xw.y), a[3]);
            a[4] = fmaf(w1[0], lo_bf(xw.z), a[4]); a[5] = fmaf(w1[1], hi_bf(xw.z), a[5]); a[6] = fmaf(w1[2], lo_bf(xw.w), a[6]); a[7] = fmaf(w1[3], hi_bf(xw.w), a[7]); }
        float ss = 0.f;
#pragma unroll
        for (int e = 0; e < 8; ++e) { a[e] = silu_f(a[e]); ss += a[e] * a[e]; }
        ss += __shfl_xor(ss, 1); ss += __shfl_xor(ss, 2); ss += __shfl_xor(ss, 4); ss += __shfl_xor(ss, 8);
        const float rn = rsqrtf(ss + 1e-6f);
        if (part == 0) { const float sc = rn * 0.08838834764831845f;
#pragma unroll
            for (int e = 0; e < 8; ++e) a[e] *= sc;
            *(LAS bf16x8*)(QH + row * QP + g16 * 8) = pack8(a);
        } else if (part == 1) {
#pragma unroll
            for (int e = 0; e < 8; ++e) a[e] *= rn;
            *(LAS bf16x8*)(KH + row * QP + g16 * 8) = pack8(a);
            const float s1 = BETA[row] * EGC[row], s2 = EGD[row];
#pragma unroll
            for (int e = 0; e < 8; ++e) { KBGT[(g16 * 8 + e) * TP + row] = f2bf(a[e] * s1); KHDT[(g16 * 8 + e) * TP + row] = f2bf(a[e] * s2); }
        } else { const float b = BETA[row];
#pragma unroll
            for (int e = 0; e < 8; ++e) VBT[(g16 * 8 + e) * TP + row] = f2bf(a[e] * b);
        }
    }
    __syncthreads();
    if (wid < 3) { const int it = wid > 0, jt = wid > 1; f32x16 acc = {};
#pragma unroll
        for (int ks = 0; ks < 8; ++ks) { const bf16x8 a = *(const LAS bf16x8*)(KH + (32 * it + r32) * QP + 16 * ks + 8 * hi), b = *(const LAS bf16x8*)(KH + (32 * jt + r32) * QP + 16 * ks + 8 * hi);
            acc = MFMA32(a, b, acc); }
        const int j = 32 * jt + r32; const float gj = GC[j];
#pragma unroll
        for (int r = 0; r < 16; ++r) { const int i = 32 * it + crow(r, hi); LF[i * LP + j] = i > j ? BETA[i] * __expf(GC[i] - gj) * acc[r] : 0.f; }
    } else if (wid < 6) { const int w = wid - 3, ctp = w > 1, ct = w > 0; f32x16 acc = {};
#pragma unroll
        for (int ks = 0; ks < 8; ++ks) { const bf16x8 a = *(const LAS bf16x8*)(KH + (32 * ctp + r32) * QP + 16 * ks + 8 * hi), b = *(const LAS bf16x8*)(QH + (32 * ct + r32) * QP + 16 * ks + 8 * hi);
            acc = MFMA32(a, b, acc); }
        const int c = 32 * ct + r32; const float gcq = GC[c];
#pragma unroll
        for (int r = 0; r < 16; ++r) { const int cp = 32 * ctp + crow(r, hi); acc[r] = c >= cp ? acc[r] * __expf(gcq - GC[cp]) : 0.f; }
        bf16_t* dst = AQKg + (((size_t)(n * 4 + h) * 8 + (ct * 2 + ctp) * 2) * 64 + lane) * 8;
        *(bf16x8*)dst = pack_step(acc, 0); *(bf16x8*)(dst + 512) = pack_step(acc, 1);
    } else { const int w = wid - 6;
        if (w == 0) { const bf16x8 z = {0, 0, 0, 0, 0, 0, 0, 0}; bf16_t* dst = AQKg + (((size_t)(n * 4 + h) * 8 + 2) * 64 + lane) * 8; *(bf16x8*)dst = z; *(bf16x8*)(dst + 512) = z; }
#pragma unroll
        for (int ff = 0; ff < 8; ++ff) { const int f = w * 8 + ff, s = f & 1, mt = (f >> 1) & 3, ct = f >> 3, c = 32 * ct + r32, d0 = 32 * mt + 16 * s + 4 * hi; const float eg = EGC[c];
            const u32x2 lo = *(const LAS u32x2*)(QH + c * QP + d0), hw = *(const LAS u32x2*)(QH + c * QP + d0 + 8);
            u32x4 o; o.x = cvtpk(lo_bf(lo.x) * eg, hi_bf(lo.x) * eg); o.y = cvtpk(lo_bf(lo.y) * eg, hi_bf(lo.y) * eg); o.z = cvtpk(lo_bf(hw.x) * eg, hi_bf(hw.x) * eg); o.w = cvtpk(lo_bf(hw.y) * eg, hi_bf(hw.y) * eg);
            *(u32x4*)frag_ptr(PROJ, n, h, 16 + f, lane) = o; }
    }
    __syncthreads();
    if (wid == 0) {
        float T[64];
#pragma unroll
        for (int i = 0; i < 64; ++i) { float acc = (lane == i) ? 1.f : 0.f;
#pragma unroll
            for (int j = 0; j < i; ++j) acc = fmaf(-LF[i * LP + j], T[j], acc);
            T[i] = acc; }
#pragma unroll
        for (int i = 0; i < 64; ++i) TB[i * TP + lane] = f2bf(T[i]);
    } else {
        for (int f = wid - 1; f < 16; f += 7) { const int s = f & 1, ctp = (f >> 1) & 1, mt = f >> 2, dk = 32 * mt + r32, c0 = 32 * ctp + 16 * s + 4 * hi;
            const u32x2 lo = *(const LAS u32x2*)(KHDT + dk * TP + c0), hw = *(const LAS u32x2*)(KHDT + dk * TP + c0 + 8);
            u32x4 o = {lo.x, lo.y, hw.x, hw.y}; *(u32x4*)frag_ptr(PROJ, n, h, 32 + f, lane) = o; }
    }
    __syncthreads();
    { const int mt = wid >> 1, ct = wid & 1; f32x16 acc = {};
#pragma unroll
      for (int ks = 0; ks < 4; ++ks) { const bf16x8 a = *(const LAS bf16x8*)(KBGT + (32 * mt + r32) * TP + 16 * ks + 8 * hi), b = *(const LAS bf16x8*)(TB + (32 * ct + r32) * TP + 16 * ks + 8 * hi);
          acc = MFMA32(a, b, acc); }
#pragma unroll
      for (int r = 0; r < 16; ++r) acc[r] = -acc[r];
      *(bf16x8*)frag_ptr(PROJ, n, h, (ct * 4 + mt) * 2, lane) = pack_step(acc, 0); *(bf16x8*)frag_ptr(PROJ, n, h, (ct * 4 + mt) * 2 + 1, lane) = pack_step(acc, 1); }
    { const int ct = wid >> 2, dt = wid & 3; f32x16 acc = {};
#pragma unroll
      for (int ks = 0; ks < 4; ++ks) { const bf16x8 a = *(const LAS bf16x8*)(TB + (32 * ct + r32) * TP + 16 * ks + 8 * hi), b = *(const LAS bf16x8*)(VBT + (32 * dt + r32) * TP + 16 * ks + 8 * hi);
          acc = MFMA32(a, b, acc); }
#pragma unroll
      for (int r = 0; r < 16; ++r) Ug[(size_t)(t0 + 32 * ct + crow(r, hi)) * 512 + h * 128 + 32 * dt + r32] = f2bf(acc[r]); }
}
__device__ __forceinline__ void scan_wave(const Params& p, int h, int sl, int lane) {
    const int r32 = lane & 31, hi = lane >> 5;
    bf16_t* PROJ = (bf16_t*)(p.ws + WS_PROJ); const bf16_t* AQKg = (const bf16_t*)(p.ws + WS_AQK); bf16_t* Ug = (bf16_t*)(p.ws + WS_U); const float* EGL = (const float*)(p.ws + WS_MISC + MISC_EGL);
    f32x16 St[4] = {};
#pragma unroll 1
    for (int n = 0; n < S / 64; ++n) {
        const float egl = EGL[n * 4 + h];
        bf16_t* ub = Ug + (size_t)(n * 64) * 512 + h * 128 + sl * 32 + r32;
        f32x16 vn[2], o[2] = {};
#pragma unroll
        for (int ct = 0; ct < 2; ++ct)
#pragma unroll
            for (int r = 0; r < 16; ++r) vn[ct][r] = bf2f(ub[(size_t)(32 * ct + crow(r, hi)) * 512]);
        bf16x8 Sb[4][2];
#pragma unroll
        for (int mt = 0; mt < 4; ++mt) { Sb[mt][0] = pack_step(St[mt], 0); Sb[mt][1] = pack_step(St[mt], 1); }
#pragma unroll
        for (int ct = 0; ct < 2; ++ct)
#pragma unroll
            for (int mt = 0; mt < 4; ++mt)
#pragma unroll
                for (int s = 0; s < 2; ++s) { const int f = (ct * 4 + mt) * 2 + s;
                    vn[ct] = MFMA32(*(const bf16x8*)frag_ptr(PROJ, n, h, f, lane), Sb[mt][s], vn[ct]);
                    o[ct] = MFMA32(*(const bf16x8*)frag_ptr(PROJ, n, h, 16 + f, lane), Sb[mt][s], o[ct]); }
        bf16x8 Vb[2][2];
#pragma unroll
        for (int ct = 0; ct < 2; ++ct) { Vb[ct][0] = pack_step(vn[ct], 0); Vb[ct][1] = pack_step(vn[ct], 1); }
        const bf16_t* aq = AQKg + ((size_t)(n * 4 + h) * 8 * 64 + lane) * 8;
#pragma unroll
        for (int ct = 0; ct < 2; ++ct)
#pragma unroll
            for (int ctp = 0; ctp < 2; ++ctp)
#pragma unroll
                for (int s = 0; s < 2; ++s) o[ct] = MFMA32(*(const bf16x8*)(aq + ((ct * 2 + ctp) * 2 + s) * 512), Vb[ctp][s], o[ct]);
#pragma unroll
        for (int mt = 0; mt < 4; ++mt) {
#pragma unroll
            for (int r = 0; r < 16; ++r) St[mt][r] *= egl;
#pragma unroll
            for (int ctp = 0; ctp < 2; ++ctp)
#pragma unroll
                for (int s = 0; s < 2; ++s) St[mt] = MFMA32(*(const bf16x8*)frag_ptr(PROJ, n, h, 32 + (mt * 2 + ctp) * 2 + s, lane), Vb[ctp][s], St[mt]);
        }
#pragma unroll
        for (int ct = 0; ct < 2; ++ct)
#pragma unroll
            for (int r = 0; r < 16; ++r) ub[(size_t)(32 * ct + crow(r, hi)) * 512] = f2bf(o[ct][r]);
    }
}
}
constexpr int N_PHASES = 2 + 7 * DEPTH;
constexpr int SCAN_WGS = 16;
constexpr float QSCALE = 0.07216878364870322f * LOG2E;

template <int KIND> __device__ __forceinline__ void run_kind(const Params& p, int l, LAS unsigned char* lds) {
    const int tid = threadIdx.x, lane = tid & 63, wid = __builtin_amdgcn_readfirstlane(tid >> 6);
    const int bid = blockIdx.x, nblk = gridDim.x, gw = bid * 8 + wid, ngw = nblk * 8, gtid = bid * NT_THREADS + tid, gn = nblk * NT_THREADS;
    bf16_t* PROJ = (bf16_t*)(p.ws + WS_PROJ);
    if constexpr (KIND == 0) {
        job_win(p, 0, bid, nblk, lds); job_wout(p, 0, bid, nblk, lds); job_wmem(p, bid, nblk, lds);
        job_wq(p, gtid, gn); job_wuv(p, gtid, gn); job_rope(p, gtid, gn); job_btab(p, gtid, gn); job_memn(p, gw, ngw, lane);
    } else if constexpr (KIND == 1) {
        for (int ll = 0; ll < 2; ++ll) {
            pg8::Gemm g{(const bf16_t*)(p.ws + WS_MEMN) + (size_t)ll * MEML * DM, (const bf16_t*)(p.ws + WS_WMEM) + (size_t)ll * DM * DM, MEML, DM, DM, DM};
            pg8::StaticOrder so; so.init(MEML, DM, nblk, (bid + nblk - 4 * ll) % nblk);
            pg8::EpiStore E{(bf16_t*)(p.ws + WS_MEMKV) + (size_t)ll * MEML * DM, DM, nullptr};
            pg8::gemm_phase<pg8::EpiStore, pg8::StaticOrder, true, true>(lds, g, so, E);
        }
        job_norm_rows(p, 0, gw, ngw, lane);
    } else if constexpr (KIND == 2) {
        pg8::Gemm g{(const bf16_t*)(p.ws + WS_H), (const bf16_t*)(p.ws + WS_WIN), S, NP, DM, DM};
        pg8::StaticOrder so; so.init(S, NP, nblk, bid);
        pg8::EpiStore E{PROJ, NP, (bf16_t*)(p.ws + WS_HALO)};
        pg8::gemm_phase<pg8::EpiStore, pg8::StaticOrder, true, true>(lds, g, so, E);
    } else if constexpr (KIND == 3) {
        job_mla_rows(p, l, gw, ngw, lane);
        for (int u = bid; u < 512; u += nblk) att::swa_unit(lds, u >> 1, u & 1, PROJ, p.pos, p.sinks + l * 8, (const float*)(p.ws + WS_MISC + MISC_BTAB));
        for (int u = bid; u < 256; u += nblk) att::cross_unit(lds, u >> 2, u & 3, PROJ, (const bf16_t*)(p.ws + WS_MEMKV) + (size_t)l * MEML * DM);
        for (int it = bid; it < 1024; it += nblk) gdn::prep_item(p, l, it >> 2, it & 3, lds);
        __syncthreads();
        if (l == 0) job_win(p, 1, bid, nblk, lds);
    } else if constexpr (KIND == 4) {
        pg8::Gemm g{PROJ + C_CQ, (const bf16_t*)(p.ws + WS_WQ) + (size_t)l * 768 * 256, S, 768, 256, NP};
        pg8::StaticOrder so; so.init(S, 768, nblk, bid);
        pg8::EpiStore E{(bf16_t*)(p.ws + WS_QABS), 768, nullptr};
        pg8::gemm_phase<pg8::EpiStore, pg8::StaticOrder, true, true>(lds, g, so, E);
    } else if constexpr (KIND == 5) {
        if (bid < SCAN_WGS) { if (wid == 0) gdn::scan_wave(p, bid >> 2, bid & 3, lane); }
        else for (int u = bid - SCAN_WGS; u < 256; u += nblk - SCAN_WGS) att::mla_unit(lds, 63 - (u >> 2), u & 3, (const bf16_t*)(p.ws + WS_QABS), (const bf16_t*)(p.ws + WS_KVLAT), PROJ, (const float*)(p.ws + WS_MISC + MISC_RSQ), (const float*)(p.ws + WS_COS), (const float*)(p.ws + WS_SIN), QSCALE);
    } else if constexpr (KIND == 6) {
        pg8::Gemm g{PROJ + C_OLAT, (const bf16_t*)(p.ws + WS_WUV) + (size_t)l * 512 * 512, S, 512, 512, NP};
        pg8::StaticOrder so; so.init(S, 512, nblk, bid);
        pg8::EpiGate E{PROJ + C_Z + 1024, NP};
        pg8::gemm_phase<pg8::EpiGate, pg8::StaticOrder, true, true>(lds, g, so, E);
        job_gdn_final(p, l, gw, ngw, lane);
    } else if constexpr (KIND == 7) {
        pg8::Gemm g{PROJ + C_Z, (const bf16_t*)(p.ws + WS_WOUT), S, DM, MIXW, NP};
        pg8::StaticOrder so; so.init(S, DM, nblk, bid);
        pg8::EpiStore E{(bf16_t*)(p.ws + WS_Y), DM, nullptr};
        pg8::gemm_phase<pg8::EpiStore, pg8::StaticOrder, true, true>(lds, g, so, E);
    } else {
        job_norm_rows(p, l == 0 ? 1 : 2, gw, ngw, lane);
        if (l == 0) job_wout(p, 1, bid, nblk, lds);
    }
}
__device__ __forceinline__ void run_phase(const Params& p, int ph, LAS unsigned char* lds) {
    int kind, l;
    if (ph < 2) { kind = ph; l = 0; } else { l = (ph - 2) / 7; kind = 2 + (ph - 2) % 7; }
    switch (kind) {
    case 0: run_kind<0>(p, l, lds); break; case 1: run_kind<1>(p, l, lds); break; case 2: run_kind<2>(p, l, lds); break; case 3: run_kind<3>(p, l, lds); break;
    case 4: run_kind<4>(p, l, lds); break; case 5: run_kind<5>(p, l, lds); break; case 6: run_kind<6>(p, l, lds); break; case 7: run_kind<7>(p, l, lds); break;
    default: run_kind<8>(p, l, lds); break;
    }
}
template <int KIND> __global__ void __launch_bounds__(NT_THREADS, 2) mk_kind(Params p, int l) {
    extern __shared__ __attribute__((aligned(16))) unsigned char lds_raw[];
    run_kind<KIND>(p, l, (LAS unsigned char*)lds_raw);
}

#ifndef MK_LAUNCHES_PER_PHASE
#define MK_LAUNCHES_PER_PHASE 1
#endif
#if !MK_LAUNCHES_PER_PHASE
__global__ void __launch_bounds__(NT_THREADS, 2) mk_fwd(Params p) {
    extern __shared__ __attribute__((aligned(16))) unsigned char lds_raw[];
    LAS unsigned char* lds = (LAS unsigned char*)lds_raw;
    cg::grid_group grid = cg::this_grid();
    for (int ph = p.ph_lo; ph < p.ph_hi; ++ph) {
        run_phase(p, ph, lds);
        if (ph + 1 < p.ph_hi) grid.sync();
    }
}
#endif

#ifndef MK_LAUNCHES_PER_PHASE
#define MK_LAUNCHES_PER_PHASE 1
#endif
extern "C" void kernel_launch(void* const* d_in, const int* in_sizes, int n_in, void* d_out, int out_size, void* d_ws, size_t ws_size, hipStream_t stream) {
    static int grid = 0;
    if (grid == 0) {
        if (n_in != 19 || in_sizes[0] != S * DM || out_size != S * DM || ws_size < WS_END) { fprintf(stderr, "kernel_launch: unexpected shapes (n_in %d, in0 %d, out %d, ws %zu)\n", n_in, n_in > 0 ? in_sizes[0] : -1, out_size, ws_size); grid = -1; return; }
        int dev = 0, cus = 0, per_cu = 0;
        (void)hipGetDevice(&dev); (void)hipDeviceGetAttribute(&cus, hipDeviceAttributeMultiprocessorCount, dev);
#if !MK_LAUNCHES_PER_PHASE
        if (hipFuncSetAttribute((const void*)mk_fwd, hipFuncAttributeMaxDynamicSharedMemorySize, LDS_BYTES) != hipSuccess) { fprintf(stderr, "kernel_launch: hipFuncSetAttribute failed\n"); grid = -1; return; }
        if (hipOccupancyMaxActiveBlocksPerMultiprocessor(&per_cu, (const void*)mk_fwd, NT_THREADS, LDS_BYTES) != hipSuccess || per_cu < 1) { fprintf(stderr, "kernel_launch: occupancy query gave %d\n", per_cu); per_cu = 1; }
#else
#define SA(K) (void)hipFuncSetAttribute((const void*)mk_kind<K>, hipFuncAttributeMaxDynamicSharedMemorySize, LDS_BYTES)
        SA(0); SA(1); SA(2); SA(3); SA(4); SA(5); SA(6); SA(7); SA(8);
#undef SA
#endif
        (void)hipGetLastError();
        if (cus <= 0) cus = 256;
        grid = cus;
        fprintf(stderr, "kernel_launch: cus %d per_cu %d grid %d\n", cus, per_cu, grid);
    }
    if (grid < 0) return;
    Params p{};
    p.x = (const float*)d_in[0]; p.mem = (const float*)d_in[1]; p.pos = (const int*)d_in[2]; p.rel_bias = (const float*)d_in[3];
    p.norm_pre = (const float*)d_in[4]; p.norm_post = (const float*)d_in[5]; p.w_in = (const float*)d_in[6]; p.sinks = (const float*)d_in[7];
    p.conv_w = (const float*)d_in[8]; p.a_log = (const float*)d_in[9]; p.dt_bias = (const float*)d_in[10]; p.gdn_norm = (const float*)d_in[11];
    p.q_norm = (const float*)d_in[12]; p.kv_norm = (const float*)d_in[13]; p.w_uq = (const float*)d_in[14]; p.w_ukv = (const float*)d_in[15];
    p.mem_norm = (const float*)d_in[16]; p.w_mem = (const float*)d_in[17]; p.w_out = (const float*)d_in[18];
    p.out = (float*)d_out; p.ws = (unsigned char*)d_ws;
#if MK_LAUNCHES_PER_PHASE
    p.ph_lo = 0; p.ph_hi = 0;
#define LK(K, L) hipLaunchKernelGGL(mk_kind<K>, dim3(grid), dim3(NT_THREADS), LDS_BYTES, stream, p, L)
    LK(0, 0); LK(1, 0);
    for (int l = 0; l < DEPTH; ++l) { LK(2, l); LK(3, l); LK(4, l); LK(5, l); LK(6, l); LK(7, l); LK(8, l); }
#undef LK
#else
    p.ph_lo = 0; p.ph_hi = N_PHASES;
    void* args[] = {&p};
    hipError_t e = hipLaunchCooperativeKernel((const void*)mk_fwd, dim3(grid), dim3(NT_THREADS), args, LDS_BYTES, stream);
    if (e != hipSuccess) fprintf(stderr, "kernel_launch: cooperative launch failed: %s (grid %d)\n", hipGetErrorString(e), grid);
#endif
}
```

```cpp
#include <hip/hip_runtime.h>
#include <hip/hip_cooperative_groups.h>
#include <cstdint>
#include <cstdio>
namespace cg = cooperative_groups;

#define LAS __attribute__((address_space(3)))
typedef unsigned short bf16_t;
typedef short bf16x8 __attribute__((ext_vector_type(8)));
typedef short s16x4 __attribute__((ext_vector_type(4)));
typedef float f32x2 __attribute__((ext_vector_type(2)));
typedef float f32x4 __attribute__((ext_vector_type(4)));
typedef float f32x16 __attribute__((ext_vector_type(16)));
typedef unsigned u32x2 __attribute__((ext_vector_type(2)));
typedef unsigned u32x4 __attribute__((ext_vector_type(4)));
typedef __bf16 bf16x2_t __attribute__((ext_vector_type(2)));

constexpr int S = 16384, DM = 1024, MEML = 256, NP = 5376, DEPTH = 2, DIN = 5320, MIXW = 2048;
constexpr int C_Z = 0, C_AQ = 2048, C_AK = 2560, C_AV = 2688, C_DQ = 2816, C_BQKV = 3328, C_CQ = 4864, C_CKV = 5120, C_KR = 5248, C_BA = 5312, C_BB = 5316;
constexpr int C_OLAT = 2048;
constexpr float RMS_EPS = 1e-6f;
constexpr float LOG2E = 1.4426950408889634f;
constexpr int NT_THREADS = 512;

constexpr size_t MiB = 1u << 20;
constexpr size_t WS_CTL = 0, WS_COS = 1 * MiB, WS_SIN = 3 * MiB, WS_MEMKV = 5 * MiB, WS_MISC = 6 * MiB, WS_MEMN = 7 * MiB;
constexpr size_t WS_WIN = 8 * MiB, WS_WOUT = 19 * MiB, WS_WMEM = 23 * MiB, WS_WQ = 27 * MiB, WS_WUV = 28 * MiB, WS_HALO = 29 * MiB;
constexpr size_t WS_AQK = 32 * MiB, WS_U = 40 * MiB, WS_H = 56 * MiB, WS_PROJ = 88 * MiB, WS_END = 256 * MiB;
constexpr size_t WS_QABS = WS_H, WS_KVLAT = WS_H + 24 * MiB, WS_Y = WS_H;
constexpr size_t MISC_BTAB = 0, MISC_RSQ = 8192, MISC_EGL = 8192 + 65536;

constexpr int LDS_BYTES = 147456;

struct Params {
    const float* x; const float* mem; const int* pos; const float* rel_bias;
    const float* norm_pre; const float* norm_post; const float* w_in; const float* sinks;
    const float* conv_w; const float* a_log; const float* dt_bias; const float* gdn_norm;
    const float* q_norm; const float* kv_norm; const float* w_uq; const float* w_ukv;
    const float* mem_norm; const float* w_mem; const float* w_out;
    float* out; unsigned char* ws;
    int ph_lo, ph_hi;
};

__device__ __forceinline__ int tidx() { int t = threadIdx.x; asm volatile("" : "+v"(t)); return t; }
__device__ __forceinline__ int bidx() { int b = blockIdx.x; asm volatile("" : "+s"(b)); return b; }
__device__ __forceinline__ float bf2f(bf16_t v) { return __uint_as_float((unsigned)v << 16); }
__device__ __forceinline__ unsigned cvtpk(float lo, float hi) { f32x2 v = {lo, hi}; bf16x2_t b = __builtin_convertvector(v, bf16x2_t); return __builtin_bit_cast(unsigned, b); }
__device__ __forceinline__ bf16_t f2bf(float f) { return (bf16_t)(cvtpk(f, 0.f) & 0xffffu); }
__device__ __forceinline__ float lo_bf(unsigned w) { return __uint_as_float(w << 16); }
__device__ __forceinline__ float hi_bf(unsigned w) { return __uint_as_float(w & 0xffff0000u); }
__device__ __forceinline__ float silu_f(float v) { return v / (1.f + __expf(-v)); }
__device__ __forceinline__ float wave_sum(float v) {
#pragma unroll
    for (int o = 1; o < 64; o <<= 1) v += __shfl_xor(v, o);
    return v;
}
__device__ __forceinline__ int crow(int r, int hi) { return (r & 3) + 8 * (r >> 2) + 4 * hi; }
#define MFMA32(a, b, c) __builtin_amdgcn_mfma_f32_32x32x16_bf16((a), (b), (c), 0, 0, 0)
#define SBAR() __builtin_amdgcn_sched_barrier(0)
#define LDS_WAIT() asm volatile("s_waitcnt lgkmcnt(0)" ::: "memory")
__device__ __forceinline__ bf16x8 pack8(const float* v) { u32x4 w = {cvtpk(v[0], v[1]), cvtpk(v[2], v[3]), cvtpk(v[4], v[5]), cvtpk(v[6], v[7])}; return __builtin_bit_cast(bf16x8, w); }
__device__ __forceinline__ bf16x8 pack_step(const f32x16& x, int s) {
    u32x4 w = {cvtpk(x[8 * s + 0], x[8 * s + 1]), cvtpk(x[8 * s + 2], x[8 * s + 3]), cvtpk(x[8 * s + 4], x[8 * s + 5]), cvtpk(x[8 * s + 6], x[8 * s + 7])};
    return __builtin_bit_cast(bf16x8, w);
}

__device__ __forceinline__ int win_src(int n) {
    if (n < 512) return 768 + n;
    if (n < 1024) return 2824 + (n - 512);
    if (n < 1536) return 3784 + (n - 1024);
    if (n < 2048) return 4808 + (n - 1536);
    if (n < 2560) return n - 2048;
    if (n < 2688) return 512 + (n - 2560);
    if (n < 2816) return 640 + (n - 2688);
    if (n < 3328) return 4296 + (n - 2816);
    if (n < 4864) return 1280 + (n - 3328);
    if (n < 5120) return 3336 + (n - 4864);
    if (n < 5248) return 3592 + (n - 5120);
    if (n < 5312) return 3720 + (n - 5248);
    if (n < 5316) return 2816 + (n - 5312);
    if (n < 5320) return 2820 + (n - 5316);
    return -1;
}

__device__ __forceinline__ int t5_bucket(int n) {
    if (n < 16) return n < 0 ? 0 : n;
    if (n >= 128) return 31;
    const float v = __logf((float)n * 0.0625f) * (16.0f / 2.0794415416798357f);
    int b = 16 + (int)v; return b > 31 ? 31 : b;
}
__device__ __forceinline__ float inv_freq(int i) {
    const float t[32] = {1.000000000e+00f, 7.498942018e-01f, 5.623413324e-01f, 4.216965139e-01f, 3.162277639e-01f, 2.371373922e-01f, 1.778279394e-01f, 1.333521456e-01f,
                         1.000000015e-01f, 7.498941571e-02f, 5.623412877e-02f, 4.216964915e-02f, 3.162277862e-02f, 2.371373586e-02f, 1.778279431e-02f, 1.333521493e-02f,
                         9.999999776e-03f, 7.498942316e-03f, 5.623413250e-03f, 4.216964822e-03f, 3.162277862e-03f, 2.371373819e-03f, 1.778279431e-03f, 1.333521446e-03f,
                         1.000000047e-03f, 7.498941850e-04f, 5.623413017e-04f, 4.216965463e-04f, 3.162277862e-04f, 2.371373848e-04f, 1.778279402e-04f, 1.333521504e-04f};
    return t[i];
}
namespace pg8 {
#define PG8_LAS __attribute__((address_space(3)))
constexpr int BM = 256, BK = 64, HALF = 128, HTB = HALF * BK * 2  , STAGE_BYTES = 8 * HTB, NXCD = 8, WGM = 8;
__host__ __device__ __forceinline__ int lds_byte(int r, int c) { const int st = (r >> 4) * 2 + (c >> 5), rr = r & 15, cc = c & 31, ob = rr * 64 + cc * 2; return st * 1024 + (ob ^ (((ob >> 9) & 1) << 5)); }
__host__ __device__ __forceinline__ void stage_rc(int b, int& R, int& C) { const int st = b / 1024, sb = b % 1024, swz = sb ^ (((sb >> 9) & 1) << 5); R = (st >> 1) * 16 + swz / 64; C = (st & 1) * 32 + (swz % 64) / 2; }
__host__ __device__ __forceinline__ int perm32(int rho) { const int n = rho >> 4, i = rho & 15; return 8 * (i >> 2) + 4 * n + (i & 3); }
struct Unit { int pm, pn; };
struct Gemm { const bf16_t* A; const bf16_t* Bt; int M, N, K, lda; };
struct StaticOrder {
    int nM, nN, nwg, G, c;
    __device__ void init(int M, int N, int G_, int c_) { nM = M / BM; nN = N / BM; nwg = nM * nN; G = G_; c = c_; }
    __device__ bool next(int i, Unit& u) const {
        const long L = (long)i * G + c; if (L >= nwg) return false;
        int wgid = (int)L; { const int q = nwg / NXCD, r = nwg % NXCD, xcd = wgid % NXCD, off = wgid / NXCD; wgid = (xcd < r ? xcd * (q + 1) : r * (q + 1) + (xcd - r) * q) + off; }
        const int nig = WGM * nN, gid = wgid / nig, fm = gid * WGM, gsz = (nM - fm) < WGM ? (nM - fm) : WGM;
        u.pm = fm + ((wgid % nig) % gsz); u.pn = (wgid % nig) / gsz; return true;
    }
    __device__ __forceinline__ void a_ready(const Unit&) const {}
    __device__ __forceinline__ void done(const Unit&) const {}
};
struct EpiStore {
    static constexpr bool PERM = true, AFTER_DRAIN = false;
    bf16_t* O; int ldc; bf16_t* halo;
    __device__ __forceinline__ void operator()(const f32x4 (&acc)[2][2][4][2], const Unit& u, int wr, int wc, int fr, int fq) const {
        const int row0 = u.pm * BM + wr * 64 + fr, col0 = u.pn * BM + wc * 32 + 8 * fq;
        const bool hz = halo != nullptr && col0 >= C_BQKV && col0 < C_BQKV + 1536;
#pragma unroll
        for (int ai = 0; ai < 2; ++ai)
#pragma unroll
            for (int m = 0; m < 4; ++m) { const int row = row0 + ai * HALF + m * 16; bf16_t* rowp = O + (size_t)row * ldc + col0;
#pragma unroll
                for (int bj = 0; bj < 2; ++bj) { const f32x4 v0 = acc[ai][bj][m][0], v1 = acc[ai][bj][m][1];
                    u32x4 w; w.x = cvtpk(v0[0], v0[1]); w.y = cvtpk(v0[2], v0[3]); w.z = cvtpk(v1[0], v1[1]); w.w = cvtpk(v1[2], v1[3]);
                    *(u32x4*)(rowp + bj * HALF) = w;
                    if (m == 3 && hz && fr >= 13) *(u32x4*)(halo + ((size_t)(row >> 6) * 3 + (fr - 13)) * 1536 + (col0 + bj * HALF - C_BQKV)) = w; } }
    }
};
struct EpiGate {
    static constexpr bool PERM = true, AFTER_DRAIN = false;
    bf16_t* G; int ldc;
    __device__ __forceinline__ void operator()(const f32x4 (&acc)[2][2][4][2], const Unit& u, int wr, int wc, int fr, int fq) const {
        const int row0 = u.pm * BM + wr * 64 + fr, col0 = u.pn * BM + wc * 32 + 8 * fq;
#pragma unroll
        for (int ai = 0; ai < 2; ++ai)
#pragma unroll
            for (int m = 0; m < 4; ++m) { bf16_t* rowp = G + (size_t)(row0 + ai * HALF + m * 16) * ldc + col0;
#pragma unroll
                for (int bj = 0; bj < 2; ++bj) { const f32x4 v0 = acc[ai][bj][m][0], v1 = acc[ai][bj][m][1];
                    const u32x4 z = *(const u32x4*)(rowp + bj * HALF);
                    u32x4 w; w.x = cvtpk(v0[0] * silu_f(lo_bf(z.x)), v0[1] * silu_f(hi_bf(z.x))); w.y = cvtpk(v0[2] * silu_f(lo_bf(z.y)), v0[3] * silu_f(hi_bf(z.y)));
                    w.z = cvtpk(v1[0] * silu_f(lo_bf(z.z)), v1[1] * silu_f(hi_bf(z.z))); w.w = cvtpk(v1[2] * silu_f(lo_bf(z.w)), v1[3] * silu_f(hi_bf(z.w)));
                    *(u32x4*)(rowp + bj * HALF) = w; } }
    }
};
template <class Epi, class Sched, bool ALIGN_EPI = false, bool SP2 = false>
__device__ __forceinline__ void gemm_phase(PG8_LAS unsigned char* lds, const Gemm g, const Sched& S, const Epi& E) {
    const int tid = tidx(), wid = __builtin_amdgcn_readfirstlane(tid >> 6), lane = tid & 63, wr = wid >> 2, wc = wid & 3, fr = lane & 15, fq = lane >> 4;
    const int K = g.K, nt = K / BK;
    unsigned voffA[2], voffB[2];
#pragma unroll
    for (int i = 0; i < 2; ++i) { int R, C; stage_rc(tid * 16 + i * 8192, R, C); const int Rb = Epi::PERM ? ((R & ~31) + perm32(R & 31)) : R;
        voffA[i] = (unsigned)(R * g.lda + C) * 2u; voffB[i] = (unsigned)(Rb * K + C) * 2u; }
    const size_t kstep = (size_t)(BK * 2);
    const size_t hstepA = (size_t)HALF * g.lda * 2, hstepB = (size_t)HALF * K * 2;
    const size_t tstepA = 2 * hstepA, tstepB = 2 * hstepB;
    const unsigned ldsw = (unsigned)wid * 1024u;
    const int aoff = lds_byte(wr * 64 + fr, fq * 8), boff = lds_byte(wc * 32 + fr, fq * 8);
#define PG8_SA(b, h) (((b) * 2 + (h)) * HTB)
#define PG8_SB(b, h) ((4 + (b) * 2 + (h)) * HTB)
#define PG8_STAGE(bufoff, gbase, voff) do { _Pragma("unroll") for (int _i = 0; _i < 2; ++_i) \
        __builtin_amdgcn_global_load_lds((const unsigned*)((const char*)(gbase) + (voff)[_i]), (PG8_LAS unsigned*)(lds + (bufoff) + ldsw + _i * 8192), 16, 0, 0); } while (0)
#define PG8_LDA(dst, b, h) do { _Pragma("unroll") for (int m = 0; m < 4; ++m) _Pragma("unroll") for (int k = 0; k < 2; ++k) dst[m][k] = *(const PG8_LAS bf16x8*)(lds + PG8_SA(b, h) + aoff + m * 2048 + k * 1024); } while (0)
#define PG8_LDB(dst, b, h) do { _Pragma("unroll") for (int n = 0; n < 2; ++n) _Pragma("unroll") for (int k = 0; k < 2; ++k) dst[n][k] = *(const PG8_LAS bf16x8*)(lds + PG8_SB(b, h) + boff + n * 2048 + k * 1024); } while (0)
#define PG8_MMA(ai, bj, At, Bt) do { __builtin_amdgcn_s_setprio(1); _Pragma("unroll") for (int m = 0; m < 4; ++m) _Pragma("unroll") for (int n = 0; n < 2; ++n) _Pragma("unroll") for (int k = 0; k < 2; ++k) \
        acc[ai][bj][m][n] = __builtin_amdgcn_mfma_f32_16x16x32_bf16(Bt[n][k], At[m][k], acc[ai][bj][m][n], 0, 0, 0); __builtin_amdgcn_s_setprio(0); } while (0)
#define PG8_WAIT_V(n) asm volatile("s_waitcnt vmcnt(" #n ")" ::: "memory")
#define PG8_WAIT_L(n) asm volatile("s_waitcnt lgkmcnt(" #n ")" ::: "memory")
#define PG8_BAR __builtin_amdgcn_s_barrier()
#define PG8_SCHED __builtin_amdgcn_sched_barrier(0)
    Unit cur, nxt; int ui = 0;
    if (!S.next(0, cur)) return;
    f32x4 acc[2][2][4][2];
#pragma unroll
    for (int a = 0; a < 2; ++a)
#pragma unroll
        for (int b = 0; b < 2; ++b)
#pragma unroll
            for (int m = 0; m < 4; ++m)
#pragma unroll
                for (int n = 0; n < 2; ++n) acc[a][b][m][n] = (f32x4){0.f, 0.f, 0.f, 0.f};
    bf16x8 At[4][2], B0[2][2], B1[2][2];
    const char* cA = (const char*)g.A + (size_t)cur.pm * tstepA; const char* cB = (const char*)g.Bt + (size_t)cur.pn * tstepB;
    S.a_ready(cur);
    if constexpr (SP2) {
        PG8_STAGE(PG8_SB(0, 0), cB, voffB); PG8_STAGE(PG8_SB(0, 1), cB + hstepB, voffB); PG8_STAGE(PG8_SA(0, 0), cA, voffA); PG8_STAGE(PG8_SA(0, 1), cA + hstepA, voffA);
        if (wr == 1) PG8_BAR;
        PG8_WAIT_V(2); PG8_BAR;
        PG8_STAGE(PG8_SB(1, 0), cB + kstep, voffB); PG8_STAGE(PG8_SA(1, 0), cA + kstep, voffA); PG8_STAGE(PG8_SB(1, 1), cB + hstepB + kstep, voffB);
        PG8_WAIT_V(6); PG8_BAR;
    } else {
        PG8_STAGE(PG8_SB(0, 0), cB, voffB); PG8_STAGE(PG8_SA(0, 0), cA, voffA); PG8_STAGE(PG8_SB(0, 1), cB + hstepB, voffB); PG8_STAGE(PG8_SA(0, 1), cA + hstepA, voffA);
        if (wr == 1) PG8_BAR;
        PG8_WAIT_V(4); PG8_BAR;
        PG8_STAGE(PG8_SB(1, 0), cB + kstep, voffB); PG8_STAGE(PG8_SA(1, 0), cA + kstep, voffA); PG8_STAGE(PG8_SB(1, 1), cB + hstepB + kstep, voffB);
        PG8_WAIT_V(6); PG8_BAR;
    }
    for (;;) {
        const bool has_next = S.next(ui + 1, nxt);
        const char* nA = has_next ? (const char*)g.A + (size_t)nxt.pm * tstepA : cA; const char* nB = has_next ? (const char*)g.Bt + (size_t)nxt.pn * tstepB : cB;
        for (int t = 0; t < nt; t += 2) {
            const bool last = (t == nt - 2);
            const char* a1 = cA + (size_t)(t + 1) * kstep;
            const char* a2 = last ? nA : cA + (size_t)(t + 2) * kstep; const char* b2 = last ? nB : cB + (size_t)(t + 2) * kstep;
            const char* a3 = a2 + kstep; const char* b3 = b2 + kstep;
            if (last && has_next) S.a_ready(nxt);
            if constexpr (SP2) {
            PG8_LDB(B0, 0, 0); PG8_LDB(B1, 0, 1); PG8_SCHED; PG8_LDA(At, 0, 0); PG8_STAGE(PG8_SA(1, 1), a1 + hstepA, voffA);
            PG8_WAIT_V(8); PG8_WAIT_L(0); PG8_BAR; PG8_MMA(0, 0, At, B0); PG8_MMA(0, 1, At, B1); PG8_BAR; PG8_SCHED;
            PG8_LDA(At, 0, 1); PG8_STAGE(PG8_SB(0, 0), b2, voffB); PG8_STAGE(PG8_SB(0, 1), b2 + hstepB, voffB); PG8_STAGE(PG8_SA(0, 0), a2, voffA);
            PG8_WAIT_V(8); PG8_WAIT_L(0); PG8_BAR; PG8_MMA(1, 0, At, B0); PG8_MMA(1, 1, At, B1); PG8_BAR; PG8_SCHED;
            PG8_LDB(B0, 1, 0); PG8_LDB(B1, 1, 1); PG8_SCHED; PG8_LDA(At, 1, 0); PG8_STAGE(PG8_SA(0, 1), a2 + hstepA, voffA);
            PG8_WAIT_V(8); PG8_WAIT_L(0); PG8_BAR; PG8_MMA(0, 0, At, B0); PG8_MMA(0, 1, At, B1); PG8_BAR; PG8_SCHED;
            PG8_LDA(At, 1, 1); PG8_STAGE(PG8_SB(1, 0), b3, voffB); PG8_STAGE(PG8_SB(1, 1), b3 + hstepB, voffB); PG8_STAGE(PG8_SA(1, 0), a3, voffA);
            PG8_WAIT_V(8); PG8_WAIT_L(0); PG8_BAR; PG8_MMA(1, 0, At, B0); PG8_MMA(1, 1, At, B1); PG8_BAR; PG8_SCHED;
            } else {
            PG8_LDB(B0, 0, 0); PG8_SCHED; PG8_LDA(At, 0, 0); PG8_STAGE(PG8_SA(1, 1), a1 + hstepA, voffA);
            PG8_WAIT_L(8); PG8_BAR; PG8_WAIT_L(0); PG8_MMA(0, 0, At, B0); PG8_BAR; PG8_SCHED;
            PG8_LDB(B1, 0, 1); PG8_STAGE(PG8_SB(0, 0), b2, voffB);
            PG8_BAR; PG8_WAIT_L(0); PG8_MMA(0, 1, At, B1); PG8_BAR;
            PG8_LDA(At, 0, 1); PG8_STAGE(PG8_SA(0, 0), a2, voffA);
            PG8_BAR; PG8_WAIT_L(0); PG8_MMA(1, 0, At, B0); PG8_BAR; PG8_SCHED;
            PG8_STAGE(PG8_SB(0, 1), b2 + hstepB, voffB);
            PG8_WAIT_V(6); PG8_BAR; PG8_MMA(1, 1, At, B1); PG8_BAR;
            PG8_LDB(B0, 1, 0); PG8_SCHED; PG8_LDA(At, 1, 0); PG8_STAGE(PG8_SA(0, 1), a2 + hstepA, voffA);
            PG8_WAIT_L(8); PG8_BAR; PG8_WAIT_L(0); PG8_MMA(0, 0, At, B0); PG8_BAR; PG8_SCHED;
            PG8_LDB(B1, 1, 1); PG8_STAGE(PG8_SB(1, 0), b3, voffB);
            PG8_BAR; PG8_WAIT_L(0); PG8_MMA(0, 1, At, B1); PG8_BAR;
            PG8_LDA(At, 1, 1); PG8_STAGE(PG8_SA(1, 0), a3, voffA);
            PG8_BAR; PG8_WAIT_L(0); PG8_MMA(1, 0, At, B0); PG8_BAR; PG8_SCHED;
            PG8_STAGE(PG8_SB(1, 1), b3 + hstepB, voffB);
            PG8_WAIT_V(6); PG8_BAR; PG8_MMA(1, 1, At, B1); PG8_BAR;
            }
        }
        if constexpr (ALIGN_EPI) { if (wr == 0) PG8_BAR; }
        if constexpr (!Epi::AFTER_DRAIN) { E(acc, cur, wr, wc, fr, fq); S.done(cur); }
        if (!has_next) break;
#pragma unroll
        for (int a = 0; a < 2; ++a)
#pragma unroll
            for (int b = 0; b < 2; ++b)
#pragma unroll
                for (int m = 0; m < 4; ++m)
#pragma unroll
                    for (int n = 0; n < 2; ++n) acc[a][b][m][n] = (f32x4){0.f, 0.f, 0.f, 0.f};
        cur = nxt; cA = nA; cB = nB; ++ui;
        if constexpr (ALIGN_EPI) { if (wr == 1) PG8_BAR; }
    }
    PG8_WAIT_V(0);
    if constexpr (!ALIGN_EPI) { if (wr == 0) PG8_BAR; }
    PG8_BAR;
    if constexpr (Epi::AFTER_DRAIN) { E.fused(acc, cur, wr, wc, fr, fq, lds, wid, lane); S.done(cur); }
#undef PG8_SA
#undef PG8_SB
#undef PG8_STAGE
#undef PG8_LDA
#undef PG8_LDB
#undef PG8_MMA
#undef PG8_WAIT_V
#undef PG8_WAIT_L
#undef PG8_BAR
#undef PG8_SCHED
}
}
namespace att {
constexpr int KVBLK = 64;
constexpr int L_K = 0, L_V = 24576, L_WS = 40960, L_POSK = 43008, L_BTAB = 43264, L_END = 47392;
template <int DV> __device__ __forceinline__ int v_st(int k, int c) { const int kk = (k & ~0xC) | ((k & 4) << 1) | ((k & 8) >> 1); return ((kk >> 3) * (DV / 32) + (c >> 5)) * 512 + ((kk & 7) * 32 + (c & 31)) * 2; }
__device__ __forceinline__ int v_rd_base(int lane) { return ((lane & 3) << 3) | (((lane >> 2) & 3) << 6) | (((lane >> 4) & 1) << 5) | (((lane >> 5) & 1) << 8); }
__device__ __forceinline__ int koff(int row, int colB, int RB) { return row * RB + (colB ^ ((row & 7) << 4)); }

template <int DQK, int DV, int MODE>
__device__ __forceinline__ void attn_core(LAS unsigned char* lds, const bf16_t* qrow, const bf16_t* Kg, int ldk, const bf16_t* Vg, int ldv, int t_lo, int t_hi, float c2,
                                          int qidx, int qlo_wave, int head, const int* pos, const float* rsq, const float* cosT, const float* sinT,
                                          float& m_reg, float& l_reg, f32x16 (&o)[DV / 32]) {
    constexpr int ND = DQK / 16, NV = DV / 32, RB = DQK * 2;
    const int tid = tidx(), lane = tid & 63, r32 = lane & 31, hi = lane >> 5, wid = __builtin_amdgcn_readfirstlane(tid >> 6);
    bf16x8 qr[ND];
#pragma unroll
    for (int d0 = 0; d0 < ND; ++d0) qr[d0] = *(const bf16x8*)(qrow + d0 * 16 + hi * 8);
    if (MODE == 0) {
        const float sc = rsq[qidx] * c2;
#pragma unroll
        for (int d0 = 0; d0 < ND; ++d0) { const u32x4 w = __builtin_bit_cast(u32x4, qr[d0]);
            float v[8] = {lo_bf(w.x) * sc, hi_bf(w.x) * sc, lo_bf(w.y) * sc, hi_bf(w.y) * sc, lo_bf(w.z) * sc, hi_bf(w.z) * sc, lo_bf(w.w) * sc, hi_bf(w.w) * sc};
            if (d0 >= 8) { const int i0 = (d0 - 8) * 8 + hi * 4; const f32x4 c = *(const f32x4*)(cosT + (size_t)qidx * 32 + i0), s = *(const f32x4*)(sinT + (size_t)qidx * 32 + i0);
#pragma unroll
                for (int jj = 0; jj < 4; ++jj) { const float t1 = v[2 * jj], t2 = v[2 * jj + 1]; v[2 * jj] = t1 * c[jj] - t2 * s[jj]; v[2 * jj + 1] = t1 * s[jj] + t2 * c[jj]; } }
            qr[d0] = pack8(v); }
    }
    LAS unsigned char* K_lds = lds + L_K; LAS unsigned char* V_lds = lds + L_V;
    LAS float* al_l = (LAS float*)(lds + L_WS) + wid * 64;
    LAS int* posk = (LAS int*)(lds + L_POSK); LAS float* btab = (LAS float*)(lds + L_BTAB);
    const unsigned vb0 = (unsigned)(uintptr_t)V_lds + (unsigned)v_rd_base(lane);
    int posq = 0; if (MODE == 1) posq = pos[qidx];
    for (int t = t_lo; t < t_hi; ++t) {
        const int kbase = t * KVBLK;
        __syncthreads();
        for (int c = tid; c < 64 * (DQK / 8); c += NT_THREADS) { const int row = c / (DQK / 8), ch = c % (DQK / 8);
            *(LAS bf16x8*)(K_lds + koff(row, ch * 16, RB)) = *(const bf16x8*)(Kg + (size_t)(kbase + row) * ldk + ch * 8); }
        for (int c = tid; c < 64 * (DV / 8); c += NT_THREADS) { const int row = c / (DV / 8), ch = c % (DV / 8);
            *(LAS bf16x8*)(V_lds + v_st<DV>(row, ch * 8)) = *(const bf16x8*)(Vg + (size_t)(kbase + row) * ldv + ch * 8); }
        if (MODE == 1) { if (tid < 64) posk[tid] = pos[kbase + tid]; }
        __syncthreads();
        f32x16 p0 = {}, p1 = {};
#pragma unroll
        for (int d0 = 0; d0 < ND; ++d0) {
            const bf16x8 a0 = *(const LAS bf16x8*)(K_lds + koff(r32, (d0 * 16 + hi * 8) * 2, RB));
            const bf16x8 a1 = *(const LAS bf16x8*)(K_lds + koff(32 + r32, (d0 * 16 + hi * 8) * 2, RB));
            p0 = MFMA32(a0, qr[d0], p0); p1 = MFMA32(a1, qr[d0], p1);
        }
        if (MODE == 0) {
            if (kbase + 63 > qlo_wave) {
#pragma unroll
                for (int r = 0; r < 16; ++r) { const int kk = kbase + crow(r, hi); if (kk > qidx) p0[r] = -__builtin_inff(); if (kk + 32 > qidx) p1[r] = -__builtin_inff(); }
            }
        } else if (MODE == 1) {
#pragma unroll
            for (int r = 0; r < 16; ++r) { const int kl = crow(r, hi);
                { const int kk = kbase + kl; int dist = posq - posk[kl]; dist = dist < 0 ? 0 : (dist > 128 ? 128 : dist);
                  const float b = btab[dist * 8 + head]; p0[r] = ((unsigned)(qidx - kk) < 128u) ? fmaf(p0[r], c2, b) : -__builtin_inff(); }
                { const int kk = kbase + kl + 32; int dist = posq - posk[kl + 32]; dist = dist < 0 ? 0 : (dist > 128 ? 128 : dist);
                  const float b = btab[dist * 8 + head]; p1[r] = ((unsigned)(qidx - kk) < 128u) ? fmaf(p1[r], c2, b) : -__builtin_inff(); } }
        } else {
#pragma unroll
            for (int r = 0; r < 16; ++r) { p0[r] *= c2; p1[r] *= c2; }
        }
        float pmax = p0[0];
#pragma unroll
        for (int r = 1; r < 16; ++r) pmax = fmaxf(pmax, p0[r]);
#pragma unroll
        for (int r = 0; r < 16; ++r) pmax = fmaxf(pmax, p1[r]);
        { auto rr = __builtin_amdgcn_permlane32_swap(__float_as_uint(pmax), __float_as_uint(pmax), false, false); pmax = fmaxf(__uint_as_float(rr[0]), __uint_as_float(rr[1])); }
        const float mn = fmaxf(m_reg, pmax); const float alpha = __builtin_amdgcn_exp2f(m_reg - mn); m_reg = mn;
        float ps = 0.f;
#pragma unroll
        for (int r = 0; r < 16; ++r) { p0[r] = __builtin_amdgcn_exp2f(p0[r] - mn); ps += p0[r]; }
#pragma unroll
        for (int r = 0; r < 16; ++r) { p1[r] = __builtin_amdgcn_exp2f(p1[r] - mn); ps += p1[r]; }
        { auto rr = __builtin_amdgcn_permlane32_swap(__float_as_uint(ps), __float_as_uint(ps), false, false); ps = __uint_as_float(rr[0]) + __uint_as_float(rr[1]); }
        l_reg = l_reg * alpha + ps;
        if (__any(alpha < 1.f)) {
            if (hi == 0) al_l[r32] = alpha;
            LDS_WAIT();
#pragma unroll
            for (int g = 0; g < 4; ++g) { const f32x4 a4 = *(const LAS f32x4*)(al_l + 8 * g + 4 * hi);
#pragma unroll
                for (int d = 0; d < NV; ++d) { o[d][4 * g + 0] *= a4[0]; o[d][4 * g + 1] *= a4[1]; o[d][4 * g + 2] *= a4[2]; o[d][4 * g + 3] *= a4[3]; } }
        }
        bf16x8 pa0, pa1, pa2, pa3;
#define PK4(P, B_, OUT) do { const unsigned a0_ = cvtpk(P[B_ + 0], P[B_ + 1]), a1_ = cvtpk(P[B_ + 2], P[B_ + 3]), b0_ = cvtpk(P[B_ + 4], P[B_ + 5]), b1_ = cvtpk(P[B_ + 6], P[B_ + 7]); \
        auto r0_ = __builtin_amdgcn_permlane32_swap(a0_, b0_, false, false); auto r1_ = __builtin_amdgcn_permlane32_swap(a1_, b1_, false, false); \
        u32x4 w_ = {r0_[0], r1_[0], r0_[1], r1_[1]}; OUT = __builtin_bit_cast(bf16x8, w_); } while (0)
        PK4(p0, 0, pa0); PK4(p0, 8, pa1); PK4(p1, 0, pa2); PK4(p1, 8, pa3);
#undef PK4
#define TRRD(dst, off) asm volatile("ds_read_b64_tr_b16 %0, %1 offset:%2" : "=&v"(dst) : "v"(vb0), "i"(off) : "memory")
#pragma unroll
        for (int d0 = 0; d0 < NV; ++d0) {
            s16x4 l0, l1, l2, l3, h0, h1, h2, h3; constexpr int KS = NV * 1024, HF = NV * 512; const int b_ = d0 * 512;
            if (d0 == 0) { TRRD(l0, 0); TRRD(h0, HF); TRRD(l1, KS); TRRD(h1, KS + HF); TRRD(l2, 2 * KS); TRRD(h2, 2 * KS + HF); TRRD(l3, 3 * KS); TRRD(h3, 3 * KS + HF); }
            else if (d0 == 1) { TRRD(l0, 512); TRRD(h0, 512 + HF); TRRD(l1, 512 + KS); TRRD(h1, 512 + KS + HF); TRRD(l2, 512 + 2 * KS); TRRD(h2, 512 + 2 * KS + HF); TRRD(l3, 512 + 3 * KS); TRRD(h3, 512 + 3 * KS + HF); }
            else if (d0 == 2) { TRRD(l0, 1024); TRRD(h0, 1024 + HF); TRRD(l1, 1024 + KS); TRRD(h1, 1024 + KS + HF); TRRD(l2, 1024 + 2 * KS); TRRD(h2, 1024 + 2 * KS + HF); TRRD(l3, 1024 + 3 * KS); TRRD(h3, 1024 + 3 * KS + HF); }
            else { TRRD(l0, 1536); TRRD(h0, 1536 + HF); TRRD(l1, 1536 + KS); TRRD(h1, 1536 + KS + HF); TRRD(l2, 1536 + 2 * KS); TRRD(h2, 1536 + 2 * KS + HF); TRRD(l3, 1536 + 3 * KS); TRRD(h3, 1536 + 3 * KS + HF); }
            (void)b_;
            asm volatile("s_waitcnt lgkmcnt(0)" ::: "memory"); SBAR();
            o[d0] = MFMA32(pa0, ((bf16x8){l0[0], l0[1], l0[2], l0[3], h0[0], h0[1], h0[2], h0[3]}), o[d0]);
            o[d0] = MFMA32(pa1, ((bf16x8){l1[0], l1[1], l1[2], l1[3], h1[0], h1[1], h1[2], h1[3]}), o[d0]);
            o[d0] = MFMA32(pa2, ((bf16x8){l2[0], l2[1], l2[2], l2[3], h2[0], h2[1], h2[2], h2[3]}), o[d0]);
            o[d0] = MFMA32(pa3, ((bf16x8){l3[0], l3[1], l3[2], l3[3], h3[0], h3[1], h3[2], h3[3]}), o[d0]);
        }
#undef TRRD
    }
}
__device__ __forceinline__ void row_recip(LAS float* li_l, float l_reg, int r32, int hi, float (&rli)[16]) {
    asm volatile("s_waitcnt lgkmcnt(0)" ::: "memory");
    if (hi == 0) li_l[r32] = l_reg;
    asm volatile("s_waitcnt lgkmcnt(0)" ::: "memory");
#pragma unroll
    for (int g = 0; g < 4; ++g) { const f32x4 a4 = *(const LAS f32x4*)(li_l + 8 * g + 4 * hi); rli[4 * g] = 1.f / a4[0]; rli[4 * g + 1] = 1.f / a4[1]; rli[4 * g + 2] = 1.f / a4[2]; rli[4 * g + 3] = 1.f / a4[3]; }
}

__device__ __forceinline__ void mla_unit(LAS unsigned char* lds, int qb, int h, const bf16_t* QABS, const bf16_t* KVLAT, bf16_t* PROJ, const float* rsq, const float* cosT, const float* sinT, float qscale) {
    const int tid = tidx(), lane = tid & 63, r32 = lane & 31, hi = lane >> 5, wid = __builtin_amdgcn_readfirstlane(tid >> 6);
    const int q0 = qb * 256 + wid * 32;
    float m = -1e30f, l = 0.f; f32x16 o[4] = {};
    attn_core<192, 128, 0>(lds, QABS + (size_t)(q0 + r32) * 768 + h * 192, KVLAT, 192, KVLAT, 192, 0, 4 * (qb + 1), qscale, q0 + r32, q0, 0, nullptr, rsq, cosT, sinT, m, l, o);
    LAS float* li_l = (LAS float*)(lds + L_WS) + wid * 64; float rli[16]; row_recip(li_l, l, r32, hi, rli);
#pragma unroll
    for (int r = 0; r < 16; ++r) { bf16_t* op = PROJ + (size_t)(q0 + crow(r, hi)) * NP + C_OLAT + h * 128 + r32;
#pragma unroll
        for (int d0 = 0; d0 < 4; ++d0) op[d0 * 32] = f2bf(o[d0][r] * rli[r]); }
}
__device__ __forceinline__ void swa_unit(LAS unsigned char* lds, int qb, int hk, bf16_t* PROJ, const int* pos, const float* sinks  , const float* btab_g) {
    const int tid = tidx(), lane = tid & 63, r32 = lane & 31, hi = lane >> 5, wid = __builtin_amdgcn_readfirstlane(tid >> 6);
    const int head = hk * 4 + (wid >> 1), q0 = qb * 64 + (wid & 1) * 32;
    __syncthreads();
    for (int i = tid; i < 129 * 8; i += NT_THREADS) ((LAS float*)(lds + L_BTAB))[i] = btab_g[i];
    const float sink = sinks[head] * LOG2E;
    float m = sink, l = 1.f; f32x16 o[2] = {};
    int t_lo = (qb * 64 - 128) / 64; if (t_lo < 0) t_lo = 0;
    attn_core<64, 64, 1>(lds, PROJ + (size_t)(q0 + r32) * NP + C_AQ + head * 64, PROJ + C_AK + hk * 64, NP, PROJ + C_AV + hk * 64, NP, t_lo, qb + 1, 0.125f * LOG2E,
                         q0 + r32, q0, head, pos, nullptr, nullptr, nullptr, m, l, o);
    LAS float* li_l = (LAS float*)(lds + L_WS) + wid * 64; float rli[16]; row_recip(li_l, l, r32, hi, rli);
#pragma unroll
    for (int r = 0; r < 16; ++r) { bf16_t* op = PROJ + (size_t)(q0 + crow(r, hi)) * NP + C_Z + head * 64 + r32;
#pragma unroll
        for (int d0 = 0; d0 < 2; ++d0) { const float z = bf2f(op[d0 * 32]); op[d0 * 32] = f2bf(o[d0][r] * rli[r] * silu_f(z)); } }
}
__device__ __forceinline__ void cross_unit(LAS unsigned char* lds, int qb, int h, bf16_t* PROJ, const bf16_t* MEMKV  ) {
    const int tid = tidx(), lane = tid & 63, r32 = lane & 31, hi = lane >> 5, wid = __builtin_amdgcn_readfirstlane(tid >> 6);
    const int q0 = qb * 256 + wid * 32;
    float m = -1e30f, l = 0.f; f32x16 o[4] = {};
    attn_core<128, 128, 2>(lds, PROJ + (size_t)(q0 + r32) * NP + C_DQ + h * 128, MEMKV + h * 128, 1024, MEMKV + 512 + h * 128, 1024, 0, 4, 0.08838834764831845f * LOG2E,
                           q0 + r32, q0, 0, nullptr, nullptr, nullptr, nullptr, m, l, o);
    LAS float* li_l = (LAS float*)(lds + L_WS) + wid * 64; float rli[16]; row_recip(li_l, l, r32, hi, rli);
#pragma unroll
    for (int r = 0; r < 16; ++r) { bf16_t* op = PROJ + (size_t)(q0 + crow(r, hi)) * NP + C_Z + 1536 + h * 128 + r32;
#pragma unroll
        for (int d0 = 0; d0 < 4; ++d0) { const float z = bf2f(op[d0 * 32]); op[d0 * 32] = f2bf(o[d0][r] * rli[r] * silu_f(z)); } }
}
}
template <class Map>
__device__ __forceinline__ void transpose_tile(const float* W, int ldw, bf16_t* WT, int K, int n0, int k0, LAS float* tile, Map map) {
    const int tid = tidx();
    { const int n = tid & 63, src = map(n0 + n);
#pragma unroll
      for (int i = 0; i < 8; ++i) { const int k = (tid >> 6) + 8 * i; tile[k * 65 + n] = src >= 0 ? W[(size_t)(k0 + k) * ldw + src] : 0.f; } }
    __syncthreads();
    { const int n = tid >> 3, kc = (tid & 7) * 8; float v[8];
#pragma unroll
      for (int j = 0; j < 8; ++j) v[j] = tile[(kc + j) * 65 + n];
      u32x4 w = {cvtpk(v[0], v[1]), cvtpk(v[2], v[3]), cvtpk(v[4], v[5]), cvtpk(v[6], v[7])};
      *(u32x4*)(WT + (size_t)(n0 + n) * K + k0 + kc) = w; }
    __syncthreads();
}
struct MapWin { __device__ int operator()(int n) const { return win_src(n); } };
struct MapId { __device__ int operator()(int n) const { return n; } };

__device__ __forceinline__ void job_win(const Params& p, int l, int vb, int nb, LAS unsigned char* lds) {
    bf16_t* WT = (bf16_t*)(p.ws + WS_WIN); const float* W = p.w_in + (size_t)l * DM * DIN;
    for (int t = vb; t < (NP / 64) * (DM / 64); t += nb) transpose_tile(W, DIN, WT, DM, (t / (DM / 64)) * 64, (t % (DM / 64)) * 64, (LAS float*)lds, MapWin());
}
__device__ __forceinline__ void job_wout(const Params& p, int l, int vb, int nb, LAS unsigned char* lds) {
    bf16_t* WT = (bf16_t*)(p.ws + WS_WOUT); const float* W = p.w_out + (size_t)l * MIXW * DM;
    for (int t = vb; t < (DM / 64) * (MIXW / 64); t += nb) transpose_tile(W, DM, WT, MIXW, (t / (MIXW / 64)) * 64, (t % (MIXW / 64)) * 64, (LAS float*)lds, MapId());
}
__device__ __forceinline__ void job_wmem(const Params& p, int vb, int nb, LAS unsigned char* lds) {
    for (int t = vb; t < 2 * 16 * 16; t += nb) { const int l = t >> 8, r = t & 255;
        transpose_tile(p.w_mem + (size_t)l * DM * DM, DM, (bf16_t*)(p.ws + WS_WMEM) + (size_t)l * DM * DM, DM, (r >> 4) * 64, (r & 15) * 64, (LAS float*)lds, MapId()); }
}
__device__ __forceinline__ void job_wq(const Params& p, int gtid, int gn) {
    for (int idx = gtid; idx < 2 * 768 * 256; idx += gn) {
        const int l = idx / (768 * 256), r = idx % (768 * 256), n = r / 256, k = r % 256;
        const float* uq = p.w_uq + (size_t)l * 256 * 768 + (size_t)k * 768; const float* ukv = p.w_ukv + (size_t)l * 128 * 1024;
        float v;
        const int h = n / 192, c = n % 192;
        if (c < 128) { float s = 0.f;
            for (int j = 0; j < 128; ++j) s = fmaf(uq[h * 192 + j], ukv[(size_t)c * 1024 + h * 256 + j], s);
            v = s;
        } else { const int w = c - 128, i = w >> 1, which = w & 1; v = uq[h * 192 + 128 + i + 32 * which]; }
        ((bf16_t*)(p.ws + WS_WQ))[idx] = f2bf(v * p.q_norm[l * 256 + k]);
    }
}
__device__ __forceinline__ void job_wuv(const Params& p, int gtid, int gn) {
    for (int idx = gtid; idx < 2 * 512 * 512; idx += gn) {
        const int l = idx / (512 * 512), r = idx % (512 * 512), n = r / 512, k = r % 512, h = n >> 7;
        const float v = (k >> 7) == h ? p.w_ukv[(size_t)l * 128 * 1024 + (size_t)(k & 127) * 1024 + h * 256 + 128 + (n & 127)] : 0.f;
        ((bf16_t*)(p.ws + WS_WUV))[idx] = f2bf(v);
    }
}
__device__ __forceinline__ void job_rope(const Params& p, int gtid, int gn) {
    float* cosT = (float*)(p.ws + WS_COS); float* sinT = (float*)(p.ws + WS_SIN);
    for (int idx = gtid; idx < S * 32; idx += gn) {
        const int s = idx >> 5, i = idx & 31;
        const float angf = (float)p.pos[s] * inv_freq(i);
        const double a = (double)angf; const double kq = __builtin_rint(a * 0.63661977236758134308);
        const double x = (a - kq * 1.5707963267948966192) - kq * 6.123233995736766036e-17;
        const double x2 = x * x;
        const double sn = x * (1.0 + x2 * (-1.0 / 6 + x2 * (1.0 / 120 + x2 * (-1.0 / 5040 + x2 * (1.0 / 362880 + x2 * (-1.0 / 39916800 + x2 * (1.0 / 6227020800.0)))))));
        const double cs = 1.0 + x2 * (-0.5 + x2 * (1.0 / 24 + x2 * (-1.0 / 720 + x2 * (1.0 / 40320 + x2 * (-1.0 / 3628800 + x2 * (1.0 / 479001600.0 + x2 * (-1.0 / 87178291200.0)))))));
        const int q = ((int)kq) & 3;
        const double c = (q == 0) ? cs : (q == 1) ? -sn : (q == 2) ? -cs : sn;
        const double sv = (q == 0) ? sn : (q == 1) ? cs : (q == 2) ? -sn : -cs;
        cosT[idx] = (float)c; sinT[idx] = (float)sv;
    }
}
__device__ __forceinline__ void job_btab(const Params& p, int gtid, int gn) {
    float* bt = (float*)(p.ws + WS_MISC + MISC_BTAB);
    for (int idx = gtid; idx < 129 * 8; idx += gn) { const int d = idx >> 3, h = idx & 7; bt[idx] = p.rel_bias[t5_bucket(d) * 8 + h] * LOG2E; }
}
__device__ __forceinline__ void rms_row_to_bf16(const float* xrow, const float* gain, bf16_t* orow, int lane) {
    f32x4 v[4]; float ss = 0.f;
#pragma unroll
    for (int j = 0; j < 4; ++j) { v[j] = *(const f32x4*)(xrow + 256 * j + 4 * lane); ss += (v[j].x * v[j].x + v[j].y * v[j].y) + (v[j].z * v[j].z + v[j].w * v[j].w); }
    const float rs = rsqrtf(wave_sum(ss) * (1.f / DM) + RMS_EPS);
#pragma unroll
    for (int j = 0; j < 4; ++j) { const f32x4 g = *(const f32x4*)(gain + 256 * j + 4 * lane);
        u32x2 w; w.x = cvtpk(v[j].x * rs * g.x, v[j].y * rs * g.y); w.y = cvtpk(v[j].z * rs * g.z, v[j].w * rs * g.w);
        *(u32x2*)(orow + 256 * j + 4 * lane) = w; }
}
__device__ __forceinline__ void job_memn(const Params& p, int gw, int ngw, int lane) {
    for (int r = gw; r < 2 * MEML; r += ngw) { const int l = r >> 8, m = r & 255;
        rms_row_to_bf16(p.mem + (size_t)m * DM, p.mem_norm + l * DM, (bf16_t*)(p.ws + WS_MEMN) + ((size_t)l * MEML + m) * DM, lane); }
}
__device__ __forceinline__ void job_norm_rows(const Params& p, int mode, int gw, int ngw, int lane) {
    bf16_t* H = (bf16_t*)(p.ws + WS_H); const bf16_t* Y = (const bf16_t*)(p.ws + WS_Y);
    for (int row = gw; row < S; row += ngw) {
        if (mode == 0) { rms_row_to_bf16(p.x + (size_t)row * DM, p.norm_pre, H + (size_t)row * DM, lane); continue; }
        const float* xin = (mode == 1 ? p.x : p.out) + (size_t)row * DM; const float* gpost = p.norm_post + (mode == 1 ? 0 : DM);
        float y[16]; float ss = 0.f;
#pragma unroll
        for (int j = 0; j < 4; ++j) { const u32x2 w = *(const u32x2*)(Y + (size_t)row * DM + 256 * j + 4 * lane);
            y[4 * j] = lo_bf(w.x); y[4 * j + 1] = hi_bf(w.x); y[4 * j + 2] = lo_bf(w.y); y[4 * j + 3] = hi_bf(w.y);
            ss += (y[4 * j] * y[4 * j] + y[4 * j + 1] * y[4 * j + 1]) + (y[4 * j + 2] * y[4 * j + 2] + y[4 * j + 3] * y[4 * j + 3]); }
        const float rs = rsqrtf(wave_sum(ss) * (1.f / DM) + RMS_EPS);
        f32x4 x1[4]; float s2 = 0.f;
#pragma unroll
        for (int j = 0; j < 4; ++j) { const f32x4 xv = *(const f32x4*)(xin + 256 * j + 4 * lane); const f32x4 g = *(const f32x4*)(gpost + 256 * j + 4 * lane);
            x1[j].x = xv.x + y[4 * j] * rs * g.x; x1[j].y = xv.y + y[4 * j + 1] * rs * g.y; x1[j].z = xv.z + y[4 * j + 2] * rs * g.z; x1[j].w = xv.w + y[4 * j + 3] * rs * g.w;
            *(f32x4*)(p.out + (size_t)row * DM + 256 * j + 4 * lane) = x1[j];
            s2 += (x1[j].x * x1[j].x + x1[j].y * x1[j].y) + (x1[j].z * x1[j].z + x1[j].w * x1[j].w); }
        if (mode == 1) { const float r2 = rsqrtf(wave_sum(s2) * (1.f / DM) + RMS_EPS); const float* gpre = p.norm_pre + DM;
#pragma unroll
            for (int j = 0; j < 4; ++j) { const f32x4 g = *(const f32x4*)(gpre + 256 * j + 4 * lane);
                u32x2 w; w.x = cvtpk(x1[j].x * r2 * g.x, x1[j].y * r2 * g.y); w.y = cvtpk(x1[j].z * r2 * g.z, x1[j].w * r2 * g.w);
                *(u32x2*)(H + (size_t)row * DM + 256 * j + 4 * lane) = w; } }
    }
}
__device__ __forceinline__ void job_mla_rows(const Params& p, int l, int gw, int ngw, int lane) {
    const bf16_t* PROJ = (const bf16_t*)(p.ws + WS_PROJ); bf16_t* KV = (bf16_t*)(p.ws + WS_KVLAT); float* RSQ = (float*)(p.ws + WS_MISC + MISC_RSQ);
    const float* cosT = (const float*)(p.ws + WS_COS); const float* sinT = (const float*)(p.ws + WS_SIN);
    for (int row = gw; row < S; row += ngw) {
        const bf16_t* pr = PROJ + (size_t)row * NP;
        { const u32x2 w = *(const u32x2*)(pr + C_CQ + 4 * lane); const float a = lo_bf(w.x), b = hi_bf(w.x), c = lo_bf(w.y), d = hi_bf(w.y);
          const float ss = wave_sum((a * a + b * b) + (c * c + d * d)); if (lane == 0) RSQ[row] = rsqrtf(ss * (1.f / 256.f) + RMS_EPS); }
        { const unsigned w = *(const unsigned*)(pr + C_CKV + 2 * lane); const float a = lo_bf(w), b = hi_bf(w);
          const float rs = rsqrtf(wave_sum(a * a + b * b) * (1.f / 128.f) + RMS_EPS); const float* g = p.kv_norm + l * 128 + 2 * lane;
          *(unsigned*)(KV + (size_t)row * 192 + 2 * lane) = cvtpk(a * rs * g[0], b * rs * g[1]); }
        if (lane < 32) { const float t1 = bf2f(pr[C_KR + lane]), t2 = bf2f(pr[C_KR + 32 + lane]); const float c = cosT[(size_t)row * 32 + lane], s = sinT[(size_t)row * 32 + lane];
          *(unsigned*)(KV + (size_t)row * 192 + 128 + 2 * lane) = cvtpk(t1 * c - t2 * s, t1 * s + t2 * c); }
    }
}
__device__ __forceinline__ void job_gdn_final(const Params& p, int l, int gw, int ngw, int lane) {
    bf16_t* PROJ = (bf16_t*)(p.ws + WS_PROJ); const bf16_t* U = (const bf16_t*)(p.ws + WS_U);
    for (int row = gw; row < S; row += ngw) {
        const u32x4 w = *(const u32x4*)(U + (size_t)row * 512 + 8 * lane);
        float v[8] = {lo_bf(w.x), hi_bf(w.x), lo_bf(w.y), hi_bf(w.y), lo_bf(w.z), hi_bf(w.z), lo_bf(w.w), hi_bf(w.w)};
        float ss = 0.f;
#pragma unroll
        for (int j = 0; j < 8; ++j) ss += v[j] * v[j];
        ss += __shfl_xor(ss, 1); ss += __shfl_xor(ss, 2); ss += __shfl_xor(ss, 4); ss += __shfl_xor(ss, 8);
        const float rs = rsqrtf(ss * (1.f / 128.f) + RMS_EPS);
        bf16_t* zp = PROJ + (size_t)row * NP + C_Z + 512 + 8 * lane; const u32x4 z = *(const u32x4*)zp;
        const float zz[8] = {lo_bf(z.x), hi_bf(z.x), lo_bf(z.y), hi_bf(z.y), lo_bf(z.z), hi_bf(z.z), lo_bf(z.w), hi_bf(z.w)};
        const float* g = p.gdn_norm + l * 128 + (8 * lane & 127); float o[8];
#pragma unroll
        for (int j = 0; j < 8; ++j) o[j] = v[j] * rs * g[j] * silu_f(zz[j]);
        u32x4 ow = {cvtpk(o[0], o[1]), cvtpk(o[2], o[3]), cvtpk(o[4], o[5]), cvtpk(o[6], o[7])};
        *(u32x4*)zp = ow;
    }
}
namespace gdn {
constexpr int L_QH = 0, L_KH = 17408, L_KBGT = 34816, L_KHDT = 53248, L_VBT = 71680, L_LF = 90112, L_TB = 107520, L_GV = 116736, L_END = 118016;
constexpr int QP = 136, TP = 72, LP = 68;
__device__ __forceinline__ bf16_t* frag_ptr(bf16_t* PROJ, int n, int h, int f, int lane) {
    const int seg = 4 * f + (lane >> 4), part = seg >> 6, row = seg & 63;
    return PROJ + (size_t)(n * 64 + row) * NP + C_BQKV + part * 512 + h * 128 + (lane & 15) * 8;
}
__device__ __forceinline__ void prep_item(const Params& p, int l, int n, int h, LAS unsigned char* lds) {
    const int tid = tidx(), lane = tid & 63, r32 = lane & 31, hi = lane >> 5, wid = __builtin_amdgcn_readfirstlane(tid >> 6);
    bf16_t* PROJ = (bf16_t*)(p.ws + WS_PROJ); const bf16_t* HALO = (const bf16_t*)(p.ws + WS_HALO);
    bf16_t* AQKg = (bf16_t*)(p.ws + WS_AQK); bf16_t* Ug = (bf16_t*)(p.ws + WS_U); float* EGL = (float*)(p.ws + WS_MISC + MISC_EGL);
    LAS bf16_t* QH = (LAS bf16_t*)(lds + L_QH); LAS bf16_t* KH = (LAS bf16_t*)(lds + L_KH); LAS bf16_t* KBGT = (LAS bf16_t*)(lds + L_KBGT);
    LAS bf16_t* KHDT = (LAS bf16_t*)(lds + L_KHDT); LAS bf16_t* VBT = (LAS bf16_t*)(lds + L_VBT); LAS float* LF = (LAS float*)(lds + L_LF);
    LAS bf16_t* TB = (LAS bf16_t*)(lds + L_TB); LAS float* GC = (LAS float*)(lds + L_GV); LAS float* BETA = GC + 64; LAS float* EGC = GC + 128; LAS float* EGD = GC + 192;
    const int t0 = n * 64;
    __syncthreads();
    if (wid == 0) {
        const bf16_t* pr = PROJ + (size_t)(t0 + lane) * NP;
        const float xa = bf2f(pr[C_BA + h]) + p.dt_bias[l * 4 + h], xb = bf2f(pr[C_BB + h]);
        const float e = __expf(xa); const float sp = xa > 20.f ? xa : (e < 1e-3f ? e * (1.f - e * (0.5f - e * (1.f / 3.f))) : logf(1.f + e));
        float gc = -__expf(p.a_log[l * 4 + h]) * sp;
#pragma unroll
        for (int o = 1; o < 64; o <<= 1) { const float t_ = __shfl_up(gc, o); if (lane >= o) gc += t_; }
        const float gl = __shfl(gc, 63);
        GC[lane] = gc; BETA[lane] = 1.f / (1.f + __expf(-xb)); EGC[lane] = __expf(gc); EGD[lane] = __expf(gl - gc);
        if (lane == 0) EGL[n * 4 + h] = __expf(gl);
    }
    __syncthreads();
#pragma unroll 1
    for (int it = 0; it < 6; ++it) {
        const int idx = tid + NT_THREADS * it, g16 = idx & 15, pr_ = idx >> 4, part = pr_ >> 6, row = pr_ & 63, cb = part * 512 + h * 128 + g16 * 8;
        float a[8] = {0.f, 0.f, 0.f, 0.f, 0.f, 0.f, 0.f, 0.f};
#pragma unroll
        for (int j = 0; j < 4; ++j) { const int t = t0 + row - 3 + j; u32x4 xw = {0u, 0u, 0u, 0u};
            if (t >= t0) xw = *(const u32x4*)(PROJ + (size_t)t * NP + C_BQKV + cb);
            else if (n > 0) xw = *(const u32x4*)(HALO + ((size_t)(n - 1) * 3 + (t - (t0 - 3))) * 1536 + cb);
            const float* cw = p.conv_w + ((size_t)l * 4 + j) * 1536 + cb; const f32x4 w0 = *(const f32x4*)cw, w1 = *(const f32x4*)(cw + 4);
            a[0] = fmaf(w0[0], lo_bf(xw.x), a[0]); a[1] = fmaf(w0[1], hi_bf(xw.x), a[1]); a[2] = fmaf(w0[2], lo_bf(xw.y), a[2]); a[3] = fmaf(w0[3], hi_bf(xw.y), a[3]);
            a[4] = fmaf(w1[0], lo_bf(xw.z), a[4]); a[5] = fmaf(w1[1], hi_bf(xw.z), a[5]); a[6] = fmaf(w1[2], lo_bf(xw.w), a[6]); a[7] = fmaf(w1[3], hi_bf(xw.w), a[7]); }
        float ss = 0.f;
#pragma unroll
        for (int e = 0; e < 8; ++e) { a[e] = silu_f(a[e]); ss += a[e] * a[e]; }
        ss += __shfl_xor(ss, 1); ss += __shfl_xor(ss, 2); ss += __shfl_xor(ss, 4); ss += __shfl_xor(ss, 8);
        const float rn = rsqrtf(ss + 1e-6f);
        if (part == 0) { const float sc = rn * 0.08838834764831845f;
#pragma unroll
            for (int e = 0; e < 8; ++e) a[e] *= sc;
            *(LAS bf16x8*)(QH + row * QP + g16 * 8) = pack8(a);
        } else if (part == 1) {
#pragma unroll
            for (int e = 0; e < 8; ++e) a[e] *= rn;
            *(LAS bf16x8*)(KH + row * QP + g16 * 8) = pack8(a);
            const float s1 = BETA[row] * EGC[row], s2 = EGD[row];
#pragma unroll
            for (int e = 0; e < 8; ++e) { KBGT[(g16 * 8 + e) * TP + row] = f2bf(a[e] * s1); KHDT[(g16 * 8 + e) * TP + row] = f2bf(a[e] * s2); }
        } else { const float b = BETA[row];
#pragma unroll
            for (int e = 0; e < 8; ++e) VBT[(g16 * 8 + e) * TP + row] = f2bf(a[e] * b);
        }
    }
    __syncthreads();
    if (wid < 3) { const int it = wid > 0, jt = wid > 1; f32x16 acc = {};
#pragma unroll
        for (int ks = 0; ks < 8; ++ks) { const bf16x8 a = *(const LAS bf16x8*)(KH + (32 * it + r32) * QP + 16 * ks + 8 * hi), b = *(const LAS bf16x8*)(KH + (32 * jt + r32) * QP + 16 * ks + 8 * hi);
            acc = MFMA32(a, b, acc); }
        const int j = 32 * jt + r32; const float gj = GC[j];
#pragma unroll
        for (int r = 0; r < 16; ++r) { const int i = 32 * it + crow(r, hi); LF[i * LP + j] = i > j ? BETA[i] * __expf(GC[i] - gj) * acc[r] : 0.f; }
    } else if (wid < 6) { const int w = wid - 3, ctp = w > 1, ct = w > 0; f32x16 acc = {};
#pragma unroll
        for (int ks = 0; ks < 8; ++ks) { const bf16x8 a = *(const LAS bf16x8*)(KH + (32 * ctp + r32) * QP + 16 * ks + 8 * hi), b = *(const LAS bf16x8*)(QH + (32 * ct + r32) * QP + 16 * ks + 8 * hi);
            acc = MFMA32(a, b, acc); }
        const int c = 32 * ct + r32; const float gcq = GC[c];
#pragma unroll
        for (int r = 0; r < 16; ++r) { const int cp = 32 * ctp + crow(r, hi); acc[r] = c >= cp ? acc[r] * __expf(gcq - GC[cp]) : 0.f; }
        bf16_t* dst = AQKg + (((size_t)(n * 4 + h) * 8 + (ct * 2 + ctp) * 2) * 64 + lane) * 8;
        *(bf16x8*)dst = pack_step(acc, 0); *(bf16x8*)(dst + 512) = pack_step(acc, 1);
    } else { const int w = wid - 6;
        if (w == 0) { const bf16x8 z = {0, 0, 0, 0, 0, 0, 0, 0}; bf16_t* dst = AQKg + (((size_t)(n * 4 + h) * 8 + 2) * 64 + lane) * 8; *(bf16x8*)dst = z; *(bf16x8*)(dst + 512) = z; }
#pragma unroll
        for (int ff = 0; ff < 8; ++ff) { const int f = w * 8 + ff, s = f & 1, mt = (f >> 1) & 3, ct = f >> 3, c = 32 * ct + r32, d0 = 32 * mt + 16 * s + 4 * hi; const float eg = EGC[c];
            const u32x2 lo = *(const LAS u32x2*)(QH + c * QP + d0), hw = *(const LAS u32x2*)(QH + c * QP + d0 + 8);
            u32x4 o; o.x = cvtpk(lo_bf(lo.x) * eg, hi_bf(lo.x) * eg); o.y = cvtpk(lo_bf(lo.y) * eg, hi_bf(lo.y) * eg); o.z = cvtpk(lo_bf(hw.x) * eg, hi_bf(hw.x) * eg); o.w = cvtpk(lo_bf(hw.y) * eg, hi_bf(hw.y) * eg);
            *(u32x4*)frag_ptr(PROJ, n, h, 16 + f, lane) = o; }
    }
    __syncthreads();
    if (wid == 0) {
        float T[64];
        unsigned lfb = (unsigned)(uintptr_t)LF; asm volatile("" : "+v"(lfb));
        const LAS float* LFv = (const LAS float*)(uintptr_t)lfb;
#pragma unroll
        for (int i = 0; i < 64; ++i) { float acc = (lane == i) ? 1.f : 0.f;
#pragma unroll
            for (int j = 0; j < i; ++j) acc = fmaf(-LFv[i * LP + j], T[j], acc);
            T[i] = acc; }
#pragma unroll
        for (int i = 0; i < 64; ++i) TB[i * TP + lane] = f2bf(T[i]);
    } else {
        for (int f = wid - 1; f < 16; f += 7) { const int s = f & 1, ctp = (f >> 1) & 1, mt = f >> 2, dk = 32 * mt + r32, c0 = 32 * ctp + 16 * s + 4 * hi;
            const u32x2 lo = *(const LAS u32x2*)(KHDT + dk * TP + c0), hw = *(const LAS u32x2*)(KHDT + dk * TP + c0 + 8);
            u32x4 o = {lo.x, lo.y, hw.x, hw.y}; *(u32x4*)frag_ptr(PROJ, n, h, 32 + f, lane) = o; }
    }
    __syncthreads();
    { const int mt = wid >> 1, ct = wid & 1; f32x16 acc = {};
#pragma unroll
      for (int ks = 0; ks < 4; ++ks) { const bf16x8 a = *(const LAS bf16x8*)(KBGT + (32 * mt + r32) * TP + 16 * ks + 8 * hi), b = *(const LAS bf16x8*)(TB + (32 * ct + r32) * TP + 16 * ks + 8 * hi);
          acc = MFMA32(a, b, acc); }
#pragma unroll
      for (int r = 0; r < 16; ++r) acc[r] = -acc[r];
      *(bf16x8*)frag_ptr(PROJ, n, h, (ct * 4 + mt) * 2, lane) = pack_step(acc, 0); *(bf16x8*)frag_ptr(PROJ, n, h, (ct * 4 + mt) * 2 + 1, lane) = pack_step(acc, 1); }
    { const int ct = wid >> 2, dt = wid & 3; f32x16 acc = {};
#pragma unroll
      for (int ks = 0; ks < 4; ++ks) { const bf16x8 a = *(const LAS bf16x8*)(TB + (32 * ct + r32) * TP + 16 * ks + 8 * hi), b = *(const LAS bf16x8*)(VBT + (32 * dt + r32) * TP + 16 * ks + 8 * hi);
          acc = MFMA32(a, b, acc); }
#pragma unroll
      for (int r = 0; r < 16; ++r) Ug[(size_t)(t0 + 32 * ct + crow(r, hi)) * 512 + h * 128 + 32 * dt + r32] = f2bf(acc[r]); }
}
__device__ __forceinline__ void scan_wave(const Params& p, int h, int sl, int lane) {
    const int r32 = lane & 31, hi = lane >> 5;
    bf16_t* PROJ = (bf16_t*)(p.ws + WS_PROJ); const bf16_t* AQKg = (const bf16_t*)(p.ws + WS_AQK); bf16_t* Ug = (bf16_t*)(p.ws + WS_U); const float* EGL = (const float*)(p.ws + WS_MISC + MISC_EGL);
    f32x16 St[4] = {};
#pragma unroll 1
    for (int n = 0; n < S / 64; ++n) {
        const float egl = EGL[n * 4 + h];
        bf16_t* ub = Ug + (size_t)(n * 64) * 512 + h * 128 + sl * 32 + r32;
        f32x16 vn[2], o[2] = {};
#pragma unroll
        for (int ct = 0; ct < 2; ++ct)
#pragma unroll
            for (int r = 0; r < 16; ++r) vn[ct][r] = bf2f(ub[(size_t)(32 * ct + crow(r, hi)) * 512]);
        bf16x8 Sb[4][2];
#pragma unroll
        for (int mt = 0; mt < 4; ++mt) { Sb[mt][0] = pack_step(St[mt], 0); Sb[mt][1] = pack_step(St[mt], 1); }
#pragma unroll
        for (int ct = 0; ct < 2; ++ct)
#pragma unroll
            for (int mt = 0; mt < 4; ++mt)
#pragma unroll
                for (int s = 0; s < 2; ++s) { const int f = (ct * 4 + mt) * 2 + s;
                    vn[ct] = MFMA32(*(const bf16x8*)frag_ptr(PROJ, n, h, f, lane), Sb[mt][s], vn[ct]);
                    o[ct] = MFMA32(*(const bf16x8*)frag_ptr(PROJ, n, h, 16 + f, lane), Sb[mt][s], o[ct]); }
        bf16x8 Vb[2][2];
#pragma unroll
        for (int ct = 0; ct < 2; ++ct) { Vb[ct][0] = pack_step(vn[ct], 0); Vb[ct][1] = pack_step(vn[ct], 1); }
        const bf16_t* aq = AQKg + ((size_t)(n * 4 + h) * 8 * 64 + lane) * 8;
#pragma unroll
        for (int ct = 0; ct < 2; ++ct)
#pragma unroll
            for (int ctp = 0; ctp < 2; ++ctp)
#pragma unroll
                for (int s = 0; s < 2; ++s) o[ct] = MFMA32(*(const bf16x8*)(aq + ((ct * 2 + ctp) * 2 + s) * 512), Vb[ctp][s], o[ct]);
#pragma unroll
        for (int mt = 0; mt < 4; ++mt) {
#pragma unroll
            for (int r = 0; r < 16; ++r) St[mt][r] *= egl;
#pragma unroll
            for (int ctp = 0; ctp < 2; ++ctp)
#pragma unroll
                for (int s = 0; s < 2; ++s) St[mt] = MFMA32(*(const bf16x8*)frag_ptr(PROJ, n, h, 32 + (mt * 2 + ctp) * 2 + s, lane), Vb[ctp][s], St[mt]);
        }
#pragma unroll
        for (int ct = 0; ct < 2; ++ct)
#pragma unroll
            for (int r = 0; r < 16; ++r) ub[(size_t)(32 * ct + crow(r, hi)) * 512] = f2bf(o[ct][r]);
    }
}
}
constexpr int N_PHASES = 2 + 7 * DEPTH;
constexpr int SCAN_WGS = 16;
constexpr float QSCALE = 0.07216878364870322f * LOG2E;

template <int KIND> __device__ __forceinline__ void run_kind(const Params& p, int l, LAS unsigned char* lds) {
    const int tid = tidx(), lane = tid & 63, wid = __builtin_amdgcn_readfirstlane(tid >> 6);
    const int bid = bidx(), nblk = gridDim.x, gw = bid * 8 + wid, ngw = nblk * 8, gtid = bid * NT_THREADS + tid, gn = nblk * NT_THREADS;
    bf16_t* PROJ = (bf16_t*)(p.ws + WS_PROJ);
    if constexpr (KIND == 0) {
        job_win(p, 0, bid, nblk, lds); job_wout(p, 0, bid, nblk, lds); job_wmem(p, bid, nblk, lds);
        job_wq(p, gtid, gn); job_wuv(p, gtid, gn); job_rope(p, gtid, gn); job_btab(p, gtid, gn); job_memn(p, gw, ngw, lane);
    } else if constexpr (KIND == 1) {
        for (int ll = 0; ll < 2; ++ll) {
            pg8::Gemm g{(const bf16_t*)(p.ws + WS_MEMN) + (size_t)ll * MEML * DM, (const bf16_t*)(p.ws + WS_WMEM) + (size_t)ll * DM * DM, MEML, DM, DM, DM};
            pg8::StaticOrder so; so.init(MEML, DM, nblk, (bid + nblk - 4 * ll) % nblk);
            pg8::EpiStore E{(bf16_t*)(p.ws + WS_MEMKV) + (size_t)ll * MEML * DM, DM, nullptr};
            pg8::gemm_phase<pg8::EpiStore, pg8::StaticOrder, true, true>(lds, g, so, E);
        }
        job_norm_rows(p, 0, gw, ngw, lane);
    } else if constexpr (KIND == 2) {
        pg8::Gemm g{(const bf16_t*)(p.ws + WS_H), (const bf16_t*)(p.ws + WS_WIN), S, NP, DM, DM};
        pg8::StaticOrder so; so.init(S, NP, nblk, bid);
        pg8::EpiStore E{PROJ, NP, (bf16_t*)(p.ws + WS_HALO)};
        pg8::gemm_phase<pg8::EpiStore, pg8::StaticOrder, true, true>(lds, g, so, E);
    } else if constexpr (KIND == 3) {
        job_mla_rows(p, l, gw, ngw, lane);
        for (int u = bid; u < 512; u += nblk) att::swa_unit(lds, u >> 1, u & 1, PROJ, p.pos, p.sinks + l * 8, (const float*)(p.ws + WS_MISC + MISC_BTAB));
        for (int u = bid; u < 256; u += nblk) att::cross_unit(lds, u >> 2, u & 3, PROJ, (const bf16_t*)(p.ws + WS_MEMKV) + (size_t)l * MEML * DM);
        for (int it = bid; it < 1024; it += nblk) gdn::prep_item(p, l, it >> 2, it & 3, lds);
        __syncthreads();
        if (l == 0) job_win(p, 1, bid, nblk, lds);
    } else if constexpr (KIND == 4) {
        pg8::Gemm g{PROJ + C_CQ, (const bf16_t*)(p.ws + WS_WQ) + (size_t)l * 768 * 256, S, 768, 256, NP};
        pg8::StaticOrder so; so.init(S, 768, nblk, bid);
        pg8::EpiStore E{(bf16_t*)(p.ws + WS_QABS), 768, nullptr};
        pg8::gemm_phase<pg8::EpiStore, pg8::StaticOrder, true, true>(lds, g, so, E);
    } else if constexpr (KIND == 5) {
        if (bid < SCAN_WGS) { if (wid == 0) gdn::scan_wave(p, bid >> 2, bid & 3, lane); }
        else for (int u = bid - SCAN_WGS; u < 256; u += nblk - SCAN_WGS) att::mla_unit(lds, 63 - (u >> 2), u & 3, (const bf16_t*)(p.ws + WS_QABS), (const bf16_t*)(p.ws + WS_KVLAT), PROJ, (const float*)(p.ws + WS_MISC + MISC_RSQ), (const float*)(p.ws + WS_COS), (const float*)(p.ws + WS_SIN), QSCALE);
    } else if constexpr (KIND == 6) {
        pg8::Gemm g{PROJ + C_OLAT, (const bf16_t*)(p.ws + WS_WUV) + (size_t)l * 512 * 512, S, 512, 512, NP};
        pg8::StaticOrder so; so.init(S, 512, nblk, bid);
        pg8::EpiGate E{PROJ + C_Z + 1024, NP};
        pg8::gemm_phase<pg8::EpiGate, pg8::StaticOrder, true, true>(lds, g, so, E);
        job_gdn_final(p, l, gw, ngw, lane);
    } else if constexpr (KIND == 7) {
        pg8::Gemm g{PROJ + C_Z, (const bf16_t*)(p.ws + WS_WOUT), S, DM, MIXW, NP};
        pg8::StaticOrder so; so.init(S, DM, nblk, bid);
        pg8::EpiStore E{(bf16_t*)(p.ws + WS_Y), DM, nullptr};
        pg8::gemm_phase<pg8::EpiStore, pg8::StaticOrder, true, true>(lds, g, so, E);
    } else {
        job_norm_rows(p, l == 0 ? 1 : 2, gw, ngw, lane);
        if (l == 0) job_wout(p, 1, bid, nblk, lds);
    }
}
__device__ __forceinline__ void run_phase(const Params& p, int ph, LAS unsigned char* lds) {
    int kind, l;
    if (ph < 2) { kind = ph; l = 0; } else { l = (ph - 2) / 7; kind = 2 + (ph - 2) % 7; }
    switch (kind) {
    case 0: run_kind<0>(p, l, lds); break; case 1: run_kind<1>(p, l, lds); break; case 2: run_kind<2>(p, l, lds); break; case 3: run_kind<3>(p, l, lds); break;
    case 4: run_kind<4>(p, l, lds); break; case 5: run_kind<5>(p, l, lds); break; case 6: run_kind<6>(p, l, lds); break; case 7: run_kind<7>(p, l, lds); break;
    default: run_kind<8>(p, l, lds); break;
    }
}
template <int KIND> __global__ void __launch_bounds__(NT_THREADS, 2) mk_kind(Params p, int l) {
    extern __shared__ __attribute__((aligned(16))) unsigned char lds_raw[];
    run_kind<KIND>(p, l, (LAS unsigned char*)lds_raw);
}

#ifndef MK_LAUNCHES_PER_PHASE
#define MK_LAUNCHES_PER_PHASE 0
#endif
#if !MK_LAUNCHES_PER_PHASE
__global__ void __launch_bounds__(NT_THREADS, 2) mk_fwd(Params p) {
    extern __shared__ __attribute__((aligned(16))) unsigned char lds_raw[];
    LAS unsigned char* lds = (LAS unsigned char*)lds_raw;
    cg::grid_group grid = cg::this_grid();
    for (int ph = p.ph_lo; ph < p.ph_hi; ++ph) {
        run_phase(p, ph, lds);
        if (ph + 1 < p.ph_hi) grid.sync();
    }
}
#endif

#ifndef MK_LAUNCHES_PER_PHASE
#define MK_LAUNCHES_PER_PHASE 0
#endif
extern "C" void kernel_launch(void* const* d_in, const int* in_sizes, int n_in, void* d_out, int out_size, void* d_ws, size_t ws_size, hipStream_t stream) {
    static int grid = 0;
    if (grid == 0) {
        if (n_in != 19 || in_sizes[0] != S * DM || out_size != S * DM || ws_size < WS_END) { fprintf(stderr, "kernel_launch: unexpected shapes (n_in %d, in0 %d, out %d, ws %zu)\n", n_in, n_in > 0 ? in_sizes[0] : -1, out_size, ws_size); grid = -1; return; }
        int dev = 0, cus = 0, per_cu = 0;
        (void)hipGetDevice(&dev); (void)hipDeviceGetAttribute(&cus, hipDeviceAttributeMultiprocessorCount, dev);
#if !MK_LAUNCHES_PER_PHASE
        if (hipFuncSetAttribute((const void*)mk_fwd, hipFuncAttributeMaxDynamicSharedMemorySize, LDS_BYTES) != hipSuccess) { fprintf(stderr, "kernel_launch: hipFuncSetAttribute failed\n"); grid = -1; return; }
        if (hipOccupancyMaxActiveBlocksPerMultiprocessor(&per_cu, (const void*)mk_fwd, NT_THREADS, LDS_BYTES) != hipSuccess || per_cu < 1) { fprintf(stderr, "kernel_launch: occupancy query gave %d\n", per_cu); per_cu = 1; }
#else
#define SA(K) (void)hipFuncSetAttribute((const void*)mk_kind<K>, hipFuncAttributeMaxDynamicSharedMemorySize, LDS_BYTES)
        SA(0); SA(1); SA(2); SA(3); SA(4); SA(5); SA(6); SA(7); SA(8);
#undef SA
#endif
        (void)hipGetLastError();
        if (cus <= 0) cus = 256;
        grid = cus;
        fprintf(stderr, "kernel_launch: cus %d per_cu %d grid %d\n", cus, per_cu, grid);
    }
    if (grid < 0) return;
    Params p{};
    p.x = (const float*)d_in[0]; p.mem = (const float*)d_in[1]; p.pos = (const int*)d_in[2]; p.rel_bias = (const float*)d_in[3];
    p.norm_pre = (const float*)d_in[4]; p.norm_post = (const float*)d_in[5]; p.w_in = (const float*)d_in[6]; p.sinks = (const float*)d_in[7];
    p.conv_w = (const float*)d_in[8]; p.a_log = (const float*)d_in[9]; p.dt_bias = (const float*)d_in[10]; p.gdn_norm = (const float*)d_in[11];
    p.q_norm = (const float*)d_in[12]; p.kv_norm = (const float*)d_in[13]; p.w_uq = (const float*)d_in[14]; p.w_ukv = (const float*)d_in[15];
    p.mem_norm = (const float*)d_in[16]; p.w_mem = (const float*)d_in[17]; p.w_out = (const float*)d_in[18];
    p.out = (float*)d_out; p.ws = (unsigned char*)d_ws;
#if MK_LAUNCHES_PER_PHASE
    p.ph_lo = 0; p.ph_hi = 0;
#define LK(K, L) hipLaunchKernelGGL(mk_kind<K>, dim3(grid), dim3(NT_THREADS), LDS_BYTES, stream, p, L)
    LK(0, 0); LK(1, 0);
    for (int l = 0; l < DEPTH; ++l) { LK(2, l); LK(3, l); LK(4, l); LK(5, l); LK(6, l); LK(7, l); LK(8, l); }
#undef LK
#else
    p.ph_lo = 0; p.ph_hi = N_PHASES;
    void* args[] = {&p};
    hipError_t e = hipLaunchCooperativeKernel((const void*)mk_fwd, dim3(grid), dim3(NT_THREADS), args, LDS_BYTES, stream);
    if (e != hipSuccess) fprintf(stderr, "kernel_launch: cooperative launch failed: %s (grid %d)\n", hipGetErrorString(e), grid);
#endif
}
```

```cpp
#include <hip/hip_runtime.h>
#include <hip/hip_cooperative_groups.h>
#include <cstdint>
#include <cstdio>
namespace cg = cooperative_groups;

#define LAS __attribute__((address_space(3)))
typedef unsigned short bf16_t;
typedef short bf16x8 __attribute__((ext_vector_type(8)));
typedef short s16x4 __attribute__((ext_vector_type(4)));
typedef float f32x2 __attribute__((ext_vector_type(2)));
typedef float f32x4 __attribute__((ext_vector_type(4)));
typedef float f32x16 __attribute__((ext_vector_type(16)));
typedef unsigned u32x2 __attribute__((ext_vector_type(2)));
typedef unsigned u32x4 __attribute__((ext_vector_type(4)));
typedef __bf16 bf16x2_t __attribute__((ext_vector_type(2)));

constexpr int S = 16384, DM = 1024, MEML = 256, NP = 5376, DEPTH = 2, DIN = 5320, MIXW = 2048;
constexpr int C_Z = 0, C_AQ = 2048, C_AK = 2560, C_AV = 2688, C_DQ = 2816, C_BQKV = 3328, C_CQ = 4864, C_CKV = 5120, C_KR = 5248, C_BA = 5312, C_BB = 5316;
constexpr int C_OLAT = 2048;
constexpr float RMS_EPS = 1e-6f;
constexpr float LOG2E = 1.4426950408889634f;
constexpr int NT_THREADS = 512;

constexpr size_t MiB = 1u << 20;
constexpr size_t WS_CTL = 0, WS_COS = 1 * MiB, WS_SIN = 3 * MiB, WS_MEMKV = 5 * MiB, WS_MISC = 6 * MiB, WS_MEMN = 7 * MiB;
constexpr size_t WS_WIN = 8 * MiB, WS_WOUT = 19 * MiB, WS_WMEM = 23 * MiB, WS_WQ = 27 * MiB, WS_WUV = 28 * MiB, WS_HALO = 29 * MiB;
constexpr size_t WS_AQK = 32 * MiB, WS_U = 40 * MiB, WS_H = 56 * MiB, WS_PROJ = 88 * MiB, WS_END = 256 * MiB;
constexpr size_t WS_QABS = WS_H, WS_KVLAT = WS_H + 24 * MiB, WS_Y = WS_H;
constexpr size_t MISC_BTAB = 0, MISC_RSQ = 8192, MISC_EGL = 8192 + 65536;

constexpr int LDS_BYTES = 147456;

struct Params {
    const float* x; const float* mem; const int* pos; const float* rel_bias;
    const float* norm_pre; const float* norm_post; const float* w_in; const float* sinks;
    const float* conv_w; const float* a_log; const float* dt_bias; const float* gdn_norm;
    const float* q_norm; const float* kv_norm; const float* w_uq; const float* w_ukv;
    const float* mem_norm; const float* w_mem; const float* w_out;
    float* out; unsigned char* ws;
    int ph_lo, ph_hi;
};

__device__ __forceinline__ int tidx() { int t = threadIdx.x; asm volatile("" : "+v"(t)); return t; }
__device__ __forceinline__ int bidx() { int b = blockIdx.x; asm volatile("" : "+s"(b)); return b; }
__device__ __forceinline__ float bf2f(bf16_t v) { return __uint_as_float((unsigned)v << 16); }
__device__ __forceinline__ unsigned cvtpk(float lo, float hi) { f32x2 v = {lo, hi}; bf16x2_t b = __builtin_convertvector(v, bf16x2_t); return __builtin_bit_cast(unsigned, b); }
__device__ __forceinline__ bf16_t f2bf(float f) { return (bf16_t)(cvtpk(f, 0.f) & 0xffffu); }
__device__ __forceinline__ float lo_bf(unsigned w) { return __uint_as_float(w << 16); }
__device__ __forceinline__ float hi_bf(unsigned w) { return __uint_as_float(w & 0xffff0000u); }
__device__ __forceinline__ float silu_f(float v) { return v / (1.f + __expf(-v)); }
__device__ __forceinline__ float wave_sum(float v) {
#pragma unroll
    for (int o = 1; o < 64; o <<= 1) v += __shfl_xor(v, o);
    return v;
}
__device__ __forceinline__ int crow(int r, int hi) { return (r & 3) + 8 * (r >> 2) + 4 * hi; }
#define MFMA32(a, b, c) __builtin_amdgcn_mfma_f32_32x32x16_bf16((a), (b), (c), 0, 0, 0)
#define SBAR() __builtin_amdgcn_sched_barrier(0)
#define LDS_WAIT() asm volatile("s_waitcnt lgkmcnt(0)" ::: "memory")
__device__ __forceinline__ bf16x8 pack8(const float* v) { u32x4 w = {cvtpk(v[0], v[1]), cvtpk(v[2], v[3]), cvtpk(v[4], v[5]), cvtpk(v[6], v[7])}; return __builtin_bit_cast(bf16x8, w); }
__device__ __forceinline__ bf16x8 pack_step(const f32x16& x, int s) {
    u32x4 w = {cvtpk(x[8 * s + 0], x[8 * s + 1]), cvtpk(x[8 * s + 2], x[8 * s + 3]), cvtpk(x[8 * s + 4], x[8 * s + 5]), cvtpk(x[8 * s + 6], x[8 * s + 7])};
    return __builtin_bit_cast(bf16x8, w);
}

__device__ __forceinline__ int win_src(int n) {
    if (n < 512) return 768 + n;
    if (n < 1024) return 2824 + (n - 512);
    if (n < 1536) return 3784 + (n - 1024);
    if (n < 2048) return 4808 + (n - 1536);
    if (n < 2560) return n - 2048;
    if (n < 2688) return 512 + (n - 2560);
    if (n < 2816) return 640 + (n - 2688);
    if (n < 3328) return 4296 + (n - 2816);
    if (n < 4864) return 1280 + (n - 3328);
    if (n < 5120) return 3336 + (n - 4864);
    if (n < 5248) return 3592 + (n - 5120);
    if (n < 5312) return 3720 + (n - 5248);
    if (n < 5316) return 2816 + (n - 5312);
    if (n < 5320) return 2820 + (n - 5316);
    return -1;
}

__device__ __forceinline__ int t5_bucket(int n) {
    if (n < 16) return n < 0 ? 0 : n;
    if (n >= 128) return 31;
    const float v = __logf((float)n * 0.0625f) * (16.0f / 2.0794415416798357f);
    int b = 16 + (int)v; return b > 31 ? 31 : b;
}
__device__ __forceinline__ float inv_freq(int i) {
    const float t[32] = {1.000000000e+00f, 7.498942018e-01f, 5.623413324e-01f, 4.216965139e-01f, 3.162277639e-01f, 2.371373922e-01f, 1.778279394e-01f, 1.333521456e-01f,
                         1.000000015e-01f, 7.498941571e-02f, 5.623412877e-02f, 4.216964915e-02f, 3.162277862e-02f, 2.371373586e-02f, 1.778279431e-02f, 1.333521493e-02f,
                         9.999999776e-03f, 7.498942316e-03f, 5.623413250e-03f, 4.216964822e-03f, 3.162277862e-03f, 2.371373819e-03f, 1.778279431e-03f, 1.333521446e-03f,
                         1.000000047e-03f, 7.498941850e-04f, 5.623413017e-04f, 4.216965463e-04f, 3.162277862e-04f, 2.371373848e-04f, 1.778279402e-04f, 1.333521504e-04f};
    return t[i];
}
namespace pg8 {
#define PG8_LAS __attribute__((address_space(3)))
constexpr int BM = 256, BK = 64, HALF = 128, HTB = HALF * BK * 2  , STAGE_BYTES = 8 * HTB, NXCD = 8, WGM = 8;
__host__ __device__ __forceinline__ int lds_byte(int r, int c) { const int st = (r >> 4) * 2 + (c >> 5), rr = r & 15, cc = c & 31, ob = rr * 64 + cc * 2; return st * 1024 + (ob ^ (((ob >> 9) & 1) << 5)); }
__host__ __device__ __forceinline__ void stage_rc(int b, int& R, int& C) { const int st = b / 1024, sb = b % 1024, swz = sb ^ (((sb >> 9) & 1) << 5); R = (st >> 1) * 16 + swz / 64; C = (st & 1) * 32 + (swz % 64) / 2; }
__host__ __device__ __forceinline__ int perm32(int rho) { const int n = rho >> 4, i = rho & 15; return 8 * (i >> 2) + 4 * n + (i & 3); }
struct Unit { int pm, pn; };
struct Gemm { const bf16_t* A; const bf16_t* Bt; int M, N, K, lda; };
struct StaticOrder {
    int nM, nN, nwg, G, c;
    __device__ void init(int M, int N, int G_, int c_) { nM = M / BM; nN = N / BM; nwg = nM * nN; G = G_; c = c_; }
    __device__ bool next(int i, Unit& u) const {
        const long L = (long)i * G + c; if (L >= nwg) return false;
        int wgid = (int)L; { const int q = nwg / NXCD, r = nwg % NXCD, xcd = wgid % NXCD, off = wgid / NXCD; wgid = (xcd < r ? xcd * (q + 1) : r * (q + 1) + (xcd - r) * q) + off; }
        const int nig = WGM * nN, gid = wgid / nig, fm = gid * WGM, gsz = (nM - fm) < WGM ? (nM - fm) : WGM;
        u.pm = fm + ((wgid % nig) % gsz); u.pn = (wgid % nig) / gsz; return true;
    }
    __device__ __forceinline__ void a_ready(const Unit&) const {}
    __device__ __forceinline__ void done(const Unit&) const {}
};
struct EpiStore {
    static constexpr bool PERM = true, AFTER_DRAIN = false;
    bf16_t* O; int ldc; bf16_t* halo;
    __device__ __forceinline__ void operator()(const f32x4 (&acc)[2][2][4][2], const Unit& u, int wr, int wc, int fr, int fq) const {
        const int row0 = u.pm * BM + wr * 64 + fr, col0 = u.pn * BM + wc * 32 + 8 * fq;
        const bool hz = halo != nullptr && col0 >= C_BQKV && col0 < C_BQKV + 1536;
#pragma unroll
        for (int ai = 0; ai < 2; ++ai)
#pragma unroll
            for (int m = 0; m < 4; ++m) { const int row = row0 + ai * HALF + m * 16; bf16_t* rowp = O + (size_t)row * ldc + col0;
#pragma unroll
                for (int bj = 0; bj < 2; ++bj) { const f32x4 v0 = acc[ai][bj][m][0], v1 = acc[ai][bj][m][1];
                    u32x4 w; w.x = cvtpk(v0[0], v0[1]); w.y = cvtpk(v0[2], v0[3]); w.z = cvtpk(v1[0], v1[1]); w.w = cvtpk(v1[2], v1[3]);
                    *(u32x4*)(rowp + bj * HALF) = w;
                    if (m == 3 && hz && fr >= 13) *(u32x4*)(halo + ((size_t)(row >> 6) * 3 + (fr - 13)) * 1536 + (col0 + bj * HALF - C_BQKV)) = w; } }
    }
};
struct EpiGate {
    static constexpr bool PERM = true, AFTER_DRAIN = false;
    bf16_t* G; int ldc;
    __device__ __forceinline__ void operator()(const f32x4 (&acc)[2][2][4][2], const Unit& u, int wr, int wc, int fr, int fq) const {
        const int row0 = u.pm * BM + wr * 64 + fr, col0 = u.pn * BM + wc * 32 + 8 * fq;
#pragma unroll
        for (int ai = 0; ai < 2; ++ai)
#pragma unroll
            for (int m = 0; m < 4; ++m) { bf16_t* rowp = G + (size_t)(row0 + ai * HALF + m * 16) * ldc + col0;
#pragma unroll
                for (int bj = 0; bj < 2; ++bj) { const f32x4 v0 = acc[ai][bj][m][0], v1 = acc[ai][bj][m][1];
                    const u32x4 z = *(const u32x4*)(rowp + bj * HALF);
                    u32x4 w; w.x = cvtpk(v0[0] * silu_f(lo_bf(z.x)), v0[1] * silu_f(hi_bf(z.x))); w.y = cvtpk(v0[2] * silu_f(lo_bf(z.y)), v0[3] * silu_f(hi_bf(z.y)));
                    w.z = cvtpk(v1[0] * silu_f(lo_bf(z.z)), v1[1] * silu_f(hi_bf(z.z))); w.w = cvtpk(v1[2] * silu_f(lo_bf(z.w)), v1[3] * silu_f(hi_bf(z.w)));
                    *(u32x4*)(rowp + bj * HALF) = w; } }
    }
};
template <class Epi, class Sched, bool ALIGN_EPI = false, bool SP2 = false>
__device__ __forceinline__ void gemm_phase(PG8_LAS unsigned char* lds, const Gemm g, const Sched& S, const Epi& E) {
    const int tid = tidx(), wid = __builtin_amdgcn_readfirstlane(tid >> 6), lane = tid & 63, wr = wid >> 2, wc = wid & 3, fr = lane & 15, fq = lane >> 4;
    const int K = g.K, nt = K / BK;
    unsigned voffA[2], voffB[2];
#pragma unroll
    for (int i = 0; i < 2; ++i) { int R, C; stage_rc(tid * 16 + i * 8192, R, C); const int Rb = Epi::PERM ? ((R & ~31) + perm32(R & 31)) : R;
        voffA[i] = (unsigned)(R * g.lda + C) * 2u; voffB[i] = (unsigned)(Rb * K + C) * 2u; }
    const size_t kstep = (size_t)(BK * 2);
    const size_t hstepA = (size_t)HALF * g.lda * 2, hstepB = (size_t)HALF * K * 2;
    const size_t tstepA = 2 * hstepA, tstepB = 2 * hstepB;
    const unsigned ldsw = (unsigned)wid * 1024u;
    const int aoff = lds_byte(wr * 64 + fr, fq * 8), boff = lds_byte(wc * 32 + fr, fq * 8);
#define PG8_SA(b, h) (((b) * 2 + (h)) * HTB)
#define PG8_SB(b, h) ((4 + (b) * 2 + (h)) * HTB)
#define PG8_STAGE(bufoff, gbase, voff) do { _Pragma("unroll") for (int _i = 0; _i < 2; ++_i) \
        __builtin_amdgcn_global_load_lds((const unsigned*)((const char*)(gbase) + (voff)[_i]), (PG8_LAS unsigned*)(lds + (bufoff) + ldsw + _i * 8192), 16, 0, 0); } while (0)
#define PG8_LDA(dst, b, h) do { _Pragma("unroll") for (int m = 0; m < 4; ++m) _Pragma("unroll") for (int k = 0; k < 2; ++k) dst[m][k] = *(const PG8_LAS bf16x8*)(lds + PG8_SA(b, h) + aoff + m * 2048 + k * 1024); } while (0)
#define PG8_LDB(dst, b, h) do { _Pragma("unroll") for (int n = 0; n < 2; ++n) _Pragma("unroll") for (int k = 0; k < 2; ++k) dst[n][k] = *(const PG8_LAS bf16x8*)(lds + PG8_SB(b, h) + boff + n * 2048 + k * 1024); } while (0)
#define PG8_MMA(ai, bj, At, Bt) do { __builtin_amdgcn_s_setprio(1); _Pragma("unroll") for (int m = 0; m < 4; ++m) _Pragma("unroll") for (int n = 0; n < 2; ++n) _Pragma("unroll") for (int k = 0; k < 2; ++k) \
        acc[ai][bj][m][n] = __builtin_amdgcn_mfma_f32_16x16x32_bf16(Bt[n][k], At[m][k], acc[ai][bj][m][n], 0, 0, 0); __builtin_amdgcn_s_setprio(0); } while (0)
#define PG8_WAIT_V(n) asm volatile("s_waitcnt vmcnt(" #n ")" ::: "memory")
#define PG8_WAIT_L(n) asm volatile("s_waitcnt lgkmcnt(" #n ")" ::: "memory")
#define PG8_BAR __builtin_amdgcn_s_barrier()
#define PG8_SCHED __builtin_amdgcn_sched_barrier(0)
    Unit cur, nxt; int ui = 0;
    if (!S.next(0, cur)) return;
    f32x4 acc[2][2][4][2];
#pragma unroll
    for (int a = 0; a < 2; ++a)
#pragma unroll
        for (int b = 0; b < 2; ++b)
#pragma unroll
            for (int m = 0; m < 4; ++m)
#pragma unroll
                for (int n = 0; n < 2; ++n) acc[a][b][m][n] = (f32x4){0.f, 0.f, 0.f, 0.f};
    bf16x8 At[4][2], B0[2][2], B1[2][2];
    const char* cA = (const char*)g.A + (size_t)cur.pm * tstepA; const char* cB = (const char*)g.Bt + (size_t)cur.pn * tstepB;
    S.a_ready(cur);
    if constexpr (SP2) {
        PG8_STAGE(PG8_SB(0, 0), cB, voffB); PG8_STAGE(PG8_SB(0, 1), cB + hstepB, voffB); PG8_STAGE(PG8_SA(0, 0), cA, voffA); PG8_STAGE(PG8_SA(0, 1), cA + hstepA, voffA);
        if (wr == 1) PG8_BAR;
        PG8_WAIT_V(2); PG8_BAR;
        PG8_STAGE(PG8_SB(1, 0), cB + kstep, voffB); PG8_STAGE(PG8_SA(1, 0), cA + kstep, voffA); PG8_STAGE(PG8_SB(1, 1), cB + hstepB + kstep, voffB);
        PG8_WAIT_V(6); PG8_BAR;
    } else {
        PG8_STAGE(PG8_SB(0, 0), cB, voffB); PG8_STAGE(PG8_SA(0, 0), cA, voffA); PG8_STAGE(PG8_SB(0, 1), cB + hstepB, voffB); PG8_STAGE(PG8_SA(0, 1), cA + hstepA, voffA);
        if (wr == 1) PG8_BAR;
        PG8_WAIT_V(4); PG8_BAR;
        PG8_STAGE(PG8_SB(1, 0), cB + kstep, voffB); PG8_STAGE(PG8_SA(1, 0), cA + kstep, voffA); PG8_STAGE(PG8_SB(1, 1), cB + hstepB + kstep, voffB);
        PG8_WAIT_V(6); PG8_BAR;
    }
    for (;;) {
        const bool has_next = S.next(ui + 1, nxt);
        const char* nA = has_next ? (const char*)g.A + (size_t)nxt.pm * tstepA : cA; const char* nB = has_next ? (const char*)g.Bt + (size_t)nxt.pn * tstepB : cB;
        for (int t = 0; t < nt; t += 2) {
            const bool last = (t == nt - 2);
            const char* a1 = cA + (size_t)(t + 1) * kstep;
            const char* a2 = last ? nA : cA + (size_t)(t + 2) * kstep; const char* b2 = last ? nB : cB + (size_t)(t + 2) * kstep;
            const char* a3 = a2 + kstep; const char* b3 = b2 + kstep;
            if (last && has_next) S.a_ready(nxt);
            if constexpr (SP2) {
            PG8_LDB(B0, 0, 0); PG8_LDB(B1, 0, 1); PG8_SCHED; PG8_LDA(At, 0, 0); PG8_STAGE(PG8_SA(1, 1), a1 + hstepA, voffA);
            PG8_WAIT_V(8); PG8_WAIT_L(0); PG8_BAR; PG8_MMA(0, 0, At, B0); PG8_MMA(0, 1, At, B1); PG8_BAR; PG8_SCHED;
            PG8_LDA(At, 0, 1); PG8_STAGE(PG8_SB(0, 0), b2, voffB); PG8_STAGE(PG8_SB(0, 1), b2 + hstepB, voffB); PG8_STAGE(PG8_SA(0, 0), a2, voffA);
            PG8_WAIT_V(8); PG8_WAIT_L(0); PG8_BAR; PG8_MMA(1, 0, At, B0); PG8_MMA(1, 1, At, B1); PG8_BAR; PG8_SCHED;
            PG8_LDB(B0, 1, 0); PG8_LDB(B1, 1, 1); PG8_SCHED; PG8_LDA(At, 1, 0); PG8_STAGE(PG8_SA(0, 1), a2 + hstepA, voffA);
            PG8_WAIT_V(8); PG8_WAIT_L(0); PG8_BAR; PG8_MMA(0, 0, At, B0); PG8_MMA(0, 1, At, B1); PG8_BAR; PG8_SCHED;
            PG8_LDA(At, 1, 1); PG8_STAGE(PG8_SB(1, 0), b3, voffB); PG8_STAGE(PG8_SB(1, 1), b3 + hstepB, voffB); PG8_STAGE(PG8_SA(1, 0), a3, voffA);
            PG8_WAIT_V(8); PG8_WAIT_L(0); PG8_BAR; PG8_MMA(1, 0, At, B0); PG8_MMA(1, 1, At, B1); PG8_BAR; PG8_SCHED;
            } else {
            PG8_LDB(B0, 0, 0); PG8_SCHED; PG8_LDA(At, 0, 0); PG8_STAGE(PG8_SA(1, 1), a1 + hstepA, voffA);
            PG8_WAIT_L(8); PG8_BAR; PG8_WAIT_L(0); PG8_MMA(0, 0, At, B0); PG8_BAR; PG8_SCHED;
            PG8_LDB(B1, 0, 1); PG8_STAGE(PG8_SB(0, 0), b2, voffB);
            PG8_BAR; PG8_WAIT_L(0); PG8_MMA(0, 1, At, B1); PG8_BAR;
            PG8_LDA(At, 0, 1); PG8_STAGE(PG8_SA(0, 0), a2, voffA);
            PG8_BAR; PG8_WAIT_L(0); PG8_MMA(1, 0, At, B0); PG8_BAR; PG8_SCHED;
            PG8_STAGE(PG8_SB(0, 1), b2 + hstepB, voffB);
            PG8_WAIT_V(6); PG8_BAR; PG8_MMA(1, 1, At, B1); PG8_BAR;
            PG8_LDB(B0, 1, 0); PG8_SCHED; PG8_LDA(At, 1, 0); PG8_STAGE(PG8_SA(0, 1), a2 + hstepA, voffA);
            PG8_WAIT_L(8); PG8_BAR; PG8_WAIT_L(0); PG8_MMA(0, 0, At, B0); PG8_BAR; PG8_SCHED;
            PG8_LDB(B1, 1, 1); PG8_STAGE(PG8_SB(1, 0), b3, voffB);
            PG8_BAR; PG8_WAIT_L(0); PG8_MMA(0, 1, At, B1); PG8_BAR;
            PG8_LDA(At, 1, 1); PG8_STAGE(PG8_SA(1, 0), a3, voffA);
            PG8_BAR; PG8_WAIT_L(0); PG8_MMA(1, 0, At, B0); PG8_BAR; PG8_SCHED;
            PG8_STAGE(PG8_SB(1, 1), b3 + hstepB, voffB);
            PG8_WAIT_V(6); PG8_BAR; PG8_MMA(1, 1, At, B1); PG8_BAR;
            }
        }
        if constexpr (ALIGN_EPI) { if (wr == 0) PG8_BAR; }
        if constexpr (!Epi::AFTER_DRAIN) { E(acc, cur, wr, wc, fr, fq); S.done(cur); }
        if (!has_next) break;
#pragma unroll
        for (int a = 0; a < 2; ++a)
#pragma unroll
            for (int b = 0; b < 2; ++b)
#pragma unroll
                for (int m = 0; m < 4; ++m)
#pragma unroll
                    for (int n = 0; n < 2; ++n) acc[a][b][m][n] = (f32x4){0.f, 0.f, 0.f, 0.f};
        cur = nxt; cA = nA; cB = nB; ++ui;
        if constexpr (ALIGN_EPI) { if (wr == 1) PG8_BAR; }
    }
    PG8_WAIT_V(0);
    if constexpr (!ALIGN_EPI) { if (wr == 0) PG8_BAR; }
    PG8_BAR;
    if constexpr (Epi::AFTER_DRAIN) { E.fused(acc, cur, wr, wc, fr, fq, lds, wid, lane); S.done(cur); }
#undef PG8_SA
#undef PG8_SB
#undef PG8_STAGE
#undef PG8_LDA
#undef PG8_LDB
#undef PG8_MMA
#undef PG8_WAIT_V
#undef PG8_WAIT_L
#undef PG8_BAR
#undef PG8_SCHED
}
}
namespace att {
constexpr int KVBLK = 64;
constexpr int L_K = 0, L_V = 24576, L_WS = 40960, L_POSK = 43008, L_BTAB = 43264, L_END = 47392;
template <int DV> __device__ __forceinline__ int v_st(int k, int c) { const int kk = (k & ~0xC) | ((k & 4) << 1) | ((k & 8) >> 1); return ((kk >> 3) * (DV / 32) + (c >> 5)) * 512 + ((kk & 7) * 32 + (c & 31)) * 2; }
__device__ __forceinline__ int v_rd_base(int lane) { return ((lane & 3) << 3) | (((lane >> 2) & 3) << 6) | (((lane >> 4) & 1) << 5) | (((lane >> 5) & 1) << 8); }
__device__ __forceinline__ int koff(int row, int colB, int RB) { return row * RB + (colB ^ ((row & 7) << 4)); }

template <int DQK, int DV, int MODE>
__device__ __forceinline__ void attn_core(LAS unsigned char* lds, const bf16_t* qrow, const bf16_t* Kg, int ldk, const bf16_t* Vg, int ldv, int t_lo, int t_hi, float c2,
                                          int qidx, int qlo_wave, int head, const int* pos, const float* rsq, const float* cosT, const float* sinT,
                                          float& m_reg, float& l_reg, f32x16 (&o)[DV / 32]) {
    constexpr int ND = DQK / 16, NV = DV / 32, RB = DQK * 2;
    const int tid = tidx(), lane = tid & 63, r32 = lane & 31, hi = lane >> 5, wid = __builtin_amdgcn_readfirstlane(tid >> 6);
    bf16x8 qr[ND];
#pragma unroll
    for (int d0 = 0; d0 < ND; ++d0) qr[d0] = *(const bf16x8*)(qrow + d0 * 16 + hi * 8);
    if (MODE == 0) {
        const float sc = rsq[qidx] * c2;
#pragma unroll
        for (int d0 = 0; d0 < ND; ++d0) { const u32x4 w = __builtin_bit_cast(u32x4, qr[d0]);
            float v[8] = {lo_bf(w.x) * sc, hi_bf(w.x) * sc, lo_bf(w.y) * sc, hi_bf(w.y) * sc, lo_bf(w.z) * sc, hi_bf(w.z) * sc, lo_bf(w.w) * sc, hi_bf(w.w) * sc};
            if (d0 >= 8) { const int i0 = (d0 - 8) * 8 + hi * 4; const f32x4 c = *(const f32x4*)(cosT + (size_t)qidx * 32 + i0), s = *(const f32x4*)(sinT + (size_t)qidx * 32 + i0);
#pragma unroll
                for (int jj = 0; jj < 4; ++jj) { const float t1 = v[2 * jj], t2 = v[2 * jj + 1]; v[2 * jj] = t1 * c[jj] - t2 * s[jj]; v[2 * jj + 1] = t1 * s[jj] + t2 * c[jj]; } }
            qr[d0] = pack8(v); }
    }
    LAS unsigned char* K_lds = lds + L_K; LAS unsigned char* V_lds = lds + L_V;
    LAS float* al_l = (LAS float*)(lds + L_WS) + wid * 64;
    LAS int* posk = (LAS int*)(lds + L_POSK); LAS float* btab = (LAS float*)(lds + L_BTAB);
    const unsigned vb0 = (unsigned)(uintptr_t)V_lds + (unsigned)v_rd_base(lane);
    int posq = 0; if (MODE == 1) posq = pos[qidx];
    for (int t = t_lo; t < t_hi; ++t) {
        const int kbase = t * KVBLK;
        __syncthreads();
        for (int c = tid; c < 64 * (DQK / 8); c += NT_THREADS) { const int row = c / (DQK / 8), ch = c % (DQK / 8);
            *(LAS bf16x8*)(K_lds + koff(row, ch * 16, RB)) = *(const bf16x8*)(Kg + (size_t)(kbase + row) * ldk + ch * 8); }
        for (int c = tid; c < 64 * (DV / 8); c += NT_THREADS) { const int row = c / (DV / 8), ch = c % (DV / 8);
            *(LAS bf16x8*)(V_lds + v_st<DV>(row, ch * 8)) = *(const bf16x8*)(Vg + (size_t)(kbase + row) * ldv + ch * 8); }
        if (MODE == 1) { if (tid < 64) posk[tid] = pos[kbase + tid]; }
        __syncthreads();
        f32x16 p0 = {}, p1 = {};
#pragma unroll
        for (int d0 = 0; d0 < ND; ++d0) {
            const bf16x8 a0 = *(const LAS bf16x8*)(K_lds + koff(r32, (d0 * 16 + hi * 8) * 2, RB));
            const bf16x8 a1 = *(const LAS bf16x8*)(K_lds + koff(32 + r32, (d0 * 16 + hi * 8) * 2, RB));
            p0 = MFMA32(a0, qr[d0], p0); p1 = MFMA32(a1, qr[d0], p1);
        }
        if (MODE == 0) {
            if (kbase + 63 > qlo_wave) {
#pragma unroll
                for (int r = 0; r < 16; ++r) { const int kk = kbase + crow(r, hi); if (kk > qidx) p0[r] = -__builtin_inff(); if (kk + 32 > qidx) p1[r] = -__builtin_inff(); }
            }
        } else if (MODE == 1) {
#pragma unroll
            for (int r = 0; r < 16; ++r) { const int kl = crow(r, hi);
                { const int kk = kbase + kl; int dist = posq - posk[kl]; dist = dist < 0 ? 0 : (dist > 128 ? 128 : dist);
                  const float b = btab[dist * 8 + head]; p0[r] = ((unsigned)(qidx - kk) < 128u) ? fmaf(p0[r], c2, b) : -__builtin_inff(); }
                { const int kk = kbase + kl + 32; int dist = posq - posk[kl + 32]; dist = dist < 0 ? 0 : (dist > 128 ? 128 : dist);
                  const float b = btab[dist * 8 + head]; p1[r] = ((unsigned)(qidx - kk) < 128u) ? fmaf(p1[r], c2, b) : -__builtin_inff(); } }
        } else {
#pragma unroll
            for (int r = 0; r < 16; ++r) { p0[r] *= c2; p1[r] *= c2; }
        }
        float pmax = p0[0];
#pragma unroll
        for (int r = 1; r < 16; ++r) pmax = fmaxf(pmax, p0[r]);
#pragma unroll
        for (int r = 0; r < 16; ++r) pmax = fmaxf(pmax, p1[r]);
        { auto rr = __builtin_amdgcn_permlane32_swap(__float_as_uint(pmax), __float_as_uint(pmax), false, false); pmax = fmaxf(__uint_as_float(rr[0]), __uint_as_float(rr[1])); }
        const float mn = fmaxf(m_reg, pmax); const float alpha = __builtin_amdgcn_exp2f(m_reg - mn); m_reg = mn;
        float ps = 0.f;
#pragma unroll
        for (int r = 0; r < 16; ++r) { p0[r] = __builtin_amdgcn_exp2f(p0[r] - mn); ps += p0[r]; }
#pragma unroll
        for (int r = 0; r < 16; ++r) { p1[r] = __builtin_amdgcn_exp2f(p1[r] - mn); ps += p1[r]; }
        { auto rr = __builtin_amdgcn_permlane32_swap(__float_as_uint(ps), __float_as_uint(ps), false, false); ps = __uint_as_float(rr[0]) + __uint_as_float(rr[1]); }
        l_reg = l_reg * alpha + ps;
        if (__any(alpha < 1.f)) {
            if (hi == 0) al_l[r32] = alpha;
            LDS_WAIT();
#pragma unroll
            for (int g = 0; g < 4; ++g) { const f32x4 a4 = *(const LAS f32x4*)(al_l + 8 * g + 4 * hi);
#pragma unroll
                for (int d = 0; d < NV; ++d) { o[d][4 * g + 0] *= a4[0]; o[d][4 * g + 1] *= a4[1]; o[d][4 * g + 2] *= a4[2]; o[d][4 * g + 3] *= a4[3]; } }
        }
        bf16x8 pa0, pa1, pa2, pa3;
#define PK4(P, B_, OUT) do { const unsigned a0_ = cvtpk(P[B_ + 0], P[B_ + 1]), a1_ = cvtpk(P[B_ + 2], P[B_ + 3]), b0_ = cvtpk(P[B_ + 4], P[B_ + 5]), b1_ = cvtpk(P[B_ + 6], P[B_ + 7]); \
        auto r0_ = __builtin_amdgcn_permlane32_swap(a0_, b0_, false, false); auto r1_ = __builtin_amdgcn_permlane32_swap(a1_, b1_, false, false); \
        u32x4 w_ = {r0_[0], r1_[0], r0_[1], r1_[1]}; OUT = __builtin_bit_cast(bf16x8, w_); } while (0)
        PK4(p0, 0, pa0); PK4(p0, 8, pa1); PK4(p1, 0, pa2); PK4(p1, 8, pa3);
#undef PK4
#define TRRD(dst, off) asm volatile("ds_read_b64_tr_b16 %0, %1 offset:%2" : "=&v"(dst) : "v"(vb0), "i"(off) : "memory")
#pragma unroll
        for (int d0 = 0; d0 < NV; ++d0) {
            s16x4 l0, l1, l2, l3, h0, h1, h2, h3; constexpr int KS = NV * 1024, HF = NV * 512; const int b_ = d0 * 512;
            if (d0 == 0) { TRRD(l0, 0); TRRD(h0, HF); TRRD(l1, KS); TRRD(h1, KS + HF); TRRD(l2, 2 * KS); TRRD(h2, 2 * KS + HF); TRRD(l3, 3 * KS); TRRD(h3, 3 * KS + HF); }
            else if (d0 == 1) { TRRD(l0, 512); TRRD(h0, 512 + HF); TRRD(l1, 512 + KS); TRRD(h1, 512 + KS + HF); TRRD(l2, 512 + 2 * KS); TRRD(h2, 512 + 2 * KS + HF); TRRD(l3, 512 + 3 * KS); TRRD(h3, 512 + 3 * KS + HF); }
            else if (d0 == 2) { TRRD(l0, 1024); TRRD(h0, 1024 + HF); TRRD(l1, 1024 + KS); TRRD(h1, 1024 + KS + HF); TRRD(l2, 1024 + 2 * KS); TRRD(h2, 1024 + 2 * KS + HF); TRRD(l3, 1024 + 3 * KS); TRRD(h3, 1024 + 3 * KS + HF); }
            else { TRRD(l0, 1536); TRRD(h0, 1536 + HF); TRRD(l1, 1536 + KS); TRRD(h1, 1536 + KS + HF); TRRD(l2, 1536 + 2 * KS); TRRD(h2, 1536 + 2 * KS + HF); TRRD(l3, 1536 + 3 * KS); TRRD(h3, 1536 + 3 * KS + HF); }
            (void)b_;
            asm volatile("s_waitcnt lgkmcnt(0)" ::: "memory"); SBAR();
            o[d0] = MFMA32(pa0, ((bf16x8){l0[0], l0[1], l0[2], l0[3], h0[0], h0[1], h0[2], h0[3]}), o[d0]);
            o[d0] = MFMA32(pa1, ((bf16x8){l1[0], l1[1], l1[2], l1[3], h1[0], h1[1], h1[2], h1[3]}), o[d0]);
            o[d0] = MFMA32(pa2, ((bf16x8){l2[0], l2[1], l2[2], l2[3], h2[0], h2[1], h2[2], h2[3]}), o[d0]);
            o[d0] = MFMA32(pa3, ((bf16x8){l3[0], l3[1], l3[2], l3[3], h3[0], h3[1], h3[2], h3[3]}), o[d0]);
        }
#undef TRRD
    }
}
__device__ __forceinline__ void row_recip(LAS float* li_l, float l_reg, int r32, int hi, float (&rli)[16]) {
    asm volatile("s_waitcnt lgkmcnt(0)" ::: "memory");
    if (hi == 0) li_l[r32] = l_reg;
    asm volatile("s_waitcnt lgkmcnt(0)" ::: "memory");
#pragma unroll
    for (int g = 0; g < 4; ++g) { const f32x4 a4 = *(const LAS f32x4*)(li_l + 8 * g + 4 * hi); rli[4 * g] = 1.f / a4[0]; rli[4 * g + 1] = 1.f / a4[1]; rli[4 * g + 2] = 1.f / a4[2]; rli[4 * g + 3] = 1.f / a4[3]; }
}

__device__ __forceinline__ void mla_unit(LAS unsigned char* lds, int qb, int h, const bf16_t* QABS, const bf16_t* KVLAT, bf16_t* PROJ, const float* rsq, const float* cosT, const float* sinT, float qscale) {
    const int tid = tidx(), lane = tid & 63, r32 = lane & 31, hi = lane >> 5, wid = __builtin_amdgcn_readfirstlane(tid >> 6);
    const int q0 = qb * 256 + wid * 32;
    float m = -1e30f, l = 0.f; f32x16 o[4] = {};
    attn_core<192, 128, 0>(lds, QABS + (size_t)(q0 + r32) * 768 + h * 192, KVLAT, 192, KVLAT, 192, 0, 4 * (qb + 1), qscale, q0 + r32, q0, 0, nullptr, rsq, cosT, sinT, m, l, o);
    LAS float* li_l = (LAS float*)(lds + L_WS) + wid * 64; float rli[16]; row_recip(li_l, l, r32, hi, rli);
#pragma unroll
    for (int r = 0; r < 16; ++r) { bf16_t* op = PROJ + (size_t)(q0 + crow(r, hi)) * NP + C_OLAT + h * 128 + r32;
#pragma unroll
        for (int d0 = 0; d0 < 4; ++d0) op[d0 * 32] = f2bf(o[d0][r] * rli[r]); }
}
__device__ __forceinline__ void swa_unit(LAS unsigned char* lds, int qb, int hk, bf16_t* PROJ, const int* pos, const float* sinks  , const float* btab_g) {
    const int tid = tidx(), lane = tid & 63, r32 = lane & 31, hi = lane >> 5, wid = __builtin_amdgcn_readfirstlane(tid >> 6);
    const int head = hk * 4 + (wid >> 1), q0 = qb * 64 + (wid & 1) * 32;
    __syncthreads();
    for (int i = tid; i < 129 * 8; i += NT_THREADS) ((LAS float*)(lds + L_BTAB))[i] = btab_g[i];
    const float sink = sinks[head] * LOG2E;
    float m = sink, l = 1.f; f32x16 o[2] = {};
    int t_lo = (qb * 64 - 128) / 64; if (t_lo < 0) t_lo = 0;
    attn_core<64, 64, 1>(lds, PROJ + (size_t)(q0 + r32) * NP + C_AQ + head * 64, PROJ + C_AK + hk * 64, NP, PROJ + C_AV + hk * 64, NP, t_lo, qb + 1, 0.125f * LOG2E,
                         q0 + r32, q0, head, pos, nullptr, nullptr, nullptr, m, l, o);
    LAS float* li_l = (LAS float*)(lds + L_WS) + wid * 64; float rli[16]; row_recip(li_l, l, r32, hi, rli);
#pragma unroll
    for (int r = 0; r < 16; ++r) { bf16_t* op = PROJ + (size_t)(q0 + crow(r, hi)) * NP + C_Z + head * 64 + r32;
#pragma unroll
        for (int d0 = 0; d0 < 2; ++d0) { const float z = bf2f(op[d0 * 32]); op[d0 * 32] = f2bf(o[d0][r] * rli[r] * silu_f(z)); } }
}
__device__ __forceinline__ void cross_unit(LAS unsigned char* lds, int qb, int h, bf16_t* PROJ, const bf16_t* MEMKV  ) {
    const int tid = tidx(), lane = tid & 63, r32 = lane & 31, hi = lane >> 5, wid = __builtin_amdgcn_readfirstlane(tid >> 6);
    const int q0 = qb * 256 + wid * 32;
    float m = -1e30f, l = 0.f; f32x16 o[4] = {};
    attn_core<128, 128, 2>(lds, PROJ + (size_t)(q0 + r32) * NP + C_DQ + h * 128, MEMKV + h * 128, 1024, MEMKV + 512 + h * 128, 1024, 0, 4, 0.08838834764831845f * LOG2E,
                           q0 + r32, q0, 0, nullptr, nullptr, nullptr, nullptr, m, l, o);
    LAS float* li_l = (LAS float*)(lds + L_WS) + wid * 64; float rli[16]; row_recip(li_l, l, r32, hi, rli);
#pragma unroll
    for (int r = 0; r < 16; ++r) { bf16_t* op = PROJ + (size_t)(q0 + crow(r, hi)) * NP + C_Z + 1536 + h * 128 + r32;
#pragma unroll
        for (int d0 = 0; d0 < 4; ++d0) { const float z = bf2f(op[d0 * 32]); op[d0 * 32] = f2bf(o[d0][r] * rli[r] * silu_f(z)); } }
}
}
template <class Map>
__device__ __forceinline__ void transpose_tile(const float* W, int ldw, bf16_t* WT, int K, int n0, int k0, LAS float* tile, Map map) {
    const int tid = tidx();
    { const int n = tid & 63, src = map(n0 + n);
#pragma unroll
      for (int i = 0; i < 8; ++i) { const int k = (tid >> 6) + 8 * i; tile[k * 65 + n] = src >= 0 ? W[(size_t)(k0 + k) * ldw + src] : 0.f; } }
    __syncthreads();
    { const int n = tid >> 3, kc = (tid & 7) * 8; float v[8];
#pragma unroll
      for (int j = 0; j < 8; ++j) v[j] = tile[(kc + j) * 65 + n];
      u32x4 w = {cvtpk(v[0], v[1]), cvtpk(v[2], v[3]), cvtpk(v[4], v[5]), cvtpk(v[6], v[7])};
      *(u32x4*)(WT + (size_t)(n0 + n) * K + k0 + kc) = w; }
    __syncthreads();
}
struct MapWin { __device__ int operator()(int n) const { return win_src(n); } };
struct MapId { __device__ int operator()(int n) const { return n; } };

__device__ __forceinline__ void job_win(const Params& p, int l, int vb, int nb, LAS unsigned char* lds) {
    bf16_t* WT = (bf16_t*)(p.ws + WS_WIN); const float* W = p.w_in + (size_t)l * DM * DIN;
    for (int t = vb; t < (NP / 64) * (DM / 64); t += nb) transpose_tile(W, DIN, WT, DM, (t / (DM / 64)) * 64, (t % (DM / 64)) * 64, (LAS float*)lds, MapWin());
}
__device__ __forceinline__ void job_wout(const Params& p, int l, int vb, int nb, LAS unsigned char* lds) {
    bf16_t* WT = (bf16_t*)(p.ws + WS_WOUT); const float* W = p.w_out + (size_t)l * MIXW * DM;
    for (int t = vb; t < (DM / 64) * (MIXW / 64); t += nb) transpose_tile(W, DM, WT, MIXW, (t / (MIXW / 64)) * 64, (t % (MIXW / 64)) * 64, (LAS float*)lds, MapId());
}
__device__ __forceinline__ void job_wmem(const Params& p, int vb, int nb, LAS unsigned char* lds) {
    for (int t = vb; t < 2 * 16 * 16; t += nb) { const int l = t >> 8, r = t & 255;
        transpose_tile(p.w_mem + (size_t)l * DM * DM, DM, (bf16_t*)(p.ws + WS_WMEM) + (size_t)l * DM * DM, DM, (r >> 4) * 64, (r & 15) * 64, (LAS float*)lds, MapId()); }
}
__device__ __forceinline__ void job_wq(const Params& p, int gtid, int gn) {
    for (int idx = gtid; idx < 2 * 768 * 256; idx += gn) {
        const int l = idx / (768 * 256), r = idx % (768 * 256), n = r / 256, k = r % 256;
        const float* uq = p.w_uq + (size_t)l * 256 * 768 + (size_t)k * 768; const float* ukv = p.w_ukv + (size_t)l * 128 * 1024;
        float v;
        const int h = n / 192, c = n % 192;
        if (c < 128) { float s = 0.f;
            for (int j = 0; j < 128; ++j) s = fmaf(uq[h * 192 + j], ukv[(size_t)c * 1024 + h * 256 + j], s);
            v = s;
        } else { const int w = c - 128, i = w >> 1, which = w & 1; v = uq[h * 192 + 128 + i + 32 * which]; }
        ((bf16_t*)(p.ws + WS_WQ))[idx] = f2bf(v * p.q_norm[l * 256 + k]);
    }
}
__device__ __forceinline__ void job_wuv(const Params& p, int gtid, int gn) {
    for (int idx = gtid; idx < 2 * 512 * 512; idx += gn) {
        const int l = idx / (512 * 512), r = idx % (512 * 512), n = r / 512, k = r % 512, h = n >> 7;
        const float v = (k >> 7) == h ? p.w_ukv[(size_t)l * 128 * 1024 + (size_t)(k & 127) * 1024 + h * 256 + 128 + (n & 127)] : 0.f;
        ((bf16_t*)(p.ws + WS_WUV))[idx] = f2bf(v);
    }
}
__device__ __forceinline__ void job_rope(const Params& p, int gtid, int gn) {
    float* cosT = (float*)(p.ws + WS_COS); float* sinT = (float*)(p.ws + WS_SIN);
    for (int idx = gtid; idx < S * 32; idx += gn) {
        const int s = idx >> 5, i = idx & 31;
        const float angf = (float)p.pos[s] * inv_freq(i);
        const double a = (double)angf; const double kq = __builtin_rint(a * 0.63661977236758134308);
        const double x = (a - kq * 1.5707963267948966192) - kq * 6.123233995736766036e-17;
        const double x2 = x * x;
        const double sn = x * (1.0 + x2 * (-1.0 / 6 + x2 * (1.0 / 120 + x2 * (-1.0 / 5040 + x2 * (1.0 / 362880 + x2 * (-1.0 / 39916800 + x2 * (1.0 / 6227020800.0)))))));
        const double cs = 1.0 + x2 * (-0.5 + x2 * (1.0 / 24 + x2 * (-1.0 / 720 + x2 * (1.0 / 40320 + x2 * (-1.0 / 3628800 + x2 * (1.0 / 479001600.0 + x2 * (-1.0 / 87178291200.0)))))));
        const int q = ((int)kq) & 3;
        const double c = (q == 0) ? cs : (q == 1) ? -sn : (q == 2) ? -cs : sn;
        const double sv = (q == 0) ? sn : (q == 1) ? cs : (q == 2) ? -sn : -cs;
        cosT[idx] = (float)c; sinT[idx] = (float)sv;
    }
}
__device__ __forceinline__ void job_btab(const Params& p, int gtid, int gn) {
    float* bt = (float*)(p.ws + WS_MISC + MISC_BTAB);
    for (int idx = gtid; idx < 129 * 8; idx += gn) { const int d = idx >> 3, h = idx & 7; bt[idx] = p.rel_bias[t5_bucket(d) * 8 + h] * LOG2E; }
}
__device__ __forceinline__ void rms_row_to_bf16(const float* xrow, const float* gain, bf16_t* orow, int lane) {
    f32x4 v[4]; float ss = 0.f;
#pragma unroll
    for (int j = 0; j < 4; ++j) { v[j] = *(const f32x4*)(xrow + 256 * j + 4 * lane); ss += (v[j].x * v[j].x + v[j].y * v[j].y) + (v[j].z * v[j].z + v[j].w * v[j].w); }
    const float rs = rsqrtf(wave_sum(ss) * (1.f / DM) + RMS_EPS);
#pragma unroll
    for (int j = 0; j < 4; ++j) { const f32x4 g = *(const f32x4*)(gain + 256 * j + 4 * lane);
        u32x2 w; w.x = cvtpk(v[j].x * rs * g.x, v[j].y * rs * g.y); w.y = cvtpk(v[j].z * rs * g.z, v[j].w * rs * g.w);
        *(u32x2*)(orow + 256 * j + 4 * lane) = w; }
}
__device__ __forceinline__ void job_memn(const Params& p, int gw, int ngw, int lane) {
    for (int r = gw; r < 2 * MEML; r += ngw) { const int l = r >> 8, m = r & 255;
        rms_row_to_bf16(p.mem + (size_t)m * DM, p.mem_norm + l * DM, (bf16_t*)(p.ws + WS_MEMN) + ((size_t)l * MEML + m) * DM, lane); }
}
__device__ __forceinline__ void job_norm_rows(const Params& p, int mode, int gw, int ngw, int lane) {
    bf16_t* H = (bf16_t*)(p.ws + WS_H); const bf16_t* Y = (const bf16_t*)(p.ws + WS_Y);
    for (int row = gw; row < S; row += ngw) {
        if (mode == 0) { rms_row_to_bf16(p.x + (size_t)row * DM, p.norm_pre, H + (size_t)row * DM, lane); continue; }
        const float* xin = (mode == 1 ? p.x : p.out) + (size_t)row * DM; const float* gpost = p.norm_post + (mode == 1 ? 0 : DM);
        float y[16]; float ss = 0.f;
#pragma unroll
        for (int j = 0; j < 4; ++j) { const u32x2 w = *(const u32x2*)(Y + (size_t)row * DM + 256 * j + 4 * lane);
            y[4 * j] = lo_bf(w.x); y[4 * j + 1] = hi_bf(w.x); y[4 * j + 2] = lo_bf(w.y); y[4 * j + 3] = hi_bf(w.y);
            ss += (y[4 * j] * y[4 * j] + y[4 * j + 1] * y[4 * j + 1]) + (y[4 * j + 2] * y[4 * j + 2] + y[4 * j + 3] * y[4 * j + 3]); }
        const float rs = rsqrtf(wave_sum(ss) * (1.f / DM) + RMS_EPS);
        f32x4 x1[4]; float s2 = 0.f;
#pragma unroll
        for (int j = 0; j < 4; ++j) { const f32x4 xv = *(const f32x4*)(xin + 256 * j + 4 * lane); const f32x4 g = *(const f32x4*)(gpost + 256 * j + 4 * lane);
            x1[j].x = xv.x + y[4 * j] * rs * g.x; x1[j].y = xv.y + y[4 * j + 1] * rs * g.y; x1[j].z = xv.z + y[4 * j + 2] * rs * g.z; x1[j].w = xv.w + y[4 * j + 3] * rs * g.w;
            *(f32x4*)(p.out + (size_t)row * DM + 256 * j + 4 * lane) = x1[j];
            s2 += (x1[j].x * x1[j].x + x1[j].y * x1[j].y) + (x1[j].z * x1[j].z + x1[j].w * x1[j].w); }
        if (mode == 1) { const float r2 = rsqrtf(wave_sum(s2) * (1.f / DM) + RMS_EPS); const float* gpre = p.norm_pre + DM;
#pragma unroll
            for (int j = 0; j < 4; ++j) { const f32x4 g = *(const f32x4*)(gpre + 256 * j + 4 * lane);
                u32x2 w; w.x = cvtpk(x1[j].x * r2 * g.x, x1[j].y * r2 * g.y); w.y = cvtpk(x1[j].z * r2 * g.z, x1[j].w * r2 * g.w);
                *(u32x2*)(H + (size_t)row * DM + 256 * j + 4 * lane) = w; } }
    }
}
__device__ __forceinline__ void job_mla_rows(const Params& p, int l, int gw, int ngw, int lane) {
    const bf16_t* PROJ = (const bf16_t*)(p.ws + WS_PROJ); bf16_t* KV = (bf16_t*)(p.ws + WS_KVLAT); float* RSQ = (float*)(p.ws + WS_MISC + MISC_RSQ);
    const float* cosT = (const float*)(p.ws + WS_COS); const float* sinT = (const float*)(p.ws + WS_SIN);
    for (int row = gw; row < S; row += ngw) {
        const bf16_t* pr = PROJ + (size_t)row * NP;
        { const u32x2 w = *(const u32x2*)(pr + C_CQ + 4 * lane); const float a = lo_bf(w.x), b = hi_bf(w.x), c = lo_bf(w.y), d = hi_bf(w.y);
          const float ss = wave_sum((a * a + b * b) + (c * c + d * d)); if (lane == 0) RSQ[row] = rsqrtf(ss * (1.f / 256.f) + RMS_EPS); }
        { const unsigned w = *(const unsigned*)(pr + C_CKV + 2 * lane); const float a = lo_bf(w), b = hi_bf(w);
          const float rs = rsqrtf(wave_sum(a * a + b * b) * (1.f / 128.f) + RMS_EPS); const float* g = p.kv_norm + l * 128 + 2 * lane;
          *(unsigned*)(KV + (size_t)row * 192 + 2 * lane) = cvtpk(a * rs * g[0], b * rs * g[1]); }
        if (lane < 32) { const float t1 = bf2f(pr[C_KR + lane]), t2 = bf2f(pr[C_KR + 32 + lane]); const float c = cosT[(size_t)row * 32 + lane], s = sinT[(size_t)row * 32 + lane];
          *(unsigned*)(KV + (size_t)row * 192 + 128 + 2 * lane) = cvtpk(t1 * c - t2 * s, t1 * s + t2 * c); }
    }
}
__device__ __forceinline__ void job_gdn_final(const Params& p, int l, int gw, int ngw, int lane, int wid, LAS unsigned char* lds) {
    bf16_t* PROJ = (bf16_t*)(p.ws + WS_PROJ); const bf16_t* U = (const bf16_t*)(p.ws + WS_U);
    LAS bf16_t* T = (LAS bf16_t*)(lds + wid * 17408);
    const int cg = lane & 7, dvb = lane >> 3;
    for (int it = gw; it < 1024; it += ngw) {
        const int n = it >> 2, h = it & 3; const bf16_t* ut = U + (size_t)it * 8192;
        float ss[8] = {0.f, 0.f, 0.f, 0.f, 0.f, 0.f, 0.f, 0.f}; u32x4 w[16];
#pragma unroll
        for (int j = 0; j < 16; ++j) { w[j] = *(const u32x4*)(ut + (dvb + 8 * j) * 64 + 8 * cg);
            const float v0 = lo_bf(w[j].x), v1 = hi_bf(w[j].x), v2 = lo_bf(w[j].y), v3 = hi_bf(w[j].y), v4 = lo_bf(w[j].z), v5 = hi_bf(w[j].z), v6 = lo_bf(w[j].w), v7 = hi_bf(w[j].w);
            ss[0] += v0 * v0; ss[1] += v1 * v1; ss[2] += v2 * v2; ss[3] += v3 * v3; ss[4] += v4 * v4; ss[5] += v5 * v5; ss[6] += v6 * v6; ss[7] += v7 * v7; }
#pragma unroll
        for (int e = 0; e < 8; ++e) { ss[e] += __shfl_xor(ss[e], 8); ss[e] += __shfl_xor(ss[e], 16); ss[e] += __shfl_xor(ss[e], 32); ss[e] = rsqrtf(ss[e] * (1.f / 128.f) + RMS_EPS); }
#pragma unroll
        for (int j = 0; j < 16; ++j) { const int dv = dvb + 8 * j; const float g = p.gdn_norm[l * 128 + dv];
            T[(8 * cg + 0) * 136 + dv] = f2bf(lo_bf(w[j].x) * ss[0] * g); T[(8 * cg + 1) * 136 + dv] = f2bf(hi_bf(w[j].x) * ss[1] * g);
            T[(8 * cg + 2) * 136 + dv] = f2bf(lo_bf(w[j].y) * ss[2] * g); T[(8 * cg + 3) * 136 + dv] = f2bf(hi_bf(w[j].y) * ss[3] * g);
            T[(8 * cg + 4) * 136 + dv] = f2bf(lo_bf(w[j].z) * ss[4] * g); T[(8 * cg + 5) * 136 + dv] = f2bf(hi_bf(w[j].z) * ss[5] * g);
            T[(8 * cg + 6) * 136 + dv] = f2bf(lo_bf(w[j].w) * ss[6] * g); T[(8 * cg + 7) * 136 + dv] = f2bf(hi_bf(w[j].w) * ss[7] * g); }
        LDS_WAIT();
#pragma unroll 4
        for (int i = 0; i < 16; ++i) { const int id = lane + 64 * i, c = id >> 4, dc = id & 15;
            const u32x4 v = *(const LAS u32x4*)(T + c * 136 + dc * 8);
            bf16_t* zp = PROJ + (size_t)(n * 64 + c) * NP + C_Z + 512 + h * 128 + dc * 8; const u32x4 z = *(const u32x4*)zp;
            u32x4 o; o.x = cvtpk(lo_bf(v.x) * silu_f(lo_bf(z.x)), hi_bf(v.x) * silu_f(hi_bf(z.x))); o.y = cvtpk(lo_bf(v.y) * silu_f(lo_bf(z.y)), hi_bf(v.y) * silu_f(hi_bf(z.y)));
            o.z = cvtpk(lo_bf(v.z) * silu_f(lo_bf(z.z)), hi_bf(v.z) * silu_f(hi_bf(z.z))); o.w = cvtpk(lo_bf(v.w) * silu_f(lo_bf(z.w)), hi_bf(v.w) * silu_f(hi_bf(z.w)));
            *(u32x4*)zp = o; }
        LDS_WAIT();
    }
}
namespace gdn {
constexpr int L_QH = 0, L_KH = 17408, L_KBGT = 34816, L_KHDT = 53248, L_VBT = 71680, L_LF = 90112, L_TB = 107520, L_GV = 116736, L_END = 118016;
constexpr int QP = 136, TP = 72, LP = 68;
__device__ __forceinline__ bf16_t* frag_ptr(bf16_t* PROJ, int n, int h, int f, int lane) {
    const int seg = 4 * f + (lane >> 4), part = seg >> 6, row = seg & 63;
    return PROJ + (size_t)(n * 64 + row) * NP + C_BQKV + part * 512 + h * 128 + (lane & 15) * 8;
}
__device__ __forceinline__ void prep_item(const Params& p, int l, int n, int h, LAS unsigned char* lds) {
    const int tid = tidx(), lane = tid & 63, r32 = lane & 31, hi = lane >> 5, wid = __builtin_amdgcn_readfirstlane(tid >> 6);
    bf16_t* PROJ = (bf16_t*)(p.ws + WS_PROJ); const bf16_t* HALO = (const bf16_t*)(p.ws + WS_HALO);
    bf16_t* AQKg = (bf16_t*)(p.ws + WS_AQK); bf16_t* Ug = (bf16_t*)(p.ws + WS_U); float* EGL = (float*)(p.ws + WS_MISC + MISC_EGL);
    LAS bf16_t* QH = (LAS bf16_t*)(lds + L_QH); LAS bf16_t* KH = (LAS bf16_t*)(lds + L_KH); LAS bf16_t* KBGT = (LAS bf16_t*)(lds + L_KBGT);
    LAS bf16_t* KHDT = (LAS bf16_t*)(lds + L_KHDT); LAS bf16_t* VBT = (LAS bf16_t*)(lds + L_VBT); LAS float* LF = (LAS float*)(lds + L_LF);
    LAS bf16_t* TB = (LAS bf16_t*)(lds + L_TB); LAS float* GC = (LAS float*)(lds + L_GV); LAS float* BETA = GC + 64; LAS float* EGC = GC + 128; LAS float* EGD = GC + 192;
    const int t0 = n * 64;
    __syncthreads();
    if (wid == 0) {
        const bf16_t* pr = PROJ + (size_t)(t0 + lane) * NP;
        const float xa = bf2f(pr[C_BA + h]) + p.dt_bias[l * 4 + h], xb = bf2f(pr[C_BB + h]);
        const float e = __expf(xa); const float sp = xa > 20.f ? xa : (e < 1e-3f ? e * (1.f - e * (0.5f - e * (1.f / 3.f))) : logf(1.f + e));
        float gc = -__expf(p.a_log[l * 4 + h]) * sp;
#pragma unroll
        for (int o = 1; o < 64; o <<= 1) { const float t_ = __shfl_up(gc, o); if (lane >= o) gc += t_; }
        const float gl = __shfl(gc, 63);
        GC[lane] = gc; BETA[lane] = 1.f / (1.f + __expf(-xb)); EGC[lane] = __expf(gc); EGD[lane] = __expf(gl - gc);
        if (lane == 0) EGL[n * 4 + h] = __expf(gl);
    }
    __syncthreads();
#pragma unroll 1
    for (int it = 0; it < 6; ++it) {
        const int idx = tid + NT_THREADS * it, g16 = idx & 15, pr_ = idx >> 4, part = pr_ >> 6, row = pr_ & 63, cb = part * 512 + h * 128 + g16 * 8;
        float a[8] = {0.f, 0.f, 0.f, 0.f, 0.f, 0.f, 0.f, 0.f};
#pragma unroll
        for (int j = 0; j < 4; ++j) { const int t = t0 + row - 3 + j; u32x4 xw = {0u, 0u, 0u, 0u};
            if (t >= t0) xw = *(const u32x4*)(PROJ + (size_t)t * NP + C_BQKV + cb);
            else if (n > 0) xw = *(const u32x4*)(HALO + ((size_t)(n - 1) * 3 + (t - (t0 - 3))) * 1536 + cb);
            const float* cw = p.conv_w + ((size_t)l * 4 + j) * 1536 + cb; const f32x4 w0 = *(const f32x4*)cw, w1 = *(const f32x4*)(cw + 4);
            a[0] = fmaf(w0[0], lo_bf(xw.x), a[0]); a[1] = fmaf(w0[1], hi_bf(xw.x), a[1]); a[2] = fmaf(w0[2], lo_bf(xw.y), a[2]); a[3] = fmaf(w0[3], hi_bf(xw.y), a[3]);
            a[4] = fmaf(w1[0], lo_bf(xw.z), a[4]); a[5] = fmaf(w1[1], hi_bf(xw.z), a[5]); a[6] = fmaf(w1[2], lo_bf(xw.w), a[6]); a[7] = fmaf(w1[3], hi_bf(xw.w), a[7]); }
        float ss = 0.f;
#pragma unroll
        for (int e = 0; e < 8; ++e) { a[e] = silu_f(a[e]); ss += a[e] * a[e]; }
        ss += __shfl_xor(ss, 1); ss += __shfl_xor(ss, 2); ss += __shfl_xor(ss, 4); ss += __shfl_xor(ss, 8);
        const float rn = rsqrtf(ss + 1e-6f);
        if (part == 0) { const float sc = rn * 0.08838834764831845f;
#pragma unroll
            for (int e = 0; e < 8; ++e) a[e] *= sc;
            *(LAS bf16x8*)(QH + row * QP + g16 * 8) = pack8(a);
        } else if (part == 1) {
#pragma unroll
            for (int e = 0; e < 8; ++e) a[e] *= rn;
            *(LAS bf16x8*)(KH + row * QP + g16 * 8) = pack8(a);
            const float s1 = BETA[row] * EGC[row], s2 = EGD[row];
#pragma unroll
            for (int e = 0; e < 8; ++e) { KBGT[(g16 * 8 + e) * TP + row] = f2bf(a[e] * s1); KHDT[(g16 * 8 + e) * TP + row] = f2bf(a[e] * s2); }
        } else { const float b = BETA[row];
#pragma unroll
            for (int e = 0; e < 8; ++e) VBT[(g16 * 8 + e) * TP + row] = f2bf(a[e] * b);
        }
    }
    __syncthreads();
    if (wid < 3) { const int it = wid > 0, jt = wid > 1; f32x16 acc = {};
#pragma unroll
        for (int ks = 0; ks < 8; ++ks) { const bf16x8 a = *(const LAS bf16x8*)(KH + (32 * it + r32) * QP + 16 * ks + 8 * hi), b = *(const LAS bf16x8*)(KH + (32 * jt + r32) * QP + 16 * ks + 8 * hi);
            acc = MFMA32(a, b, acc); }
        const int j = 32 * jt + r32; const float gj = GC[j];
#pragma unroll
        for (int r = 0; r < 16; ++r) { const int i = 32 * it + crow(r, hi); LF[i * LP + j] = i > j ? BETA[i] * __expf(GC[i] - gj) * acc[r] : 0.f; }
    } else if (wid < 6) { const int w = wid - 3, ctp = w > 1, ct = w > 0; f32x16 acc = {};
#pragma unroll
        for (int ks = 0; ks < 8; ++ks) { const bf16x8 a = *(const LAS bf16x8*)(KH + (32 * ctp + r32) * QP + 16 * ks + 8 * hi), b = *(const LAS bf16x8*)(QH + (32 * ct + r32) * QP + 16 * ks + 8 * hi);
            acc = MFMA32(a, b, acc); }
        const int c = 32 * ct + r32; const float gcq = GC[c];
#pragma unroll
        for (int r = 0; r < 16; ++r) { const int cp = 32 * ctp + crow(r, hi); acc[r] = c >= cp ? acc[r] * __expf(gcq - GC[cp]) : 0.f; }
        bf16_t* dst = AQKg + (((size_t)(n * 4 + h) * 8 + (ct * 2 + ctp) * 2) * 64 + lane) * 8;
        *(bf16x8*)dst = pack_step(acc, 0); *(bf16x8*)(dst + 512) = pack_step(acc, 1);
    } else { const int w = wid - 6;
        if (w == 0) { const bf16x8 z = {0, 0, 0, 0, 0, 0, 0, 0}; bf16_t* dst = AQKg + (((size_t)(n * 4 + h) * 8 + 2) * 64 + lane) * 8; *(bf16x8*)dst = z; *(bf16x8*)(dst + 512) = z; }
#pragma unroll
        for (int ff = 0; ff < 8; ++ff) { const int f = w * 8 + ff, s = f & 1, mt = (f >> 1) & 3, ct = f >> 3, c = 32 * ct + r32, d0 = 32 * mt + 16 * s + 4 * hi; const float eg = EGC[c];
            const u32x2 lo = *(const LAS u32x2*)(QH + c * QP + d0), hw = *(const LAS u32x2*)(QH + c * QP + d0 + 8);
            u32x4 o; o.x = cvtpk(lo_bf(lo.x) * eg, hi_bf(lo.x) * eg); o.y = cvtpk(lo_bf(lo.y) * eg, hi_bf(lo.y) * eg); o.z = cvtpk(lo_bf(hw.x) * eg, hi_bf(hw.x) * eg); o.w = cvtpk(lo_bf(hw.y) * eg, hi_bf(hw.y) * eg);
            *(u32x4*)frag_ptr(PROJ, n, h, 16 + f, lane) = o; }
    }
    __syncthreads();
    if (wid == 0) {
        float T[64];
        unsigned lfb = (unsigned)(uintptr_t)LF; asm volatile("" : "+v"(lfb));
        const LAS float* LFv = (const LAS float*)(uintptr_t)lfb;
#pragma unroll
        for (int i = 0; i < 64; ++i) { float acc = (lane == i) ? 1.f : 0.f;
#pragma unroll
            for (int j = 0; j < i; ++j) acc = fmaf(-LFv[i * LP + j], T[j], acc);
            T[i] = acc; }
#pragma unroll
        for (int i = 0; i < 64; ++i) TB[i * TP + lane] = f2bf(T[i]);
    } else {
        for (int f = wid - 1; f < 16; f += 7) { const int s = f & 1, ctp = (f >> 1) & 1, mt = f >> 2, dk = 32 * mt + r32, c0 = 32 * ctp + 16 * s + 4 * hi;
            const u32x2 lo = *(const LAS u32x2*)(KHDT + dk * TP + c0), hw = *(const LAS u32x2*)(KHDT + dk * TP + c0 + 8);
            u32x4 o = {lo.x, lo.y, hw.x, hw.y}; *(u32x4*)frag_ptr(PROJ, n, h, 32 + f, lane) = o; }
    }
    __syncthreads();
    { const int mt = wid >> 1, ct = wid & 1; f32x16 acc = {};
#pragma unroll
      for (int ks = 0; ks < 4; ++ks) { const bf16x8 a = *(const LAS bf16x8*)(KBGT + (32 * mt + r32) * TP + 16 * ks + 8 * hi), b = *(const LAS bf16x8*)(TB + (32 * ct + r32) * TP + 16 * ks + 8 * hi);
          acc = MFMA32(a, b, acc); }
#pragma unroll
      for (int r = 0; r < 16; ++r) acc[r] = -acc[r];
      *(bf16x8*)frag_ptr(PROJ, n, h, (ct * 4 + mt) * 2, lane) = pack_step(acc, 0); *(bf16x8*)frag_ptr(PROJ, n, h, (ct * 4 + mt) * 2 + 1, lane) = pack_step(acc, 1); }
    { const int ct = wid >> 2, dt = wid & 3; f32x16 acc = {};
#pragma unroll
      for (int ks = 0; ks < 4; ++ks) { const bf16x8 a = *(const LAS bf16x8*)(TB + (32 * ct + r32) * TP + 16 * ks + 8 * hi), b = *(const LAS bf16x8*)(VBT + (32 * dt + r32) * TP + 16 * ks + 8 * hi);
          acc = MFMA32(a, b, acc); }
      bf16_t* up = Ug + ((size_t)(n * 4 + h) * 128 + 32 * dt + r32) * 64 + 32 * ct + 4 * hi;
#pragma unroll
      for (int g = 0; g < 4; ++g) { u32x2 w; w.x = cvtpk(acc[4 * g], acc[4 * g + 1]); w.y = cvtpk(acc[4 * g + 2], acc[4 * g + 3]); *(u32x2*)(up + 8 * g) = w; } }
}
constexpr int SCAN_STAGE = 57344;
__device__ __forceinline__ const u32x4* scan_src(const bf16_t* PROJ, const bf16_t* AQKg, int n, int h, int k, int ll) {
    if (k < 12) { const int piece = k * 256 + ll; return (const u32x4*)frag_ptr((bf16_t*)PROJ, n, h, piece >> 6, piece & 63); }
    return (const u32x4*)(AQKg + ((size_t)(n * 4 + h) * 512 + (k - 12) * 256 + ll) * 8);
}
__device__ __forceinline__ void scan_wg(const Params& p, int h, LAS unsigned char* lds) {
    const int tid = tidx(), lane = tid & 63, r32 = lane & 31, hi = lane >> 5, wid = __builtin_amdgcn_readfirstlane(tid >> 6);
    const bf16_t* PROJ = (const bf16_t*)(p.ws + WS_PROJ); const bf16_t* AQKg = (const bf16_t*)(p.ws + WS_AQK); bf16_t* Ug = (bf16_t*)(p.ws + WS_U); const float* EGL = (const float*)(p.ws + WS_MISC + MISC_EGL);
    constexpr int NCH = S / 64;
    __syncthreads();
    if (wid >= 4) {
        const int ll = tid - 256; u32x4 st[14];
#pragma unroll
        for (int k = 0; k < 14; ++k) st[k] = *scan_src(PROJ, AQKg, 0, h, k, ll);
#pragma unroll
        for (int k = 0; k < 14; ++k) *(LAS u32x4*)(lds + (k * 256 + ll) * 16) = st[k];
#pragma unroll
        for (int k = 0; k < 14; ++k) st[k] = *scan_src(PROJ, AQKg, 1, h, k, ll);
        __syncthreads();
#pragma unroll 1
        for (int n = 0; n < NCH; ++n) {
            if (n + 1 < NCH) {
#pragma unroll
                for (int k = 0; k < 14; ++k) *(LAS u32x4*)(lds + ((n + 1) & 1) * SCAN_STAGE + (k * 256 + ll) * 16) = st[k];
            }
            if (n + 2 < NCH) {
#pragma unroll
                for (int k = 0; k < 14; ++k) st[k] = *scan_src(PROJ, AQKg, n + 2, h, k, ll);
            }
            __syncthreads();
        }
    } else {
        const int sl = wid;
        f32x16 St[4] = {};
        bf16_t* ub = Ug + ((size_t)h * 128 + sl * 32 + r32) * 64 + 4 * hi;
        u32x2 un[2][4];
#pragma unroll
        for (int ct = 0; ct < 2; ++ct)
#pragma unroll
            for (int g = 0; g < 4; ++g) un[ct][g] = *(const u32x2*)(ub + 32 * ct + 8 * g);
        __syncthreads();
#pragma unroll 1
        for (int n = 0; n < NCH; ++n) {
            const LAS unsigned char* stg = lds + (n & 1) * SCAN_STAGE + lane * 16;
            const float egl = EGL[n * 4 + h];
            f32x16 vn[2], o[2] = {};
#pragma unroll
            for (int ct = 0; ct < 2; ++ct)
#pragma unroll
                for (int g = 0; g < 4; ++g) { vn[ct][4 * g] = lo_bf(un[ct][g].x); vn[ct][4 * g + 1] = hi_bf(un[ct][g].x); vn[ct][4 * g + 2] = lo_bf(un[ct][g].y); vn[ct][4 * g + 3] = hi_bf(un[ct][g].y); }
            bf16_t* uc = ub + (size_t)n * (4 * 128 * 64);
            if (n + 1 < NCH) {
#pragma unroll
                for (int ct = 0; ct < 2; ++ct)
#pragma unroll
                    for (int g = 0; g < 4; ++g) un[ct][g] = *(const u32x2*)(uc + 4 * 128 * 64 + 32 * ct + 8 * g);
            }
            bf16x8 Sb[4][2];
#pragma unroll
            for (int mt = 0; mt < 4; ++mt) { Sb[mt][0] = pack_step(St[mt], 0); Sb[mt][1] = pack_step(St[mt], 1); }
#pragma unroll
            for (int mt = 0; mt < 4; ++mt)
#pragma unroll
                for (int s = 0; s < 2; ++s)
#pragma unroll
                    for (int ct = 0; ct < 2; ++ct) { const int f = (ct * 4 + mt) * 2 + s;
                        vn[ct] = MFMA32(*(const LAS bf16x8*)(stg + f * 1024), Sb[mt][s], vn[ct]);
                        o[ct] = MFMA32(*(const LAS bf16x8*)(stg + (16 + f) * 1024), Sb[mt][s], o[ct]); }
            bf16x8 Vb[2][2];
#pragma unroll
            for (int ct = 0; ct < 2; ++ct) { Vb[ct][0] = pack_step(vn[ct], 0); Vb[ct][1] = pack_step(vn[ct], 1); }
#pragma unroll
            for (int mt = 0; mt < 4; ++mt)
#pragma unroll
                for (int r = 0; r < 16; ++r) St[mt][r] *= egl;
#pragma unroll
            for (int ctp = 0; ctp < 2; ++ctp)
#pragma unroll
                for (int s = 0; s < 2; ++s) {
                    o[1] = MFMA32(*(const LAS bf16x8*)(stg + (48 + (2 + ctp) * 2 + s) * 1024), Vb[ctp][s], o[1]);
                    if (ctp == 0) o[0] = MFMA32(*(const LAS bf16x8*)(stg + (48 + s) * 1024), Vb[0][s], o[0]);
#pragma unroll
                    for (int mt = 0; mt < 4; ++mt) St[mt] = MFMA32(*(const LAS bf16x8*)(stg + (32 + (mt * 2 + ctp) * 2 + s) * 1024), Vb[ctp][s], St[mt]);
                }
#pragma unroll
            for (int ct = 0; ct < 2; ++ct)
#pragma unroll
                for (int g = 0; g < 4; ++g) { u32x2 w; w.x = cvtpk(o[ct][4 * g], o[ct][4 * g + 1]); w.y = cvtpk(o[ct][4 * g + 2], o[ct][4 * g + 3]); *(u32x2*)(uc + 32 * ct + 8 * g) = w; }
            __syncthreads();
        }
    }
}
}
constexpr int N_PHASES = 2 + 7 * DEPTH;
constexpr int SCAN_WGS = 4;
constexpr float QSCALE = 0.07216878364870322f * LOG2E;

template <int KIND> __device__ __forceinline__ void run_kind(const Params& p, int l, LAS unsigned char* lds) {
    const int tid = tidx(), lane = tid & 63, wid = __builtin_amdgcn_readfirstlane(tid >> 6);
    const int bid = bidx(), nblk = gridDim.x, gw = bid * 8 + wid, ngw = nblk * 8, gtid = bid * NT_THREADS + tid, gn = nblk * NT_THREADS;
    bf16_t* PROJ = (bf16_t*)(p.ws + WS_PROJ);
    if constexpr (KIND == 0) {
        job_win(p, 0, bid, nblk, lds); job_wout(p, 0, bid, nblk, lds); job_wmem(p, bid, nblk, lds);
        job_wq(p, gtid, gn); job_wuv(p, gtid, gn); job_rope(p, gtid, gn); job_btab(p, gtid, gn); job_memn(p, gw, ngw, lane);
    } else if constexpr (KIND == 1) {
        for (int ll = 0; ll < 2; ++ll) {
            pg8::Gemm g{(const bf16_t*)(p.ws + WS_MEMN) + (size_t)ll * MEML * DM, (const bf16_t*)(p.ws + WS_WMEM) + (size_t)ll * DM * DM, MEML, DM, DM, DM};
            pg8::StaticOrder so; so.init(MEML, DM, nblk, (bid + nblk - 4 * ll) % nblk);
            pg8::EpiStore E{(bf16_t*)(p.ws + WS_MEMKV) + (size_t)ll * MEML * DM, DM, nullptr};
            pg8::gemm_phase<pg8::EpiStore, pg8::StaticOrder, true, true>(lds, g, so, E);
        }
        job_norm_rows(p, 0, gw, ngw, lane);
    } else if constexpr (KIND == 2) {
        pg8::Gemm g{(const bf16_t*)(p.ws + WS_H), (const bf16_t*)(p.ws + WS_WIN), S, NP, DM, DM};
        pg8::StaticOrder so; so.init(S, NP, nblk, bid);
        pg8::EpiStore E{PROJ, NP, (bf16_t*)(p.ws + WS_HALO)};
        pg8::gemm_phase<pg8::EpiStore, pg8::StaticOrder, true, true>(lds, g, so, E);
    } else if constexpr (KIND == 3) {
        job_mla_rows(p, l, gw, ngw, lane);
        for (int u = bid; u < 512; u += nblk) att::swa_unit(lds, u >> 1, u & 1, PROJ, p.pos, p.sinks + l * 8, (const float*)(p.ws + WS_MISC + MISC_BTAB));
        for (int u = bid; u < 256; u += nblk) att::cross_unit(lds, u >> 2, u & 3, PROJ, (const bf16_t*)(p.ws + WS_MEMKV) + (size_t)l * MEML * DM);
        for (int it = bid; it < 1024; it += nblk) gdn::prep_item(p, l, it >> 2, it & 3, lds);
        __syncthreads();
        if (l == 0) job_win(p, 1, bid, nblk, lds);
    } else if constexpr (KIND == 4) {
        pg8::Gemm g{PROJ + C_CQ, (const bf16_t*)(p.ws + WS_WQ) + (size_t)l * 768 * 256, S, 768, 256, NP};
        pg8::StaticOrder so; so.init(S, 768, nblk, bid);
        pg8::EpiStore E{(bf16_t*)(p.ws + WS_QABS), 768, nullptr};
        pg8::gemm_phase<pg8::EpiStore, pg8::StaticOrder, true, true>(lds, g, so, E);
    } else if constexpr (KIND == 5) {
        if (bid < SCAN_WGS) gdn::scan_wg(p, bid, lds);
        else for (int u = bid - SCAN_WGS; u < 256; u += nblk - SCAN_WGS) att::mla_unit(lds, 63 - (u >> 2), u & 3, (const bf16_t*)(p.ws + WS_QABS), (const bf16_t*)(p.ws + WS_KVLAT), PROJ, (const float*)(p.ws + WS_MISC + MISC_RSQ), (const float*)(p.ws + WS_COS), (const float*)(p.ws + WS_SIN), QSCALE);
    } else if constexpr (KIND == 6) {
        pg8::Gemm g{PROJ + C_OLAT, (const bf16_t*)(p.ws + WS_WUV) + (size_t)l * 512 * 512, S, 512, 512, NP};
        pg8::StaticOrder so; so.init(S, 512, nblk, bid);
        pg8::EpiGate E{PROJ + C_Z + 1024, NP};
        pg8::gemm_phase<pg8::EpiGate, pg8::StaticOrder, true, true>(lds, g, so, E);
        __syncthreads();
        job_gdn_final(p, l, gw, ngw, lane, wid, lds);
    } else if constexpr (KIND == 7) {
        pg8::Gemm g{PROJ + C_Z, (const bf16_t*)(p.ws + WS_WOUT), S, DM, MIXW, NP};
        pg8::StaticOrder so; so.init(S, DM, nblk, bid);
        pg8::EpiStore E{(bf16_t*)(p.ws + WS_Y), DM, nullptr};
        pg8::gemm_phase<pg8::EpiStore, pg8::StaticOrder, true, true>(lds, g, so, E);
    } else {
        job_norm_rows(p, l == 0 ? 1 : 2, gw, ngw, lane);
        if (l == 0) job_wout(p, 1, bid, nblk, lds);
    }
}
__device__ __forceinline__ void run_phase(const Params& p, int ph, LAS unsigned char* lds) {
    int kind, l;
    if (ph < 2) { kind = ph; l = 0; } else { l = (ph - 2) / 7; kind = 2 + (ph - 2) % 7; }
    switch (kind) {
    case 0: run_kind<0>(p, l, lds); break; case 1: run_kind<1>(p, l, lds); break; case 2: run_kind<2>(p, l, lds); break; case 3: run_kind<3>(p, l, lds); break;
    case 4: run_kind<4>(p, l, lds); break; case 5: run_kind<5>(p, l, lds); break; case 6: run_kind<6>(p, l, lds); break; case 7: run_kind<7>(p, l, lds); break;
    default: run_kind<8>(p, l, lds); break;
    }
}
template <int KIND> __global__ void __launch_bounds__(NT_THREADS, 2) mk_kind(Params p, int l) {
    extern __shared__ __attribute__((aligned(16))) unsigned char lds_raw[];
    run_kind<KIND>(p, l, (LAS unsigned char*)lds_raw);
}

#ifndef MK_LAUNCHES_PER_PHASE
#define MK_LAUNCHES_PER_PHASE 0
#endif
#if !MK_LAUNCHES_PER_PHASE
__global__ void __launch_bounds__(NT_THREADS, 2) mk_fwd(Params p) {
    extern __shared__ __attribute__((aligned(16))) unsigned char lds_raw[];
    LAS unsigned char* lds = (LAS unsigned char*)lds_raw;
    cg::grid_group grid = cg::this_grid();
    for (int ph = p.ph_lo; ph < p.ph_hi; ++ph) {
        run_phase(p, ph, lds);
        if (ph + 1 < p.ph_hi) grid.sync();
    }
}
#endif

#ifndef MK_LAUNCHES_PER_PHASE
#define MK_LAUNCHES_PER_PHASE 0
#endif
extern "C" void kernel_launch(void* const* d_in, const int* in_sizes, int n_in, void* d_out, int out_size, void* d_ws, size_t ws_size, hipStream_t stream) {
    static int grid = 0;
    if (grid == 0) {
        if (n_in != 19 || in_sizes[0] != S * DM || out_size != S * DM || ws_size < WS_END) { fprintf(stderr, "kernel_launch: unexpected shapes (n_in %d, in0 %d, out %d, ws %zu)\n", n_in, n_in > 0 ? in_sizes[0] : -1, out_size, ws_size); grid = -1; return; }
        int dev = 0, cus = 0, per_cu = 0;
        (void)hipGetDevice(&dev); (void)hipDeviceGetAttribute(&cus, hipDeviceAttributeMultiprocessorCount, dev);
#if !MK_LAUNCHES_PER_PHASE
        if (hipFuncSetAttribute((const void*)mk_fwd, hipFuncAttributeMaxDynamicSharedMemorySize, LDS_BYTES) != hipSuccess) { fprintf(stderr, "kernel_launch: hipFuncSetAttribute failed\n"); grid = -1; return; }
        if (hipOccupancyMaxActiveBlocksPerMultiprocessor(&per_cu, (const void*)mk_fwd, NT_THREADS, LDS_BYTES) != hipSuccess || per_cu < 1) { fprintf(stderr, "kernel_launch: occupancy query gave %d\n", per_cu); per_cu = 1; }
#else
#define SA(K) (void)hipFuncSetAttribute((const void*)mk_kind<K>, hipFuncAttributeMaxDynamicSharedMemorySize, LDS_BYTES)
        SA(0); SA(1); SA(2); SA(3); SA(4); SA(5); SA(6); SA(7); SA(8);
#undef SA
#endif
        (void)hipGetLastError();
        if (cus <= 0) cus = 256;
        grid = cus;
        fprintf(stderr, "kernel_launch: cus %d per_cu %d grid %d\n", cus, per_cu, grid);
    }
    if (grid < 0) return;
    Params p{};
    p.x = (const float*)d_in[0]; p.mem = (const float*)d_in[1]; p.pos = (const int*)d_in[2]; p.rel_bias = (const float*)d_in[3];
    p.norm_pre = (const float*)d_in[4]; p.norm_post = (const float*)d_in[5]; p.w_in = (const float*)d_in[6]; p.sinks = (const float*)d_in[7];
    p.conv_w = (const float*)d_in[8]; p.a_log = (const float*)d_in[9]; p.dt_bias = (const float*)d_in[10]; p.gdn_norm = (const float*)d_in[11];
    p.q_norm = (const float*)d_in[12]; p.kv_norm = (const float*)d_in[13]; p.w_uq = (const float*)d_in[14]; p.w_ukv = (const float*)d_in[15];
    p.mem_norm = (const float*)d_in[16]; p.w_mem = (const float*)d_in[17]; p.w_out = (const float*)d_in[18];
    p.out = (float*)d_out; p.ws = (unsigned char*)d_ws;
#if MK_LAUNCHES_PER_PHASE
    p.ph_lo = 0; p.ph_hi = 0;
#define LK(K, L) hipLaunchKernelGGL(mk_kind<K>, dim3(grid), dim3(NT_THREADS), LDS_BYTES, stream, p, L)
    LK(0, 0); LK(1, 0);
    for (int l = 0; l < DEPTH; ++l) { LK(2, l); LK(3, l); LK(4, l); LK(5, l); LK(6, l); LK(7, l); LK(8, l); }
#undef LK
#else
    p.ph_lo = 0; p.ph_hi = N_PHASES;
    void* args[] = {&p};
    hipError_t e = hipLaunchCooperativeKernel((const void*)mk_fwd, dim3(grid), dim3(NT_THREADS), args, LDS_BYTES, stream);
    if (e != hipSuccess) fprintf(stderr, "kernel_launch: cooperative launch failed: %s (grid %d)\n", hipGetErrorString(e), grid);
#endif
}
```

```cpp
#include <hip/hip_runtime.h>
#include <hip/hip_cooperative_groups.h>
#include <cstdint>
#include <cstdio>
namespace cg = cooperative_groups;

#define LAS __attribute__((address_space(3)))
typedef unsigned short bf16_t;
typedef short bf16x8 __attribute__((ext_vector_type(8)));
typedef short s16x4 __attribute__((ext_vector_type(4)));
typedef float f32x2 __attribute__((ext_vector_type(2)));
typedef float f32x4 __attribute__((ext_vector_type(4)));
typedef float f32x16 __attribute__((ext_vector_type(16)));
typedef unsigned u32x2 __attribute__((ext_vector_type(2)));
typedef unsigned u32x4 __attribute__((ext_vector_type(4)));
typedef __bf16 bf16x2_t __attribute__((ext_vector_type(2)));

constexpr int S = 16384, DM = 1024, MEML = 256, NP = 5376, DEPTH = 2, DIN = 5320, MIXW = 2048;
constexpr int C_Z = 0, C_AQ = 2048, C_AK = 2560, C_AV = 2688, C_DQ = 2816, C_BQKV = 3328, C_CQ = 4864, C_CKV = 5120, C_KR = 5248, C_BA = 5312, C_BB = 5316;
constexpr int C_OLAT = 2048;
constexpr float RMS_EPS = 1e-6f;
constexpr float LOG2E = 1.4426950408889634f;
constexpr int NT_THREADS = 512;

constexpr size_t MiB = 1u << 20;
constexpr size_t WS_CTL = 0, WS_COS = 1 * MiB, WS_SIN = 3 * MiB, WS_MEMKV = 5 * MiB, WS_MISC = 6 * MiB, WS_MEMN = 7 * MiB;
constexpr size_t WS_WIN = 8 * MiB, WS_WOUT = 19 * MiB, WS_WMEM = 23 * MiB, WS_WQ = 27 * MiB, WS_WUV = 28 * MiB, WS_HALO = 29 * MiB;
constexpr size_t WS_AQK = 32 * MiB, WS_U = 40 * MiB, WS_H = 56 * MiB, WS_PROJ = 88 * MiB, WS_END = 256 * MiB;
constexpr size_t WS_QABS = WS_H, WS_KVLAT = WS_H + 24 * MiB, WS_Y = WS_H;
constexpr size_t MISC_BTAB = 0, MISC_RSQ = 8192, MISC_EGL = 8192 + 65536;

constexpr int LDS_BYTES = 163840;

struct Params {
    const float* x; const float* mem; const int* pos; const float* rel_bias;
    const float* norm_pre; const float* norm_post; const float* w_in; const float* sinks;
    const float* conv_w; const float* a_log; const float* dt_bias; const float* gdn_norm;
    const float* q_norm; const float* kv_norm; const float* w_uq; const float* w_ukv;
    const float* mem_norm; const float* w_mem; const float* w_out;
    float* out; unsigned char* ws;
    int ph_lo, ph_hi;
};

__device__ __forceinline__ int tidx() { int t = threadIdx.x; asm volatile("" : "+v"(t)); return t; }
__device__ __forceinline__ int bidx() { int b = blockIdx.x; asm volatile("" : "+s"(b)); return b; }
__device__ __forceinline__ float bf2f(bf16_t v) { return __uint_as_float((unsigned)v << 16); }
__device__ __forceinline__ unsigned cvtpk(float lo, float hi) { f32x2 v = {lo, hi}; bf16x2_t b = __builtin_convertvector(v, bf16x2_t); return __builtin_bit_cast(unsigned, b); }
__device__ __forceinline__ bf16_t f2bf(float f) { return (bf16_t)(cvtpk(f, 0.f) & 0xffffu); }
__device__ __forceinline__ float lo_bf(unsigned w) { return __uint_as_float(w << 16); }
__device__ __forceinline__ float hi_bf(unsigned w) { return __uint_as_float(w & 0xffff0000u); }
__device__ __forceinline__ float silu_f(float v) { return v / (1.f + __expf(-v)); }
__device__ __forceinline__ float wave_sum(float v) {
#pragma unroll
    for (int o = 1; o < 64; o <<= 1) v += __shfl_xor(v, o);
    return v;
}
__device__ __forceinline__ int crow(int r, int hi) { return (r & 3) + 8 * (r >> 2) + 4 * hi; }
#define MFMA32(a, b, c) __builtin_amdgcn_mfma_f32_32x32x16_bf16((a), (b), (c), 0, 0, 0)
#define SBAR() __builtin_amdgcn_sched_barrier(0)
#define LDS_WAIT() asm volatile("s_waitcnt lgkmcnt(0)" ::: "memory")
__device__ __forceinline__ bf16x8 pack8(const float* v) { u32x4 w = {cvtpk(v[0], v[1]), cvtpk(v[2], v[3]), cvtpk(v[4], v[5]), cvtpk(v[6], v[7])}; return __builtin_bit_cast(bf16x8, w); }
__device__ __forceinline__ bf16x8 pack_step(const f32x16& x, int s) {
    u32x4 w = {cvtpk(x[8 * s + 0], x[8 * s + 1]), cvtpk(x[8 * s + 2], x[8 * s + 3]), cvtpk(x[8 * s + 4], x[8 * s + 5]), cvtpk(x[8 * s + 6], x[8 * s + 7])};
    return __builtin_bit_cast(bf16x8, w);
}

__device__ __forceinline__ int win_src(int n) {
    if (n < 512) return 768 + n;
    if (n < 1024) return 2824 + (n - 512);
    if (n < 1536) return 3784 + (n - 1024);
    if (n < 2048) return 4808 + (n - 1536);
    if (n < 2560) return n - 2048;
    if (n < 2688) return 512 + (n - 2560);
    if (n < 2816) return 640 + (n - 2688);
    if (n < 3328) return 4296 + (n - 2816);
    if (n < 4864) return 1280 + (n - 3328);
    if (n < 5120) return 3336 + (n - 4864);
    if (n < 5248) return 3592 + (n - 5120);
    if (n < 5312) return 3720 + (n - 5248);
    if (n < 5316) return 2816 + (n - 5312);
    if (n < 5320) return 2820 + (n - 5316);
    return -1;
}

__device__ __forceinline__ int t5_bucket(int n) {
    if (n < 16) return n < 0 ? 0 : n;
    if (n >= 128) return 31;
    const float v = __logf((float)n * 0.0625f) * (16.0f / 2.0794415416798357f);
    int b = 16 + (int)v; return b > 31 ? 31 : b;
}
__device__ __forceinline__ float inv_freq(int i) {
    const float t[32] = {1.000000000e+00f, 7.498942018e-01f, 5.623413324e-01f, 4.216965139e-01f, 3.162277639e-01f, 2.371373922e-01f, 1.778279394e-01f, 1.333521456e-01f,
                         1.000000015e-01f, 7.498941571e-02f, 5.623412877e-02f, 4.216964915e-02f, 3.162277862e-02f, 2.371373586e-02f, 1.778279431e-02f, 1.333521493e-02f,
                         9.999999776e-03f, 7.498942316e-03f, 5.623413250e-03f, 4.216964822e-03f, 3.162277862e-03f, 2.371373819e-03f, 1.778279431e-03f, 1.333521446e-03f,
                         1.000000047e-03f, 7.498941850e-04f, 5.623413017e-04f, 4.216965463e-04f, 3.162277862e-04f, 2.371373848e-04f, 1.778279402e-04f, 1.333521504e-04f};
    return t[i];
}
namespace pg8 {
#define PG8_LAS __attribute__((address_space(3)))
constexpr int BM = 256, BK = 64, HALF = 128, HTB = HALF * BK * 2  , STAGE_BYTES = 8 * HTB, NXCD = 8, WGM = 8;
__host__ __device__ __forceinline__ int lds_byte(int r, int c) { const int st = (r >> 4) * 2 + (c >> 5), rr = r & 15, cc = c & 31, ob = rr * 64 + cc * 2; return st * 1024 + (ob ^ (((ob >> 9) & 1) << 5)); }
__host__ __device__ __forceinline__ void stage_rc(int b, int& R, int& C) { const int st = b / 1024, sb = b % 1024, swz = sb ^ (((sb >> 9) & 1) << 5); R = (st >> 1) * 16 + swz / 64; C = (st & 1) * 32 + (swz % 64) / 2; }
__host__ __device__ __forceinline__ int perm32(int rho) { const int n = rho >> 4, i = rho & 15; return 8 * (i >> 2) + 4 * n + (i & 3); }
struct Unit { int pm, pn; };
struct Gemm { const bf16_t* A; const bf16_t* Bt; int M, N, K, lda; };
struct StaticOrder {
    int nM, nN, nwg, G, c;
    __device__ void init(int M, int N, int G_, int c_) { nM = M / BM; nN = N / BM; nwg = nM * nN; G = G_; c = c_; }
    __device__ bool next(int i, Unit& u) const {
        const long L = (long)i * G + c; if (L >= nwg) return false;
        int wgid = (int)L; { const int q = nwg / NXCD, r = nwg % NXCD, xcd = wgid % NXCD, off = wgid / NXCD; wgid = (xcd < r ? xcd * (q + 1) : r * (q + 1) + (xcd - r) * q) + off; }
        const int nig = WGM * nN, gid = wgid / nig, fm = gid * WGM, gsz = (nM - fm) < WGM ? (nM - fm) : WGM;
        u.pm = fm + ((wgid % nig) % gsz); u.pn = (wgid % nig) / gsz; return true;
    }
    __device__ __forceinline__ void a_ready(const Unit&) const {}
    __device__ __forceinline__ void done(const Unit&) const {}
};
struct EpiStore {
    static constexpr bool PERM = true, AFTER_DRAIN = false;
    bf16_t* O; int ldc; bf16_t* halo;
    __device__ __forceinline__ void operator()(const f32x4 (&acc)[2][2][4][2], const Unit& u, int wr, int wc, int fr, int fq) const {
        const int row0 = u.pm * BM + wr * 64 + fr, col0 = u.pn * BM + wc * 32 + 8 * fq;
        const bool hz = halo != nullptr && col0 >= C_BQKV && col0 < C_BQKV + 1536;
#pragma unroll
        for (int ai = 0; ai < 2; ++ai)
#pragma unroll
            for (int m = 0; m < 4; ++m) { const int row = row0 + ai * HALF + m * 16; bf16_t* rowp = O + (size_t)row * ldc + col0;
#pragma unroll
                for (int bj = 0; bj < 2; ++bj) { const f32x4 v0 = acc[ai][bj][m][0], v1 = acc[ai][bj][m][1];
                    u32x4 w; w.x = cvtpk(v0[0], v0[1]); w.y = cvtpk(v0[2], v0[3]); w.z = cvtpk(v1[0], v1[1]); w.w = cvtpk(v1[2], v1[3]);
                    *(u32x4*)(rowp + bj * HALF) = w;
                    if (m == 3 && hz && fr >= 13) *(u32x4*)(halo + ((size_t)(row >> 6) * 3 + (fr - 13)) * 1536 + (col0 + bj * HALF - C_BQKV)) = w; } }
    }
};
struct EpiGate {
    static constexpr bool PERM = true, AFTER_DRAIN = false;
    bf16_t* G; int ldc;
    __device__ __forceinline__ void operator()(const f32x4 (&acc)[2][2][4][2], const Unit& u, int wr, int wc, int fr, int fq) const {
        const int row0 = u.pm * BM + wr * 64 + fr, col0 = u.pn * BM + wc * 32 + 8 * fq;
#pragma unroll
        for (int ai = 0; ai < 2; ++ai)
#pragma unroll
            for (int m = 0; m < 4; ++m) { bf16_t* rowp = G + (size_t)(row0 + ai * HALF + m * 16) * ldc + col0;
#pragma unroll
                for (int bj = 0; bj < 2; ++bj) { const f32x4 v0 = acc[ai][bj][m][0], v1 = acc[ai][bj][m][1];
                    const u32x4 z = *(const u32x4*)(rowp + bj * HALF);
                    u32x4 w; w.x = cvtpk(v0[0] * silu_f(lo_bf(z.x)), v0[1] * silu_f(hi_bf(z.x))); w.y = cvtpk(v0[2] * silu_f(lo_bf(z.y)), v0[3] * silu_f(hi_bf(z.y)));
                    w.z = cvtpk(v1[0] * silu_f(lo_bf(z.z)), v1[1] * silu_f(hi_bf(z.z))); w.w = cvtpk(v1[2] * silu_f(lo_bf(z.w)), v1[3] * silu_f(hi_bf(z.w)));
                    *(u32x4*)(rowp + bj * HALF) = w; } }
    }
};
template <class Epi, class Sched, bool ALIGN_EPI = false, bool SP2 = false>
__device__ __forceinline__ void gemm_phase(PG8_LAS unsigned char* lds, const Gemm g, const Sched& S, const Epi& E) {
    const int tid = tidx(), wid = __builtin_amdgcn_readfirstlane(tid >> 6), lane = tid & 63, wr = wid >> 2, wc = wid & 3, fr = lane & 15, fq = lane >> 4;
    const int K = g.K, nt = K / BK;
    unsigned voffA[2], voffB[2];
#pragma unroll
    for (int i = 0; i < 2; ++i) { int R, C; stage_rc(tid * 16 + i * 8192, R, C); const int Rb = Epi::PERM ? ((R & ~31) + perm32(R & 31)) : R;
        voffA[i] = (unsigned)(R * g.lda + C) * 2u; voffB[i] = (unsigned)(Rb * K + C) * 2u; }
    const size_t kstep = (size_t)(BK * 2);
    const size_t hstepA = (size_t)HALF * g.lda * 2, hstepB = (size_t)HALF * K * 2;
    const size_t tstepA = 2 * hstepA, tstepB = 2 * hstepB;
    const unsigned ldsw = (unsigned)wid * 1024u;
    const int aoff = lds_byte(wr * 64 + fr, fq * 8), boff = lds_byte(wc * 32 + fr, fq * 8);
#define PG8_SA(b, h) (((b) * 2 + (h)) * HTB)
#define PG8_SB(b, h) ((4 + (b) * 2 + (h)) * HTB)
#define PG8_STAGE(bufoff, gbase, voff) do { _Pragma("unroll") for (int _i = 0; _i < 2; ++_i) \
        __builtin_amdgcn_global_load_lds((const unsigned*)((const char*)(gbase) + (voff)[_i]), (PG8_LAS unsigned*)(lds + (bufoff) + ldsw + _i * 8192), 16, 0, 0); } while (0)
#define PG8_LDA(dst, b, h) do { _Pragma("unroll") for (int m = 0; m < 4; ++m) _Pragma("unroll") for (int k = 0; k < 2; ++k) dst[m][k] = *(const PG8_LAS bf16x8*)(lds + PG8_SA(b, h) + aoff + m * 2048 + k * 1024); } while (0)
#define PG8_LDB(dst, b, h) do { _Pragma("unroll") for (int n = 0; n < 2; ++n) _Pragma("unroll") for (int k = 0; k < 2; ++k) dst[n][k] = *(const PG8_LAS bf16x8*)(lds + PG8_SB(b, h) + boff + n * 2048 + k * 1024); } while (0)
#define PG8_MMA(ai, bj, At, Bt) do { __builtin_amdgcn_s_setprio(1); _Pragma("unroll") for (int m = 0; m < 4; ++m) _Pragma("unroll") for (int n = 0; n < 2; ++n) _Pragma("unroll") for (int k = 0; k < 2; ++k) \
        acc[ai][bj][m][n] = __builtin_amdgcn_mfma_f32_16x16x32_bf16(Bt[n][k], At[m][k], acc[ai][bj][m][n], 0, 0, 0); __builtin_amdgcn_s_setprio(0); } while (0)
#define PG8_WAIT_V(n) asm volatile("s_waitcnt vmcnt(" #n ")" ::: "memory")
#define PG8_WAIT_L(n) asm volatile("s_waitcnt lgkmcnt(" #n ")" ::: "memory")
#define PG8_BAR __builtin_amdgcn_s_barrier()
#define PG8_SCHED __builtin_amdgcn_sched_barrier(0)
    Unit cur, nxt; int ui = 0;
    if (!S.next(0, cur)) return;
    f32x4 acc[2][2][4][2];
#pragma unroll
    for (int a = 0; a < 2; ++a)
#pragma unroll
        for (int b = 0; b < 2; ++b)
#pragma unroll
            for (int m = 0; m < 4; ++m)
#pragma unroll
                for (int n = 0; n < 2; ++n) acc[a][b][m][n] = (f32x4){0.f, 0.f, 0.f, 0.f};
    bf16x8 At[4][2], B0[2][2], B1[2][2];
    const char* cA = (const char*)g.A + (size_t)cur.pm * tstepA; const char* cB = (const char*)g.Bt + (size_t)cur.pn * tstepB;
    S.a_ready(cur);
    if constexpr (SP2) {
        PG8_STAGE(PG8_SB(0, 0), cB, voffB); PG8_STAGE(PG8_SB(0, 1), cB + hstepB, voffB); PG8_STAGE(PG8_SA(0, 0), cA, voffA); PG8_STAGE(PG8_SA(0, 1), cA + hstepA, voffA);
        if (wr == 1) PG8_BAR;
        PG8_WAIT_V(2); PG8_BAR;
        PG8_STAGE(PG8_SB(1, 0), cB + kstep, voffB); PG8_STAGE(PG8_SA(1, 0), cA + kstep, voffA); PG8_STAGE(PG8_SB(1, 1), cB + hstepB + kstep, voffB);
        PG8_WAIT_V(6); PG8_BAR;
    } else {
        PG8_STAGE(PG8_SB(0, 0), cB, voffB); PG8_STAGE(PG8_SA(0, 0), cA, voffA); PG8_STAGE(PG8_SB(0, 1), cB + hstepB, voffB); PG8_STAGE(PG8_SA(0, 1), cA + hstepA, voffA);
        if (wr == 1) PG8_BAR;
        PG8_WAIT_V(4); PG8_BAR;
        PG8_STAGE(PG8_SB(1, 0), cB + kstep, voffB); PG8_STAGE(PG8_SA(1, 0), cA + kstep, voffA); PG8_STAGE(PG8_SB(1, 1), cB + hstepB + kstep, voffB);
        PG8_WAIT_V(6); PG8_BAR;
    }
    for (;;) {
        const bool has_next = S.next(ui + 1, nxt);
        const char* nA = has_next ? (const char*)g.A + (size_t)nxt.pm * tstepA : cA; const char* nB = has_next ? (const char*)g.Bt + (size_t)nxt.pn * tstepB : cB;
        for (int t = 0; t < nt; t += 2) {
            const bool last = (t == nt - 2);
            const char* a1 = cA + (size_t)(t + 1) * kstep;
            const char* a2 = last ? nA : cA + (size_t)(t + 2) * kstep; const char* b2 = last ? nB : cB + (size_t)(t + 2) * kstep;
            const char* a3 = a2 + kstep; const char* b3 = b2 + kstep;
            if (last && has_next) S.a_ready(nxt);
            if constexpr (SP2) {
            PG8_LDB(B0, 0, 0); PG8_LDB(B1, 0, 1); PG8_SCHED; PG8_LDA(At, 0, 0); PG8_STAGE(PG8_SA(1, 1), a1 + hstepA, voffA);
            PG8_WAIT_V(8); PG8_WAIT_L(0); PG8_BAR; PG8_MMA(0, 0, At, B0); PG8_MMA(0, 1, At, B1); PG8_BAR; PG8_SCHED;
            PG8_LDA(At, 0, 1); PG8_STAGE(PG8_SB(0, 0), b2, voffB); PG8_STAGE(PG8_SB(0, 1), b2 + hstepB, voffB); PG8_STAGE(PG8_SA(0, 0), a2, voffA);
            PG8_WAIT_V(8); PG8_WAIT_L(0); PG8_BAR; PG8_MMA(1, 0, At, B0); PG8_MMA(1, 1, At, B1); PG8_BAR; PG8_SCHED;
            PG8_LDB(B0, 1, 0); PG8_LDB(B1, 1, 1); PG8_SCHED; PG8_LDA(At, 1, 0); PG8_STAGE(PG8_SA(0, 1), a2 + hstepA, voffA);
            PG8_WAIT_V(8); PG8_WAIT_L(0); PG8_BAR; PG8_MMA(0, 0, At, B0); PG8_MMA(0, 1, At, B1); PG8_BAR; PG8_SCHED;
            PG8_LDA(At, 1, 1); PG8_STAGE(PG8_SB(1, 0), b3, voffB); PG8_STAGE(PG8_SB(1, 1), b3 + hstepB, voffB); PG8_STAGE(PG8_SA(1, 0), a3, voffA);
            PG8_WAIT_V(8); PG8_WAIT_L(0); PG8_BAR; PG8_MMA(1, 0, At, B0); PG8_MMA(1, 1, At, B1); PG8_BAR; PG8_SCHED;
            } else {
            PG8_LDB(B0, 0, 0); PG8_SCHED; PG8_LDA(At, 0, 0); PG8_STAGE(PG8_SA(1, 1), a1 + hstepA, voffA);
            PG8_WAIT_L(8); PG8_BAR; PG8_WAIT_L(0); PG8_MMA(0, 0, At, B0); PG8_BAR; PG8_SCHED;
            PG8_LDB(B1, 0, 1); PG8_STAGE(PG8_SB(0, 0), b2, voffB);
            PG8_BAR; PG8_WAIT_L(0); PG8_MMA(0, 1, At, B1); PG8_BAR;
            PG8_LDA(At, 0, 1); PG8_STAGE(PG8_SA(0, 0), a2, voffA);
            PG8_BAR; PG8_WAIT_L(0); PG8_MMA(1, 0, At, B0); PG8_BAR; PG8_SCHED;
            PG8_STAGE(PG8_SB(0, 1), b2 + hstepB, voffB);
            PG8_WAIT_V(6); PG8_BAR; PG8_MMA(1, 1, At, B1); PG8_BAR;
            PG8_LDB(B0, 1, 0); PG8_SCHED; PG8_LDA(At, 1, 0); PG8_STAGE(PG8_SA(0, 1), a2 + hstepA, voffA);
            PG8_WAIT_L(8); PG8_BAR; PG8_WAIT_L(0); PG8_MMA(0, 0, At, B0); PG8_BAR; PG8_SCHED;
            PG8_LDB(B1, 1, 1); PG8_STAGE(PG8_SB(1, 0), b3, voffB);
            PG8_BAR; PG8_WAIT_L(0); PG8_MMA(0, 1, At, B1); PG8_BAR;
            PG8_LDA(At, 1, 1); PG8_STAGE(PG8_SA(1, 0), a3, voffA);
            PG8_BAR; PG8_WAIT_L(0); PG8_MMA(1, 0, At, B0); PG8_BAR; PG8_SCHED;
            PG8_STAGE(PG8_SB(1, 1), b3 + hstepB, voffB);
            PG8_WAIT_V(6); PG8_BAR; PG8_MMA(1, 1, At, B1); PG8_BAR;
            }
        }
        if constexpr (ALIGN_EPI) { if (wr == 0) PG8_BAR; }
        if constexpr (!Epi::AFTER_DRAIN) { E(acc, cur, wr, wc, fr, fq); S.done(cur); }
        if (!has_next) break;
#pragma unroll
        for (int a = 0; a < 2; ++a)
#pragma unroll
            for (int b = 0; b < 2; ++b)
#pragma unroll
                for (int m = 0; m < 4; ++m)
#pragma unroll
                    for (int n = 0; n < 2; ++n) acc[a][b][m][n] = (f32x4){0.f, 0.f, 0.f, 0.f};
        cur = nxt; cA = nA; cB = nB; ++ui;
        if constexpr (ALIGN_EPI) { if (wr == 1) PG8_BAR; }
    }
    PG8_WAIT_V(0);
    if constexpr (!ALIGN_EPI) { if (wr == 0) PG8_BAR; }
    PG8_BAR;
    if constexpr (Epi::AFTER_DRAIN) { E.fused(acc, cur, wr, wc, fr, fq, lds, wid, lane); S.done(cur); }
#undef PG8_SA
#undef PG8_SB
#undef PG8_STAGE
#undef PG8_LDA
#undef PG8_LDB
#undef PG8_MMA
#undef PG8_WAIT_V
#undef PG8_WAIT_L
#undef PG8_BAR
#undef PG8_SCHED
}
}
namespace att {
constexpr int KVBLK = 64;
constexpr int STG = 32768, L_WS = 65536, L_POSK = 67584, L_BTAB = 68096, L_UNIT = 72256, L_OST = 73728, OST_WAVE = 8704;
template <int DV> __device__ __forceinline__ int v_st(int k, int c) { const int kk = (k & ~0xC) | ((k & 4) << 1) | ((k & 8) >> 1); return ((kk >> 3) * (DV / 32) + (c >> 5)) * 512 + ((kk & 7) * 32 + (c & 31)) * 2; }
__device__ __forceinline__ int v_rd_base(int lane) { return ((lane & 3) << 3) | (((lane >> 2) & 3) << 6) | (((lane >> 4) & 1) << 5) | (((lane >> 5) & 1) << 8); }
__device__ __forceinline__ int koff(int row, int colB, int RB) { return row * RB + (colB ^ ((row & 7) << 4)); }

template <int DQK, int DV, int MODE>
__device__ __forceinline__ void attn_core(LAS unsigned char* lds, const bf16_t* qrow, const bf16_t* Kg, int ldk, const bf16_t* Vg, int ldv, int t_lo, int t_hi, float c2,
                                          int qidx, int head, const int* pos, float& m_reg, float& l_reg, f32x16 (&o)[DV / 32]) {
    constexpr int ND = DQK / 16, NV = DV / 32, RB = DQK * 2, NKC = (64 * (DQK / 8)) / NT_THREADS, NVC = (64 * (DV / 8)) / NT_THREADS, KB = 64 * RB;
    const int tid = tidx(), lane = tid & 63, r32 = lane & 31, hi = lane >> 5, wid = __builtin_amdgcn_readfirstlane(tid >> 6);
    bf16x8 qr[ND];
#pragma unroll
    for (int d0 = 0; d0 < ND; ++d0) qr[d0] = *(const bf16x8*)(qrow + d0 * 16 + hi * 8);
    LAS float* al_l = (LAS float*)(lds + L_WS) + wid * 64;
    LAS int* posk = (LAS int*)(lds + L_POSK); LAS float* btab = (LAS float*)(lds + L_BTAB);
    const unsigned vb0 = (unsigned)(uintptr_t)lds + (unsigned)KB + (unsigned)v_rd_base(lane);
    int posq = 0; if (MODE == 1) posq = pos[qidx];
    unsigned kdst[NKC], ksrc[NKC], vdst[NVC], vsrc[NVC];
#pragma unroll
    for (int i = 0; i < NKC; ++i) { const int c = tid + NT_THREADS * i, row = c / (DQK / 8), ch = c % (DQK / 8); kdst[i] = koff(row, ch * 16, RB); ksrc[i] = row * ldk + ch * 8; }
#pragma unroll
    for (int i = 0; i < NVC; ++i) { const int c = tid + NT_THREADS * i, row = c / (DV / 8), ch = c % (DV / 8); vdst[i] = KB + v_st<DV>(row, ch * 8); vsrc[i] = row * ldv + ch * 8; }
    u32x4 ks[NKC], vs[NVC]; int pkn = 0;
#define LOAD_TILE(t_) do { const size_t kb_ = (size_t)(t_) * KVBLK; _Pragma("unroll") for (int i = 0; i < NKC; ++i) ks[i] = *(const u32x4*)(Kg + kb_ * ldk + ksrc[i]); \
        _Pragma("unroll") for (int i = 0; i < NVC; ++i) vs[i] = *(const u32x4*)(Vg + kb_ * ldv + vsrc[i]); if (MODE == 1 && tid < 64) pkn = pos[(t_) * KVBLK + tid]; } while (0)
#define WRITE_TILE(st_) do { _Pragma("unroll") for (int i = 0; i < NKC; ++i) *(LAS u32x4*)(lds + (st_) * STG + kdst[i]) = ks[i]; \
        _Pragma("unroll") for (int i = 0; i < NVC; ++i) *(LAS u32x4*)(lds + (st_) * STG + vdst[i]) = vs[i]; if (MODE == 1 && tid < 64) posk[(st_) * 64 + tid] = pkn; } while (0)
    LOAD_TILE(t_lo); WRITE_TILE(0);
    __syncthreads();
#pragma unroll 1
    for (int t = t_lo; t < t_hi; ++t) {
        const int st = (t - t_lo) & 1, kbase = t * KVBLK;
        if (t + 1 < t_hi) LOAD_TILE(t + 1);
        const LAS unsigned char* K_lds = lds + st * STG;
        f32x16 p0 = {}, p1 = {};
#pragma unroll
        for (int d0 = 0; d0 < ND; ++d0) {
            const bf16x8 a0 = *(const LAS bf16x8*)(K_lds + koff(r32, (d0 * 16 + hi * 8) * 2, RB));
            const bf16x8 a1 = *(const LAS bf16x8*)(K_lds + koff(32 + r32, (d0 * 16 + hi * 8) * 2, RB));
            p0 = MFMA32(a0, qr[d0], p0); p1 = MFMA32(a1, qr[d0], p1);
        }
        if (MODE == 1) {
#pragma unroll
            for (int r = 0; r < 16; ++r) { const int kl = crow(r, hi);
                { const int kk = kbase + kl; int dist = posq - posk[st * 64 + kl]; dist = dist < 0 ? 0 : (dist > 128 ? 128 : dist);
                  const float b = btab[dist * 8 + head]; p0[r] = ((unsigned)(qidx - kk) < 128u) ? fmaf(p0[r], c2, b) : -__builtin_inff(); }
                { const int kk = kbase + kl + 32; int dist = posq - posk[st * 64 + kl + 32]; dist = dist < 0 ? 0 : (dist > 128 ? 128 : dist);
                  const float b = btab[dist * 8 + head]; p1[r] = ((unsigned)(qidx - kk) < 128u) ? fmaf(p1[r], c2, b) : -__builtin_inff(); } }
        } else {
#pragma unroll
            for (int r = 0; r < 16; ++r) { p0[r] *= c2; p1[r] *= c2; }
        }
        float pmax = p0[0];
#pragma unroll
        for (int r = 1; r < 16; ++r) pmax = fmaxf(pmax, p0[r]);
#pragma unroll
        for (int r = 0; r < 16; ++r) pmax = fmaxf(pmax, p1[r]);
        { auto rr = __builtin_amdgcn_permlane32_swap(__float_as_uint(pmax), __float_as_uint(pmax), false, false); pmax = fmaxf(__uint_as_float(rr[0]), __uint_as_float(rr[1])); }
        const float mn = fmaxf(m_reg, pmax); const float alpha = __builtin_amdgcn_exp2f(m_reg - mn); m_reg = mn;
        float ps = 0.f;
#pragma unroll
        for (int r = 0; r < 16; ++r) { p0[r] = __builtin_amdgcn_exp2f(p0[r] - mn); ps += p0[r]; }
#pragma unroll
        for (int r = 0; r < 16; ++r) { p1[r] = __builtin_amdgcn_exp2f(p1[r] - mn); ps += p1[r]; }
        { auto rr = __builtin_amdgcn_permlane32_swap(__float_as_uint(ps), __float_as_uint(ps), false, false); ps = __uint_as_float(rr[0]) + __uint_as_float(rr[1]); }
        l_reg = l_reg * alpha + ps;
        if (__any(alpha < 1.f)) {
            if (hi == 0) al_l[r32] = alpha;
            LDS_WAIT();
#pragma unroll
            for (int g = 0; g < 4; ++g) { const f32x4 a4 = *(const LAS f32x4*)(al_l + 8 * g + 4 * hi);
#pragma unroll
                for (int d = 0; d < NV; ++d) { o[d][4 * g + 0] *= a4[0]; o[d][4 * g + 1] *= a4[1]; o[d][4 * g + 2] *= a4[2]; o[d][4 * g + 3] *= a4[3]; } }
        }
        bf16x8 pa0, pa1, pa2, pa3;
#define PK4(P, B_, OUT) do { const unsigned a0_ = cvtpk(P[B_ + 0], P[B_ + 1]), a1_ = cvtpk(P[B_ + 2], P[B_ + 3]), b0_ = cvtpk(P[B_ + 4], P[B_ + 5]), b1_ = cvtpk(P[B_ + 6], P[B_ + 7]); \
        auto r0_ = __builtin_amdgcn_permlane32_swap(a0_, b0_, false, false); auto r1_ = __builtin_amdgcn_permlane32_swap(a1_, b1_, false, false); \
        u32x4 w_ = {r0_[0], r1_[0], r0_[1], r1_[1]}; OUT = __builtin_bit_cast(bf16x8, w_); } while (0)
        PK4(p0, 0, pa0); PK4(p0, 8, pa1); PK4(p1, 0, pa2); PK4(p1, 8, pa3);
#undef PK4
        const unsigned vba = vb0 + (unsigned)(st * STG);
#define TRRD(dst, off) asm volatile("ds_read_b64_tr_b16 %0, %1 offset:%2" : "=&v"(dst) : "v"(vba), "i"(off) : "memory")
#define PV_D0(d0) do { s16x4 l0, l1, l2, l3, h0, h1, h2, h3; constexpr int KS_ = NV * 1024, HF_ = NV * 512, b_ = (d0) * 512; \
        TRRD(l0, b_); TRRD(h0, b_ + HF_); TRRD(l1, b_ + KS_); TRRD(h1, b_ + KS_ + HF_); TRRD(l2, b_ + 2 * KS_); TRRD(h2, b_ + 2 * KS_ + HF_); TRRD(l3, b_ + 3 * KS_); TRRD(h3, b_ + 3 * KS_ + HF_); \
        asm volatile("s_waitcnt lgkmcnt(0)" ::: "memory"); SBAR(); \
        o[d0] = MFMA32(pa0, ((bf16x8){l0[0], l0[1], l0[2], l0[3], h0[0], h0[1], h0[2], h0[3]}), o[d0]); \
        o[d0] = MFMA32(pa1, ((bf16x8){l1[0], l1[1], l1[2], l1[3], h1[0], h1[1], h1[2], h1[3]}), o[d0]); \
        o[d0] = MFMA32(pa2, ((bf16x8){l2[0], l2[1], l2[2], l2[3], h2[0], h2[1], h2[2], h2[3]}), o[d0]); \
        o[d0] = MFMA32(pa3, ((bf16x8){l3[0], l3[1], l3[2], l3[3], h3[0], h3[1], h3[2], h3[3]}), o[d0]); } while (0)
        PV_D0(0); PV_D0(1);
        if constexpr (NV == 4) { PV_D0(2); PV_D0(3); }
#undef PV_D0
#undef TRRD
        if (t + 1 < t_hi) WRITE_TILE(st ^ 1);
        __syncthreads();
    }
#undef LOAD_TILE
#undef WRITE_TILE
}
template <int DV>
__device__ __forceinline__ void gated_store(LAS unsigned char* lds, float l_reg, const f32x16 (&o)[DV / 32], bf16_t* zp0) {
    constexpr int NV = DV / 32, OP = DV + 8, CPR = DV / 8;
    const int tid = tidx(), lane = tid & 63, r32 = lane & 31, hi = lane >> 5, wid = __builtin_amdgcn_readfirstlane(tid >> 6);
    LAS float* li_l = (LAS float*)(lds + L_WS) + wid * 64; LAS bf16_t* ost = (LAS bf16_t*)(lds + L_OST + wid * OST_WAVE);
    asm volatile("s_waitcnt lgkmcnt(0)" ::: "memory");
    if (hi == 0) li_l[r32] = l_reg;
    asm volatile("s_waitcnt lgkmcnt(0)" ::: "memory");
#pragma unroll
    for (int g = 0; g < 4; ++g) { const f32x4 a4 = *(const LAS f32x4*)(li_l + 8 * g + 4 * hi);
#pragma unroll
        for (int e = 0; e < 4; ++e) { const float rl = 1.f / a4[e]; const int row = 8 * g + 4 * hi + e;
#pragma unroll
            for (int d0 = 0; d0 < NV; ++d0) ost[row * OP + d0 * 32 + r32] = f2bf(o[d0][4 * g + e] * rl); } }
    asm volatile("s_waitcnt lgkmcnt(0)" ::: "memory");
#pragma unroll
    for (int i = 0; i < (32 * CPR) / 64; ++i) { const int id = lane + 64 * i, row = id / CPR, dc = id % CPR;
        const u32x4 v = *(const LAS u32x4*)(ost + row * OP + dc * 8); bf16_t* zp = zp0 + (size_t)row * NP + dc * 8; const u32x4 z = *(const u32x4*)zp;
        u32x4 w; w.x = cvtpk(lo_bf(v.x) * silu_f(lo_bf(z.x)), hi_bf(v.x) * silu_f(hi_bf(z.x))); w.y = cvtpk(lo_bf(v.y) * silu_f(lo_bf(z.y)), hi_bf(v.y) * silu_f(hi_bf(z.y)));
        w.z = cvtpk(lo_bf(v.z) * silu_f(lo_bf(z.z)), hi_bf(v.z) * silu_f(hi_bf(z.z))); w.w = cvtpk(lo_bf(v.w) * silu_f(lo_bf(z.w)), hi_bf(v.w) * silu_f(hi_bf(z.w)));
        *(u32x4*)zp = w; }
}
__device__ __forceinline__ void swa_unit(LAS unsigned char* lds, int qb, int hk, bf16_t* PROJ, const int* pos, const float* sinks  ) {
    const int tid = tidx(), lane = tid & 63, r32 = lane & 31, wid = __builtin_amdgcn_readfirstlane(tid >> 6);
    const int head = hk * 4 + (wid >> 1), q0 = qb * 64 + (wid & 1) * 32;
    const float sink = sinks[head] * LOG2E;
    float m = sink, l = 1.f; f32x16 o[2] = {};
    int t_lo = (qb * 64 - 128) / 64; if (t_lo < 0) t_lo = 0;
    attn_core<64, 64, 1>(lds, PROJ + (size_t)(q0 + r32) * NP + C_AQ + head * 64, PROJ + C_AK + hk * 64, NP, PROJ + C_AV + hk * 64, NP, t_lo, qb + 1, 0.125f * LOG2E, q0 + r32, head, pos, m, l, o);
    gated_store<64>(lds, l, o, PROJ + (size_t)q0 * NP + C_Z + head * 64);
}
__device__ __forceinline__ void cross_unit(LAS unsigned char* lds, int qb, int h, bf16_t* PROJ, const bf16_t* MEMKV  ) {
    const int tid = tidx(), lane = tid & 63, r32 = lane & 31, wid = __builtin_amdgcn_readfirstlane(tid >> 6);
    const int q0 = qb * 256 + wid * 32;
    float m = -1e30f, l = 0.f; f32x16 o[4] = {};
    attn_core<128, 128, 2>(lds, PROJ + (size_t)(q0 + r32) * NP + C_DQ + h * 128, MEMKV + h * 128, 1024, MEMKV + 512 + h * 128, 1024, 0, 4, 0.08838834764831845f * LOG2E, q0 + r32, 0, nullptr, m, l, o);
    gated_store<128>(lds, l, o, PROJ + (size_t)q0 * NP + C_Z + 1536 + h * 128);
}
__device__ __forceinline__ void run_mixers(LAS unsigned char* lds, unsigned* ctr, bf16_t* PROJ, const int* pos, const float* sinks, const float* btab_g, const bf16_t* MEMKV) {
    LAS int* ub = (LAS int*)(lds + L_UNIT);
    __syncthreads();
    for (int i = tidx(); i < 129 * 8; i += NT_THREADS) ((LAS float*)(lds + L_BTAB))[i] = btab_g[i];
    for (;;) {
        __syncthreads();
        if (tidx() == 0) *ub = (int)atomicAdd(ctr, 1u);
        __syncthreads();
        const int u = *ub;
        if (u >= 768) break;
        if (u < 256) cross_unit(lds, u >> 2, u & 3, PROJ, MEMKV); else swa_unit(lds, (u - 256) >> 1, (u - 256) & 1, PROJ, pos, sinks);
    }
}
}
namespace mla {
constexpr int ST_BYTES = 49152, R_OFF = 32768, L_SCR = 147456  , L_UNIT = 149504, L_OLT = 67584  , L_OUT = 102400  ;
__device__ __forceinline__ unsigned off_a(unsigned row, unsigned ch) { return 2048u * (row >> 3) + 512u * (ch >> 2) + 64u * (row & 7) + 16u * ((ch & 3) ^ ((row >> 2) & 3)); }
__device__ __forceinline__ unsigned off_r(unsigned row, unsigned ch) { return 1024u * (row >> 3) + 512u * (ch >> 2) + 64u * (row & 7) + 16u * ((ch & 3) ^ ((row >> 2) & 3)); }

__device__ __forceinline__ void unit(LAS unsigned char* lds, int qb, int h, const bf16_t* QABS, const bf16_t* KVLAT, bf16_t* PROJ, const bf16_t* WUV, const float* rsq, const float* cosT, const float* sinT, float qscale) {
    const int tid = tidx(), lane = tid & 63, r32 = lane & 31, hi = lane >> 5, wid = __builtin_amdgcn_readfirstlane(tid >> 6), kg = wid >> 2, g = wid & 3;
    const int q0 = qb * 128, qloc = 32 * g + r32, qidx = q0 + qloc;
    bf16x8 qr[12];
    { const bf16_t* qrow = QABS + (size_t)qidx * 768 + h * 192;
#pragma unroll
      for (int d0 = 0; d0 < 12; ++d0) qr[d0] = *(const bf16x8*)(qrow + d0 * 16 + hi * 8);
      const float sc = rsq[qidx] * qscale;
#pragma unroll
      for (int d0 = 0; d0 < 12; ++d0) { const u32x4 w = __builtin_bit_cast(u32x4, qr[d0]);
          float v[8] = {lo_bf(w.x) * sc, hi_bf(w.x) * sc, lo_bf(w.y) * sc, hi_bf(w.y) * sc, lo_bf(w.z) * sc, hi_bf(w.z) * sc, lo_bf(w.w) * sc, hi_bf(w.w) * sc};
          if (d0 >= 8) { const int i0 = (d0 - 8) * 8 + hi * 4; const f32x4 c = *(const f32x4*)(cosT + (size_t)qidx * 32 + i0), s = *(const f32x4*)(sinT + (size_t)qidx * 32 + i0);
#pragma unroll
              for (int jj = 0; jj < 4; ++jj) { const float t1 = v[2 * jj], t2 = v[2 * jj + 1]; v[2 * jj] = t1 * c[jj] - t2 * s[jj]; v[2 * jj + 1] = t1 * s[jj] + t2 * c[jj]; } }
          qr[d0] = pack8(v); } }
    unsigned sdst[6];
    { const unsigned key = tid >> 2, c0 = 6u * (tid & 3);
#pragma unroll
      for (int i = 0; i < 6; ++i) { const unsigned cc = c0 + i; sdst[i] = cc < 16u ? off_a(key, cc) : R_OFF + off_r(key, cc - 16u); } }
    const char* sbase = (const char*)KVLAT + ((size_t)(tid >> 2) * 192 + 48 * (tid & 3)) * 2;
    u32x4 st[6];
#pragma unroll
    for (int i = 0; i < 6; ++i) st[i] = *(const u32x4*)(sbase + 16 * i);
#pragma unroll
    for (int i = 0; i < 6; ++i) *(LAS u32x4*)(lds + sdst[i]) = st[i];
    const unsigned y = (r32 >> 2) & 3, rowpart = 64u * (r32 & 7);
    const unsigned nb_e = 2048u * (8 * kg + (r32 >> 3)) + rowpart + 16u * ((unsigned)hi ^ y), nb_o = 2048u * (8 * kg + (r32 >> 3)) + rowpart + 16u * ((2u + hi) ^ y);
    const unsigned rb_e = R_OFF + 1024u * (8 * kg + (r32 >> 3)) + rowpart + 16u * ((unsigned)hi ^ y), rb_o = R_OFF + 1024u * (8 * kg + (r32 >> 3)) + rowpart + 16u * ((2u + hi) ^ y);
    const unsigned blk = (lane >> 4) & 1, q_ = (lane & 15) >> 2, p_ = lane & 3, x0 = (2u * blk + (p_ >> 1)) ^ (2u * hi);
    const unsigned ldsb = (unsigned)(uintptr_t)lds;
    const unsigned tb0 = ldsb + 2048u * (8 * kg + hi) + 64u * q_ + 16u * x0 + 8u * (p_ & 1), tb1 = ldsb + 2048u * (8 * kg + hi) + 64u * (4u + q_) + 16u * (x0 ^ 1u) + 8u * (p_ & 1);
    LAS float* scr = (LAS float*)(lds + L_SCR) + wid * 64;
    float m_reg = -1e30f, l_reg = 0.f; f32x16 o[4] = {};
    __syncthreads();
#pragma unroll 1
    for (int t = 0; t <= qb; ++t) {
        const unsigned sb = (t & 1) * ST_BYTES;
        if (t < qb) { const char* src = sbase + (size_t)(t + 1) * (128 * 192 * 2);
#pragma unroll
            for (int i = 0; i < 6; ++i) st[i] = *(const u32x4*)(src + 16 * i); }
        f32x16 p0 = {}, p1 = {};
        { const LAS unsigned char* ne = lds + sb + nb_e; const LAS unsigned char* no = lds + sb + nb_o; const LAS unsigned char* re = lds + sb + rb_e; const LAS unsigned char* ro = lds + sb + rb_o;
#define KRD(B, s) do { if ((s) < 8) { const LAS unsigned char* a_ = (((s) & 1) ? no : ne) + 512 * ((s) >> 1); B[0] = *(const LAS bf16x8*)a_; B[1] = *(const LAS bf16x8*)(a_ + 8192); } \
                       else { const LAS unsigned char* a_ = (((s) & 1) ? ro : re) + 512 * (((s) - 8) >> 1); B[0] = *(const LAS bf16x8*)a_; B[1] = *(const LAS bf16x8*)(a_ + 4096); } } while (0)
#define KMM(B, s) do { p0 = MFMA32(B[0], qr[s], p0); p1 = MFMA32(B[1], qr[s], p1); } while (0)
          bf16x8 ka[2], kb[2], kc[2];
          KRD(ka, 0); KRD(kb, 1); SBAR();
          KRD(kc, 2); SBAR(); KMM(ka, 0); SBAR();
          KRD(ka, 3); SBAR(); KMM(kb, 1); SBAR();
          KRD(kb, 4); SBAR(); KMM(kc, 2); SBAR();
          KRD(kc, 5); SBAR(); KMM(ka, 3); SBAR();
          KRD(ka, 6); SBAR(); KMM(kb, 4); SBAR();
          KRD(kb, 7); SBAR(); KMM(kc, 5); SBAR();
          KRD(kc, 8); SBAR(); KMM(ka, 6); SBAR();
          KRD(ka, 9); SBAR(); KMM(kb, 7); SBAR();
          KRD(kb, 10); SBAR(); KMM(kc, 8); SBAR();
          KRD(kc, 11); SBAR(); KMM(ka, 9); SBAR();
          KMM(kb, 10); KMM(kc, 11); SBAR();
#undef KRD
#undef KMM
        }
        if (t == qb) {
#pragma unroll
            for (int r = 0; r < 16; ++r) { const int kl = 64 * kg + crow(r, hi); if (kl > qloc) p0[r] = -__builtin_inff(); if (kl + 32 > qloc) p1[r] = -__builtin_inff(); }
        }
        float pmax = p0[0];
#pragma unroll
        for (int r = 1; r < 16; ++r) pmax = fmaxf(pmax, p0[r]);
#pragma unroll
        for (int r = 0; r < 16; ++r) pmax = fmaxf(pmax, p1[r]);
        { auto rr = __builtin_amdgcn_permlane32_swap(__float_as_uint(pmax), __float_as_uint(pmax), false, false); pmax = fmaxf(__uint_as_float(rr[0]), __uint_as_float(rr[1])); }
        const float mn = fmaxf(m_reg, pmax); const float alpha = __builtin_amdgcn_exp2f(m_reg - mn); m_reg = mn;
        float ps = 0.f;
#pragma unroll
        for (int r = 0; r < 16; ++r) { p0[r] = __builtin_amdgcn_exp2f(p0[r] - mn); ps += p0[r]; }
#pragma unroll
        for (int r = 0; r < 16; ++r) { p1[r] = __builtin_amdgcn_exp2f(p1[r] - mn); ps += p1[r]; }
        { auto rr = __builtin_amdgcn_permlane32_swap(__float_as_uint(ps), __float_as_uint(ps), false, false); ps = __uint_as_float(rr[0]) + __uint_as_float(rr[1]); }
        l_reg = l_reg * alpha + ps;
        if (__any(alpha < 1.f)) {
            if (hi == 0) scr[r32] = alpha;
            LDS_WAIT();
#pragma unroll
            for (int gg = 0; gg < 4; ++gg) { const f32x4 a4 = *(const LAS f32x4*)(scr + 8 * gg + 4 * hi);
#pragma unroll
                for (int d = 0; d < 4; ++d) { o[d][4 * gg + 0] *= a4[0]; o[d][4 * gg + 1] *= a4[1]; o[d][4 * gg + 2] *= a4[2]; o[d][4 * gg + 3] *= a4[3]; } }
        }
        bf16x8 pa0, pa1, pa2, pa3;
#define PK4(P, B_, OUT) do { const unsigned a0_ = cvtpk(P[B_ + 0], P[B_ + 1]), a1_ = cvtpk(P[B_ + 2], P[B_ + 3]), b0_ = cvtpk(P[B_ + 4], P[B_ + 5]), b1_ = cvtpk(P[B_ + 6], P[B_ + 7]); \
        auto r0_ = __builtin_amdgcn_permlane32_swap(a0_, b0_, false, false); auto r1_ = __builtin_amdgcn_permlane32_swap(a1_, b1_, false, false); \
        u32x4 w_ = {r0_[0], r1_[0], r0_[1], r1_[1]}; OUT = __builtin_bit_cast(bf16x8, w_); } while (0)
        PK4(p0, 0, pa0); PK4(p0, 8, pa1); PK4(p1, 0, pa2); PK4(p1, 8, pa3);
#undef PK4
        const unsigned t0a = tb0 + sb, t1a = tb1 + sb;
#define TRRD(dst, base, off) asm volatile("ds_read_b64_tr_b16 %0, %1 offset:%2" : "=&v"(dst) : "v"(base), "i"(off) : "memory")
#define PV_RD(L, H, d0) do { TRRD(L[0], t0a, 512 * (d0)); TRRD(H[0], t1a, 512 * (d0)); TRRD(L[1], t0a, 4096 + 512 * (d0)); TRRD(H[1], t1a, 4096 + 512 * (d0)); \
        TRRD(L[2], t0a, 8192 + 512 * (d0)); TRRD(H[2], t1a, 8192 + 512 * (d0)); TRRD(L[3], t0a, 12288 + 512 * (d0)); TRRD(H[3], t1a, 12288 + 512 * (d0)); } while (0)
#define PV_WAIT() do { asm volatile("s_waitcnt lgkmcnt(0)" ::: "memory"); SBAR(); } while (0)
#define PV_MM(L, H, d0) do { o[d0] = MFMA32(pa0, ((bf16x8){L[0][0], L[0][1], L[0][2], L[0][3], H[0][0], H[0][1], H[0][2], H[0][3]}), o[d0]); \
        o[d0] = MFMA32(pa1, ((bf16x8){L[1][0], L[1][1], L[1][2], L[1][3], H[1][0], H[1][1], H[1][2], H[1][3]}), o[d0]); \
        o[d0] = MFMA32(pa2, ((bf16x8){L[2][0], L[2][1], L[2][2], L[2][3], H[2][0], H[2][1], H[2][2], H[2][3]}), o[d0]); \
        o[d0] = MFMA32(pa3, ((bf16x8){L[3][0], L[3][1], L[3][2], L[3][3], H[3][0], H[3][1], H[3][2], H[3][3]}), o[d0]); SBAR(); } while (0)
        { s16x4 la[4], ha[4], lb[4], hb[4];
          PV_RD(la, ha, 0); PV_WAIT();
          PV_RD(lb, hb, 1); PV_MM(la, ha, 0); PV_WAIT();
          PV_RD(la, ha, 2); PV_MM(lb, hb, 1); PV_WAIT();
          PV_RD(lb, hb, 3); PV_MM(la, ha, 2); PV_WAIT();
          PV_MM(lb, hb, 3); }
#undef PV_RD
#undef PV_WAIT
#undef PV_MM
#undef TRRD
        if (t < qb) { const unsigned nb = ((t + 1) & 1) * ST_BYTES;
#pragma unroll
            for (int i = 0; i < 6; ++i) *(LAS u32x4*)(lds + nb + sdst[i]) = st[i]; }
        __syncthreads();
    }
    LAS float* xo = (LAS float*)lds + g * 4096;
    LAS float* xm = (LAS float*)(lds + 65536) + g * 128;
    if (kg == 1) {
#pragma unroll
        for (int d0 = 0; d0 < 4; ++d0)
#pragma unroll
            for (int r = 0; r < 16; ++r) xo[(d0 * 16 + r) * 64 + lane] = o[d0][r];
        xm[lane] = m_reg; xm[64 + lane] = l_reg;
    }
    __syncthreads();
    if (kg == 0) {
        const float mB = xm[lane], lB = xm[64 + lane];
        const float m = fmaxf(m_reg, mB), fA = __builtin_amdgcn_exp2f(m_reg - m), fB = __builtin_amdgcn_exp2f(mB - m), li = 1.f / (l_reg * fA + lB * fB);
        if (hi == 0) { scr[r32] = fA * li; scr[32 + r32] = fB * li; }
        LDS_WAIT();
        float sA[16], sB[16];
#pragma unroll
        for (int gg = 0; gg < 4; ++gg) { const f32x4 a4 = *(const LAS f32x4*)(scr + 8 * gg + 4 * hi), b4 = *(const LAS f32x4*)(scr + 32 + 8 * gg + 4 * hi);
            sA[4 * gg] = a4[0]; sA[4 * gg + 1] = a4[1]; sA[4 * gg + 2] = a4[2]; sA[4 * gg + 3] = a4[3]; sB[4 * gg] = b4[0]; sB[4 * gg + 1] = b4[1]; sB[4 * gg + 2] = b4[2]; sB[4 * gg + 3] = b4[3]; }
        LAS bf16_t* olt = (LAS bf16_t*)(lds + L_OLT + g * 8704); LAS bf16_t* ot = (LAS bf16_t*)(lds + L_OUT + g * 8704);
#pragma unroll
        for (int r = 0; r < 16; ++r)
#pragma unroll
            for (int d0 = 0; d0 < 4; ++d0) olt[crow(r, hi) * 136 + d0 * 32 + r32] = f2bf(o[d0][r] * sA[r] + xo[(d0 * 16 + r) * 64 + lane] * sB[r]);
        LDS_WAIT();
        bf16x8 af[8];
#pragma unroll
        for (int ks = 0; ks < 8; ++ks) af[ks] = *(const LAS bf16x8*)(olt + r32 * 136 + 16 * ks + 8 * hi);
        f32x16 y[4] = {};
        const bf16_t* wb = WUV + (size_t)(h * 128 + r32) * 512 + h * 128 + 8 * hi;
#pragma unroll
        for (int c = 0; c < 4; ++c)
#pragma unroll
            for (int ks = 0; ks < 8; ++ks) y[c] = MFMA32(af[ks], *(const bf16x8*)(wb + (size_t)(32 * c) * 512 + 16 * ks), y[c]);
#pragma unroll
        for (int r = 0; r < 16; ++r)
#pragma unroll
            for (int c = 0; c < 4; ++c) ot[crow(r, hi) * 136 + 32 * c + r32] = f2bf(y[c][r]);
        LDS_WAIT();
        bf16_t* zp0 = PROJ + (size_t)(q0 + 32 * g) * NP + C_Z + 1024 + h * 128;
#pragma unroll
        for (int i = 0; i < 8; ++i) { const int id = lane + 64 * i, row = id >> 4, dc = id & 15;
            const u32x4 v = *(const LAS u32x4*)(ot + row * 136 + dc * 8); bf16_t* zp = zp0 + (size_t)row * NP + dc * 8; const u32x4 z = *(const u32x4*)zp;
            u32x4 w; w.x = cvtpk(lo_bf(v.x) * silu_f(lo_bf(z.x)), hi_bf(v.x) * silu_f(hi_bf(z.x))); w.y = cvtpk(lo_bf(v.y) * silu_f(lo_bf(z.y)), hi_bf(v.y) * silu_f(hi_bf(z.y)));
            w.z = cvtpk(lo_bf(v.z) * silu_f(lo_bf(z.z)), hi_bf(v.z) * silu_f(hi_bf(z.z))); w.w = cvtpk(lo_bf(v.w) * silu_f(lo_bf(z.w)), hi_bf(v.w) * silu_f(hi_bf(z.w)));
            *(u32x4*)zp = w; }
    }
    __syncthreads();
}
__device__ __forceinline__ void run_queue(LAS unsigned char* lds, unsigned* ctr, const bf16_t* QABS, const bf16_t* KVLAT, bf16_t* PROJ, const bf16_t* WUV, const float* rsq, const float* cosT, const float* sinT, float qscale) {
    LAS int* ub = (LAS int*)(lds + L_UNIT);
    for (;;) {
        __syncthreads();
        if (tidx() == 0) *ub = (int)atomicAdd(ctr, 1u);
        __syncthreads();
        const int u = *ub;
        if (u >= 512) break;
        unit(lds, 127 - (u >> 2), u & 3, QABS, KVLAT, PROJ, WUV, rsq, cosT, sinT, qscale);
    }
}
}
template <class Map>
__device__ __forceinline__ void transpose_tile(const float* W, int ldw, bf16_t* WT, int K, int n0, int k0, LAS float* tile, Map map, int lane) {
    { const int src = map(n0 + lane); float v[64];
#pragma unroll
      for (int k = 0; k < 64; ++k) v[k] = src >= 0 ? W[(size_t)(k0 + k) * ldw + src] : 0.f;
#pragma unroll
      for (int k = 0; k < 64; ++k) tile[k * 65 + lane] = v[k]; }
    LDS_WAIT();
    { const int kc = (lane & 7) * 8;
#pragma unroll
      for (int i = 0; i < 8; ++i) { const int n = (lane >> 3) + 8 * i; float v[8];
#pragma unroll
          for (int j = 0; j < 8; ++j) v[j] = tile[(kc + j) * 65 + n];
          u32x4 w = {cvtpk(v[0], v[1]), cvtpk(v[2], v[3]), cvtpk(v[4], v[5]), cvtpk(v[6], v[7])};
          *(u32x4*)(WT + (size_t)(n0 + n) * K + k0 + kc) = w; } }
    LDS_WAIT();
}
struct MapWin { __device__ int operator()(int n) const { return win_src(n); } };
struct MapId { __device__ int operator()(int n) const { return n; } };

__device__ __forceinline__ void job_win(const Params& p, int l, int gw, int ngw, LAS unsigned char* lds, int wid, int lane) {
    bf16_t* WT = (bf16_t*)(p.ws + WS_WIN); const float* W = p.w_in + (size_t)l * DM * DIN; LAS float* tile = (LAS float*)(lds + wid * 16640);
    for (int t = gw; t < (NP / 64) * (DM / 64); t += ngw) transpose_tile(W, DIN, WT, DM, (t / (DM / 64)) * 64, (t % (DM / 64)) * 64, tile, MapWin(), lane);
}
__device__ __forceinline__ void job_wout(const Params& p, int l, int gw, int ngw, LAS unsigned char* lds, int wid, int lane) {
    bf16_t* WT = (bf16_t*)(p.ws + WS_WOUT); const float* W = p.w_out + (size_t)l * MIXW * DM; LAS float* tile = (LAS float*)(lds + wid * 16640);
    for (int t = gw; t < (DM / 64) * (MIXW / 64); t += ngw) transpose_tile(W, DM, WT, MIXW, (t / (MIXW / 64)) * 64, (t % (MIXW / 64)) * 64, tile, MapId(), lane);
}
__device__ __forceinline__ void job_wmem(const Params& p, int gw, int ngw, LAS unsigned char* lds, int wid, int lane) {
    LAS float* tile = (LAS float*)(lds + wid * 16640);
    for (int t = gw; t < 2 * 16 * 16; t += ngw) { const int l = t >> 8, r = t & 255;
        transpose_tile(p.w_mem + (size_t)l * DM * DM, DM, (bf16_t*)(p.ws + WS_WMEM) + (size_t)l * DM * DM, DM, (r >> 4) * 64, (r & 15) * 64, tile, MapId(), lane); }
}
__device__ __forceinline__ void job_wq(const Params& p, int bid, int nblk, int gtid, int gn, LAS unsigned char* lds) {
    const int tid = tidx(); LAS float* At = (LAS float*)lds; LAS float* Bt = At + 64 * 129;
    for (int it = bid; it < 2 * 4 * 4 * 2; it += nblk) { const int l = it >> 5, h = (it >> 3) & 3, kt = (it >> 1) & 3, ct = it & 1;
        const float* uq = p.w_uq + (size_t)l * 256 * 768 + (size_t)(kt * 64) * 768 + h * 192; const float* ukv = p.w_ukv + (size_t)l * 128 * 1024 + (size_t)(ct * 64) * 1024 + h * 256;
        __syncthreads();
#pragma unroll
        for (int i = 0; i < 16; ++i) { const int e = tid + NT_THREADS * i, r = e >> 7, j = e & 127; At[r * 129 + j] = uq[(size_t)r * 768 + j]; Bt[r * 129 + j] = ukv[(size_t)r * 1024 + j]; }
        __syncthreads();
        const int kk = tid & 63, c0 = (tid >> 6) * 8; float acc[8] = {0.f, 0.f, 0.f, 0.f, 0.f, 0.f, 0.f, 0.f};
#pragma unroll 4
        for (int j = 0; j < 128; ++j) { const float a = At[kk * 129 + j];
#pragma unroll
            for (int e = 0; e < 8; ++e) acc[e] = fmaf(a, Bt[(c0 + e) * 129 + j], acc[e]); }
        const int k = kt * 64 + kk; const float g = p.q_norm[l * 256 + k]; bf16_t* wq = (bf16_t*)(p.ws + WS_WQ) + (size_t)l * 768 * 256;
#pragma unroll
        for (int e = 0; e < 8; ++e) wq[(size_t)(h * 192 + ct * 64 + c0 + e) * 256 + k] = f2bf(acc[e] * g);
    }
    for (int idx = gtid; idx < 2 * 4 * 64 * 256; idx += gn) {
        const int l = idx >> 16, r = idx & 65535, h = r >> 14, w = (r >> 8) & 63, k = r & 255, i = w >> 1, which = w & 1;
        ((bf16_t*)(p.ws + WS_WQ))[(size_t)l * 768 * 256 + (size_t)(h * 192 + 128 + w) * 256 + k] = f2bf(p.w_uq[(size_t)l * 256 * 768 + (size_t)k * 768 + h * 192 + 128 + i + 32 * which] * p.q_norm[l * 256 + k]);
    }
}
__device__ __forceinline__ void job_wuv(const Params& p, int gtid, int gn) {
    for (int idx = gtid; idx < 2 * 512 * 512; idx += gn) {
        const int l = idx / (512 * 512), r = idx % (512 * 512), n = r / 512, k = r % 512, h = n >> 7;
        const float v = (k >> 7) == h ? p.w_ukv[(size_t)l * 128 * 1024 + (size_t)(k & 127) * 1024 + h * 256 + 128 + (n & 127)] : 0.f;
        ((bf16_t*)(p.ws + WS_WUV))[idx] = f2bf(v);
    }
}
__device__ __forceinline__ void job_rope(const Params& p, int gtid, int gn) {
    float* cosT = (float*)(p.ws + WS_COS); float* sinT = (float*)(p.ws + WS_SIN);
    for (int idx = gtid; idx < S * 32; idx += gn) {
        const int s = idx >> 5, i = idx & 31;
        const float angf = (float)p.pos[s] * inv_freq(i);
        const double a = (double)angf; const double kq = __builtin_rint(a * 0.63661977236758134308);
        const double x = (a - kq * 1.5707963267948966192) - kq * 6.123233995736766036e-17;
        const double x2 = x * x;
        const double sn = x * (1.0 + x2 * (-1.0 / 6 + x2 * (1.0 / 120 + x2 * (-1.0 / 5040 + x2 * (1.0 / 362880 + x2 * (-1.0 / 39916800 + x2 * (1.0 / 6227020800.0)))))));
        const double cs = 1.0 + x2 * (-0.5 + x2 * (1.0 / 24 + x2 * (-1.0 / 720 + x2 * (1.0 / 40320 + x2 * (-1.0 / 3628800 + x2 * (1.0 / 479001600.0 + x2 * (-1.0 / 87178291200.0)))))));
        const int q = ((int)kq) & 3;
        const double c = (q == 0) ? cs : (q == 1) ? -sn : (q == 2) ? -cs : sn;
        const double sv = (q == 0) ? sn : (q == 1) ? cs : (q == 2) ? -sn : -cs;
        cosT[idx] = (float)c; sinT[idx] = (float)sv;
    }
}
__device__ __forceinline__ void job_btab(const Params& p, int gtid, int gn) {
    float* bt = (float*)(p.ws + WS_MISC + MISC_BTAB);
    for (int idx = gtid; idx < 129 * 8; idx += gn) { const int d = idx >> 3, h = idx & 7; bt[idx] = p.rel_bias[t5_bucket(d) * 8 + h] * LOG2E; }
}
__device__ __forceinline__ void rms_row_to_bf16(const float* xrow, const float* gain, bf16_t* orow, int lane) {
    f32x4 v[4]; float ss = 0.f;
#pragma unroll
    for (int j = 0; j < 4; ++j) { v[j] = *(const f32x4*)(xrow + 256 * j + 4 * lane); ss += (v[j].x * v[j].x + v[j].y * v[j].y) + (v[j].z * v[j].z + v[j].w * v[j].w); }
    const float rs = rsqrtf(wave_sum(ss) * (1.f / DM) + RMS_EPS);
#pragma unroll
    for (int j = 0; j < 4; ++j) { const f32x4 g = *(const f32x4*)(gain + 256 * j + 4 * lane);
        u32x2 w; w.x = cvtpk(v[j].x * rs * g.x, v[j].y * rs * g.y); w.y = cvtpk(v[j].z * rs * g.z, v[j].w * rs * g.w);
        *(u32x2*)(orow + 256 * j + 4 * lane) = w; }
}
__device__ __forceinline__ void job_memn(const Params& p, int gw, int ngw, int lane) {
    for (int r = gw; r < 2 * MEML; r += ngw) { const int l = r >> 8, m = r & 255;
        rms_row_to_bf16(p.mem + (size_t)m * DM, p.mem_norm + l * DM, (bf16_t*)(p.ws + WS_MEMN) + ((size_t)l * MEML + m) * DM, lane); }
}
__device__ __forceinline__ void job_norm_rows(const Params& p, int mode, int gw, int ngw, int lane) {
    bf16_t* H = (bf16_t*)(p.ws + WS_H); const bf16_t* Y = (const bf16_t*)(p.ws + WS_Y);
    for (int row = gw; row < S; row += ngw) {
        if (mode == 0) { rms_row_to_bf16(p.x + (size_t)row * DM, p.norm_pre, H + (size_t)row * DM, lane); continue; }
        const float* xin = (mode == 1 ? p.x : p.out) + (size_t)row * DM; const float* gpost = p.norm_post + (mode == 1 ? 0 : DM);
        float y[16]; float ss = 0.f;
#pragma unroll
        for (int j = 0; j < 4; ++j) { const u32x2 w = *(const u32x2*)(Y + (size_t)row * DM + 256 * j + 4 * lane);
            y[4 * j] = lo_bf(w.x); y[4 * j + 1] = hi_bf(w.x); y[4 * j + 2] = lo_bf(w.y); y[4 * j + 3] = hi_bf(w.y);
            ss += (y[4 * j] * y[4 * j] + y[4 * j + 1] * y[4 * j + 1]) + (y[4 * j + 2] * y[4 * j + 2] + y[4 * j + 3] * y[4 * j + 3]); }
        const float rs = rsqrtf(wave_sum(ss) * (1.f / DM) + RMS_EPS);
        f32x4 x1[4]; float s2 = 0.f;
#pragma unroll
        for (int j = 0; j < 4; ++j) { const f32x4 xv = *(const f32x4*)(xin + 256 * j + 4 * lane); const f32x4 g = *(const f32x4*)(gpost + 256 * j + 4 * lane);
            x1[j].x = xv.x + y[4 * j] * rs * g.x; x1[j].y = xv.y + y[4 * j + 1] * rs * g.y; x1[j].z = xv.z + y[4 * j + 2] * rs * g.z; x1[j].w = xv.w + y[4 * j + 3] * rs * g.w;
            *(f32x4*)(p.out + (size_t)row * DM + 256 * j + 4 * lane) = x1[j];
            s2 += (x1[j].x * x1[j].x + x1[j].y * x1[j].y) + (x1[j].z * x1[j].z + x1[j].w * x1[j].w); }
        if (mode == 1) { const float r2 = rsqrtf(wave_sum(s2) * (1.f / DM) + RMS_EPS); const float* gpre = p.norm_pre + DM;
#pragma unroll
            for (int j = 0; j < 4; ++j) { const f32x4 g = *(const f32x4*)(gpre + 256 * j + 4 * lane);
                u32x2 w; w.x = cvtpk(x1[j].x * r2 * g.x, x1[j].y * r2 * g.y); w.y = cvtpk(x1[j].z * r2 * g.z, x1[j].w * r2 * g.w);
                *(u32x2*)(H + (size_t)row * DM + 256 * j + 4 * lane) = w; } }
    }
}
__device__ __forceinline__ void job_mla_rows(const Params& p, int l, int gw, int ngw, int lane) {
    const bf16_t* PROJ = (const bf16_t*)(p.ws + WS_PROJ); bf16_t* KV = (bf16_t*)(p.ws + WS_KVLAT); float* RSQ = (float*)(p.ws + WS_MISC + MISC_RSQ);
    const float* cosT = (const float*)(p.ws + WS_COS); const float* sinT = (const float*)(p.ws + WS_SIN);
    const int rs_ = lane >> 4, j = lane & 15;
    for (int row = gw * 4 + rs_; row < S; row += ngw * 4) {
        const bf16_t* pr = PROJ + (size_t)row * NP;
        const u32x4 q0 = *(const u32x4*)(pr + C_CQ + j * 16), q1 = *(const u32x4*)(pr + C_CQ + j * 16 + 8), kv = *(const u32x4*)(pr + C_CKV + j * 8); const u32x2 kr = *(const u32x2*)(pr + C_KR + j * 4);
        f32x4 cs = {0.f, 0.f, 0.f, 0.f}, sn = {0.f, 0.f, 0.f, 0.f}; if (j < 8) { cs = *(const f32x4*)(cosT + (size_t)row * 32 + 4 * j); sn = *(const f32x4*)(sinT + (size_t)row * 32 + 4 * j); }
        float sq = 0.f, sk = 0.f;
        { const unsigned w[8] = {q0.x, q0.y, q0.z, q0.w, q1.x, q1.y, q1.z, q1.w};
#pragma unroll
          for (int e = 0; e < 8; ++e) { const float a = lo_bf(w[e]), b = hi_bf(w[e]); sq += a * a + b * b; } }
        float kvf[8] = {lo_bf(kv.x), hi_bf(kv.x), lo_bf(kv.y), hi_bf(kv.y), lo_bf(kv.z), hi_bf(kv.z), lo_bf(kv.w), hi_bf(kv.w)};
#pragma unroll
        for (int e = 0; e < 8; ++e) sk += kvf[e] * kvf[e];
#pragma unroll
        for (int o = 1; o < 16; o <<= 1) { sq += __shfl_xor(sq, o); sk += __shfl_xor(sk, o); }
        if (j == 0) RSQ[row] = rsqrtf(sq * (1.f / 256.f) + RMS_EPS);
        { const float rs = rsqrtf(sk * (1.f / 128.f) + RMS_EPS); const float* g = p.kv_norm + l * 128 + j * 8; const f32x4 g0 = *(const f32x4*)g, g1 = *(const f32x4*)(g + 4);
          u32x4 w; w.x = cvtpk(kvf[0] * rs * g0[0], kvf[1] * rs * g0[1]); w.y = cvtpk(kvf[2] * rs * g0[2], kvf[3] * rs * g0[3]); w.z = cvtpk(kvf[4] * rs * g1[0], kvf[5] * rs * g1[1]); w.w = cvtpk(kvf[6] * rs * g1[2], kvf[7] * rs * g1[3]);
          *(u32x4*)(KV + (size_t)row * 192 + j * 8) = w; }
        { const unsigned px = __shfl_xor(kr.x, 8), py = __shfl_xor(kr.y, 8);
          if (j < 8) { const float t1[4] = {lo_bf(kr.x), hi_bf(kr.x), lo_bf(kr.y), hi_bf(kr.y)}, t2[4] = {lo_bf(px), hi_bf(px), lo_bf(py), hi_bf(py)};
              u32x4 w; w.x = cvtpk(t1[0] * cs[0] - t2[0] * sn[0], t1[0] * sn[0] + t2[0] * cs[0]); w.y = cvtpk(t1[1] * cs[1] - t2[1] * sn[1], t1[1] * sn[1] + t2[1] * cs[1]);
              w.z = cvtpk(t1[2] * cs[2] - t2[2] * sn[2], t1[2] * sn[2] + t2[2] * cs[2]); w.w = cvtpk(t1[3] * cs[3] - t2[3] * sn[3], t1[3] * sn[3] + t2[3] * cs[3]);
              *(u32x4*)(KV + (size_t)row * 192 + 128 + 8 * j) = w; } }
    }
}
__device__ __forceinline__ void job_gdn_final(const Params& p, int l, int gw, int ngw, int lane, int wid, LAS unsigned char* lds) {
    bf16_t* PROJ = (bf16_t*)(p.ws + WS_PROJ); const bf16_t* U = (const bf16_t*)(p.ws + WS_U);
    LAS bf16_t* T = (LAS bf16_t*)(lds + wid * 17408);
    for (int it = gw; it < 1024; it += ngw) {
        const int n = it >> 2, h = it & 3; const bf16_t* ut = U + (size_t)it * 8192 + lane * 4;
#pragma unroll 4
        for (int j = 0; j < 32; ++j) { const u32x2 w = *(const u32x2*)(ut + j * 256);
            const int g = j & 3, ct = (j >> 2) & 1, sl = j >> 3, dv = 32 * sl + (lane & 31), c0 = 32 * ct + 8 * g + 4 * (lane >> 5);
            T[(c0 + 0) * 136 + dv] = (bf16_t)(w.x & 0xffffu); T[(c0 + 1) * 136 + dv] = (bf16_t)(w.x >> 16); T[(c0 + 2) * 136 + dv] = (bf16_t)(w.y & 0xffffu); T[(c0 + 3) * 136 + dv] = (bf16_t)(w.y >> 16); }
        LDS_WAIT();
#pragma unroll 2
        for (int i = 0; i < 16; ++i) { const int id = lane + 64 * i, c = id >> 4, dc = id & 15;
            const u32x4 v = *(const LAS u32x4*)(T + c * 136 + dc * 8);
            float x[8] = {lo_bf(v.x), hi_bf(v.x), lo_bf(v.y), hi_bf(v.y), lo_bf(v.z), hi_bf(v.z), lo_bf(v.w), hi_bf(v.w)};
            float ss = 0.f;
#pragma unroll
            for (int e = 0; e < 8; ++e) ss += x[e] * x[e];
            ss += __shfl_xor(ss, 1); ss += __shfl_xor(ss, 2); ss += __shfl_xor(ss, 4); ss += __shfl_xor(ss, 8);
            const float rs = rsqrtf(ss * (1.f / 128.f) + RMS_EPS);
            const float* gn = p.gdn_norm + l * 128 + dc * 8; const f32x4 g0 = *(const f32x4*)gn, g1 = *(const f32x4*)(gn + 4);
            bf16_t* zp = PROJ + (size_t)(n * 64 + c) * NP + C_Z + 512 + h * 128 + dc * 8; const u32x4 z = *(const u32x4*)zp;
            u32x4 o; o.x = cvtpk(x[0] * rs * g0[0] * silu_f(lo_bf(z.x)), x[1] * rs * g0[1] * silu_f(hi_bf(z.x))); o.y = cvtpk(x[2] * rs * g0[2] * silu_f(lo_bf(z.y)), x[3] * rs * g0[3] * silu_f(hi_bf(z.y)));
            o.z = cvtpk(x[4] * rs * g1[0] * silu_f(lo_bf(z.z)), x[5] * rs * g1[1] * silu_f(hi_bf(z.z))); o.w = cvtpk(x[6] * rs * g1[2] * silu_f(lo_bf(z.w)), x[7] * rs * g1[3] * silu_f(hi_bf(z.w)));
            *(u32x4*)zp = o; }
        LDS_WAIT();
    }
}
namespace gdn {
constexpr int L_QH = 0, L_KH = 17408, L_KBGT = 34816, L_KHDT = 53248, L_VBT = 71680, L_LF = 90112, L_TF = 107520, L_MB = 124928, L_GV = 129280, L_END = 130560;
constexpr int QP = 136, TP = 72, LP = 68;
__device__ __forceinline__ bf16_t* frag_ptr(bf16_t* PROJ, int n, int h, int f, int lane) {
    const int seg = 4 * f + (lane >> 4), part = seg >> 6, row = seg & 63;
    return PROJ + (size_t)(n * 64 + row) * NP + C_BQKV + part * 512 + h * 128 + (lane & 15) * 8;
}
__device__ __forceinline__ bf16x8 pack8f(const LAS float* q) { const f32x4 a = *(const LAS f32x4*)q, b = *(const LAS f32x4*)(q + 4); u32x4 w = {cvtpk(a[0], a[1]), cvtpk(a[2], a[3]), cvtpk(b[0], b[1]), cvtpk(b[2], b[3])}; return __builtin_bit_cast(bf16x8, w); }
__device__ __forceinline__ void prep_item(const Params& p, int l, int n, int h, LAS unsigned char* lds) {
    const int tid = tidx(), lane = tid & 63, r32 = lane & 31, hi = lane >> 5, wid = __builtin_amdgcn_readfirstlane(tid >> 6);
    bf16_t* PROJ = (bf16_t*)(p.ws + WS_PROJ); const bf16_t* HALO = (const bf16_t*)(p.ws + WS_HALO);
    bf16_t* AQKg = (bf16_t*)(p.ws + WS_AQK); bf16_t* Ug = (bf16_t*)(p.ws + WS_U); float* EGL = (float*)(p.ws + WS_MISC + MISC_EGL);
    LAS bf16_t* QH = (LAS bf16_t*)(lds + L_QH); LAS bf16_t* KH = (LAS bf16_t*)(lds + L_KH); LAS bf16_t* KBGT = (LAS bf16_t*)(lds + L_KBGT);
    LAS bf16_t* KHDT = (LAS bf16_t*)(lds + L_KHDT); LAS bf16_t* VBT = (LAS bf16_t*)(lds + L_VBT); LAS float* LF = (LAS float*)(lds + L_LF);
    LAS float* TF = (LAS float*)(lds + L_TF); LAS float* MB = (LAS float*)(lds + L_MB); LAS float* GC = (LAS float*)(lds + L_GV); LAS float* BETA = GC + 64; LAS float* EGC = GC + 128; LAS float* EGD = GC + 192;
    const int t0 = n * 64;
    const int g16 = tid & 15, row0 = tid >> 4;
#define S2_LOAD(part, XA, XB, WA, WB) do { const int cb_ = (part) * 512 + h * 128 + g16 * 8; \
        _Pragma("unroll") for (int j = 0; j < 4; ++j) { const int ta_ = t0 + row0 - 3 + j; XA[j] = (u32x4){0u, 0u, 0u, 0u}; \
            if (ta_ >= t0) XA[j] = *(const u32x4*)(PROJ + (size_t)ta_ * NP + C_BQKV + cb_); else if (n > 0) XA[j] = *(const u32x4*)(HALO + ((size_t)(n - 1) * 3 + (ta_ - (t0 - 3))) * 1536 + cb_); \
            XB[j] = *(const u32x4*)(PROJ + (size_t)(t0 + row0 + 29 + j) * NP + C_BQKV + cb_); \
            const float* cw_ = p.conv_w + ((size_t)l * 4 + j) * 1536 + cb_; WA[j] = *(const f32x4*)cw_; WB[j] = *(const f32x4*)(cw_ + 4); } } while (0)
    u32x4 xa[4], xb[4]; f32x4 wa[4], wb[4];
    S2_LOAD(0, xa, xb, wa, wb);
    __syncthreads();
    if (wid == 0) {
        const bf16_t* pr = PROJ + (size_t)(t0 + lane) * NP;
        const float xa_ = bf2f(pr[C_BA + h]) + p.dt_bias[l * 4 + h], xb_ = bf2f(pr[C_BB + h]);
        const float e = __expf(xa_); const float sp = xa_ > 20.f ? xa_ : (e < 1e-3f ? e * (1.f - e * (0.5f - e * (1.f / 3.f))) : logf(1.f + e));
        float gc = -__expf(p.a_log[l * 4 + h]) * sp;
#pragma unroll
        for (int o = 1; o < 64; o <<= 1) { const float t_ = __shfl_up(gc, o); if (lane >= o) gc += t_; }
        const float gl = __shfl(gc, 63);
        GC[lane] = gc; BETA[lane] = 1.f / (1.f + __expf(-xb_)); EGC[lane] = __expf(gc); EGD[lane] = __expf(gl - gc);
        if (lane == 0) EGL[n * 4 + h] = __expf(gl);
    }
    __syncthreads();
#define TSW(dk, j) ((dk) * 64 + (((((j) >> 3) ^ (((dk) >> 3) & 7)) << 3) | ((j) & 7)))
#define S2_ITEM(part, X, W0, W1, row) do { float a[8] = {0.f, 0.f, 0.f, 0.f, 0.f, 0.f, 0.f, 0.f}; \
        _Pragma("unroll") for (int j = 0; j < 4; ++j) { a[0] = fmaf(W0[j][0], lo_bf(X[j].x), a[0]); a[1] = fmaf(W0[j][1], hi_bf(X[j].x), a[1]); a[2] = fmaf(W0[j][2], lo_bf(X[j].y), a[2]); a[3] = fmaf(W0[j][3], hi_bf(X[j].y), a[3]); \
            a[4] = fmaf(W1[j][0], lo_bf(X[j].z), a[4]); a[5] = fmaf(W1[j][1], hi_bf(X[j].z), a[5]); a[6] = fmaf(W1[j][2], lo_bf(X[j].w), a[6]); a[7] = fmaf(W1[j][3], hi_bf(X[j].w), a[7]); } \
        float ss = 0.f; _Pragma("unroll") for (int e = 0; e < 8; ++e) { a[e] = silu_f(a[e]); ss += a[e] * a[e]; } \
        ss += __shfl_xor(ss, 1); ss += __shfl_xor(ss, 2); ss += __shfl_xor(ss, 4); ss += __shfl_xor(ss, 8); const float rn = rsqrtf(ss + 1e-6f); \
        if ((part) == 0) { const float sc = rn * 0.08838834764831845f; _Pragma("unroll") for (int e = 0; e < 8; ++e) a[e] *= sc; *(LAS bf16x8*)(QH + (row) * QP + g16 * 8) = pack8(a); } \
        else if ((part) == 1) { _Pragma("unroll") for (int e = 0; e < 8; ++e) a[e] *= rn; *(LAS bf16x8*)(KH + (row) * QP + g16 * 8) = pack8(a); const float s1 = BETA[row] * EGC[row], s2 = EGD[row]; \
            _Pragma("unroll") for (int e = 0; e < 8; ++e) { KBGT[TSW(g16 * 8 + e, row)] = f2bf(a[e] * s1); KHDT[TSW(g16 * 8 + e, row)] = f2bf(a[e] * s2); } } \
        else { const float b = BETA[row]; _Pragma("unroll") for (int e = 0; e < 8; ++e) VBT[TSW(g16 * 8 + e, row)] = f2bf(a[e] * b); } } while (0)
#ifdef EXP_DUPS2
#pragma unroll 1
    for (int rep_ = 0; rep_ < 2; ++rep_)
#endif
    { u32x4 ya[4], yb[4]; f32x4 va[4], vb[4];
      S2_LOAD(1, ya, yb, va, vb);
      S2_ITEM(0, xa, wa, wb, row0); S2_ITEM(0, xb, wa, wb, row0 + 32);
      S2_LOAD(2, xa, xb, wa, wb);
      S2_ITEM(1, ya, va, vb, row0); S2_ITEM(1, yb, va, vb, row0 + 32);
      S2_ITEM(2, xa, wa, wb, row0); S2_ITEM(2, xb, wa, wb, row0 + 32); }
#undef S2_LOAD
#undef S2_ITEM
    __syncthreads();
    if (wid < 3) { const int it = wid > 0, jt = wid > 1; f32x16 acc = {};
#pragma unroll
        for (int ks = 0; ks < 8; ++ks) { const bf16x8 a = *(const LAS bf16x8*)(KH + (32 * it + r32) * QP + 16 * ks + 8 * hi), b = *(const LAS bf16x8*)(KH + (32 * jt + r32) * QP + 16 * ks + 8 * hi);
            acc = MFMA32(a, b, acc); }
        const int j = 32 * jt + r32; const float gj = GC[j];
#pragma unroll
        for (int r = 0; r < 16; ++r) { const int i = 32 * it + crow(r, hi); LF[i * LP + j] = i > j ? BETA[i] * __expf(GC[i] - gj) * acc[r] : 0.f; }
    } else if (wid < 6) { const int w = wid - 3, ctp = w > 1, ct = w > 0; f32x16 acc = {};
#pragma unroll
        for (int ks = 0; ks < 8; ++ks) { const bf16x8 a = *(const LAS bf16x8*)(KH + (32 * ctp + r32) * QP + 16 * ks + 8 * hi), b = *(const LAS bf16x8*)(QH + (32 * ct + r32) * QP + 16 * ks + 8 * hi);
            acc = MFMA32(a, b, acc); }
        const int c = 32 * ct + r32; const float gcq = GC[c];
#pragma unroll
        for (int r = 0; r < 16; ++r) { const int cp = 32 * ctp + crow(r, hi); acc[r] = c >= cp ? acc[r] * __expf(gcq - GC[cp]) : 0.f; }
        bf16_t* dst = AQKg + (((size_t)(n * 4 + h) * 8 + (ct * 2 + ctp) * 2) * 64 + lane) * 8;
        *(bf16x8*)dst = pack_step(acc, 0); *(bf16x8*)(dst + 512) = pack_step(acc, 1);
    } else { const int w = wid - 6;
        if (w == 0) { const bf16x8 z = {0, 0, 0, 0, 0, 0, 0, 0}; bf16_t* dst = AQKg + (((size_t)(n * 4 + h) * 8 + 2) * 64 + lane) * 8; *(bf16x8*)dst = z; *(bf16x8*)(dst + 512) = z; }
#pragma unroll
        for (int ff = 0; ff < 8; ++ff) { const int f = w * 8 + ff, s = f & 1, mt = (f >> 1) & 3, ct = f >> 3, c = 32 * ct + r32, d0 = 32 * mt + 16 * s + 4 * hi; const float eg = EGC[c];
            const u32x2 lo = *(const LAS u32x2*)(QH + c * QP + d0), hw = *(const LAS u32x2*)(QH + c * QP + d0 + 8);
            u32x4 o; o.x = cvtpk(lo_bf(lo.x) * eg, hi_bf(lo.x) * eg); o.y = cvtpk(lo_bf(lo.y) * eg, hi_bf(lo.y) * eg); o.z = cvtpk(lo_bf(hw.x) * eg, hi_bf(hw.x) * eg); o.w = cvtpk(lo_bf(hw.y) * eg, hi_bf(hw.y) * eg);
            *(u32x4*)frag_ptr(PROJ, n, h, 16 + f, lane) = o; }
    }
    __syncthreads();
    if (wid == 0) {
#ifdef EXP_DUPS4
#pragma unroll 1
      for (int rep_ = 0; rep_ < 2; ++rep_)
#endif
      {
        unsigned lfb = (unsigned)(uintptr_t)LF, tfb = (unsigned)(uintptr_t)TF, mbb = (unsigned)(uintptr_t)MB; asm volatile("" : "+v"(lfb), "+v"(tfb), "+v"(mbb));
        const LAS float* LFv = (const LAS float*)(uintptr_t)lfb; LAS float* TFv = (LAS float*)(uintptr_t)tfb; LAS float* MBv = (LAS float*)(uintptr_t)mbb;
        { const int b = lane >> 4, c = lane & 15; const LAS float* Lb = LFv + (16 * b) * LP + 16 * b; LAS float* Tb = TFv + (16 * b) * LP + 16 * b + c; float t[16];
#pragma unroll
          for (int i = 0; i < 16; ++i) { float a0 = (c == i) ? 1.f : 0.f, a1 = 0.f;
#pragma unroll
              for (int q = 0; 4 * q < i; ++q) { const f32x4 lv = *(const LAS f32x4*)(Lb + i * LP + 4 * q);
#pragma unroll
                  for (int e = 0; e < 4; ++e) if (4 * q + e < i) { if (e & 1) a1 = fmaf(-lv[e], t[4 * q + e], a1); else a0 = fmaf(-lv[e], t[4 * q + e], a0); } }
              t[i] = a0 + a1; Tb[i * LP] = t[i]; } }
        const int r16 = lane & 15, k4 = lane >> 4;
#define BLK(P, b_, a_) ((P) + (16 * (b_)) * LP + 16 * (a_))
#define MM16(acc, X, Y) do { _Pragma("unroll") for (int ks = 0; ks < 4; ++ks) acc = __builtin_amdgcn_mfma_f32_16x16x4f32((X)[r16 * LP + 4 * ks + k4], (Y)[(4 * ks + k4) * LP + r16], acc, 0, 0, 0); } while (0)
#define ST16(Z, acc, sg) do { _Pragma("unroll") for (int r = 0; r < 4; ++r) (Z)[(4 * k4 + r) * LP + r16] = (sg) * acc[r]; } while (0)
#define TBLK(b_, a_, SUM) do { f32x4 m_ = {0.f, 0.f, 0.f, 0.f}; SUM; ST16(MBv, m_, 1.f); f32x4 t_ = {0.f, 0.f, 0.f, 0.f}; MM16(t_, BLK(TFv, b_, b_), MBv); ST16(BLK(TFv, b_, a_), t_, -1.f); } while (0)
        TBLK(1, 0, MM16(m_, BLK(LFv, 1, 0), BLK(TFv, 0, 0)));
        TBLK(2, 1, MM16(m_, BLK(LFv, 2, 1), BLK(TFv, 1, 1)));
        TBLK(3, 2, MM16(m_, BLK(LFv, 3, 2), BLK(TFv, 2, 2)));
        TBLK(2, 0, MM16(m_, BLK(LFv, 2, 0), BLK(TFv, 0, 0)); MM16(m_, BLK(LFv, 2, 1), BLK(TFv, 1, 0)));
        TBLK(3, 1, MM16(m_, BLK(LFv, 3, 1), BLK(TFv, 1, 1)); MM16(m_, BLK(LFv, 3, 2), BLK(TFv, 2, 1)));
        TBLK(3, 0, MM16(m_, BLK(LFv, 3, 0), BLK(TFv, 0, 0)); MM16(m_, BLK(LFv, 3, 1), BLK(TFv, 1, 0)); MM16(m_, BLK(LFv, 3, 2), BLK(TFv, 2, 0)));
#undef BLK
#undef MM16
#undef ST16
#undef TBLK
      }
    } else {
        if (wid == 1) {
#pragma unroll
            for (int i = 0; i < 24; ++i) { const int id = lane + 64 * i, blk = id >> 8, rr = (id >> 4) & 15, cc = id & 15;
                const int b = blk < 3 ? 0 : (blk < 5 ? 1 : 2), a = blk < 3 ? blk + 1 : (blk < 5 ? blk - 1 : 3);
                TF[(16 * b + rr) * LP + 16 * a + cc] = 0.f; }
        }
        for (int f = wid - 1; f < 16; f += 7) { const int s = f & 1, ctp = (f >> 1) & 1, mt = f >> 2, dk = 32 * mt + r32, c0 = 32 * ctp + 16 * s + 4 * hi;
            const u32x2 lo = *(const LAS u32x2*)(KHDT + TSW(dk, c0)), hw = *(const LAS u32x2*)(KHDT + TSW(dk, c0 + 8));
            u32x4 o = {lo.x, lo.y, hw.x, hw.y}; *(u32x4*)frag_ptr(PROJ, n, h, 32 + f, lane) = o; }
    }
    __syncthreads();
    { const int mt = wid >> 1, ct = wid & 1; f32x16 acc = {};
#pragma unroll
      for (int ks = 0; ks < 4; ++ks) { const bf16x8 a = *(const LAS bf16x8*)(KBGT + TSW(32 * mt + r32, 16 * ks + 8 * hi)), b = pack8f(TF + (32 * ct + r32) * LP + 16 * ks + 8 * hi);
          acc = MFMA32(a, b, acc); }
#pragma unroll
      for (int r = 0; r < 16; ++r) acc[r] = -acc[r];
      *(bf16x8*)frag_ptr(PROJ, n, h, (ct * 4 + mt) * 2, lane) = pack_step(acc, 0); *(bf16x8*)frag_ptr(PROJ, n, h, (ct * 4 + mt) * 2 + 1, lane) = pack_step(acc, 1); }
    { const int ct = wid >> 2, dt = wid & 3; f32x16 acc = {};
#pragma unroll
      for (int ks = 0; ks < 4; ++ks) { const bf16x8 a = pack8f(TF + (32 * ct + r32) * LP + 16 * ks + 8 * hi), b = *(const LAS bf16x8*)(VBT + TSW(32 * dt + r32, 16 * ks + 8 * hi));
          acc = MFMA32(a, b, acc); }
      bf16_t* up = Ug + (size_t)(n * 4 + h) * 8192 + (size_t)((dt * 2 + ct) * 4) * 256 + lane * 4;
#pragma unroll
      for (int g = 0; g < 4; ++g) { u32x2 w; w.x = cvtpk(acc[4 * g], acc[4 * g + 1]); w.y = cvtpk(acc[4 * g + 2], acc[4 * g + 3]); *(u32x2*)(up + g * 256) = w; } }
}
constexpr int SCAN_STAGE = 65536, SCAN_U = 57344, SCAN_EGL = 131072, SCAN_NP = 16;
__device__ __forceinline__ const u32x4* scan_src(const bf16_t* PROJ, const bf16_t* AQKg, const bf16_t* Ug, int n, int h, int half, int k, int ll) {
    if (k < 12) { const int piece = k * 256 + ll; return (const u32x4*)frag_ptr((bf16_t*)PROJ, n, h, piece >> 6, piece & 63); }
    if (k < 14) return (const u32x4*)(AQKg + ((size_t)(n * 4 + h) * 512 + (k - 12) * 256 + ll) * 8);
    return (const u32x4*)(Ug + (size_t)(n * 4 + h) * 8192 + half * 4096 + (size_t)((k - 14) * 256 + ll) * 8);
}
constexpr int SCAN_XCH = 131584, SCAN_XCH_SLICE = 12288;
template <int ROLE>
__device__ __forceinline__ void scan_compute(LAS unsigned char* lds, bf16_t* ub  , int sp, int lane) {
    constexpr int NCH = S / 64;
    LAS unsigned char* xs = lds + SCAN_XCH + sp * SCAN_XCH_SLICE + lane * 16;
    LAS unsigned char* xv = xs + 8192;
    f32x16 St[2] = {};
    bf16x8 Sb[4][2];
#pragma unroll
    for (int mt = 0; mt < 4; ++mt) { Sb[mt][0] = (bf16x8){0, 0, 0, 0, 0, 0, 0, 0}; Sb[mt][1] = Sb[mt][0]; }
    __syncthreads();
#ifdef EXP_SCANSEC
    unsigned long long acc_s[4] = {0, 0, 0, 0}, tm_ = __builtin_amdgcn_s_memrealtime();
#define SEC(i) do { const unsigned long long t_ = __builtin_amdgcn_s_memrealtime(); acc_s[i] += t_ - tm_; tm_ = t_; } while (0)
#else
#define SEC(i)
#endif
#pragma unroll 1
    for (int n = 0; n < NCH; ++n) {
        const LAS unsigned char* stg = lds + (n & 1) * SCAN_STAGE + lane * 16;
        const LAS unsigned char* us = lds + (n & 1) * SCAN_STAGE + SCAN_U + (sp * 8 + ROLE * 4) * 512 + lane * 8;
        const float egl = *(const LAS float*)(lds + SCAN_EGL + (n & 1) * 4);
        f32x16 vn, o = {};
#pragma unroll
        for (int g = 0; g < 4; ++g) { const u32x2 w = *(const LAS u32x2*)(us + g * 512); vn[4 * g] = lo_bf(w.x); vn[4 * g + 1] = hi_bf(w.x); vn[4 * g + 2] = lo_bf(w.y); vn[4 * g + 3] = hi_bf(w.y); }
        if (n > 0) {
#pragma unroll
            for (int j = 0; j < 2; ++j) { Sb[2 * (1 - ROLE) + j][0] = *(const LAS bf16x8*)(xs + ((2 * (1 - ROLE) + j) * 2) * 1024); Sb[2 * (1 - ROLE) + j][1] = *(const LAS bf16x8*)(xs + ((2 * (1 - ROLE) + j) * 2 + 1) * 1024); }
        }
#define FR(f) (*(const LAS bf16x8*)(stg + (f) * 1024))
#define RD1(B, mt) do { const int f_ = (ROLE * 4 + (mt)) * 2; B[0] = FR(f_); B[1] = FR(f_ + 1); B[2] = FR(16 + f_); B[3] = FR(16 + f_ + 1); } while (0)
#define MM1(B, mt) do { vn = MFMA32(B[0], Sb[mt][0], vn); o = MFMA32(B[2], Sb[mt][0], o); vn = MFMA32(B[1], Sb[mt][1], vn); o = MFMA32(B[3], Sb[mt][1], o); } while (0)
        bf16x8 fa[4], fb[4];
        RD1(fa, 0); RD1(fb, 1); SBAR();
        MM1(fa, 0); SBAR(); RD1(fa, 2); SBAR();
        MM1(fb, 1); SBAR(); RD1(fb, 3); SBAR();
        MM1(fa, 2); SBAR();
        bf16x8 kd[2][4];
#pragma unroll
        for (int j = 0; j < 2; ++j)
#pragma unroll
            for (int q = 0; q < 4; ++q) kd[j][q] = FR(32 + ((2 * ROLE + j) * 2) * 2 + q);
        SBAR(); MM1(fb, 3); SBAR();
#pragma unroll
        for (int j = 0; j < 2; ++j)
#pragma unroll
            for (int r = 0; r < 16; ++r) St[j][r] *= egl;
        bf16x8 Vb[2][2];
        Vb[ROLE][0] = pack_step(vn, 0); Vb[ROLE][1] = pack_step(vn, 1);
        *(LAS bf16x8*)(xv + (ROLE * 2) * 1024) = Vb[ROLE][0]; *(LAS bf16x8*)(xv + (ROLE * 2 + 1) * 1024) = Vb[ROLE][1];
        bf16x8 aq[4];
        if (ROLE == 0) { aq[0] = FR(48); aq[1] = FR(49); } else { aq[0] = FR(52); aq[1] = FR(53); aq[2] = FR(54); aq[3] = FR(55); }
        SEC(0);
        __syncthreads();
        SEC(1);
        Vb[1 - ROLE][0] = *(const LAS bf16x8*)(xv + ((1 - ROLE) * 2) * 1024); Vb[1 - ROLE][1] = *(const LAS bf16x8*)(xv + ((1 - ROLE) * 2 + 1) * 1024);
#pragma unroll
        for (int ctp = 0; ctp < 2; ++ctp)
#pragma unroll
            for (int s = 0; s < 2; ++s) {
                St[0] = MFMA32(kd[0][ctp * 2 + s], Vb[ctp][s], St[0]); St[1] = MFMA32(kd[1][ctp * 2 + s], Vb[ctp][s], St[1]);
                if (ROLE == 1) o = MFMA32(aq[ctp * 2 + s], Vb[ctp][s], o); else if (ctp == 0) o = MFMA32(aq[s], Vb[0][s], o);
            }
        { bf16_t* uc = ub + (size_t)n * (4 * 8192);
#pragma unroll
          for (int g = 0; g < 4; ++g) { u32x2 w; w.x = cvtpk(o[4 * g], o[4 * g + 1]); w.y = cvtpk(o[4 * g + 2], o[4 * g + 3]); *(u32x2*)(uc + g * 256) = w; } }
#pragma unroll
        for (int j = 0; j < 2; ++j) { Sb[2 * ROLE + j][0] = pack_step(St[j], 0); Sb[2 * ROLE + j][1] = pack_step(St[j], 1);
            *(LAS bf16x8*)(xs + ((2 * ROLE + j) * 2) * 1024) = Sb[2 * ROLE + j][0]; *(LAS bf16x8*)(xs + ((2 * ROLE + j) * 2 + 1) * 1024) = Sb[2 * ROLE + j][1]; }
#undef FR
#undef RD1
#undef MM1
        SEC(2);
        __syncthreads();
        SEC(3);
    }
#ifdef EXP_SCANSEC
    { const unsigned long long t1_ = __builtin_amdgcn_s_memrealtime(); while (__builtin_amdgcn_s_memrealtime() - t1_ < 4 * acc_s[EXP_SCANSEC]) __builtin_amdgcn_s_sleep(8); }
#endif
#undef SEC
}
__device__ __forceinline__ void scan_wg(const Params& p, int h, int half, LAS unsigned char* lds) {
    const int tid = tidx(), lane = tid & 63, wid = __builtin_amdgcn_readfirstlane(tid >> 6);
    const bf16_t* PROJ = (const bf16_t*)(p.ws + WS_PROJ); const bf16_t* AQKg = (const bf16_t*)(p.ws + WS_AQK); bf16_t* Ug = (bf16_t*)(p.ws + WS_U); const float* EGL = (const float*)(p.ws + WS_MISC + MISC_EGL);
    constexpr int NCH = S / 64;
    __syncthreads();
    if (wid >= 4) {
        const int ll = tid - 256; u32x4 sa[SCAN_NP], sb[SCAN_NP]; float ea, eb;
        const char* pf0 = (const char*)(PROJ + (size_t)(ll >> 4) * NP + C_BQKV + h * 128 + (ll & 15) * 8); const char* pa0 = (const char*)(AQKg + ((size_t)h * 512 + ll) * 8); const char* pu0 = (const char*)(Ug + (size_t)h * 8192 + half * 4096 + (size_t)ll * 8);
#define LD_H0(R, n_) do { const char* pf_ = pf0 + (size_t)(n_) * (64 * NP * 2); SBAR(); _Pragma("unroll") for (int k = 0; k < 8; ++k) R[k] = *(const u32x4*)(pf_ + (size_t)(k & 3) * (16 * NP * 2) + (k >> 2) * 1024); SBAR(); } while (0)
#define LD_H1(R, E, n_) do { E = EGL[(n_) * 4 + h]; const char* pf_ = pf0 + (size_t)(n_) * (64 * NP * 2); const char* pa_ = pa0 + (size_t)(n_) * (4 * 512 * 16); const char* pu_ = pu0 + (size_t)(n_) * (4 * 8192 * 2); SBAR(); \
        _Pragma("unroll") for (int k = 8; k < 12; ++k) R[k] = *(const u32x4*)(pf_ + (size_t)(k & 3) * (16 * NP * 2) + (k >> 2) * 1024); SBAR(); \
        R[12] = *(const u32x4*)pa_; R[13] = *(const u32x4*)(pa_ + 4096); R[14] = *(const u32x4*)pu_; R[15] = *(const u32x4*)(pu_ + 4096); SBAR(); } while (0)
#define WR_H0(R, n_) do { _Pragma("unroll") for (int k = 0; k < 8; ++k) *(LAS u32x4*)(lds + ((n_) & 1) * SCAN_STAGE + (k * 256 + ll) * 16) = R[k]; } while (0)
#define WR_H1(R, E, n_) do { *(LAS float*)(lds + SCAN_EGL + ((n_) & 1) * 4) = E; _Pragma("unroll") for (int k = 8; k < SCAN_NP; ++k) *(LAS u32x4*)(lds + ((n_) & 1) * SCAN_STAGE + (k * 256 + ll) * 16) = R[k]; } while (0)
#define LSTEP(R, E, n_) do { WR_H0(R, (n_) + 1); if ((n_) + 3 < NCH) LD_H0(R, (n_) + 3); __syncthreads(); WR_H1(R, E, (n_) + 1); if ((n_) + 3 < NCH) LD_H1(R, E, (n_) + 3); __syncthreads(); } while (0)
        LD_H0(sa, 0); LD_H1(sa, ea, 0); WR_H0(sa, 0); WR_H1(sa, ea, 0); LD_H0(sa, 1); LD_H1(sa, ea, 1); LD_H0(sb, 2); LD_H1(sb, eb, 2);
        __syncthreads();
#pragma unroll 1
        for (int n = 0; n < NCH - 2; n += 2) { LSTEP(sa, ea, n); LSTEP(sb, eb, n + 1); }
        WR_H0(sa, NCH - 1); __syncthreads(); WR_H1(sa, ea, NCH - 1); __syncthreads();
        __syncthreads(); __syncthreads();
#undef LSTEP
#undef LD_H0
#undef LD_H1
#undef WR_H0
#undef WR_H1
    } else {
        const int sp = wid >> 1, role = wid & 1, sl = 2 * half + sp;
        bf16_t* ub = Ug + (size_t)h * 8192 + (size_t)(sl * 8 + role * 4) * 256 + lane * 4;
        if (role == 0) scan_compute<0>(lds, ub, sp, lane); else scan_compute<1>(lds, ub, sp, lane);
    }
}
}
typedef __attribute__((address_space(1))) unsigned gu32;
#define XB_TMO      128
#define XB_XCNT(j)  (256  + 64 * (j))
#define XB_XSUB(j)  (1280 + 64 * (j))
#define XB_XGEN(j)  (2304 + 64 * (j))
#define XB_TOP      3328
#define XB_TOPGEN   3392
#define XCD_BAR_WORDS 3456
#define XB_SPIN_CAP (1u << 18)

__device__ __forceinline__ unsigned xb_ld(unsigned* p)              { return __hip_atomic_load(p, __ATOMIC_RELAXED, __HIP_MEMORY_SCOPE_AGENT); }
__device__ __forceinline__ unsigned xb_add(unsigned* p, unsigned v) { return __hip_atomic_fetch_add(p, v, __ATOMIC_RELAXED, __HIP_MEMORY_SCOPE_AGENT); }
__device__ __forceinline__ unsigned xb_xcc_id() { return (unsigned)__builtin_amdgcn_s_getreg((3 << 11) | 20) & 0xFu; }
#define XB_SPIN(cond, bar) do { unsigned _sp = 0; while (cond) { __builtin_amdgcn_s_sleep(1); \
    if ((++_sp & 255u) == 0u) { if (xb_ld(&(bar)[XB_TMO])) break; if (_sp > XB_SPIN_CAP) { atomicAdd(&(bar)[XB_TMO], 1u); break; } } } } while (0)

struct XcdBarrier {
    unsigned* bar; unsigned x;
    volatile LAS unsigned* st;
};

__device__ __forceinline__ XcdBarrier xcd_barrier_post(unsigned* bar, volatile LAS unsigned* st) {
    XcdBarrier b; b.bar = bar; b.x = xb_xcc_id(); b.st = st;
    if (tidx() == 0) (void)xb_add(&bar[XB_XCNT(b.x)], 1u);
    return b;
}
__device__ __forceinline__ void xcd_barrier_complete(unsigned* bar, unsigned x, unsigned& nloc, unsigned& nx) {
    const unsigned G = gridDim.x * gridDim.y * gridDim.z;
    unsigned sum, cnt, mine, sp = 0u;
    for (;;) {
        sum = 0u; cnt = 0u; mine = 0u;
#pragma unroll
        for (unsigned j = 0; j < 16; ++j) { const unsigned c = xb_ld(&bar[XB_XCNT(j)]); sum += c; cnt += (c > 0u) ? 1u : 0u; mine = (j == x) ? c : mine; }
        if (sum == G) break;
        __builtin_amdgcn_s_sleep(1);
        if ((++sp & 255u) == 0u) { if (xb_ld(&bar[XB_TMO])) break; if (sp > XB_SPIN_CAP) { atomicAdd(&bar[XB_TMO], 1u); break; } }
    }
    nloc = mine > 0u ? mine : 1u; nx = cnt > 0u ? cnt : 1u;
}

__device__ __forceinline__ void xcd_barrier(const XcdBarrier& b) {
    asm volatile("s_waitcnt vmcnt(0)" ::: "memory");
    __syncthreads();
    if (tidx() == 0) {
        unsigned* bar = b.bar;
        __builtin_amdgcn_s_waitcnt(0);
        unsigned nloc = b.st[0], nx = b.st[1];
        if (nloc == 0u) { xcd_barrier_complete(bar, b.x, nloc, nx); b.st[0] = nloc; b.st[1] = nx; }
        const unsigned old = xb_add(&bar[XB_XSUB(b.x)], 1u);
        const unsigned gen = old / nloc;
        if (old + 1u == (gen + 1u) * nloc) {
            __builtin_amdgcn_fence(__ATOMIC_RELEASE, "agent");
            asm volatile("s_waitcnt vmcnt(0)" ::: "memory");
            const unsigned og = xb_add(&bar[XB_TOP], 1u);
            const unsigned tg = og / nx;
            if (og + 1u == (tg + 1u) * nx) xb_add(&bar[XB_TOPGEN], 1u);
            else XB_SPIN(xb_ld(&bar[XB_TOPGEN]) == tg, bar);
            __builtin_amdgcn_fence(__ATOMIC_ACQUIRE, "agent");
            xb_add(&bar[XB_XGEN(b.x)], 1u);
            asm volatile("s_waitcnt vmcnt(0)" ::: "memory");
        } else {
            XB_SPIN(xb_ld(&bar[XB_XGEN(b.x)]) == gen, bar);
            __builtin_amdgcn_fence(__ATOMIC_ACQUIRE, "agent");
            asm volatile("s_waitcnt vmcnt(0)" ::: "memory");
        }
    }
    __syncthreads();
}


constexpr int N_PHASES = 2 + 7 * DEPTH;
constexpr int SCAN_WGS = 8;
constexpr float QSCALE = 0.07216878364870322f * LOG2E;

__device__ __forceinline__ void sub_barrier(unsigned* ctr, unsigned expected, bool arrive) {
    asm volatile("s_waitcnt vmcnt(0)" ::: "memory"); __syncthreads();
    if (tidx() == 0) {
        if (arrive) { __builtin_amdgcn_fence(__ATOMIC_RELEASE, "agent"); asm volatile("s_waitcnt vmcnt(0)" ::: "memory"); (void)__hip_atomic_fetch_add(ctr, 1u, __ATOMIC_RELAXED, __HIP_MEMORY_SCOPE_AGENT); }
        unsigned sp = 0; while (__hip_atomic_load(ctr, __ATOMIC_RELAXED, __HIP_MEMORY_SCOPE_AGENT) < expected) { __builtin_amdgcn_s_sleep(2); if (++sp > (1u << 22)) break; }
        __builtin_amdgcn_fence(__ATOMIC_ACQUIRE, "agent"); asm volatile("s_waitcnt vmcnt(0)" ::: "memory");
    }
    __syncthreads();
}
template <int KIND> __device__ __forceinline__ void run_kind(const Params& p_, int l, LAS unsigned char* lds) {
    Params p = p_;
    { unsigned long long w_ = (unsigned long long)p.ws; asm volatile("" : "+s"(w_)); p.ws = (unsigned char*)(__attribute__((address_space(1))) unsigned char*)w_; }
    const int tid = tidx(), lane = tid & 63, wid = __builtin_amdgcn_readfirstlane(tid >> 6);
    const int bid = bidx(), nblk = gridDim.x, gw = bid * 8 + wid, ngw = nblk * 8, gtid = bid * NT_THREADS + tid, gn = nblk * NT_THREADS;
    bf16_t* PROJ = (bf16_t*)(p.ws + WS_PROJ);
    if constexpr (KIND == 0) {
        job_win(p, 0, gw, ngw, lds, wid, lane); job_wout(p, 0, gw, ngw, lds, wid, lane); job_wmem(p, gw, ngw, lds, wid, lane);
        job_wq(p, bid, nblk, gtid, gn, lds); job_wuv(p, gtid, gn); job_rope(p, gtid, gn); job_btab(p, gtid, gn); job_memn(p, gw, ngw, lane);
        job_norm_rows(p, 0, gw, ngw, lane);
    } else if constexpr (KIND == 2) {
        { pg8::Gemm g{(const bf16_t*)(p.ws + WS_H), (const bf16_t*)(p.ws + WS_WIN), S, NP, DM, DM};
          pg8::StaticOrder so; so.init(S, NP, nblk, bid);
          pg8::EpiStore E{PROJ, NP, (bf16_t*)(p.ws + WS_HALO)};
          pg8::gemm_phase<pg8::EpiStore, pg8::StaticOrder, true, true>(lds, g, so, E); }
        if (l == 0) {
            for (int ll = 0; ll < 2; ++ll) {
                pg8::Gemm g{(const bf16_t*)(p.ws + WS_MEMN) + (size_t)ll * MEML * DM, (const bf16_t*)(p.ws + WS_WMEM) + (size_t)ll * DM * DM, MEML, DM, DM, DM};
                pg8::StaticOrder so; so.init(MEML, DM, nblk, (bid + 8 - 4 * ll) % nblk);
                pg8::EpiStore E{(bf16_t*)(p.ws + WS_MEMKV) + (size_t)ll * MEML * DM, DM, nullptr};
                pg8::gemm_phase<pg8::EpiStore, pg8::StaticOrder, true, true>(lds, g, so, E);
            }
        }
    } else if constexpr (KIND == 3) {
        for (int it = bid; it < 1024; it += nblk) gdn::prep_item(p, l, it >> 2, it & 3, lds);
    } else if constexpr (KIND == 5) {
        unsigned* rdy = (unsigned*)(p.ws + WS_CTL) + 64 * (9 + l);
        const bool is_scan = (bid & ~8) < 4;
#ifdef EXP_SPINSCAN
        if (is_scan) { const unsigned long long t0_ = __builtin_amdgcn_s_memrealtime(); gdn::scan_wg(p, bid & 3, bid >> 3, lds); const unsigned long long t1_ = __builtin_amdgcn_s_memrealtime();
            while (__builtin_amdgcn_s_memrealtime() - t1_ < 4 * (t1_ - t0_)) __builtin_amdgcn_s_sleep(8); }
#else
        if (is_scan) gdn::scan_wg(p, bid & 3, bid >> 3, lds);
#endif
        else { const int vb = bid < 8 ? bid - 4 : bid - 8, nb = nblk - SCAN_WGS;
#ifdef EXP_SPINPRE
            const unsigned long long t0_ = __builtin_amdgcn_s_memrealtime();
#endif
            { pg8::Gemm g{PROJ + C_CQ, (const bf16_t*)(p.ws + WS_WQ) + (size_t)l * 768 * 256, S, 768, 256, NP};
              pg8::StaticOrder so; so.init(S, 768, nb, vb);
              pg8::EpiStore E{(bf16_t*)(p.ws + WS_QABS), 768, nullptr};
              pg8::gemm_phase<pg8::EpiStore, pg8::StaticOrder, true, true>(lds, g, so, E); }
            job_mla_rows(p, l, vb * 8 + wid, nb * 8, lane);
            att::run_mixers(lds, (unsigned*)(p.ws + WS_CTL) + 64 * (11 + l), PROJ, p.pos, p.sinks + l * 8, (const float*)(p.ws + WS_MISC + MISC_BTAB), (const bf16_t*)(p.ws + WS_MEMKV) + (size_t)l * MEML * DM);
            __syncthreads();

#ifdef EXP_SPINPRE
            { const unsigned long long t1_ = __builtin_amdgcn_s_memrealtime(); while (__builtin_amdgcn_s_memrealtime() - t1_ < 4 * (t1_ - t0_)) __builtin_amdgcn_s_sleep(8); }
#endif
        }
        sub_barrier(rdy, (unsigned)(nblk - SCAN_WGS), !is_scan);
#ifdef EXP_SPINMLA
        const unsigned long long tq0_ = __builtin_amdgcn_s_memrealtime();
#endif
        mla::run_queue(lds, (unsigned*)(p.ws + WS_CTL) + 64 * (1 + l), (const bf16_t*)(p.ws + WS_QABS), (const bf16_t*)(p.ws + WS_KVLAT), PROJ, (const bf16_t*)(p.ws + WS_WUV) + (size_t)l * 512 * 512, (const float*)(p.ws + WS_MISC + MISC_RSQ), (const float*)(p.ws + WS_COS), (const float*)(p.ws + WS_SIN), QSCALE);
        if (l == 0) { __syncthreads(); job_win(p, 1, gw, ngw, lds, wid, lane); }
#ifdef EXP_SPINMLA
        if (!is_scan) { const unsigned long long tq1_ = __builtin_amdgcn_s_memrealtime(); while (__builtin_amdgcn_s_memrealtime() - tq1_ < 4 * (tq1_ - tq0_)) __builtin_amdgcn_s_sleep(8); }
#endif
    } else if constexpr (KIND == 6) {
        job_gdn_final(p, l, gw, ngw, lane, wid, lds);
    } else if constexpr (KIND == 7) {
        pg8::Gemm g{PROJ + C_Z, (const bf16_t*)(p.ws + WS_WOUT), S, DM, MIXW, NP};
        pg8::StaticOrder so; so.init(S, DM, nblk, bid);
        pg8::EpiStore E{(bf16_t*)(p.ws + WS_Y), DM, nullptr};
        pg8::gemm_phase<pg8::EpiStore, pg8::StaticOrder, true, true>(lds, g, so, E);
    } else {
        job_norm_rows(p, l == 0 ? 1 : 2, gw, ngw, lane);
        if (l == 0) job_wout(p, 1, gw, ngw, lds, wid, lane);
    }
}
template <int KIND> __global__ void __launch_bounds__(NT_THREADS, 2) mk_kind(Params p, int l) {
    extern __shared__ __attribute__((aligned(16))) unsigned char lds_raw[];
    run_kind<KIND>(p, l, (LAS unsigned char*)lds_raw);
}

#ifndef MK_LAUNCHES_PER_PHASE
#define MK_LAUNCHES_PER_PHASE 0
#endif
#if !MK_LAUNCHES_PER_PHASE
#ifdef EXP_SPINKIND
#define SPIN_T0(K) unsigned long long t0_s = 0; if ((K) == EXP_SPINKIND) t0_s = __builtin_amdgcn_s_memrealtime();
#define SPIN_T1(K) if ((K) == EXP_SPINKIND) { const unsigned long long t1_s = __builtin_amdgcn_s_memrealtime(), d_s = t1_s - t0_s; while (__builtin_amdgcn_s_memrealtime() - t1_s < 4 * d_s) __builtin_amdgcn_s_sleep(8); }
#else
#define SPIN_T0(K)
#define SPIN_T1(K)
#endif
#ifdef EXP_DUPKINDS
#define DUP_PH(K, L) if ((EXP_DUPKINDS >> (K)) & 1) { GRID_BAR(); run_kind<K>(p, L, lds); }
#else
#define DUP_PH(K, L)
#endif
#define GRID_BAR() do { unsigned long long wi_ = (unsigned long long)p.ws; asm volatile("" : "+s"(wi_)); unsigned char* w_ = (unsigned char*)(__attribute__((address_space(1))) unsigned char*)wi_; XcdBarrier b_; b_.bar = (unsigned*)(w_ + WS_CTL) + 4096; b_.x = xb_xcc_id(); b_.st = (volatile LAS unsigned*)(lds + LDS_BYTES - 16); xcd_barrier(b_); } while (0)
#define PHASE(K, L, LAST) do { SPIN_T0(K) run_kind<K>(p, L, lds); DUP_PH(K, L) if (!(LAST)) GRID_BAR(); SPIN_T1(K) } while (0)
__global__ void __launch_bounds__(NT_THREADS, 2) mk_fwd(Params p) {
    extern __shared__ __attribute__((aligned(16))) unsigned char lds_raw[];
    LAS unsigned char* lds = (LAS unsigned char*)lds_raw;
    cg::grid_group grid = cg::this_grid();
    volatile LAS unsigned* bst = (volatile LAS unsigned*)(lds + LDS_BYTES - 16);
    if (tidx() < 4) bst[tidx()] = 0u;
    __syncthreads();
    (void)xcd_barrier_post((unsigned*)(p.ws + WS_CTL) + 4096, bst);
    if (p.ph_hi == 0x7fffffff) grid.sync();
    PHASE(0, 0, false);
#pragma unroll 1
    for (int l = 0; l < DEPTH; ++l) {
        PHASE(2, l, false); PHASE(3, l, false); PHASE(5, l, false);
        PHASE(6, l, false); PHASE(7, l, false); PHASE(8, l, l + 1 == DEPTH);
    }
}
#endif

#ifndef MK_LAUNCHES_PER_PHASE
#define MK_LAUNCHES_PER_PHASE 0
#endif
extern "C" void kernel_launch(void* const* d_in, const int* in_sizes, int n_in, void* d_out, int out_size, void* d_ws, size_t ws_size, hipStream_t stream) {
    static int grid = 0;
    if (grid == 0) {
        if (n_in != 19 || in_sizes[0] != S * DM || out_size != S * DM || ws_size < WS_END) { fprintf(stderr, "kernel_launch: unexpected shapes (n_in %d, in0 %d, out %d, ws %zu)\n", n_in, n_in > 0 ? in_sizes[0] : -1, out_size, ws_size); grid = -1; return; }
        int dev = 0, cus = 0, per_cu = 0;
        (void)hipGetDevice(&dev); (void)hipDeviceGetAttribute(&cus, hipDeviceAttributeMultiprocessorCount, dev);
#if !MK_LAUNCHES_PER_PHASE
        if (hipFuncSetAttribute((const void*)mk_fwd, hipFuncAttributeMaxDynamicSharedMemorySize, LDS_BYTES) != hipSuccess) { fprintf(stderr, "kernel_launch: hipFuncSetAttribute failed\n"); grid = -1; return; }
        if (hipOccupancyMaxActiveBlocksPerMultiprocessor(&per_cu, (const void*)mk_fwd, NT_THREADS, LDS_BYTES) != hipSuccess || per_cu < 1) { fprintf(stderr, "kernel_launch: occupancy query gave %d\n", per_cu); per_cu = 1; }
#else
#define SA(K) (void)hipFuncSetAttribute((const void*)mk_kind<K>, hipFuncAttributeMaxDynamicSharedMemorySize, LDS_BYTES)
        SA(0); SA(2); SA(3); SA(5); SA(6); SA(7); SA(8);
#undef SA
#endif
        (void)hipGetLastError();
        if (cus <= 0) cus = 256;
        grid = cus;
        fprintf(stderr, "kernel_launch: cus %d per_cu %d grid %d\n", cus, per_cu, grid);
    }
    if (grid < 0) return;
    Params p{};
    p.x = (const float*)d_in[0]; p.mem = (const float*)d_in[1]; p.pos = (const int*)d_in[2]; p.rel_bias = (const float*)d_in[3];
    p.norm_pre = (const float*)d_in[4]; p.norm_post = (const float*)d_in[5]; p.w_in = (const float*)d_in[6]; p.sinks = (const float*)d_in[7];
    p.conv_w = (const float*)d_in[8]; p.a_log = (const float*)d_in[9]; p.dt_bias = (const float*)d_in[10]; p.gdn_norm = (const float*)d_in[11];
    p.q_norm = (const float*)d_in[12]; p.kv_norm = (const float*)d_in[13]; p.w_uq = (const float*)d_in[14]; p.w_ukv = (const float*)d_in[15];
    p.mem_norm = (const float*)d_in[16]; p.w_mem = (const float*)d_in[17]; p.w_out = (const float*)d_in[18];
    p.out = (float*)d_out; p.ws = (unsigned char*)d_ws;
    if (hipMemsetAsync((char*)d_ws + WS_CTL, 0, 65536, stream) != hipSuccess) { fprintf(stderr, "kernel_launch: hipMemsetAsync failed\n"); return; }
#if MK_LAUNCHES_PER_PHASE
    p.ph_lo = 0; p.ph_hi = 0;
#define LK(K, L) hipLaunchKernelGGL(mk_kind<K>, dim3(grid), dim3(NT_THREADS), LDS_BYTES, stream, p, L)
    LK(0, 0);
    for (int l = 0; l < DEPTH; ++l) { LK(2, l); LK(3, l); LK(5, l); LK(6, l); LK(7, l); LK(8, l); }
#undef LK
#else
    p.ph_lo = 0; p.ph_hi = N_PHASES;
    void* args[] = {&p};
    hipError_t e = hipLaunchCooperativeKernel((const void*)mk_fwd, dim3(grid), dim3(NT_THREADS), args, LDS_BYTES, stream);
    if (e != hipSuccess) fprintf(stderr, "kernel_launch: cooperative launch failed: %s (grid %d)\n", hipGetErrorString(e), grid);
#endif
}
```

```cpp
#include <hip/hip_runtime.h>
#include <hip/hip_cooperative_groups.h>
#include <cstdint>
#include <cstdio>
namespace cg = cooperative_groups;

#define LAS __attribute__((address_space(3)))
typedef unsigned short bf16_t;
typedef short bf16x8 __attribute__((ext_vector_type(8)));
typedef short s16x4 __attribute__((ext_vector_type(4)));
typedef float f32x2 __attribute__((ext_vector_type(2)));
typedef float f32x4 __attribute__((ext_vector_type(4)));
typedef float f32x16 __attribute__((ext_vector_type(16)));
typedef unsigned u32x2 __attribute__((ext_vector_type(2)));
typedef unsigned u32x4 __attribute__((ext_vector_type(4)));
typedef __bf16 bf16x2_t __attribute__((ext_vector_type(2)));

constexpr int S = 16384, DM = 1024, MEML = 256, NP = 5376, DEPTH = 2, DIN = 5320, MIXW = 2048;
constexpr int C_Z = 0, C_AQ = 2048, C_AK = 2560, C_AV = 2688, C_DQ = 2816, C_BQKV = 3328, C_CQ = 4864, C_CKV = 5120, C_KR = 5248, C_BA = 5312, C_BB = 5316;
constexpr int C_OLAT = 2048;
constexpr float RMS_EPS = 1e-6f;
constexpr float LOG2E = 1.4426950408889634f;
constexpr int NT_THREADS = 512;

constexpr size_t MiB = 1u << 20;
constexpr size_t WS_CTL = 0, WS_COS = 1 * MiB, WS_SIN = 3 * MiB, WS_MEMKV = 5 * MiB, WS_MISC = 6 * MiB, WS_MEMN = 7 * MiB;
constexpr size_t WS_WIN = 8 * MiB, WS_WOUT = 19 * MiB, WS_WMEM = 23 * MiB, WS_WQ = 27 * MiB, WS_WUV = 28 * MiB, WS_HALO = 29 * MiB;
constexpr size_t WS_AQK = 32 * MiB, WS_U = 40 * MiB, WS_H = 56 * MiB, WS_PROJ = 88 * MiB, WS_END = 256 * MiB;
constexpr size_t WS_QABS = WS_H, WS_KVLAT = WS_H + 24 * MiB, WS_Y = WS_H;
constexpr size_t MISC_BTAB = 0, MISC_RSQ = 8192, MISC_EGL = 8192 + 65536;

constexpr int LDS_BYTES = 163840;

struct Params {
    const float* x; const float* mem; const int* pos; const float* rel_bias;
    const float* norm_pre; const float* norm_post; const float* w_in; const float* sinks;
    const float* conv_w; const float* a_log; const float* dt_bias; const float* gdn_norm;
    const float* q_norm; const float* kv_norm; const float* w_uq; const float* w_ukv;
    const float* mem_norm; const float* w_mem; const float* w_out;
    float* out; unsigned char* ws;
    int ph_lo, ph_hi;
};

__device__ __forceinline__ int tidx() { int t = threadIdx.x; asm volatile("" : "+v"(t)); return t; }
__device__ __forceinline__ int bidx() { int b = blockIdx.x; asm volatile("" : "+s"(b)); return b; }
__device__ __forceinline__ float bf2f(bf16_t v) { return __uint_as_float((unsigned)v << 16); }
__device__ __forceinline__ unsigned cvtpk(float lo, float hi) { f32x2 v = {lo, hi}; bf16x2_t b = __builtin_convertvector(v, bf16x2_t); return __builtin_bit_cast(unsigned, b); }
__device__ __forceinline__ bf16_t f2bf(float f) { return (bf16_t)(cvtpk(f, 0.f) & 0xffffu); }
__device__ __forceinline__ float lo_bf(unsigned w) { return __uint_as_float(w << 16); }
__device__ __forceinline__ float hi_bf(unsigned w) { return __uint_as_float(w & 0xffff0000u); }
__device__ __forceinline__ float silu_f(float v) { return v / (1.f + __expf(-v)); }
#define DPP_ROR(x, n) __builtin_amdgcn_update_dpp(0, (x), 0x120 + (n), 0xf, 0xf, false)
__device__ __forceinline__ float ror16_f(float v, int n) { const int x = __float_as_int(v); int r; switch (n) { case 1: r = DPP_ROR(x, 1); break; case 2: r = DPP_ROR(x, 2); break; case 4: r = DPP_ROR(x, 4); break; default: r = DPP_ROR(x, 8); break; } return __int_as_float(r); }
__device__ __forceinline__ unsigned xor8_u(unsigned v) { return (unsigned)DPP_ROR((int)v, 8); }
__device__ __forceinline__ float row16_sum(float v) { v += ror16_f(v, 1); v += ror16_f(v, 2); v += ror16_f(v, 4); v += ror16_f(v, 8); return v; }
__device__ __forceinline__ float wave_sum(float v) {
    v = row16_sum(v);
    v += __int_as_float(__builtin_amdgcn_ds_swizzle(__float_as_int(v), 0x401F));
    return __int_as_float(__builtin_amdgcn_readlane(__float_as_int(v), 0)) + __int_as_float(__builtin_amdgcn_readlane(__float_as_int(v), 32));
}
__device__ __forceinline__ int crow(int r, int hi) { return (r & 3) + 8 * (r >> 2) + 4 * hi; }
#define MFMA32(a, b, c) __builtin_amdgcn_mfma_f32_32x32x16_bf16((a), (b), (c), 0, 0, 0)
#define SBAR() __builtin_amdgcn_sched_barrier(0)
#define LDS_WAIT() asm volatile("s_waitcnt lgkmcnt(0)" ::: "memory")
__device__ __forceinline__ bf16x8 pack8(const float* v) { u32x4 w = {cvtpk(v[0], v[1]), cvtpk(v[2], v[3]), cvtpk(v[4], v[5]), cvtpk(v[6], v[7])}; return __builtin_bit_cast(bf16x8, w); }
__device__ __forceinline__ bf16x8 pack_step(const f32x16& x, int s) {
    u32x4 w = {cvtpk(x[8 * s + 0], x[8 * s + 1]), cvtpk(x[8 * s + 2], x[8 * s + 3]), cvtpk(x[8 * s + 4], x[8 * s + 5]), cvtpk(x[8 * s + 6], x[8 * s + 7])};
    return __builtin_bit_cast(bf16x8, w);
}

__device__ __forceinline__ int win_src(int n) {
    if (n < 512) return 768 + n;
    if (n < 1024) return 2824 + (n - 512);
    if (n < 1536) return 3784 + (n - 1024);
    if (n < 2048) return 4808 + (n - 1536);
    if (n < 2560) return n - 2048;
    if (n < 2688) return 512 + (n - 2560);
    if (n < 2816) return 640 + (n - 2688);
    if (n < 3328) return 4296 + (n - 2816);
    if (n < 4864) return 1280 + (n - 3328);
    if (n < 5120) return 3336 + (n - 4864);
    if (n < 5248) return 3592 + (n - 5120);
    if (n < 5312) return 3720 + (n - 5248);
    if (n < 5316) return 2816 + (n - 5312);
    if (n < 5320) return 2820 + (n - 5316);
    return -1;
}

__device__ __forceinline__ int t5_bucket(int n) {
    if (n < 16) return n < 0 ? 0 : n;
    if (n >= 128) return 31;
    const float v = __logf((float)n * 0.0625f) * (16.0f / 2.0794415416798357f);
    int b = 16 + (int)v; return b > 31 ? 31 : b;
}
__device__ __forceinline__ float inv_freq(int i) {
    const float t[32] = {1.000000000e+00f, 7.498942018e-01f, 5.623413324e-01f, 4.216965139e-01f, 3.162277639e-01f, 2.371373922e-01f, 1.778279394e-01f, 1.333521456e-01f,
                         1.000000015e-01f, 7.498941571e-02f, 5.623412877e-02f, 4.216964915e-02f, 3.162277862e-02f, 2.371373586e-02f, 1.778279431e-02f, 1.333521493e-02f,
                         9.999999776e-03f, 7.498942316e-03f, 5.623413250e-03f, 4.216964822e-03f, 3.162277862e-03f, 2.371373819e-03f, 1.778279431e-03f, 1.333521446e-03f,
                         1.000000047e-03f, 7.498941850e-04f, 5.623413017e-04f, 4.216965463e-04f, 3.162277862e-04f, 2.371373848e-04f, 1.778279402e-04f, 1.333521504e-04f};
    return t[i];
}
namespace pg8 {
#define PG8_LAS __attribute__((address_space(3)))
constexpr int BM = 256, BK = 64, HALF = 128, HTB = HALF * BK * 2  , STAGE_BYTES = 8 * HTB, NXCD = 8, WGM = 8;
__host__ __device__ __forceinline__ int lds_byte(int r, int c) { const int st = (r >> 4) * 2 + (c >> 5), rr = r & 15, cc = c & 31, ob = rr * 64 + cc * 2; return st * 1024 + (ob ^ (((ob >> 9) & 1) << 5)); }
__host__ __device__ __forceinline__ void stage_rc(int b, int& R, int& C) { const int st = b / 1024, sb = b % 1024, swz = sb ^ (((sb >> 9) & 1) << 5); R = (st >> 1) * 16 + swz / 64; C = (st & 1) * 32 + (swz % 64) / 2; }
__host__ __device__ __forceinline__ int perm32(int rho) { const int n = rho >> 4, i = rho & 15; return 8 * (i >> 2) + 4 * n + (i & 3); }
struct Unit { int pm, pn; };
struct Gemm { const bf16_t* A; const bf16_t* Bt; int M, N, K, lda; };
struct StaticOrder {
    int nM, nN, nwg, G, c;
    __device__ void init(int M, int N, int G_, int c_) { nM = M / BM; nN = N / BM; nwg = nM * nN; G = G_; c = c_; }
    __device__ bool next(int i, Unit& u) const {
        const long L = (long)i * G + c; if (L >= nwg) return false;
        int wgid = (int)L; { const int q = nwg / NXCD, r = nwg % NXCD, xcd = wgid % NXCD, off = wgid / NXCD; wgid = (xcd < r ? xcd * (q + 1) : r * (q + 1) + (xcd - r) * q) + off; }
        const int nig = WGM * nN, gid = wgid / nig, fm = gid * WGM, gsz = (nM - fm) < WGM ? (nM - fm) : WGM;
        u.pm = fm + ((wgid % nig) % gsz); u.pn = (wgid % nig) / gsz; return true;
    }
    __device__ __forceinline__ void a_ready(const Unit&) const {}
    __device__ __forceinline__ void done(const Unit&) const {}
};
struct EpiStore {
    static constexpr bool PERM = true, AFTER_DRAIN = false;
    bf16_t* O; int ldc; bf16_t* halo;
    __device__ __forceinline__ void operator()(const f32x4 (&acc)[2][2][4][2], const Unit& u, int wr, int wc, int fr, int fq) const {
        const int row0 = u.pm * BM + wr * 64 + fr, col0 = u.pn * BM + wc * 32 + 8 * fq;
        const bool hz = halo != nullptr && col0 >= C_BQKV && col0 < C_BQKV + 1536;
#pragma unroll
        for (int ai = 0; ai < 2; ++ai)
#pragma unroll
            for (int m = 0; m < 4; ++m) { const int row = row0 + ai * HALF + m * 16; bf16_t* rowp = O + (size_t)row * ldc + col0;
#pragma unroll
                for (int bj = 0; bj < 2; ++bj) { const f32x4 v0 = acc[ai][bj][m][0], v1 = acc[ai][bj][m][1];
                    u32x4 w; w.x = cvtpk(v0[0], v0[1]); w.y = cvtpk(v0[2], v0[3]); w.z = cvtpk(v1[0], v1[1]); w.w = cvtpk(v1[2], v1[3]);
                    *(u32x4*)(rowp + bj * HALF) = w;
                    if (m == 3 && hz && fr >= 13) *(u32x4*)(halo + ((size_t)(row >> 6) * 3 + (fr - 13)) * 1536 + (col0 + bj * HALF - C_BQKV)) = w; } }
    }
};
struct EpiGate {
    static constexpr bool PERM = true, AFTER_DRAIN = false;
    bf16_t* G; int ldc;
    __device__ __forceinline__ void operator()(const f32x4 (&acc)[2][2][4][2], const Unit& u, int wr, int wc, int fr, int fq) const {
        const int row0 = u.pm * BM + wr * 64 + fr, col0 = u.pn * BM + wc * 32 + 8 * fq;
#pragma unroll
        for (int ai = 0; ai < 2; ++ai)
#pragma unroll
            for (int m = 0; m < 4; ++m) { bf16_t* rowp = G + (size_t)(row0 + ai * HALF + m * 16) * ldc + col0;
#pragma unroll
                for (int bj = 0; bj < 2; ++bj) { const f32x4 v0 = acc[ai][bj][m][0], v1 = acc[ai][bj][m][1];
                    const u32x4 z = *(const u32x4*)(rowp + bj * HALF);
                    u32x4 w; w.x = cvtpk(v0[0] * silu_f(lo_bf(z.x)), v0[1] * silu_f(hi_bf(z.x))); w.y = cvtpk(v0[2] * silu_f(lo_bf(z.y)), v0[3] * silu_f(hi_bf(z.y)));
                    w.z = cvtpk(v1[0] * silu_f(lo_bf(z.z)), v1[1] * silu_f(hi_bf(z.z))); w.w = cvtpk(v1[2] * silu_f(lo_bf(z.w)), v1[3] * silu_f(hi_bf(z.w)));
                    *(u32x4*)(rowp + bj * HALF) = w; } }
    }
};
template <class Epi, class Sched, bool ALIGN_EPI = false, bool SP2 = false>
__device__ __forceinline__ void gemm_phase(PG8_LAS unsigned char* lds, const Gemm g, const Sched& S, const Epi& E) {
    const int tid = tidx(), wid = __builtin_amdgcn_readfirstlane(tid >> 6), lane = tid & 63, wr = wid >> 2, wc = wid & 3, fr = lane & 15, fq = lane >> 4;
    const int K = g.K, nt = K / BK;
    unsigned voffA[2], voffB[2];
#pragma unroll
    for (int i = 0; i < 2; ++i) { int R, C; stage_rc(tid * 16 + i * 8192, R, C); const int Rb = Epi::PERM ? ((R & ~31) + perm32(R & 31)) : R;
        voffA[i] = (unsigned)(R * g.lda + C) * 2u; voffB[i] = (unsigned)(Rb * K + C) * 2u; }
    const size_t kstep = (size_t)(BK * 2);
    const size_t hstepA = (size_t)HALF * g.lda * 2, hstepB = (size_t)HALF * K * 2;
    const size_t tstepA = 2 * hstepA, tstepB = 2 * hstepB;
    const unsigned ldsw = (unsigned)wid * 1024u;
    const int aoff = lds_byte(wr * 64 + fr, fq * 8), boff = lds_byte(wc * 32 + fr, fq * 8);
#define PG8_SA(b, h) (((b) * 2 + (h)) * HTB)
#define PG8_SB(b, h) ((4 + (b) * 2 + (h)) * HTB)
#define PG8_STAGE(bufoff, gbase, voff) do { _Pragma("unroll") for (int _i = 0; _i < 2; ++_i) \
        __builtin_amdgcn_global_load_lds((const unsigned*)((const char*)(gbase) + (voff)[_i]), (PG8_LAS unsigned*)(lds + (bufoff) + ldsw + _i * 8192), 16, 0, 0); } while (0)
#define PG8_LDA(dst, b, h) do { _Pragma("unroll") for (int m = 0; m < 4; ++m) _Pragma("unroll") for (int k = 0; k < 2; ++k) dst[m][k] = *(const PG8_LAS bf16x8*)(lds + PG8_SA(b, h) + aoff + m * 2048 + k * 1024); } while (0)
#define PG8_LDB(dst, b, h) do { _Pragma("unroll") for (int n = 0; n < 2; ++n) _Pragma("unroll") for (int k = 0; k < 2; ++k) dst[n][k] = *(const PG8_LAS bf16x8*)(lds + PG8_SB(b, h) + boff + n * 2048 + k * 1024); } while (0)
#define PG8_MMA(ai, bj, At, Bt) do { __builtin_amdgcn_s_setprio(1); _Pragma("unroll") for (int m = 0; m < 4; ++m) _Pragma("unroll") for (int n = 0; n < 2; ++n) _Pragma("unroll") for (int k = 0; k < 2; ++k) \
        acc[ai][bj][m][n] = __builtin_amdgcn_mfma_f32_16x16x32_bf16(Bt[n][k], At[m][k], acc[ai][bj][m][n], 0, 0, 0); __builtin_amdgcn_s_setprio(0); } while (0)
#define PG8_WAIT_V(n) asm volatile("s_waitcnt vmcnt(" #n ")" ::: "memory")
#define PG8_WAIT_L(n) asm volatile("s_waitcnt lgkmcnt(" #n ")" ::: "memory")
#define PG8_BAR __builtin_amdgcn_s_barrier()
#define PG8_SCHED __builtin_amdgcn_sched_barrier(0)
    Unit cur, nxt; int ui = 0;
    if (!S.next(0, cur)) return;
    f32x4 acc[2][2][4][2];
#pragma unroll
    for (int a = 0; a < 2; ++a)
#pragma unroll
        for (int b = 0; b < 2; ++b)
#pragma unroll
            for (int m = 0; m < 4; ++m)
#pragma unroll
                for (int n = 0; n < 2; ++n) acc[a][b][m][n] = (f32x4){0.f, 0.f, 0.f, 0.f};
    bf16x8 At[4][2], B0[2][2], B1[2][2];
    const char* cA = (const char*)g.A + (size_t)cur.pm * tstepA; const char* cB = (const char*)g.Bt + (size_t)cur.pn * tstepB;
    S.a_ready(cur);
    if constexpr (SP2) {
        PG8_STAGE(PG8_SB(0, 0), cB, voffB); PG8_STAGE(PG8_SB(0, 1), cB + hstepB, voffB); PG8_STAGE(PG8_SA(0, 0), cA, voffA); PG8_STAGE(PG8_SA(0, 1), cA + hstepA, voffA);
        if (wr == 1) PG8_BAR;
        PG8_WAIT_V(2); PG8_BAR;
        PG8_STAGE(PG8_SB(1, 0), cB + kstep, voffB); PG8_STAGE(PG8_SA(1, 0), cA + kstep, voffA); PG8_STAGE(PG8_SB(1, 1), cB + hstepB + kstep, voffB);
        PG8_WAIT_V(6); PG8_BAR;
    } else {
        PG8_STAGE(PG8_SB(0, 0), cB, voffB); PG8_STAGE(PG8_SA(0, 0), cA, voffA); PG8_STAGE(PG8_SB(0, 1), cB + hstepB, voffB); PG8_STAGE(PG8_SA(0, 1), cA + hstepA, voffA);
        if (wr == 1) PG8_BAR;
        PG8_WAIT_V(4); PG8_BAR;
        PG8_STAGE(PG8_SB(1, 0), cB + kstep, voffB); PG8_STAGE(PG8_SA(1, 0), cA + kstep, voffA); PG8_STAGE(PG8_SB(1, 1), cB + hstepB + kstep, voffB);
        PG8_WAIT_V(6); PG8_BAR;
    }
    for (;;) {
        const bool has_next = S.next(ui + 1, nxt);
        const char* nA = has_next ? (const char*)g.A + (size_t)nxt.pm * tstepA : cA; const char* nB = has_next ? (const char*)g.Bt + (size_t)nxt.pn * tstepB : cB;
        for (int t = 0; t < nt; t += 2) {
            const bool last = (t == nt - 2);
            const char* a1 = cA + (size_t)(t + 1) * kstep;
            const char* a2 = last ? nA : cA + (size_t)(t + 2) * kstep; const char* b2 = last ? nB : cB + (size_t)(t + 2) * kstep;
            const char* a3 = a2 + kstep; const char* b3 = b2 + kstep;
            if (last && has_next) S.a_ready(nxt);
            if constexpr (SP2) {
            PG8_LDB(B0, 0, 0); PG8_LDB(B1, 0, 1); PG8_SCHED; PG8_LDA(At, 0, 0); PG8_STAGE(PG8_SA(1, 1), a1 + hstepA, voffA);
            PG8_WAIT_V(8); PG8_WAIT_L(0); PG8_BAR; PG8_MMA(0, 0, At, B0); PG8_MMA(0, 1, At, B1); PG8_BAR; PG8_SCHED;
            PG8_LDA(At, 0, 1); PG8_STAGE(PG8_SB(0, 0), b2, voffB); PG8_STAGE(PG8_SB(0, 1), b2 + hstepB, voffB); PG8_STAGE(PG8_SA(0, 0), a2, voffA);
            PG8_WAIT_V(8); PG8_WAIT_L(0); PG8_BAR; PG8_MMA(1, 0, At, B0); PG8_MMA(1, 1, At, B1); PG8_BAR; PG8_SCHED;
            PG8_LDB(B0, 1, 0); PG8_LDB(B1, 1, 1); PG8_SCHED; PG8_LDA(At, 1, 0); PG8_STAGE(PG8_SA(0, 1), a2 + hstepA, voffA);
            PG8_WAIT_V(8); PG8_WAIT_L(0); PG8_BAR; PG8_MMA(0, 0, At, B0); PG8_MMA(0, 1, At, B1); PG8_BAR; PG8_SCHED;
            PG8_LDA(At, 1, 1); PG8_STAGE(PG8_SB(1, 0), b3, voffB); PG8_STAGE(PG8_SB(1, 1), b3 + hstepB, voffB); PG8_STAGE(PG8_SA(1, 0), a3, voffA);
            PG8_WAIT_V(8); PG8_WAIT_L(0); PG8_BAR; PG8_MMA(1, 0, At, B0); PG8_MMA(1, 1, At, B1); PG8_BAR; PG8_SCHED;
            } else {
            PG8_LDB(B0, 0, 0); PG8_SCHED; PG8_LDA(At, 0, 0); PG8_STAGE(PG8_SA(1, 1), a1 + hstepA, voffA);
            PG8_WAIT_L(8); PG8_BAR; PG8_WAIT_L(0); PG8_MMA(0, 0, At, B0); PG8_BAR; PG8_SCHED;
            PG8_LDB(B1, 0, 1); PG8_STAGE(PG8_SB(0, 0), b2, voffB);
            PG8_BAR; PG8_WAIT_L(0); PG8_MMA(0, 1, At, B1); PG8_BAR;
            PG8_LDA(At, 0, 1); PG8_STAGE(PG8_SA(0, 0), a2, voffA);
            PG8_BAR; PG8_WAIT_L(0); PG8_MMA(1, 0, At, B0); PG8_BAR; PG8_SCHED;
            PG8_STAGE(PG8_SB(0, 1), b2 + hstepB, voffB);
            PG8_WAIT_V(6); PG8_BAR; PG8_MMA(1, 1, At, B1); PG8_BAR;
            PG8_LDB(B0, 1, 0); PG8_SCHED; PG8_LDA(At, 1, 0); PG8_STAGE(PG8_SA(0, 1), a2 + hstepA, voffA);
            PG8_WAIT_L(8); PG8_BAR; PG8_WAIT_L(0); PG8_MMA(0, 0, At, B0); PG8_BAR; PG8_SCHED;
            PG8_LDB(B1, 1, 1); PG8_STAGE(PG8_SB(1, 0), b3, voffB);
            PG8_BAR; PG8_WAIT_L(0); PG8_MMA(0, 1, At, B1); PG8_BAR;
            PG8_LDA(At, 1, 1); PG8_STAGE(PG8_SA(1, 0), a3, voffA);
            PG8_BAR; PG8_WAIT_L(0); PG8_MMA(1, 0, At, B0); PG8_BAR; PG8_SCHED;
            PG8_STAGE(PG8_SB(1, 1), b3 + hstepB, voffB);
            PG8_WAIT_V(6); PG8_BAR; PG8_MMA(1, 1, At, B1); PG8_BAR;
            }
        }
        if constexpr (ALIGN_EPI) { if (wr == 0) PG8_BAR; }
        if constexpr (!Epi::AFTER_DRAIN) { E(acc, cur, wr, wc, fr, fq); S.done(cur); }
        if (!has_next) break;
#pragma unroll
        for (int a = 0; a < 2; ++a)
#pragma unroll
            for (int b = 0; b < 2; ++b)
#pragma unroll
                for (int m = 0; m < 4; ++m)
#pragma unroll
                    for (int n = 0; n < 2; ++n) acc[a][b][m][n] = (f32x4){0.f, 0.f, 0.f, 0.f};
        cur = nxt; cA = nA; cB = nB; ++ui;
        if constexpr (ALIGN_EPI) { if (wr == 1) PG8_BAR; }
    }
    PG8_WAIT_V(0);
    if constexpr (!ALIGN_EPI) { if (wr == 0) PG8_BAR; }
    PG8_BAR;
    if constexpr (Epi::AFTER_DRAIN) { E.fused(acc, cur, wr, wc, fr, fq, lds, wid, lane); S.done(cur); }
#undef PG8_SA
#undef PG8_SB
#undef PG8_STAGE
#undef PG8_LDA
#undef PG8_LDB
#undef PG8_MMA
#undef PG8_WAIT_V
#undef PG8_WAIT_L
#undef PG8_BAR
#undef PG8_SCHED
}
}
namespace att {
constexpr int KVBLK = 64;
constexpr int STG = 32768, L_WS = 65536, L_POSK = 67584, L_BTAB = 68096, L_UNIT = 72256, L_OST = 73728, OST_WAVE = 8704;
template <int DV> __device__ __forceinline__ int v_st(int k, int c) { const int kk = (k & ~0xC) | ((k & 4) << 1) | ((k & 8) >> 1); return ((kk >> 3) * (DV / 32) + (c >> 5)) * 512 + ((kk & 7) * 32 + (c & 31)) * 2; }
__device__ __forceinline__ int v_rd_base(int lane) { return ((lane & 3) << 3) | (((lane >> 2) & 3) << 6) | (((lane >> 4) & 1) << 5) | (((lane >> 5) & 1) << 8); }
__device__ __forceinline__ int koff(int row, int colB, int RB) { return row * RB + (colB ^ ((row & 7) << 4)); }

template <int DQK, int DV, int MODE>
__device__ __forceinline__ void attn_core(LAS unsigned char* lds, const bf16_t* qrow, const bf16_t* Kg, int ldk, const bf16_t* Vg, int ldv, int t_lo, int t_hi, float c2,
                                          int qidx, int head, const int* pos, float& m_reg, float& l_reg, f32x16 (&o)[DV / 32]) {
    constexpr int ND = DQK / 16, NV = DV / 32, RB = DQK * 2, NKC = (64 * (DQK / 8)) / NT_THREADS, NVC = (64 * (DV / 8)) / NT_THREADS, KB = 64 * RB;
    const int tid = tidx(), lane = tid & 63, r32 = lane & 31, hi = lane >> 5, wid = __builtin_amdgcn_readfirstlane(tid >> 6);
    bf16x8 qr[ND];
#pragma unroll
    for (int d0 = 0; d0 < ND; ++d0) qr[d0] = *(const bf16x8*)(qrow + d0 * 16 + hi * 8);
    LAS float* al_l = (LAS float*)(lds + L_WS) + wid * 64;
    LAS int* posk = (LAS int*)(lds + L_POSK); LAS float* btab = (LAS float*)(lds + L_BTAB);
    const unsigned vb0 = (unsigned)(uintptr_t)lds + (unsigned)KB + (unsigned)v_rd_base(lane);
    int posq = 0; if (MODE == 1) posq = pos[qidx];
    unsigned kdst[NKC], ksrc[NKC], vdst[NVC], vsrc[NVC];
#pragma unroll
    for (int i = 0; i < NKC; ++i) { const int c = tid + NT_THREADS * i, row = c / (DQK / 8), ch = c % (DQK / 8); kdst[i] = koff(row, ch * 16, RB); ksrc[i] = row * ldk + ch * 8; }
#pragma unroll
    for (int i = 0; i < NVC; ++i) { const int c = tid + NT_THREADS * i, row = c / (DV / 8), ch = c % (DV / 8); vdst[i] = KB + v_st<DV>(row, ch * 8); vsrc[i] = row * ldv + ch * 8; }
    u32x4 ks[NKC], vs[NVC]; int pkn = 0;
#define LOAD_TILE(t_) do { const size_t kb_ = (size_t)(t_) * KVBLK; _Pragma("unroll") for (int i = 0; i < NKC; ++i) ks[i] = *(const u32x4*)(Kg + kb_ * ldk + ksrc[i]); \
        _Pragma("unroll") for (int i = 0; i < NVC; ++i) vs[i] = *(const u32x4*)(Vg + kb_ * ldv + vsrc[i]); if (MODE == 1 && tid < 64) pkn = pos[(t_) * KVBLK + tid]; } while (0)
#define WRITE_TILE(st_) do { _Pragma("unroll") for (int i = 0; i < NKC; ++i) *(LAS u32x4*)(lds + (st_) * STG + kdst[i]) = ks[i]; \
        _Pragma("unroll") for (int i = 0; i < NVC; ++i) *(LAS u32x4*)(lds + (st_) * STG + vdst[i]) = vs[i]; if (MODE == 1 && tid < 64) posk[(st_) * 64 + tid] = pkn; } while (0)
    LOAD_TILE(t_lo); WRITE_TILE(0);
    __syncthreads();
#pragma unroll 1
    for (int t = t_lo; t < t_hi; ++t) {
        const int st = (t - t_lo) & 1, kbase = t * KVBLK;
        if (t + 1 < t_hi) LOAD_TILE(t + 1);
        const LAS unsigned char* K_lds = lds + st * STG;
        f32x16 p0 = {}, p1 = {};
#pragma unroll
        for (int d0 = 0; d0 < ND; ++d0) {
            const bf16x8 a0 = *(const LAS bf16x8*)(K_lds + koff(r32, (d0 * 16 + hi * 8) * 2, RB));
            const bf16x8 a1 = *(const LAS bf16x8*)(K_lds + koff(32 + r32, (d0 * 16 + hi * 8) * 2, RB));
            p0 = MFMA32(a0, qr[d0], p0); p1 = MFMA32(a1, qr[d0], p1);
        }
        if (MODE == 1) {
#pragma unroll
            for (int r = 0; r < 16; ++r) { const int kl = crow(r, hi);
                { const int kk = kbase + kl; int dist = posq - posk[st * 64 + kl]; dist = dist < 0 ? 0 : (dist > 128 ? 128 : dist);
                  const float b = btab[dist * 8 + head]; p0[r] = ((unsigned)(qidx - kk) < 128u) ? fmaf(p0[r], c2, b) : -__builtin_inff(); }
                { const int kk = kbase + kl + 32; int dist = posq - posk[st * 64 + kl + 32]; dist = dist < 0 ? 0 : (dist > 128 ? 128 : dist);
                  const float b = btab[dist * 8 + head]; p1[r] = ((unsigned)(qidx - kk) < 128u) ? fmaf(p1[r], c2, b) : -__builtin_inff(); } }
        } else {
#pragma unroll
            for (int r = 0; r < 16; ++r) { p0[r] *= c2; p1[r] *= c2; }
        }
        float pmax = p0[0];
#pragma unroll
        for (int r = 1; r < 16; ++r) pmax = fmaxf(pmax, p0[r]);
#pragma unroll
        for (int r = 0; r < 16; ++r) pmax = fmaxf(pmax, p1[r]);
        { auto rr = __builtin_amdgcn_permlane32_swap(__float_as_uint(pmax), __float_as_uint(pmax), false, false); pmax = fmaxf(__uint_as_float(rr[0]), __uint_as_float(rr[1])); }
        const float mn = fmaxf(m_reg, pmax); const float alpha = __builtin_amdgcn_exp2f(m_reg - mn); m_reg = mn;
        float ps = 0.f;
#pragma unroll
        for (int r = 0; r < 16; ++r) { p0[r] = __builtin_amdgcn_exp2f(p0[r] - mn); ps += p0[r]; }
#pragma unroll
        for (int r = 0; r < 16; ++r) { p1[r] = __builtin_amdgcn_exp2f(p1[r] - mn); ps += p1[r]; }
        { auto rr = __builtin_amdgcn_permlane32_swap(__float_as_uint(ps), __float_as_uint(ps), false, false); ps = __uint_as_float(rr[0]) + __uint_as_float(rr[1]); }
        l_reg = l_reg * alpha + ps;
        if (__any(alpha < 1.f)) {
            if (hi == 0) al_l[r32] = alpha;
            LDS_WAIT();
#pragma unroll
            for (int g = 0; g < 4; ++g) { const f32x4 a4 = *(const LAS f32x4*)(al_l + 8 * g + 4 * hi);
#pragma unroll
                for (int d = 0; d < NV; ++d) { o[d][4 * g + 0] *= a4[0]; o[d][4 * g + 1] *= a4[1]; o[d][4 * g + 2] *= a4[2]; o[d][4 * g + 3] *= a4[3]; } }
        }
        bf16x8 pa0, pa1, pa2, pa3;
#define PK4(P, B_, OUT) do { const unsigned a0_ = cvtpk(P[B_ + 0], P[B_ + 1]), a1_ = cvtpk(P[B_ + 2], P[B_ + 3]), b0_ = cvtpk(P[B_ + 4], P[B_ + 5]), b1_ = cvtpk(P[B_ + 6], P[B_ + 7]); \
        auto r0_ = __builtin_amdgcn_permlane32_swap(a0_, b0_, false, false); auto r1_ = __builtin_amdgcn_permlane32_swap(a1_, b1_, false, false); \
        u32x4 w_ = {r0_[0], r1_[0], r0_[1], r1_[1]}; OUT = __builtin_bit_cast(bf16x8, w_); } while (0)
        PK4(p0, 0, pa0); PK4(p0, 8, pa1); PK4(p1, 0, pa2); PK4(p1, 8, pa3);
#undef PK4
        const unsigned vba = vb0 + (unsigned)(st * STG);
#define TRRD(dst, off) asm volatile("ds_read_b64_tr_b16 %0, %1 offset:%2" : "=&v"(dst) : "v"(vba), "i"(off) : "memory")
#define PV_D0(d0) do { s16x4 l0, l1, l2, l3, h0, h1, h2, h3; constexpr int KS_ = NV * 1024, HF_ = NV * 512, b_ = (d0) * 512; \
        TRRD(l0, b_); TRRD(h0, b_ + HF_); TRRD(l1, b_ + KS_); TRRD(h1, b_ + KS_ + HF_); TRRD(l2, b_ + 2 * KS_); TRRD(h2, b_ + 2 * KS_ + HF_); TRRD(l3, b_ + 3 * KS_); TRRD(h3, b_ + 3 * KS_ + HF_); \
        asm volatile("s_waitcnt lgkmcnt(0)" ::: "memory"); SBAR(); \
        o[d0] = MFMA32(pa0, ((bf16x8){l0[0], l0[1], l0[2], l0[3], h0[0], h0[1], h0[2], h0[3]}), o[d0]); \
        o[d0] = MFMA32(pa1, ((bf16x8){l1[0], l1[1], l1[2], l1[3], h1[0], h1[1], h1[2], h1[3]}), o[d0]); \
        o[d0] = MFMA32(pa2, ((bf16x8){l2[0], l2[1], l2[2], l2[3], h2[0], h2[1], h2[2], h2[3]}), o[d0]); \
        o[d0] = MFMA32(pa3, ((bf16x8){l3[0], l3[1], l3[2], l3[3], h3[0], h3[1], h3[2], h3[3]}), o[d0]); } while (0)
        PV_D0(0); PV_D0(1);
        if constexpr (NV == 4) { PV_D0(2); PV_D0(3); }
#undef PV_D0
#undef TRRD
        if (t + 1 < t_hi) WRITE_TILE(st ^ 1);
        __syncthreads();
    }
#undef LOAD_TILE
#undef WRITE_TILE
}
template <int DV>
__device__ __forceinline__ void gated_store(LAS unsigned char* lds, float l_reg, const f32x16 (&o)[DV / 32], bf16_t* zp0) {
    constexpr int NV = DV / 32, OP = DV + 8, CPR = DV / 8;
    const int tid = tidx(), lane = tid & 63, r32 = lane & 31, hi = lane >> 5, wid = __builtin_amdgcn_readfirstlane(tid >> 6);
    LAS float* li_l = (LAS float*)(lds + L_WS) + wid * 64; LAS bf16_t* ost = (LAS bf16_t*)(lds + L_OST + wid * OST_WAVE);
    asm volatile("s_waitcnt lgkmcnt(0)" ::: "memory");
    if (hi == 0) li_l[r32] = l_reg;
    asm volatile("s_waitcnt lgkmcnt(0)" ::: "memory");
#pragma unroll
    for (int g = 0; g < 4; ++g) { const f32x4 a4 = *(const LAS f32x4*)(li_l + 8 * g + 4 * hi);
#pragma unroll
        for (int e = 0; e < 4; ++e) { const float rl = 1.f / a4[e]; const int row = 8 * g + 4 * hi + e;
#pragma unroll
            for (int d0 = 0; d0 < NV; ++d0) ost[row * OP + d0 * 32 + r32] = f2bf(o[d0][4 * g + e] * rl); } }
    asm volatile("s_waitcnt lgkmcnt(0)" ::: "memory");
#pragma unroll
    for (int i = 0; i < (32 * CPR) / 64; ++i) { const int id = lane + 64 * i, row = id / CPR, dc = id % CPR;
        const u32x4 v = *(const LAS u32x4*)(ost + row * OP + dc * 8); bf16_t* zp = zp0 + (size_t)row * NP + dc * 8; const u32x4 z = *(const u32x4*)zp;
        u32x4 w; w.x = cvtpk(lo_bf(v.x) * silu_f(lo_bf(z.x)), hi_bf(v.x) * silu_f(hi_bf(z.x))); w.y = cvtpk(lo_bf(v.y) * silu_f(lo_bf(z.y)), hi_bf(v.y) * silu_f(hi_bf(z.y)));
        w.z = cvtpk(lo_bf(v.z) * silu_f(lo_bf(z.z)), hi_bf(v.z) * silu_f(hi_bf(z.z))); w.w = cvtpk(lo_bf(v.w) * silu_f(lo_bf(z.w)), hi_bf(v.w) * silu_f(hi_bf(z.w)));
        *(u32x4*)zp = w; }
}
__device__ __forceinline__ void swa_unit(LAS unsigned char* lds, int qb, int hk, bf16_t* PROJ, const int* pos, const float* sinks  ) {
    const int tid = tidx(), lane = tid & 63, r32 = lane & 31, wid = __builtin_amdgcn_readfirstlane(tid >> 6);
    const int head = hk * 4 + (wid >> 1), q0 = qb * 64 + (wid & 1) * 32;
    const float sink = sinks[head] * LOG2E;
    float m = sink, l = 1.f; f32x16 o[2] = {};
    int t_lo = (qb * 64 - 128) / 64; if (t_lo < 0) t_lo = 0;
    attn_core<64, 64, 1>(lds, PROJ + (size_t)(q0 + r32) * NP + C_AQ + head * 64, PROJ + C_AK + hk * 64, NP, PROJ + C_AV + hk * 64, NP, t_lo, qb + 1, 0.125f * LOG2E, q0 + r32, head, pos, m, l, o);
    gated_store<64>(lds, l, o, PROJ + (size_t)q0 * NP + C_Z + head * 64);
}
__device__ __forceinline__ void cross_unit(LAS unsigned char* lds, int qb, int h, bf16_t* PROJ, const bf16_t* MEMKV  ) {
    const int tid = tidx(), lane = tid & 63, r32 = lane & 31, wid = __builtin_amdgcn_readfirstlane(tid >> 6);
    const int q0 = qb * 256 + wid * 32;
    float m = -1e30f, l = 0.f; f32x16 o[4] = {};
    attn_core<128, 128, 2>(lds, PROJ + (size_t)(q0 + r32) * NP + C_DQ + h * 128, MEMKV + h * 128, 1024, MEMKV + 512 + h * 128, 1024, 0, 4, 0.08838834764831845f * LOG2E, q0 + r32, 0, nullptr, m, l, o);
    gated_store<128>(lds, l, o, PROJ + (size_t)q0 * NP + C_Z + 1536 + h * 128);
}
__device__ __forceinline__ void run_mixers(LAS unsigned char* lds, unsigned* ctr, bf16_t* PROJ, const int* pos, const float* sinks, const float* btab_g, const bf16_t* MEMKV) {
    LAS int* ub = (LAS int*)(lds + L_UNIT);
    __syncthreads();
    for (int i = tidx(); i < 129 * 8; i += NT_THREADS) ((LAS float*)(lds + L_BTAB))[i] = btab_g[i];
    for (;;) {
        __syncthreads();
        if (tidx() == 0) *ub = (int)atomicAdd(ctr, 1u);
        __syncthreads();
        const int u = *ub;
        if (u >= 768) break;
        if (u < 256) cross_unit(lds, u >> 2, u & 3, PROJ, MEMKV); else swa_unit(lds, (u - 256) >> 1, (u - 256) & 1, PROJ, pos, sinks);
    }
}
}
namespace mla {
constexpr int ST_BYTES = 49152  , R_OFF = 32768, L_SCR = 147456  , L_UNIT = 149504, L_OLT = 67584  , L_OUT = 102400  ;
__device__ __forceinline__ unsigned off_a(unsigned row, unsigned ch) { return 2048u * (row >> 3) + 512u * (ch >> 2) + 64u * (row & 7) + 16u * ((ch & 3) ^ ((row >> 2) & 3)); }
__device__ __forceinline__ unsigned off_r(unsigned row, unsigned ch) { return 1024u * (row >> 3) + 512u * (ch >> 2) + 64u * (row & 7) + 16u * ((ch & 3) ^ ((row >> 2) & 3)); }

#ifdef EXP_MLASEC
#define MSEC(i) do { const unsigned long long t_ = __builtin_amdgcn_s_memrealtime(); macc[i] += t_ - mtm; mtm = t_; } while (0)
#define MSEC_ARGS , unsigned long long (&macc)[8], unsigned long long& mtm
#define MSEC_PASS , macc, mtm
#else
#define MSEC(i)
#define MSEC_ARGS
#define MSEC_PASS
#endif
template <int VAR> __device__ __forceinline__ void unit(LAS unsigned char* lds, int qb, int h, const bf16_t* QABS, const bf16_t* KVLAT, bf16_t* PROJ, const bf16_t* WUV, const float* rsq, const float* cosT, const float* sinT, float qscale MSEC_ARGS) {
    const int tid = tidx(), lane = tid & 63, r32 = lane & 31, hi = lane >> 5, wid = __builtin_amdgcn_readfirstlane(tid >> 6), kg = wid >> 2, g = wid & 3;
    const int q0 = qb * 128, qloc = 32 * g + r32, qidx = q0 + qloc;
    bf16x8 qr[12];
    { const bf16_t* qrow = QABS + (size_t)qidx * 768 + h * 192;
#pragma unroll
      for (int d0 = 0; d0 < 12; ++d0) qr[d0] = *(const bf16x8*)(qrow + d0 * 16 + hi * 8);
      const float sc = rsq[qidx] * qscale;
#pragma unroll
      for (int d0 = 0; d0 < 12; ++d0) { const u32x4 w = __builtin_bit_cast(u32x4, qr[d0]);
          float v[8] = {lo_bf(w.x) * sc, hi_bf(w.x) * sc, lo_bf(w.y) * sc, hi_bf(w.y) * sc, lo_bf(w.z) * sc, hi_bf(w.z) * sc, lo_bf(w.w) * sc, hi_bf(w.w) * sc};
          if (d0 >= 8) { const int i0 = (d0 - 8) * 8 + hi * 4; const f32x4 c = *(const f32x4*)(cosT + (size_t)qidx * 32 + i0), s = *(const f32x4*)(sinT + (size_t)qidx * 32 + i0);
#pragma unroll
              for (int jj = 0; jj < 4; ++jj) { const float t1 = v[2 * jj], t2 = v[2 * jj + 1]; v[2 * jj] = t1 * c[jj] - t2 * s[jj]; v[2 * jj + 1] = t1 * s[jj] + t2 * c[jj]; }
              SBAR(); }
          qr[d0] = pack8(v); } }
    SBAR();
    unsigned goff[6];
#pragma unroll
    for (int i = 0; i < 6; ++i) { const unsigned o_ = (unsigned)(wid * 6 + i) * 1024u + lane * 16u; unsigned key, cc;
        if (o_ < (unsigned)R_OFF) { const unsigned r = o_ & 2047u, k7 = (r & 511u) >> 6, x = (r & 63u) >> 4; key = (o_ >> 11) * 8u + k7; cc = (r >> 9) * 4u + (x ^ ((key >> 2) & 3u)); }
        else { const unsigned o2 = o_ - R_OFF, r = o2 & 1023u, k7 = (r & 511u) >> 6, x = (r & 63u) >> 4; key = (o2 >> 10) * 8u + k7; cc = 16u + (r >> 9) * 4u + (x ^ ((key >> 2) & 3u)); }
        goff[i] = (key * 192u + cc * 8u) * 2u; }
#define STAGE_TILE(t_, SB) do { const char* src_ = (const char*)KVLAT + (size_t)(t_) * (128 * 192 * 2); const unsigned la_ = (unsigned)(uintptr_t)lds + (SB) + wid * 6144; \
        _Pragma("unroll") for (int i = 0; i < 6; ++i) asm volatile("s_mov_b32 m0, %0\n\ts_nop 0\n\tglobal_load_lds_dwordx4 %1, %2" :: "s"(la_ + i * 1024), "v"(goff[i]), "s"(src_) : "memory", "m0"); } while (0)
    STAGE_TILE(0, 0);
    if (qb >= 1) STAGE_TILE(1, ST_BYTES);
    const unsigned y = (r32 >> 2) & 3, rowpart = 64u * (r32 & 7);
    const unsigned nb_e = 2048u * (8 * kg + (r32 >> 3)) + rowpart + 16u * ((unsigned)hi ^ y), nb_o = 2048u * (8 * kg + (r32 >> 3)) + rowpart + 16u * ((2u + hi) ^ y);
    const unsigned rb_e = R_OFF + 1024u * (8 * kg + (r32 >> 3)) + rowpart + 16u * ((unsigned)hi ^ y), rb_o = R_OFF + 1024u * (8 * kg + (r32 >> 3)) + rowpart + 16u * ((2u + hi) ^ y);
    const unsigned blk = (lane >> 4) & 1, q_ = (lane & 15) >> 2, p_ = lane & 3, x0 = (2u * blk + (p_ >> 1)) ^ (2u * hi);
    const unsigned ldsb = (unsigned)(uintptr_t)lds;
    const unsigned tb0 = ldsb + 2048u * (8 * kg + hi) + 64u * q_ + 16u * x0 + 8u * (p_ & 1), tb1 = ldsb + 2048u * (8 * kg + hi) + 64u * (4u + q_) + 16u * (x0 ^ 1u) + 8u * (p_ & 1);
    LAS float* scr = (LAS float*)(lds + L_SCR) + wid * 64;
    float m_reg = -1e30f, l_reg = 0.f; f32x16 o[4] = {};
    const unsigned tbo0 = tb0 - ldsb, tbo1 = tb1 - ldsb;
    constexpr float THR = 8.f;
    bf16x8 paX0, paX1, paY0 = {}, paY1 = {};
    f32x16 pA, pB;
#define KADDR(s, hf) ((s) < 8 ? ((((s) & 1) ? no_ : ne_) + 512 * ((s) >> 1) + 8192 * (hf)) : ((((s) & 1) ? ro_ : re_) + 512 * (((s) - 8) >> 1) + 4096 * (hf)))
#define KRD1(dst, s, hf) dst = *(const LAS bf16x8*)KADDR(s, hf)
#define VRD1(L, H, d0, ka) do { L = __builtin_amdgcn_ds_read_tr16_b64_v4i16((LAS s16x4*)(t0a_ + 4096 * (ka) + 512 * (d0))); H = __builtin_amdgcn_ds_read_tr16_b64_v4i16((LAS s16x4*)(t1a_ + 4096 * (ka) + 512 * (d0))); } while (0)
#define VFR(L, H) ((bf16x8){L[0], L[1], L[2], L[3], H[0], H[1], H[2], H[3]})
#define QBASES(SB) const LAS unsigned char* ne_ = lds + (SB) + nb_e; const LAS unsigned char* no_ = lds + (SB) + nb_o; const LAS unsigned char* re_ = lds + (SB) + rb_e; const LAS unsigned char* ro_ = lds + (SB) + rb_o
#define PBASES(SB) LAS unsigned char* t0a_ = lds + (SB) + tbo0; LAS unsigned char* t1a_ = lds + (SB) + tbo1
#define QKQ_SERIAL(PN, SB, hf) do { QBASES(SB); PN = (f32x16){}; _Pragma("unroll") for (int s_ = 0; s_ < 12; ++s_) { bf16x8 k_; KRD1(k_, s_, hf); PN = MFMA32(k_, qr[s_], PN); } } while (0)
#define PVQ_SERIAL(SB, hf, PA0, PA1) do { PBASES(SB); _Pragma("unroll") for (int j_ = 0; j_ < 8; ++j_) { s16x4 l_, h_; VRD1(l_, h_, j_ >> 1, 2 * (hf) + (j_ & 1)); o[j_ >> 1] = MFMA32((j_ & 1) ? PA1 : PA0, VFR(l_, h_), o[j_ >> 1]); } } while (0)
#define PK4(P, B_, OUT) do { const unsigned a0_ = cvtpk(P[B_ + 0], P[B_ + 1]), a1_ = cvtpk(P[B_ + 2], P[B_ + 3]), b0_ = cvtpk(P[B_ + 4], P[B_ + 5]), b1_ = cvtpk(P[B_ + 6], P[B_ + 7]); \
        auto r0_ = __builtin_amdgcn_permlane32_swap(a0_, b0_, false, false); auto r1_ = __builtin_amdgcn_permlane32_swap(a1_, b1_, false, false); \
        u32x4 w_ = {r0_[0], r1_[0], r0_[1], r1_[1]}; OUT = __builtin_bit_cast(bf16x8, w_); } while (0)
#define RESCALE_O(alpha_) do { if (hi == 0) scr[r32] = (alpha_); LDS_WAIT(); \
            _Pragma("unroll") for (int gg = 0; gg < 4; ++gg) { const f32x4 a4 = *(const LAS f32x4*)(scr + 8 * gg + 4 * hi); \
                _Pragma("unroll") for (int d = 0; d < 4; ++d) { o[d][4 * gg + 0] *= a4[0]; o[d][4 * gg + 1] *= a4[1]; o[d][4 * gg + 2] *= a4[2]; o[d][4 * gg + 3] *= a4[3]; } } } while (0)
#define SMC(i, PC, PE0, PE1) do { \
        if ((i) == 0) { t0_ = fmaxf(fmaxf(PC[0], PC[1]), PC[2]); t1_ = fmaxf(fmaxf(PC[3], PC[4]), PC[5]); t2_ = fmaxf(fmaxf(PC[6], PC[7]), PC[8]); t3_ = fmaxf(fmaxf(PC[9], PC[10]), PC[11]); } \
        if ((i) == 1) { const float t4_ = fmaxf(fmaxf(PC[12], PC[13]), PC[14]); t0_ = fmaxf(fmaxf(t0_, t1_), PC[15]); t2_ = fmaxf(fmaxf(t2_, t3_), t4_); t0_ = fmaxf(t0_, t2_); } \
        if ((i) == 2) { auto rr = __builtin_amdgcn_permlane32_swap(__float_as_uint(t0_), __float_as_uint(t0_), false, false); const float pm_ = fmaxf(__uint_as_float(rr[0]), __uint_as_float(rr[1])); \
            need_ = pm_ > m_reg + THR; mn_ = need_ ? pm_ : m_reg; alpha_ = __builtin_amdgcn_exp2f(m_reg - mn_); m_reg = mn_; } \
        if ((i) >= 3 && (i) <= 10) { PC[2 * ((i) - 3)] = __builtin_amdgcn_exp2f(PC[2 * ((i) - 3)] - mn_); PC[2 * ((i) - 3) + 1] = __builtin_amdgcn_exp2f(PC[2 * ((i) - 3) + 1] - mn_); } \
        if ((i) == 11) { t0_ = PC[0] + PC[1]; t1_ = PC[2] + PC[3]; t2_ = PC[4] + PC[5]; t3_ = PC[6] + PC[7]; } \
        if ((i) == 12) { t0_ += PC[8] + PC[9]; t1_ += PC[10] + PC[11]; } \
        if ((i) == 13) { t2_ += PC[12] + PC[13]; t3_ += PC[14] + PC[15]; } \
        if ((i) == 14) { t0_ += t1_; t2_ += t3_; t0_ += t2_; } \
        if ((i) == 15) { auto rr = __builtin_amdgcn_permlane32_swap(__float_as_uint(t0_), __float_as_uint(t0_), false, false); l_reg = l_reg * alpha_ + (__uint_as_float(rr[0]) + __uint_as_float(rr[1])); } \
        if ((i) == 16) { c0_ = cvtpk(PC[0], PC[1]); c1_ = cvtpk(PC[2], PC[3]); c2_ = cvtpk(PC[4], PC[5]); c3_ = cvtpk(PC[6], PC[7]); } \
        if ((i) == 17) { auto r0_ = __builtin_amdgcn_permlane32_swap(c0_, c2_, false, false); auto r1_ = __builtin_amdgcn_permlane32_swap(c1_, c3_, false, false); u32x4 w_ = {r0_[0], r1_[0], r0_[1], r1_[1]}; PE0 = __builtin_bit_cast(bf16x8, w_); } \
        if ((i) == 18) { c0_ = cvtpk(PC[8], PC[9]); c1_ = cvtpk(PC[10], PC[11]); c2_ = cvtpk(PC[12], PC[13]); c3_ = cvtpk(PC[14], PC[15]); } \
        if ((i) == 19) { auto r0_ = __builtin_amdgcn_permlane32_swap(c0_, c2_, false, false); auto r1_ = __builtin_amdgcn_permlane32_swap(c1_, c3_, false, false); u32x4 w_ = {r0_[0], r1_[0], r0_[1], r1_[1]}; PE1 = __builtin_bit_cast(bf16x8, w_); } \
    } while (0)
#define SLOT_ISQ(i) (((i) < 16) ? (((i) & 1) == 0) : true)
#define SLOT_QS(i) (((i) < 16) ? ((i) >> 1) : ((i) - 8))
#define SLOT_PJ(i) ((i) >> 1)
#define RD_SLOT(i, HQ, HP) do { if ((i) < 20) { if (SLOT_ISQ(i)) { if (SLOT_QS(i) % 3 == 0) KRD1(kf0, SLOT_QS(i), HQ); else if (SLOT_QS(i) % 3 == 1) KRD1(kf1, SLOT_QS(i), HQ); else KRD1(kf2, SLOT_QS(i), HQ); } \
        else { if (SLOT_PJ(i) & 1) VRD1(vl1, vh1, SLOT_PJ(i) >> 1, 2 * (HP) + 1); else VRD1(vl0, vh0, SLOT_PJ(i) >> 1, 2 * (HP)); } } } while (0)
#define MM_SLOT(i, PN, PA0, PA1) do { if (SLOT_ISQ(i)) { if (SLOT_QS(i) % 3 == 0) PN = MFMA32(kf0, qr[SLOT_QS(i)], PN); else if (SLOT_QS(i) % 3 == 1) PN = MFMA32(kf1, qr[SLOT_QS(i)], PN); else PN = MFMA32(kf2, qr[SLOT_QS(i)], PN); } \
        else { if (SLOT_PJ(i) & 1) o[SLOT_PJ(i) >> 1] = MFMA32(PA1, VFR(vl1, vh1), o[SLOT_PJ(i) >> 1]); else o[SLOT_PJ(i) >> 1] = MFMA32(PA0, VFR(vl0, vh0), o[SLOT_PJ(i) >> 1]); } } while (0)
#define SLOT(i, PN, HQ, HP, PA0, PA1, PC, PE0, PE1) do { MM_SLOT(i, PN, PA0, PA1); RD_SLOT((i) + 2, HQ, HP); if (!(VAR & 2)) SMC(i, PC, PE0, PE1); SBAR(); } while (0)
#define ITER(PN, SBQ, HQ, SBP, HP, PA0, PA1, PC, PE0, PE1) do { QBASES(SBQ); PBASES(SBP); bf16x8 kf0, kf1, kf2; s16x4 vl0, vh0, vl1, vh1; float t0_, t1_, t2_, t3_, mn_, alpha_; unsigned c0_, c1_, c2_, c3_; bool need_; \
        PN = (f32x16){}; RD_SLOT(0, HQ, HP); RD_SLOT(1, HQ, HP); SBAR(); \
        SLOT(0, PN, HQ, HP, PA0, PA1, PC, PE0, PE1); SLOT(1, PN, HQ, HP, PA0, PA1, PC, PE0, PE1); SLOT(2, PN, HQ, HP, PA0, PA1, PC, PE0, PE1); SLOT(3, PN, HQ, HP, PA0, PA1, PC, PE0, PE1); \
        SLOT(4, PN, HQ, HP, PA0, PA1, PC, PE0, PE1); SLOT(5, PN, HQ, HP, PA0, PA1, PC, PE0, PE1); SLOT(6, PN, HQ, HP, PA0, PA1, PC, PE0, PE1); SLOT(7, PN, HQ, HP, PA0, PA1, PC, PE0, PE1); \
        SLOT(8, PN, HQ, HP, PA0, PA1, PC, PE0, PE1); SLOT(9, PN, HQ, HP, PA0, PA1, PC, PE0, PE1); SLOT(10, PN, HQ, HP, PA0, PA1, PC, PE0, PE1); SLOT(11, PN, HQ, HP, PA0, PA1, PC, PE0, PE1); \
        SLOT(12, PN, HQ, HP, PA0, PA1, PC, PE0, PE1); SLOT(13, PN, HQ, HP, PA0, PA1, PC, PE0, PE1); SLOT(14, PN, HQ, HP, PA0, PA1, PC, PE0, PE1); SLOT(15, PN, HQ, HP, PA0, PA1, PC, PE0, PE1); \
        SLOT(16, PN, HQ, HP, PA0, PA1, PC, PE0, PE1); SLOT(17, PN, HQ, HP, PA0, PA1, PC, PE0, PE1); SLOT(18, PN, HQ, HP, PA0, PA1, PC, PE0, PE1); SLOT(19, PN, HQ, HP, PA0, PA1, PC, PE0, PE1); \
        if (!(VAR & 2)) { if (__any(need_)) RESCALE_O(alpha_); } } while (0)
    asm volatile("s_waitcnt vmcnt(0)" ::: "memory");
    __syncthreads();
    MSEC(0);
    unsigned s_prev = 2 * ST_BYTES, s_cur = 0, s_next = ST_BYTES;
    QKQ_SERIAL(pA, s_cur, 0);
#pragma unroll 1
    for (int t = 0; t < qb; ++t) {
        { const unsigned sp_ = t ? s_prev : s_cur; ITER(pB, s_cur, 1, sp_, 1, paY0, paY1, pA, paX0, paX1); }
        asm volatile("s_waitcnt vmcnt(0)" ::: "memory");
        if (!(VAR & 16)) __syncthreads();
        if (t + 2 <= qb && !(VAR & 8)) STAGE_TILE(t + 2, s_prev);
        ITER(pA, s_next, 0, s_cur, 0, paX0, paX1, pB, paY0, paY1);
        { const unsigned tmp_ = s_prev; s_prev = s_cur; s_cur = s_next; s_next = tmp_; }
    }
    if (qb > 0) PVQ_SERIAL(s_prev, 1, paY0, paY1);
    QKQ_SERIAL(pB, s_cur, 1);
    { const int t2_ = tidx(); int ql_ = 32 * ((t2_ >> 6) & 3) + (t2_ & 31) - 64 * (t2_ >> 8) - 4 * ((t2_ >> 5) & 1); asm volatile("" : "+v"(ql_));
#pragma unroll
      for (int r = 0; r < 16; ++r) { const int kc_ = (r & 3) + 8 * (r >> 2); if (kc_ > ql_) pA[r] = -__builtin_inff(); if (kc_ + 32 > ql_) pB[r] = -__builtin_inff(); }
      float pmax = pA[0];
#pragma unroll
      for (int r = 1; r < 16; ++r) pmax = fmaxf(pmax, pA[r]);
#pragma unroll
      for (int r = 0; r < 16; ++r) pmax = fmaxf(pmax, pB[r]);
      { auto rr = __builtin_amdgcn_permlane32_swap(__float_as_uint(pmax), __float_as_uint(pmax), false, false); pmax = fmaxf(__uint_as_float(rr[0]), __uint_as_float(rr[1])); }
      const float mn = fmaxf(m_reg, pmax); const float alpha = __builtin_amdgcn_exp2f(m_reg - mn); m_reg = mn; float ps = 0.f;
#pragma unroll
      for (int r = 0; r < 16; ++r) { pA[r] = __builtin_amdgcn_exp2f(pA[r] - mn); ps += pA[r]; }
#pragma unroll
      for (int r = 0; r < 16; ++r) { pB[r] = __builtin_amdgcn_exp2f(pB[r] - mn); ps += pB[r]; }
      { auto rr = __builtin_amdgcn_permlane32_swap(__float_as_uint(ps), __float_as_uint(ps), false, false); ps = __uint_as_float(rr[0]) + __uint_as_float(rr[1]); }
      l_reg = l_reg * alpha + ps;
      if (__any(alpha < 1.f)) RESCALE_O(alpha);
      PK4(pA, 0, paX0); PK4(pA, 8, paX1); PK4(pB, 0, paY0); PK4(pB, 8, paY1); }
    PVQ_SERIAL(s_cur, 0, paX0, paX1);
    PVQ_SERIAL(s_cur, 1, paY0, paY1);
    __syncthreads();
#undef KADDR
#undef KRD1
#undef VRD1
#undef VFR
#undef QBASES
#undef PBASES
#undef QKQ_SERIAL
#undef PVQ_SERIAL
#undef PK4
#undef RESCALE_O
#undef SMC
#undef SLOT_ISQ
#undef SLOT_QS
#undef SLOT_PJ
#undef RD_SLOT
#undef MM_SLOT
#undef SLOT
#undef ITER
    if (VAR != 0) { asm volatile("" :: "v"(o[0]), "v"(o[1]), "v"(o[2]), "v"(o[3]), "v"(m_reg), "v"(l_reg)); return; }
#undef STAGE_TILE
    const int tid_e = tidx(), lane_e = tid_e & 63; const int wid_e = __builtin_amdgcn_readfirstlane(tid_e >> 6);
#define lane lane_e
#define r32 (lane_e & 31)
#define hi (lane_e >> 5)
#define kg (wid_e >> 2)
#define g (wid_e & 3)
    LAS float* scr_e = (LAS float*)(lds + L_SCR) + wid_e * 64;
#define scr scr_e
    LAS float* xo = (LAS float*)lds + g * 4096;
    LAS float* xm = (LAS float*)(lds + 65536) + g * 128;
    if (kg == 1) {
#pragma unroll
        for (int d0 = 0; d0 < 4; ++d0)
#pragma unroll
            for (int r = 0; r < 16; ++r) xo[(d0 * 16 + r) * 64 + lane] = o[d0][r];
        xm[lane] = m_reg; xm[64 + lane] = l_reg;
    }
    __syncthreads();
    if (kg == 0) {
        const float mB = xm[lane], lB = xm[64 + lane];
        const float m = fmaxf(m_reg, mB), fA = __builtin_amdgcn_exp2f(m_reg - m), fB = __builtin_amdgcn_exp2f(mB - m), li = 1.f / (l_reg * fA + lB * fB);
        if (hi == 0) { scr[r32] = fA * li; scr[32 + r32] = fB * li; }
        LDS_WAIT();
        float sA[16], sB[16];
#pragma unroll
        for (int gg = 0; gg < 4; ++gg) { const f32x4 a4 = *(const LAS f32x4*)(scr + 8 * gg + 4 * hi), b4 = *(const LAS f32x4*)(scr + 32 + 8 * gg + 4 * hi);
            sA[4 * gg] = a4[0]; sA[4 * gg + 1] = a4[1]; sA[4 * gg + 2] = a4[2]; sA[4 * gg + 3] = a4[3]; sB[4 * gg] = b4[0]; sB[4 * gg + 1] = b4[1]; sB[4 * gg + 2] = b4[2]; sB[4 * gg + 3] = b4[3]; }
        LAS bf16_t* olt = (LAS bf16_t*)(lds + L_OLT + g * 8704); LAS bf16_t* ot = (LAS bf16_t*)(lds + L_OUT + g * 8704);
#pragma unroll
        for (int d0 = 0; d0 < 4; ++d0) {
#pragma unroll
            for (int r = 0; r < 16; ++r) olt[crow(r, hi) * 136 + d0 * 32 + r32] = f2bf(o[d0][r] * sA[r] + xo[(d0 * 16 + r) * 64 + lane] * sB[r]);
            SBAR(); }
        LDS_WAIT();
        bf16x8 af[8];
#pragma unroll
        for (int ks = 0; ks < 8; ++ks) af[ks] = *(const LAS bf16x8*)(olt + r32 * 136 + 16 * ks + 8 * hi);
        f32x16 y[4] = {};
        const bf16_t* wb = WUV + (size_t)(h * 128 + r32) * 512 + h * 128 + 8 * hi;
#pragma unroll
        for (int c = 0; c < 4; ++c)
#pragma unroll
            for (int ks = 0; ks < 8; ++ks) y[c] = MFMA32(af[ks], *(const bf16x8*)(wb + (size_t)(32 * c) * 512 + 16 * ks), y[c]);
#pragma unroll
        for (int r = 0; r < 16; ++r)
#pragma unroll
            for (int c = 0; c < 4; ++c) ot[crow(r, hi) * 136 + 32 * c + r32] = f2bf(y[c][r]);
        LDS_WAIT();
        bf16_t* zp0 = PROJ + (size_t)(q0 + 32 * g) * NP + C_Z + 1024 + h * 128;
#pragma unroll
        for (int i = 0; i < 8; ++i) { const int id = lane + 64 * i, row = id >> 4, dc = id & 15;
            const u32x4 v = *(const LAS u32x4*)(ot + row * 136 + dc * 8); bf16_t* zp = zp0 + (size_t)row * NP + dc * 8; const u32x4 z = *(const u32x4*)zp;
            u32x4 w; w.x = cvtpk(lo_bf(v.x) * silu_f(lo_bf(z.x)), hi_bf(v.x) * silu_f(hi_bf(z.x))); w.y = cvtpk(lo_bf(v.y) * silu_f(lo_bf(z.y)), hi_bf(v.y) * silu_f(hi_bf(z.y)));
            w.z = cvtpk(lo_bf(v.z) * silu_f(lo_bf(z.z)), hi_bf(v.z) * silu_f(hi_bf(z.z))); w.w = cvtpk(lo_bf(v.w) * silu_f(lo_bf(z.w)), hi_bf(v.w) * silu_f(hi_bf(z.w)));
            *(u32x4*)zp = w; }
    }
    __syncthreads();
    MSEC(6);
#undef lane
#undef r32
#undef hi
#undef kg
#undef g
#undef scr
}
__device__ __forceinline__ void run_queue(LAS unsigned char* lds, unsigned* ctr, const bf16_t* QABS, const bf16_t* KVLAT, bf16_t* PROJ, const bf16_t* WUV, const float* rsq, const float* cosT, const float* sinT, float qscale) {
    LAS int* ub = (LAS int*)(lds + L_UNIT);
#ifdef EXP_MLASEC
    unsigned long long macc[8] = {0, 0, 0, 0, 0, 0, 0, 0}, mtm = __builtin_amdgcn_s_memrealtime();
#endif
    for (;;) {
        __syncthreads();
        if (tidx() == 0) *ub = (int)atomicAdd(ctr, 1u);
        __syncthreads();
        const int u = *ub;
        if (u >= 512) break;
        MSEC(7);
        unit<0>(lds, 127 - (u >> 2), u & 3, QABS, KVLAT, PROJ, WUV, rsq, cosT, sinT, qscale MSEC_PASS);
    }
#ifdef EXP_MLAVAR
    for (;;) {
        __syncthreads();
        if (tidx() == 0) *ub = (int)atomicAdd(ctr + 32, 1u);
        __syncthreads();
        const int u = *ub;
        if (u >= 512) break;
        unit<EXP_MLAVAR>(lds, 127 - (u >> 2), u & 3, QABS, KVLAT, PROJ, WUV, rsq, cosT, sinT, qscale MSEC_PASS);
    }
#endif
#ifdef EXP_MLASEC
    { const unsigned long long t1_ = __builtin_amdgcn_s_memrealtime(); while (__builtin_amdgcn_s_memrealtime() - t1_ < 4 * macc[EXP_MLASEC]) __builtin_amdgcn_s_sleep(8); }
#endif
}
}
template <class Map>
__device__ __forceinline__ void transpose_tile(const float* W, int ldw, bf16_t* WT, int K, int n0, int k0, LAS float* tile, Map map, int lane) {
    { const int src = map(n0 + lane); float v[64];
#pragma unroll
      for (int k = 0; k < 64; ++k) v[k] = src >= 0 ? W[(size_t)(k0 + k) * ldw + src] : 0.f;
#pragma unroll
      for (int k = 0; k < 64; ++k) tile[k * 65 + lane] = v[k]; }
    LDS_WAIT();
    { const int kc = (lane & 7) * 8;
#pragma unroll
      for (int i = 0; i < 8; ++i) { const int n = (lane >> 3) + 8 * i; float v[8];
#pragma unroll
          for (int j = 0; j < 8; ++j) v[j] = tile[(kc + j) * 65 + n];
          u32x4 w = {cvtpk(v[0], v[1]), cvtpk(v[2], v[3]), cvtpk(v[4], v[5]), cvtpk(v[6], v[7])};
          *(u32x4*)(WT + (size_t)(n0 + n) * K + k0 + kc) = w; } }
    LDS_WAIT();
}
struct MapWin { __device__ int operator()(int n) const { return win_src(n); } };
struct MapId { __device__ int operator()(int n) const { return n; } };

__device__ __forceinline__ void job_win(const Params& p, int l, int gw, int ngw, LAS unsigned char* lds, int wid, int lane) {
    bf16_t* WT = (bf16_t*)(p.ws + WS_WIN); const float* W = p.w_in + (size_t)l * DM * DIN; LAS float* tile = (LAS float*)(lds + wid * 16640);
    for (int t = gw; t < (NP / 64) * (DM / 64); t += ngw) transpose_tile(W, DIN, WT, DM, (t / (DM / 64)) * 64, (t % (DM / 64)) * 64, tile, MapWin(), lane);
}
__device__ __forceinline__ void job_wout(const Params& p, int l, int gw, int ngw, LAS unsigned char* lds, int wid, int lane) {
    bf16_t* WT = (bf16_t*)(p.ws + WS_WOUT); const float* W = p.w_out + (size_t)l * MIXW * DM; LAS float* tile = (LAS float*)(lds + wid * 16640);
    for (int t = gw; t < (DM / 64) * (MIXW / 64); t += ngw) transpose_tile(W, DM, WT, MIXW, (t / (MIXW / 64)) * 64, (t % (MIXW / 64)) * 64, tile, MapId(), lane);
}
__device__ __forceinline__ void job_wmem(const Params& p, int gw, int ngw, LAS unsigned char* lds, int wid, int lane) {
    LAS float* tile = (LAS float*)(lds + wid * 16640);
    for (int t = gw; t < 2 * 16 * 16; t += ngw) { const int l = t >> 8, r = t & 255;
        transpose_tile(p.w_mem + (size_t)l * DM * DM, DM, (bf16_t*)(p.ws + WS_WMEM) + (size_t)l * DM * DM, DM, (r >> 4) * 64, (r & 15) * 64, tile, MapId(), lane); }
}
__device__ __forceinline__ void job_wq(const Params& p, int bid, int nblk, int gtid, int gn, LAS unsigned char* lds) {
    const int tid = tidx(); LAS float* At = (LAS float*)lds; LAS float* Bt = At + 64 * 129;
    for (int it = bid; it < 2 * 4 * 4 * 2; it += nblk) { const int l = it >> 5, h = (it >> 3) & 3, kt = (it >> 1) & 3, ct = it & 1;
        const float* uq = p.w_uq + (size_t)l * 256 * 768 + (size_t)(kt * 64) * 768 + h * 192; const float* ukv = p.w_ukv + (size_t)l * 128 * 1024 + (size_t)(ct * 64) * 1024 + h * 256;
        __syncthreads();
#pragma unroll
        for (int i = 0; i < 16; ++i) { const int e = tid + NT_THREADS * i, r = e >> 7, j = e & 127; At[r * 129 + j] = uq[(size_t)r * 768 + j]; Bt[r * 129 + j] = ukv[(size_t)r * 1024 + j]; }
        __syncthreads();
        const int kk = tid & 63, c0 = (tid >> 6) * 8; float acc[8] = {0.f, 0.f, 0.f, 0.f, 0.f, 0.f, 0.f, 0.f};
#pragma unroll 4
        for (int j = 0; j < 128; ++j) { const float a = At[kk * 129 + j];
#pragma unroll
            for (int e = 0; e < 8; ++e) acc[e] = fmaf(a, Bt[(c0 + e) * 129 + j], acc[e]); }
        const int k = kt * 64 + kk; const float g = p.q_norm[l * 256 + k]; bf16_t* wq = (bf16_t*)(p.ws + WS_WQ) + (size_t)l * 768 * 256;
#pragma unroll
        for (int e = 0; e < 8; ++e) wq[(size_t)(h * 192 + ct * 64 + c0 + e) * 256 + k] = f2bf(acc[e] * g);
    }
    for (int idx = gtid; idx < 2 * 4 * 64 * 256; idx += gn) {
        const int l = idx >> 16, r = idx & 65535, h = r >> 14, w = (r >> 8) & 63, k = r & 255, i = w >> 1, which = w & 1;
        ((bf16_t*)(p.ws + WS_WQ))[(size_t)l * 768 * 256 + (size_t)(h * 192 + 128 + w) * 256 + k] = f2bf(p.w_uq[(size_t)l * 256 * 768 + (size_t)k * 768 + h * 192 + 128 + i + 32 * which] * p.q_norm[l * 256 + k]);
    }
}
__device__ __forceinline__ void job_wuv(const Params& p, int gtid, int gn) {
    for (int idx = gtid; idx < 2 * 512 * 512; idx += gn) {
        const int l = idx / (512 * 512), r = idx % (512 * 512), n = r / 512, k = r % 512, h = n >> 7;
        const float v = (k >> 7) == h ? p.w_ukv[(size_t)l * 128 * 1024 + (size_t)(k & 127) * 1024 + h * 256 + 128 + (n & 127)] : 0.f;
        ((bf16_t*)(p.ws + WS_WUV))[idx] = f2bf(v);
    }
}
__device__ __forceinline__ void job_rope(const Params& p, int gtid, int gn) {
    float* cosT = (float*)(p.ws + WS_COS); float* sinT = (float*)(p.ws + WS_SIN);
    for (int idx = gtid; idx < S * 32; idx += gn) {
        const int s = idx >> 5, i = idx & 31;
        const float angf = (float)p.pos[s] * inv_freq(i);
        const double a = (double)angf; const double kq = __builtin_rint(a * 0.63661977236758134308);
        const double x = (a - kq * 1.5707963267948966192) - kq * 6.123233995736766036e-17;
        const double x2 = x * x;
        const double sn = x * (1.0 + x2 * (-1.0 / 6 + x2 * (1.0 / 120 + x2 * (-1.0 / 5040 + x2 * (1.0 / 362880 + x2 * (-1.0 / 39916800 + x2 * (1.0 / 6227020800.0)))))));
        const double cs = 1.0 + x2 * (-0.5 + x2 * (1.0 / 24 + x2 * (-1.0 / 720 + x2 * (1.0 / 40320 + x2 * (-1.0 / 3628800 + x2 * (1.0 / 479001600.0 + x2 * (-1.0 / 87178291200.0)))))));
        const int q = ((int)kq) & 3;
        const double c = (q == 0) ? cs : (q == 1) ? -sn : (q == 2) ? -cs : sn;
        const double sv = (q == 0) ? sn : (q == 1) ? cs : (q == 2) ? -sn : -cs;
        cosT[idx] = (float)c; sinT[idx] = (float)sv;
    }
}
__device__ __forceinline__ void job_btab(const Params& p, int gtid, int gn) {
    float* bt = (float*)(p.ws + WS_MISC + MISC_BTAB);
    for (int idx = gtid; idx < 129 * 8; idx += gn) { const int d = idx >> 3, h = idx & 7; bt[idx] = p.rel_bias[t5_bucket(d) * 8 + h] * LOG2E; }
}
__device__ __forceinline__ void rms_row_to_bf16(const float* xrow, const float* gain, bf16_t* orow, int lane) {
    f32x4 v[4]; float ss = 0.f;
#pragma unroll
    for (int j = 0; j < 4; ++j) { v[j] = *(const f32x4*)(xrow + 256 * j + 4 * lane); ss += (v[j].x * v[j].x + v[j].y * v[j].y) + (v[j].z * v[j].z + v[j].w * v[j].w); }
    const float rs = rsqrtf(wave_sum(ss) * (1.f / DM) + RMS_EPS);
#pragma unroll
    for (int j = 0; j < 4; ++j) { const f32x4 g = *(const f32x4*)(gain + 256 * j + 4 * lane);
        u32x2 w; w.x = cvtpk(v[j].x * rs * g.x, v[j].y * rs * g.y); w.y = cvtpk(v[j].z * rs * g.z, v[j].w * rs * g.w);
        *(u32x2*)(orow + 256 * j + 4 * lane) = w; }
}
__device__ __forceinline__ void job_memn(const Params& p, int gw, int ngw, int lane) {
    for (int r = gw; r < 2 * MEML; r += ngw) { const int l = r >> 8, m = r & 255;
        rms_row_to_bf16(p.mem + (size_t)m * DM, p.mem_norm + l * DM, (bf16_t*)(p.ws + WS_MEMN) + ((size_t)l * MEML + m) * DM, lane); }
}
__device__ __forceinline__ void job_norm_rows(const Params& p, int mode, int gw, int ngw, int lane) {
    bf16_t* H = (bf16_t*)(p.ws + WS_H); const bf16_t* Y = (const bf16_t*)(p.ws + WS_Y);
    for (int row = gw; row < S; row += ngw) {
        if (mode == 0) { rms_row_to_bf16(p.x + (size_t)row * DM, p.norm_pre, H + (size_t)row * DM, lane); continue; }
        const float* xin = (mode == 1 ? p.x : p.out) + (size_t)row * DM; const float* gpost = p.norm_post + (mode == 1 ? 0 : DM);
        float y[16]; float ss = 0.f;
#pragma unroll
        for (int j = 0; j < 4; ++j) { const u32x2 w = *(const u32x2*)(Y + (size_t)row * DM + 256 * j + 4 * lane);
            y[4 * j] = lo_bf(w.x); y[4 * j + 1] = hi_bf(w.x); y[4 * j + 2] = lo_bf(w.y); y[4 * j + 3] = hi_bf(w.y);
            ss += (y[4 * j] * y[4 * j] + y[4 * j + 1] * y[4 * j + 1]) + (y[4 * j + 2] * y[4 * j + 2] + y[4 * j + 3] * y[4 * j + 3]); }
        const float rs = rsqrtf(wave_sum(ss) * (1.f / DM) + RMS_EPS);
        f32x4 x1[4]; float s2 = 0.f;
#pragma unroll
        for (int j = 0; j < 4; ++j) { const f32x4 xv = *(const f32x4*)(xin + 256 * j + 4 * lane); const f32x4 g = *(const f32x4*)(gpost + 256 * j + 4 * lane);
            x1[j].x = xv.x + y[4 * j] * rs * g.x; x1[j].y = xv.y + y[4 * j + 1] * rs * g.y; x1[j].z = xv.z + y[4 * j + 2] * rs * g.z; x1[j].w = xv.w + y[4 * j + 3] * rs * g.w;
            *(f32x4*)(p.out + (size_t)row * DM + 256 * j + 4 * lane) = x1[j];
            s2 += (x1[j].x * x1[j].x + x1[j].y * x1[j].y) + (x1[j].z * x1[j].z + x1[j].w * x1[j].w); }
        if (mode == 1) { const float r2 = rsqrtf(wave_sum(s2) * (1.f / DM) + RMS_EPS); const float* gpre = p.norm_pre + DM;
#pragma unroll
            for (int j = 0; j < 4; ++j) { const f32x4 g = *(const f32x4*)(gpre + 256 * j + 4 * lane);
                u32x2 w; w.x = cvtpk(x1[j].x * r2 * g.x, x1[j].y * r2 * g.y); w.y = cvtpk(x1[j].z * r2 * g.z, x1[j].w * r2 * g.w);
                *(u32x2*)(H + (size_t)row * DM + 256 * j + 4 * lane) = w; } }
    }
}
__device__ __forceinline__ void job_mla_rows(const Params& p, int l, int gw, int ngw, int lane) {
    const bf16_t* PROJ = (const bf16_t*)(p.ws + WS_PROJ); bf16_t* KV = (bf16_t*)(p.ws + WS_KVLAT); float* RSQ = (float*)(p.ws + WS_MISC + MISC_RSQ);
    const float* cosT = (const float*)(p.ws + WS_COS); const float* sinT = (const float*)(p.ws + WS_SIN);
    const int rs_ = lane >> 4, j = lane & 15;
    for (int row = gw * 4 + rs_; row < S; row += ngw * 4) {
        const bf16_t* pr = PROJ + (size_t)row * NP;
        const u32x4 q0 = *(const u32x4*)(pr + C_CQ + j * 16), q1 = *(const u32x4*)(pr + C_CQ + j * 16 + 8), kv = *(const u32x4*)(pr + C_CKV + j * 8); const u32x2 kr = *(const u32x2*)(pr + C_KR + j * 4);
        f32x4 cs = {0.f, 0.f, 0.f, 0.f}, sn = {0.f, 0.f, 0.f, 0.f}; if (j < 8) { cs = *(const f32x4*)(cosT + (size_t)row * 32 + 4 * j); sn = *(const f32x4*)(sinT + (size_t)row * 32 + 4 * j); }
        float sq = 0.f, sk = 0.f;
        { const unsigned w[8] = {q0.x, q0.y, q0.z, q0.w, q1.x, q1.y, q1.z, q1.w};
#pragma unroll
          for (int e = 0; e < 8; ++e) { const float a = lo_bf(w[e]), b = hi_bf(w[e]); sq += a * a + b * b; } }
        float kvf[8] = {lo_bf(kv.x), hi_bf(kv.x), lo_bf(kv.y), hi_bf(kv.y), lo_bf(kv.z), hi_bf(kv.z), lo_bf(kv.w), hi_bf(kv.w)};
#pragma unroll
        for (int e = 0; e < 8; ++e) sk += kvf[e] * kvf[e];
        sq = row16_sum(sq); sk = row16_sum(sk);
        if (j == 0) RSQ[row] = rsqrtf(sq * (1.f / 256.f) + RMS_EPS);
        { const float rs = rsqrtf(sk * (1.f / 128.f) + RMS_EPS); const float* g = p.kv_norm + l * 128 + j * 8; const f32x4 g0 = *(const f32x4*)g, g1 = *(const f32x4*)(g + 4);
          u32x4 w; w.x = cvtpk(kvf[0] * rs * g0[0], kvf[1] * rs * g0[1]); w.y = cvtpk(kvf[2] * rs * g0[2], kvf[3] * rs * g0[3]); w.z = cvtpk(kvf[4] * rs * g1[0], kvf[5] * rs * g1[1]); w.w = cvtpk(kvf[6] * rs * g1[2], kvf[7] * rs * g1[3]);
          *(u32x4*)(KV + (size_t)row * 192 + j * 8) = w; }
        { const unsigned px = xor8_u(kr.x), py = xor8_u(kr.y);
          if (j < 8) { const float t1[4] = {lo_bf(kr.x), hi_bf(kr.x), lo_bf(kr.y), hi_bf(kr.y)}, t2[4] = {lo_bf(px), hi_bf(px), lo_bf(py), hi_bf(py)};
              u32x4 w; w.x = cvtpk(t1[0] * cs[0] - t2[0] * sn[0], t1[0] * sn[0] + t2[0] * cs[0]); w.y = cvtpk(t1[1] * cs[1] - t2[1] * sn[1], t1[1] * sn[1] + t2[1] * cs[1]);
              w.z = cvtpk(t1[2] * cs[2] - t2[2] * sn[2], t1[2] * sn[2] + t2[2] * cs[2]); w.w = cvtpk(t1[3] * cs[3] - t2[3] * sn[3], t1[3] * sn[3] + t2[3] * cs[3]);
              *(u32x4*)(KV + (size_t)row * 192 + 128 + 8 * j) = w; } }
    }
}
__device__ __forceinline__ void job_gdn_final(const Params& p, int l, int gw, int ngw, int lane, int wid, LAS unsigned char* lds) {
    bf16_t* PROJ = (bf16_t*)(p.ws + WS_PROJ); const bf16_t* U = (const bf16_t*)(p.ws + WS_U);
    LAS bf16_t* T = (LAS bf16_t*)(lds + wid * 17408);
    for (int it = gw; it < 1024; it += ngw) {
        const int n = it >> 2, h = it & 3; const bf16_t* ut = U + (size_t)it * 8192 + lane * 4;
#pragma unroll 4
        for (int j = 0; j < 32; ++j) { const u32x2 w = *(const u32x2*)(ut + j * 256);
            const int g = j & 3, ct = (j >> 2) & 1, sl = j >> 3, dv = 32 * sl + (lane & 31), c0 = 32 * ct + 8 * g + 4 * (lane >> 5);
            T[(c0 + 0) * 136 + dv] = (bf16_t)(w.x & 0xffffu); T[(c0 + 1) * 136 + dv] = (bf16_t)(w.x >> 16); T[(c0 + 2) * 136 + dv] = (bf16_t)(w.y & 0xffffu); T[(c0 + 3) * 136 + dv] = (bf16_t)(w.y >> 16); }
        LDS_WAIT();
#pragma unroll 2
        for (int i = 0; i < 16; ++i) { const int id = lane + 64 * i, c = id >> 4, dc = id & 15;
            const u32x4 v = *(const LAS u32x4*)(T + c * 136 + dc * 8);
            float x[8] = {lo_bf(v.x), hi_bf(v.x), lo_bf(v.y), hi_bf(v.y), lo_bf(v.z), hi_bf(v.z), lo_bf(v.w), hi_bf(v.w)};
            float ss = 0.f;
#pragma unroll
            for (int e = 0; e < 8; ++e) ss += x[e] * x[e];
            ss = row16_sum(ss);
            const float rs = rsqrtf(ss * (1.f / 128.f) + RMS_EPS);
            const float* gn = p.gdn_norm + l * 128 + dc * 8; const f32x4 g0 = *(const f32x4*)gn, g1 = *(const f32x4*)(gn + 4);
            bf16_t* zp = PROJ + (size_t)(n * 64 + c) * NP + C_Z + 512 + h * 128 + dc * 8; const u32x4 z = *(const u32x4*)zp;
            u32x4 o; o.x = cvtpk(x[0] * rs * g0[0] * silu_f(lo_bf(z.x)), x[1] * rs * g0[1] * silu_f(hi_bf(z.x))); o.y = cvtpk(x[2] * rs * g0[2] * silu_f(lo_bf(z.y)), x[3] * rs * g0[3] * silu_f(hi_bf(z.y)));
            o.z = cvtpk(x[4] * rs * g1[0] * silu_f(lo_bf(z.z)), x[5] * rs * g1[1] * silu_f(hi_bf(z.z))); o.w = cvtpk(x[6] * rs * g1[2] * silu_f(lo_bf(z.w)), x[7] * rs * g1[3] * silu_f(hi_bf(z.w)));
            *(u32x4*)zp = o; }
        LDS_WAIT();
    }
}
namespace gdn {
constexpr int L_QH = 0, L_KH = 17408, L_KBGT = 34816, L_KHDT = 53248, L_VBT = 71680, L_LF = 90112, L_TF = 107520, L_MB = 124928, L_GV = 129280, L_END = 130560;
constexpr int QP = 136, TP = 72, LP = 68;
__device__ __forceinline__ bf16_t* frag_ptr(bf16_t* PROJ, int n, int h, int f, int lane) {
    const int seg = 4 * f + (lane >> 4), part = seg >> 6, row = seg & 63;
    return PROJ + (size_t)(n * 64 + row) * NP + C_BQKV + part * 512 + h * 128 + (lane & 15) * 8;
}
__device__ __forceinline__ bf16x8 pack8f(const LAS float* q) { const f32x4 a = *(const LAS f32x4*)q, b = *(const LAS f32x4*)(q + 4); u32x4 w = {cvtpk(a[0], a[1]), cvtpk(a[2], a[3]), cvtpk(b[0], b[1]), cvtpk(b[2], b[3])}; return __builtin_bit_cast(bf16x8, w); }
__device__ __forceinline__ void prep_item(const Params& p, int l, int n, int h, LAS unsigned char* lds) {
    const int tid = tidx(), lane = tid & 63, r32 = lane & 31, hi = lane >> 5, wid = __builtin_amdgcn_readfirstlane(tid >> 6);
    bf16_t* PROJ = (bf16_t*)(p.ws + WS_PROJ); const bf16_t* HALO = (const bf16_t*)(p.ws + WS_HALO);
    bf16_t* AQKg = (bf16_t*)(p.ws + WS_AQK); bf16_t* Ug = (bf16_t*)(p.ws + WS_U); float* EGL = (float*)(p.ws + WS_MISC + MISC_EGL);
    LAS bf16_t* QH = (LAS bf16_t*)(lds + L_QH); LAS bf16_t* KH = (LAS bf16_t*)(lds + L_KH); LAS bf16_t* KBGT = (LAS bf16_t*)(lds + L_KBGT);
    LAS bf16_t* KHDT = (LAS bf16_t*)(lds + L_KHDT); LAS bf16_t* VBT = (LAS bf16_t*)(lds + L_VBT); LAS float* LF = (LAS float*)(lds + L_LF);
    LAS float* TF = (LAS float*)(lds + L_TF); LAS float* MB = (LAS float*)(lds + L_MB); LAS float* GC = (LAS float*)(lds + L_GV); LAS float* BETA = GC + 64; LAS float* EGC = GC + 128; LAS float* EGD = GC + 192;
    const int t0 = n * 64;
    const int g16 = tid & 15, row0 = tid >> 4;
#define S2_LOAD(part, XA, XB, WA, WB) do { const int cb_ = (part) * 512 + h * 128 + g16 * 8; \
        _Pragma("unroll") for (int j = 0; j < 4; ++j) { const int ta_ = t0 + row0 - 3 + j; XA[j] = (u32x4){0u, 0u, 0u, 0u}; \
            if (ta_ >= t0) XA[j] = *(const u32x4*)(PROJ + (size_t)ta_ * NP + C_BQKV + cb_); else if (n > 0) XA[j] = *(const u32x4*)(HALO + ((size_t)(n - 1) * 3 + (ta_ - (t0 - 3))) * 1536 + cb_); \
            XB[j] = *(const u32x4*)(PROJ + (size_t)(t0 + row0 + 29 + j) * NP + C_BQKV + cb_); \
            const float* cw_ = p.conv_w + ((size_t)l * 4 + j) * 1536 + cb_; WA[j] = *(const f32x4*)cw_; WB[j] = *(const f32x4*)(cw_ + 4); } } while (0)
    u32x4 xa[4], xb[4]; f32x4 wa[4], wb[4];
    S2_LOAD(0, xa, xb, wa, wb);
    __syncthreads();
    if (wid == 0) {
        const bf16_t* pr = PROJ + (size_t)(t0 + lane) * NP;
        const float xa_ = bf2f(pr[C_BA + h]) + p.dt_bias[l * 4 + h], xb_ = bf2f(pr[C_BB + h]);
        const float e = __expf(xa_); const float sp = xa_ > 20.f ? xa_ : (e < 1e-3f ? e * (1.f - e * (0.5f - e * (1.f / 3.f))) : logf(1.f + e));
        float gc = -__expf(p.a_log[l * 4 + h]) * sp;
#pragma unroll
        for (int o = 1; o < 64; o <<= 1) { const float t_ = __int_as_float(__builtin_amdgcn_ds_bpermute((lane - o) << 2, __float_as_int(gc))); if (lane >= o) gc += t_; }
        const float gl = __int_as_float(__builtin_amdgcn_readlane(__float_as_int(gc), 63));
        GC[lane] = gc; BETA[lane] = 1.f / (1.f + __expf(-xb_)); EGC[lane] = __expf(gc); EGD[lane] = __expf(gl - gc);
        if (lane == 0) EGL[n * 4 + h] = __expf(gl);
    }
    __syncthreads();
#define TSW(dk, j) ((dk) * 64 + (((((j) >> 3) ^ (((dk) >> 3) & 7)) << 3) | ((j) & 7)))
#define S2_ITEM(part, X, W0, W1, row) do { float a[8] = {0.f, 0.f, 0.f, 0.f, 0.f, 0.f, 0.f, 0.f}; \
        _Pragma("unroll") for (int j = 0; j < 4; ++j) { a[0] = fmaf(W0[j][0], lo_bf(X[j].x), a[0]); a[1] = fmaf(W0[j][1], hi_bf(X[j].x), a[1]); a[2] = fmaf(W0[j][2], lo_bf(X[j].y), a[2]); a[3] = fmaf(W0[j][3], hi_bf(X[j].y), a[3]); \
            a[4] = fmaf(W1[j][0], lo_bf(X[j].z), a[4]); a[5] = fmaf(W1[j][1], hi_bf(X[j].z), a[5]); a[6] = fmaf(W1[j][2], lo_bf(X[j].w), a[6]); a[7] = fmaf(W1[j][3], hi_bf(X[j].w), a[7]); } \
        float ss = 0.f; _Pragma("unroll") for (int e = 0; e < 8; ++e) { a[e] = silu_f(a[e]); ss += a[e] * a[e]; } \
        ss = row16_sum(ss); const float rn = rsqrtf(ss + 1e-6f); \
        if ((part) == 0) { const float sc = rn * 0.08838834764831845f; _Pragma("unroll") for (int e = 0; e < 8; ++e) a[e] *= sc; *(LAS bf16x8*)(QH + (row) * QP + g16 * 8) = pack8(a); } \
        else if ((part) == 1) { _Pragma("unroll") for (int e = 0; e < 8; ++e) a[e] *= rn; *(LAS bf16x8*)(KH + (row) * QP + g16 * 8) = pack8(a); const float s1 = BETA[row] * EGC[row], s2 = EGD[row]; \
            _Pragma("unroll") for (int e = 0; e < 8; ++e) { KBGT[TSW(g16 * 8 + e, row)] = f2bf(a[e] * s1); KHDT[TSW(g16 * 8 + e, row)] = f2bf(a[e] * s2); } } \
        else { const float b = BETA[row]; _Pragma("unroll") for (int e = 0; e < 8; ++e) VBT[TSW(g16 * 8 + e, row)] = f2bf(a[e] * b); } } while (0)
#ifdef EXP_DUPS2
#pragma unroll 1
    for (int rep_ = 0; rep_ < 2; ++rep_)
#endif
    { u32x4 ya[4], yb[4]; f32x4 va[4], vb[4];
      S2_LOAD(1, ya, yb, va, vb);
      S2_ITEM(0, xa, wa, wb, row0); S2_ITEM(0, xb, wa, wb, row0 + 32);
      S2_LOAD(2, xa, xb, wa, wb);
      S2_ITEM(1, ya, va, vb, row0); S2_ITEM(1, yb, va, vb, row0 + 32);
      S2_ITEM(2, xa, wa, wb, row0); S2_ITEM(2, xb, wa, wb, row0 + 32); }
#undef S2_LOAD
#undef S2_ITEM
    __syncthreads();
    if (wid < 3) { const int it = wid > 0, jt = wid > 1; f32x16 acc = {};
#pragma unroll
        for (int ks = 0; ks < 8; ++ks) { const bf16x8 a = *(const LAS bf16x8*)(KH + (32 * it + r32) * QP + 16 * ks + 8 * hi), b = *(const LAS bf16x8*)(KH + (32 * jt + r32) * QP + 16 * ks + 8 * hi);
            acc = MFMA32(a, b, acc); }
        const int j = 32 * jt + r32; const float gj = GC[j];
#pragma unroll
        for (int r = 0; r < 16; ++r) { const int i = 32 * it + crow(r, hi); LF[i * LP + j] = i > j ? BETA[i] * __expf(GC[i] - gj) * acc[r] : 0.f; }
    } else if (wid < 6) { const int w = wid - 3, ctp = w > 1, ct = w > 0; f32x16 acc = {};
#pragma unroll
        for (int ks = 0; ks < 8; ++ks) { const bf16x8 a = *(const LAS bf16x8*)(KH + (32 * ctp + r32) * QP + 16 * ks + 8 * hi), b = *(const LAS bf16x8*)(QH + (32 * ct + r32) * QP + 16 * ks + 8 * hi);
            acc = MFMA32(a, b, acc); }
        const int c = 32 * ct + r32; const float gcq = GC[c];
#pragma unroll
        for (int r = 0; r < 16; ++r) { const int cp = 32 * ctp + crow(r, hi); acc[r] = c >= cp ? acc[r] * __expf(gcq - GC[cp]) : 0.f; }
        bf16_t* dst = AQKg + (((size_t)(n * 4 + h) * 8 + (ct * 2 + ctp) * 2) * 64 + lane) * 8;
        *(bf16x8*)dst = pack_step(acc, 0); *(bf16x8*)(dst + 512) = pack_step(acc, 1);
    } else { const int w = wid - 6;
        if (w == 0) { const bf16x8 z = {0, 0, 0, 0, 0, 0, 0, 0}; bf16_t* dst = AQKg + (((size_t)(n * 4 + h) * 8 + 2) * 64 + lane) * 8; *(bf16x8*)dst = z; *(bf16x8*)(dst + 512) = z; }
#pragma unroll
        for (int ff = 0; ff < 8; ++ff) { const int f = w * 8 + ff, s = f & 1, mt = (f >> 1) & 3, ct = f >> 3, c = 32 * ct + r32, d0 = 32 * mt + 16 * s + 4 * hi; const float eg = EGC[c];
            const u32x2 lo = *(const LAS u32x2*)(QH + c * QP + d0), hw = *(const LAS u32x2*)(QH + c * QP + d0 + 8);
            u32x4 o; o.x = cvtpk(lo_bf(lo.x) * eg, hi_bf(lo.x) * eg); o.y = cvtpk(lo_bf(lo.y) * eg, hi_bf(lo.y) * eg); o.z = cvtpk(lo_bf(hw.x) * eg, hi_bf(hw.x) * eg); o.w = cvtpk(lo_bf(hw.y) * eg, hi_bf(hw.y) * eg);
            *(u32x4*)frag_ptr(PROJ, n, h, 16 + f, lane) = o; }
    }
    __syncthreads();
    if (wid == 0) {
#ifdef EXP_DUPS4
#pragma unroll 1
      for (int rep_ = 0; rep_ < 2; ++rep_)
#endif
      {
        unsigned lfb = (unsigned)(uintptr_t)LF, tfb = (unsigned)(uintptr_t)TF, mbb = (unsigned)(uintptr_t)MB; asm volatile("" : "+v"(lfb), "+v"(tfb), "+v"(mbb));
        const LAS float* LFv = (const LAS float*)(uintptr_t)lfb; LAS float* TFv = (LAS float*)(uintptr_t)tfb; LAS float* MBv = (LAS float*)(uintptr_t)mbb;
        { const int b = lane >> 4, c = lane & 15; const LAS float* Lb = LFv + (16 * b) * LP + 16 * b; LAS float* Tb = TFv + (16 * b) * LP + 16 * b + c; float t[16];
#pragma unroll
          for (int i = 0; i < 16; ++i) { float a0 = (c == i) ? 1.f : 0.f, a1 = 0.f;
#pragma unroll
              for (int q = 0; 4 * q < i; ++q) { const f32x4 lv = *(const LAS f32x4*)(Lb + i * LP + 4 * q);
#pragma unroll
                  for (int e = 0; e < 4; ++e) if (4 * q + e < i) { if (e & 1) a1 = fmaf(-lv[e], t[4 * q + e], a1); else a0 = fmaf(-lv[e], t[4 * q + e], a0); } }
              t[i] = a0 + a1; Tb[i * LP] = t[i]; } }
        const int r16 = lane & 15, k4 = lane >> 4;
#define BLK(P, b_, a_) ((P) + (16 * (b_)) * LP + 16 * (a_))
#define MM16(acc, X, Y) do { _Pragma("unroll") for (int ks = 0; ks < 4; ++ks) acc = __builtin_amdgcn_mfma_f32_16x16x4f32((X)[r16 * LP + 4 * ks + k4], (Y)[(4 * ks + k4) * LP + r16], acc, 0, 0, 0); } while (0)
#define ST16(Z, acc, sg) do { _Pragma("unroll") for (int r = 0; r < 4; ++r) (Z)[(4 * k4 + r) * LP + r16] = (sg) * acc[r]; } while (0)
#define TBLK(b_, a_, SUM) do { f32x4 m_ = {0.f, 0.f, 0.f, 0.f}; SUM; ST16(MBv, m_, 1.f); f32x4 t_ = {0.f, 0.f, 0.f, 0.f}; MM16(t_, BLK(TFv, b_, b_), MBv); ST16(BLK(TFv, b_, a_), t_, -1.f); } while (0)
        TBLK(1, 0, MM16(m_, BLK(LFv, 1, 0), BLK(TFv, 0, 0)));
        TBLK(2, 1, MM16(m_, BLK(LFv, 2, 1), BLK(TFv, 1, 1)));
        TBLK(3, 2, MM16(m_, BLK(LFv, 3, 2), BLK(TFv, 2, 2)));
        TBLK(2, 0, MM16(m_, BLK(LFv, 2, 0), BLK(TFv, 0, 0)); MM16(m_, BLK(LFv, 2, 1), BLK(TFv, 1, 0)));
        TBLK(3, 1, MM16(m_, BLK(LFv, 3, 1), BLK(TFv, 1, 1)); MM16(m_, BLK(LFv, 3, 2), BLK(TFv, 2, 1)));
        TBLK(3, 0, MM16(m_, BLK(LFv, 3, 0), BLK(TFv, 0, 0)); MM16(m_, BLK(LFv, 3, 1), BLK(TFv, 1, 0)); MM16(m_, BLK(LFv, 3, 2), BLK(TFv, 2, 0)));
#undef BLK
#undef MM16
#undef ST16
#undef TBLK
      }
    } else {
        if (wid == 1) {
#pragma unroll
            for (int i = 0; i < 24; ++i) { const int id = lane + 64 * i, blk = id >> 8, rr = (id >> 4) & 15, cc = id & 15;
                const int b = blk < 3 ? 0 : (blk < 5 ? 1 : 2), a = blk < 3 ? blk + 1 : (blk < 5 ? blk - 1 : 3);
                TF[(16 * b + rr) * LP + 16 * a + cc] = 0.f; }
        }
        for (int f = wid - 1; f < 16; f += 7) { const int s = f & 1, ctp = (f >> 1) & 1, mt = f >> 2, dk = 32 * mt + r32, c0 = 32 * ctp + 16 * s + 4 * hi;
            const u32x2 lo = *(const LAS u32x2*)(KHDT + TSW(dk, c0)), hw = *(const LAS u32x2*)(KHDT + TSW(dk, c0 + 8));
            u32x4 o = {lo.x, lo.y, hw.x, hw.y}; *(u32x4*)frag_ptr(PROJ, n, h, 32 + f, lane) = o; }
    }
    __syncthreads();
    { const int mt = wid >> 1, ct = wid & 1; f32x16 acc = {};
#pragma unroll
      for (int ks = 0; ks < 4; ++ks) { const bf16x8 a = *(const LAS bf16x8*)(KBGT + TSW(32 * mt + r32, 16 * ks + 8 * hi)), b = pack8f(TF + (32 * ct + r32) * LP + 16 * ks + 8 * hi);
          acc = MFMA32(a, b, acc); }
#pragma unroll
      for (int r = 0; r < 16; ++r) acc[r] = -acc[r];
      *(bf16x8*)frag_ptr(PROJ, n, h, (ct * 4 + mt) * 2, lane) = pack_step(acc, 0); *(bf16x8*)frag_ptr(PROJ, n, h, (ct * 4 + mt) * 2 + 1, lane) = pack_step(acc, 1); }
    { const int ct = wid >> 2, dt = wid & 3; f32x16 acc = {};
#pragma unroll
      for (int ks = 0; ks < 4; ++ks) { const bf16x8 a = pack8f(TF + (32 * ct + r32) * LP + 16 * ks + 8 * hi), b = *(const LAS bf16x8*)(VBT + TSW(32 * dt + r32, 16 * ks + 8 * hi));
          acc = MFMA32(a, b, acc); }
      bf16_t* up = Ug + (size_t)(n * 4 + h) * 8192 + (size_t)((dt * 2 + ct) * 4) * 256 + lane * 4;
#pragma unroll
      for (int g = 0; g < 4; ++g) { u32x2 w; w.x = cvtpk(acc[4 * g], acc[4 * g + 1]); w.y = cvtpk(acc[4 * g + 2], acc[4 * g + 3]); *(u32x2*)(up + g * 256) = w; } }
}
constexpr int SCAN_STAGE = 65536, SCAN_U = 57344, SCAN_EGL = 131072, SCAN_NP = 16;
__device__ __forceinline__ const u32x4* scan_src(const bf16_t* PROJ, const bf16_t* AQKg, const bf16_t* Ug, int n, int h, int half, int k, int ll) {
    if (k < 12) { const int piece = k * 256 + ll; return (const u32x4*)frag_ptr((bf16_t*)PROJ, n, h, piece >> 6, piece & 63); }
    if (k < 14) return (const u32x4*)(AQKg + ((size_t)(n * 4 + h) * 512 + (k - 12) * 256 + ll) * 8);
    return (const u32x4*)(Ug + (size_t)(n * 4 + h) * 8192 + half * 4096 + (size_t)((k - 14) * 256 + ll) * 8);
}
constexpr int SCAN_XCH = 131584, SCAN_XCH_SLICE = 12288;
template <int ROLE>
__device__ __forceinline__ void scan_compute(LAS unsigned char* lds, bf16_t* ub  , int sp, int lane) {
    constexpr int NCH = S / 64;
    LAS unsigned char* xs = lds + SCAN_XCH + sp * SCAN_XCH_SLICE + lane * 16;
    LAS unsigned char* xv = xs + 8192;
    f32x16 St[2] = {};
    bf16x8 Sb[4][2];
#pragma unroll
    for (int mt = 0; mt < 4; ++mt) { Sb[mt][0] = (bf16x8){0, 0, 0, 0, 0, 0, 0, 0}; Sb[mt][1] = Sb[mt][0]; }
    __syncthreads();
#ifdef EXP_SCANSEC
    unsigned long long acc_s[4] = {0, 0, 0, 0}, tm_ = __builtin_amdgcn_s_memrealtime();
#define SEC(i) do { const unsigned long long t_ = __builtin_amdgcn_s_memrealtime(); acc_s[i] += t_ - tm_; tm_ = t_; } while (0)
#else
#define SEC(i)
#endif
#pragma unroll 1
    for (int n = 0; n < NCH; ++n) {
        const LAS unsigned char* stg = lds + (n & 1) * SCAN_STAGE + lane * 16;
        const LAS unsigned char* us = lds + (n & 1) * SCAN_STAGE + SCAN_U + (sp * 8 + ROLE * 4) * 512 + lane * 8;
        const float egl = *(const LAS float*)(lds + SCAN_EGL + (n & 1) * 4);
        f32x16 vn, o = {};
#pragma unroll
        for (int g = 0; g < 4; ++g) { const u32x2 w = *(const LAS u32x2*)(us + g * 512); vn[4 * g] = lo_bf(w.x); vn[4 * g + 1] = hi_bf(w.x); vn[4 * g + 2] = lo_bf(w.y); vn[4 * g + 3] = hi_bf(w.y); }
        if (n > 0) {
#pragma unroll
            for (int j = 0; j < 2; ++j) { Sb[2 * (1 - ROLE) + j][0] = *(const LAS bf16x8*)(xs + ((2 * (1 - ROLE) + j) * 2) * 1024); Sb[2 * (1 - ROLE) + j][1] = *(const LAS bf16x8*)(xs + ((2 * (1 - ROLE) + j) * 2 + 1) * 1024); }
        }
#define FR(f) (*(const LAS bf16x8*)(stg + (f) * 1024))
#define RD1(B, mt) do { const int f_ = (ROLE * 4 + (mt)) * 2; B[0] = FR(f_); B[1] = FR(f_ + 1); B[2] = FR(16 + f_); B[3] = FR(16 + f_ + 1); } while (0)
#define MM1(B, mt) do { vn = MFMA32(B[0], Sb[mt][0], vn); o = MFMA32(B[2], Sb[mt][0], o); vn = MFMA32(B[1], Sb[mt][1], vn); o = MFMA32(B[3], Sb[mt][1], o); } while (0)
        bf16x8 fa[4], fb[4];
        RD1(fa, 0); RD1(fb, 1); SBAR();
        MM1(fa, 0); SBAR(); RD1(fa, 2); SBAR();
        MM1(fb, 1); SBAR(); RD1(fb, 3); SBAR();
        MM1(fa, 2); SBAR();
        bf16x8 kd[2][4];
#pragma unroll
        for (int j = 0; j < 2; ++j)
#pragma unroll
            for (int q = 0; q < 4; ++q) kd[j][q] = FR(32 + ((2 * ROLE + j) * 2) * 2 + q);
        SBAR(); MM1(fb, 3); SBAR();
#pragma unroll
        for (int j = 0; j < 2; ++j)
#pragma unroll
            for (int r = 0; r < 16; ++r) St[j][r] *= egl;
        bf16x8 Vb[2][2];
        Vb[ROLE][0] = pack_step(vn, 0); Vb[ROLE][1] = pack_step(vn, 1);
        *(LAS bf16x8*)(xv + (ROLE * 2) * 1024) = Vb[ROLE][0]; *(LAS bf16x8*)(xv + (ROLE * 2 + 1) * 1024) = Vb[ROLE][1];
        bf16x8 aq[4];
        if (ROLE == 0) { aq[0] = FR(48); aq[1] = FR(49); } else { aq[0] = FR(52); aq[1] = FR(53); aq[2] = FR(54); aq[3] = FR(55); }
        SEC(0);
        __syncthreads();
        SEC(1);
        Vb[1 - ROLE][0] = *(const LAS bf16x8*)(xv + ((1 - ROLE) * 2) * 1024); Vb[1 - ROLE][1] = *(const LAS bf16x8*)(xv + ((1 - ROLE) * 2 + 1) * 1024);
#pragma unroll
        for (int ctp = 0; ctp < 2; ++ctp)
#pragma unroll
            for (int s = 0; s < 2; ++s) {
                St[0] = MFMA32(kd[0][ctp * 2 + s], Vb[ctp][s], St[0]); St[1] = MFMA32(kd[1][ctp * 2 + s], Vb[ctp][s], St[1]);
                if (ROLE == 1) o = MFMA32(aq[ctp * 2 + s], Vb[ctp][s], o); else if (ctp == 0) o = MFMA32(aq[s], Vb[0][s], o);
            }
        { bf16_t* uc = ub + (size_t)n * (4 * 8192);
#pragma unroll
          for (int g = 0; g < 4; ++g) { u32x2 w; w.x = cvtpk(o[4 * g], o[4 * g + 1]); w.y = cvtpk(o[4 * g + 2], o[4 * g + 3]); *(u32x2*)(uc + g * 256) = w; } }
#pragma unroll
        for (int j = 0; j < 2; ++j) { Sb[2 * ROLE + j][0] = pack_step(St[j], 0); Sb[2 * ROLE + j][1] = pack_step(St[j], 1);
            *(LAS bf16x8*)(xs + ((2 * ROLE + j) * 2) * 1024) = Sb[2 * ROLE + j][0]; *(LAS bf16x8*)(xs + ((2 * ROLE + j) * 2 + 1) * 1024) = Sb[2 * ROLE + j][1]; }
#undef FR
#undef RD1
#undef MM1
        SEC(2);
        __syncthreads();
        SEC(3);
    }
#ifdef EXP_SCANSEC
    { const unsigned long long t1_ = __builtin_amdgcn_s_memrealtime(); while (__builtin_amdgcn_s_memrealtime() - t1_ < 4 * acc_s[EXP_SCANSEC]) __builtin_amdgcn_s_sleep(8); }
#endif
#undef SEC
}
__device__ __forceinline__ void scan_wg(const Params& p, int h, int half, LAS unsigned char* lds) {
    const int tid = tidx(), lane = tid & 63, wid = __builtin_amdgcn_readfirstlane(tid >> 6);
    const bf16_t* PROJ = (const bf16_t*)(p.ws + WS_PROJ); const bf16_t* AQKg = (const bf16_t*)(p.ws + WS_AQK); bf16_t* Ug = (bf16_t*)(p.ws + WS_U); const float* EGL = (const float*)(p.ws + WS_MISC + MISC_EGL);
    constexpr int NCH = S / 64;
    __syncthreads();
    if (wid >= 4) {
        const int ll = tid - 256; u32x4 sa[SCAN_NP], sb[SCAN_NP]; float ea, eb;
        const char* pf0 = (const char*)(PROJ + (size_t)(ll >> 4) * NP + C_BQKV + h * 128 + (ll & 15) * 8); const char* pa0 = (const char*)(AQKg + ((size_t)h * 512 + ll) * 8); const char* pu0 = (const char*)(Ug + (size_t)h * 8192 + half * 4096 + (size_t)ll * 8);
#define LD_H0(R, n_) do { const char* pf_ = pf0 + (size_t)(n_) * (64 * NP * 2); SBAR(); _Pragma("unroll") for (int k = 0; k < 8; ++k) R[k] = *(const u32x4*)(pf_ + (size_t)(k & 3) * (16 * NP * 2) + (k >> 2) * 1024); SBAR(); } while (0)
#define LD_H1(R, E, n_) do { E = EGL[(n_) * 4 + h]; const char* pf_ = pf0 + (size_t)(n_) * (64 * NP * 2); const char* pa_ = pa0 + (size_t)(n_) * (4 * 512 * 16); const char* pu_ = pu0 + (size_t)(n_) * (4 * 8192 * 2); SBAR(); \
        _Pragma("unroll") for (int k = 8; k < 12; ++k) R[k] = *(const u32x4*)(pf_ + (size_t)(k & 3) * (16 * NP * 2) + (k >> 2) * 1024); SBAR(); \
        R[12] = *(const u32x4*)pa_; R[13] = *(const u32x4*)(pa_ + 4096); R[14] = *(const u32x4*)pu_; R[15] = *(const u32x4*)(pu_ + 4096); SBAR(); } while (0)
#define WR_H0(R, n_) do { _Pragma("unroll") for (int k = 0; k < 8; ++k) *(LAS u32x4*)(lds + ((n_) & 1) * SCAN_STAGE + (k * 256 + ll) * 16) = R[k]; } while (0)
#define WR_H1(R, E, n_) do { *(LAS float*)(lds + SCAN_EGL + ((n_) & 1) * 4) = E; _Pragma("unroll") for (int k = 8; k < SCAN_NP; ++k) *(LAS u32x4*)(lds + ((n_) & 1) * SCAN_STAGE + (k * 256 + ll) * 16) = R[k]; } while (0)
#define LSTEP(R, E, n_) do { WR_H0(R, (n_) + 1); if ((n_) + 3 < NCH) LD_H0(R, (n_) + 3); __syncthreads(); WR_H1(R, E, (n_) + 1); if ((n_) + 3 < NCH) LD_H1(R, E, (n_) + 3); __syncthreads(); } while (0)
        LD_H0(sa, 0); LD_H1(sa, ea, 0); WR_H0(sa, 0); WR_H1(sa, ea, 0); LD_H0(sa, 1); LD_H1(sa, ea, 1); LD_H0(sb, 2); LD_H1(sb, eb, 2);
        __syncthreads();
#pragma unroll 1
        for (int n = 0; n < NCH - 2; n += 2) { LSTEP(sa, ea, n); LSTEP(sb, eb, n + 1); }
        WR_H0(sa, NCH - 1); __syncthreads(); WR_H1(sa, ea, NCH - 1); __syncthreads();
        __syncthreads(); __syncthreads();
#undef LSTEP
#undef LD_H0
#undef LD_H1
#undef WR_H0
#undef WR_H1
    } else {
        const int sp = wid >> 1, role = wid & 1, sl = 2 * half + sp;
        bf16_t* ub = Ug + (size_t)h * 8192 + (size_t)(sl * 8 + role * 4) * 256 + lane * 4;
        if (role == 0) scan_compute<0>(lds, ub, sp, lane); else scan_compute<1>(lds, ub, sp, lane);
    }
}
}
typedef __attribute__((address_space(1))) unsigned gu32;
#define XB_TMO      128
#define XB_XCNT(j)  (256  + 64 * (j))
#define XB_XSUB(j)  (1280 + 64 * (j))
#define XB_XGEN(j)  (2304 + 64 * (j))
#define XB_TOP      3328
#define XB_TOPGEN   3392
#define XCD_BAR_WORDS 3456
#define XB_SPIN_CAP (1u << 18)

__device__ __forceinline__ unsigned xb_ld(unsigned* p)              { return __hip_atomic_load(p, __ATOMIC_RELAXED, __HIP_MEMORY_SCOPE_AGENT); }
__device__ __forceinline__ unsigned xb_add(unsigned* p, unsigned v) { return __hip_atomic_fetch_add(p, v, __ATOMIC_RELAXED, __HIP_MEMORY_SCOPE_AGENT); }
__device__ __forceinline__ unsigned xb_xcc_id() { return (unsigned)__builtin_amdgcn_s_getreg((3 << 11) | 20) & 0xFu; }
#define XB_SPIN(cond, bar) do { unsigned _sp = 0; while (cond) { __builtin_amdgcn_s_sleep(1); \
    if ((++_sp & 255u) == 0u) { if (xb_ld(&(bar)[XB_TMO])) break; if (_sp > XB_SPIN_CAP) { atomicAdd(&(bar)[XB_TMO], 1u); break; } } } } while (0)

struct XcdBarrier {
    unsigned* bar; unsigned x;
    volatile LAS unsigned* st;
};

__device__ __forceinline__ XcdBarrier xcd_barrier_post(unsigned* bar, volatile LAS unsigned* st) {
    XcdBarrier b; b.bar = bar; b.x = xb_xcc_id(); b.st = st;
    if (tidx() == 0) (void)xb_add(&bar[XB_XCNT(b.x)], 1u);
    return b;
}
__device__ __forceinline__ void xcd_barrier_complete(unsigned* bar, unsigned x, unsigned& nloc, unsigned& nx) {
    const unsigned G = gridDim.x * gridDim.y * gridDim.z;
    unsigned sum, cnt, mine, sp = 0u;
    for (;;) {
        sum = 0u; cnt = 0u; mine = 0u;
#pragma unroll
        for (unsigned j = 0; j < 16; ++j) { const unsigned c = xb_ld(&bar[XB_XCNT(j)]); sum += c; cnt += (c > 0u) ? 1u : 0u; mine = (j == x) ? c : mine; }
        if (sum == G) break;
        __builtin_amdgcn_s_sleep(1);
        if ((++sp & 255u) == 0u) { if (xb_ld(&bar[XB_TMO])) break; if (sp > XB_SPIN_CAP) { atomicAdd(&bar[XB_TMO], 1u); break; } }
    }
    nloc = mine > 0u ? mine : 1u; nx = cnt > 0u ? cnt : 1u;
}

__device__ __forceinline__ void xcd_barrier(const XcdBarrier& b) {
    asm volatile("s_waitcnt vmcnt(0)" ::: "memory");
    __syncthreads();
    if (tidx() == 0) {
        unsigned* bar = b.bar;
        __builtin_amdgcn_s_waitcnt(0);
        unsigned nloc = b.st[0], nx = b.st[1];
        if (nloc == 0u) { xcd_barrier_complete(bar, b.x, nloc, nx); b.st[0] = nloc; b.st[1] = nx; }
        const unsigned old = xb_add(&bar[XB_XSUB(b.x)], 1u);
        const unsigned gen = old / nloc;
        if (old + 1u == (gen + 1u) * nloc) {
            __builtin_amdgcn_fence(__ATOMIC_RELEASE, "agent");
            asm volatile("s_waitcnt vmcnt(0)" ::: "memory");
            const unsigned og = xb_add(&bar[XB_TOP], 1u);
            const unsigned tg = og / nx;
            if (og + 1u == (tg + 1u) * nx) xb_add(&bar[XB_TOPGEN], 1u);
            else XB_SPIN(xb_ld(&bar[XB_TOPGEN]) == tg, bar);
            __builtin_amdgcn_fence(__ATOMIC_ACQUIRE, "agent");
            xb_add(&bar[XB_XGEN(b.x)], 1u);
            asm volatile("s_waitcnt vmcnt(0)" ::: "memory");
        } else {
            XB_SPIN(xb_ld(&bar[XB_XGEN(b.x)]) == gen, bar);
            __builtin_amdgcn_fence(__ATOMIC_ACQUIRE, "agent");
            asm volatile("s_waitcnt vmcnt(0)" ::: "memory");
        }
    }
    __syncthreads();
}


constexpr int N_PHASES = 2 + 7 * DEPTH;
constexpr int SCAN_WGS = 8;
constexpr float QSCALE = 0.07216878364870322f * LOG2E;

__device__ __forceinline__ void sub_barrier(unsigned* ctr, unsigned expected, bool arrive) {
    asm volatile("s_waitcnt vmcnt(0)" ::: "memory"); __syncthreads();
    if (tidx() == 0) {
        if (arrive) { __builtin_amdgcn_fence(__ATOMIC_RELEASE, "agent"); asm volatile("s_waitcnt vmcnt(0)" ::: "memory"); (void)__hip_atomic_fetch_add(ctr, 1u, __ATOMIC_RELAXED, __HIP_MEMORY_SCOPE_AGENT); }
        unsigned sp = 0; while (__hip_atomic_load(ctr, __ATOMIC_RELAXED, __HIP_MEMORY_SCOPE_AGENT) < expected) { __builtin_amdgcn_s_sleep(2); if (++sp > (1u << 22)) break; }
        __builtin_amdgcn_fence(__ATOMIC_ACQUIRE, "agent"); asm volatile("s_waitcnt vmcnt(0)" ::: "memory");
    }
    __syncthreads();
}
template <int KIND> __device__ __forceinline__ void run_kind(const Params& p_, int l, LAS unsigned char* lds) {
    Params p = p_;
    { unsigned long long w_ = (unsigned long long)p.ws; asm volatile("" : "+s"(w_)); p.ws = (unsigned char*)(__attribute__((address_space(1))) unsigned char*)w_; }
    const int tid = tidx(), lane = tid & 63, wid = __builtin_amdgcn_readfirstlane(tid >> 6);
    const int bid = bidx(), nblk = gridDim.x, gw = bid * 8 + wid, ngw = nblk * 8, gtid = bid * NT_THREADS + tid, gn = nblk * NT_THREADS;
    bf16_t* PROJ = (bf16_t*)(p.ws + WS_PROJ);
    if constexpr (KIND == 0) {
        job_win(p, 0, gw, ngw, lds, wid, lane); job_wout(p, 0, gw, ngw, lds, wid, lane); job_wmem(p, gw, ngw, lds, wid, lane);
        job_wq(p, bid, nblk, gtid, gn, lds); job_wuv(p, gtid, gn); job_rope(p, gtid, gn); job_btab(p, gtid, gn); job_memn(p, gw, ngw, lane);
        job_norm_rows(p, 0, gw, ngw, lane);
    } else if constexpr (KIND == 2) {
        { pg8::Gemm g{(const bf16_t*)(p.ws + WS_H), (const bf16_t*)(p.ws + WS_WIN), S, NP, DM, DM};
          pg8::StaticOrder so; so.init(S, NP, nblk, bid);
          pg8::EpiStore E{PROJ, NP, (bf16_t*)(p.ws + WS_HALO)};
          pg8::gemm_phase<pg8::EpiStore, pg8::StaticOrder, true, true>(lds, g, so, E); }
        if (l == 0) {
            for (int ll = 0; ll < 2; ++ll) {
                pg8::Gemm g{(const bf16_t*)(p.ws + WS_MEMN) + (size_t)ll * MEML * DM, (const bf16_t*)(p.ws + WS_WMEM) + (size_t)ll * DM * DM, MEML, DM, DM, DM};
                pg8::StaticOrder so; so.init(MEML, DM, nblk, (bid + 8 - 4 * ll) % nblk);
                pg8::EpiStore E{(bf16_t*)(p.ws + WS_MEMKV) + (size_t)ll * MEML * DM, DM, nullptr};
                pg8::gemm_phase<pg8::EpiStore, pg8::StaticOrder, true, true>(lds, g, so, E);
            }
        }
    } else if constexpr (KIND == 3) {
        for (int it = bid; it < 1024; it += nblk) gdn::prep_item(p, l, it >> 2, it & 3, lds);
    } else if constexpr (KIND == 5) {
        unsigned* rdy = (unsigned*)(p.ws + WS_CTL) + 64 * (9 + l);
        const bool is_scan = (bid & ~8) < 4;
#ifdef EXP_SPINSCAN
        if (is_scan) { const unsigned long long t0_ = __builtin_amdgcn_s_memrealtime(); gdn::scan_wg(p, bid & 3, bid >> 3, lds); const unsigned long long t1_ = __builtin_amdgcn_s_memrealtime();
            while (__builtin_amdgcn_s_memrealtime() - t1_ < 4 * (t1_ - t0_)) __builtin_amdgcn_s_sleep(8); }
#else
        if (is_scan) gdn::scan_wg(p, bid & 3, bid >> 3, lds);
#endif
        else { const int vb = bid < 8 ? bid - 4 : bid - 8, nb = nblk - SCAN_WGS;
#ifdef EXP_SPINPRE
            const unsigned long long t0_ = __builtin_amdgcn_s_memrealtime();
#endif
            { pg8::Gemm g{PROJ + C_CQ, (const bf16_t*)(p.ws + WS_WQ) + (size_t)l * 768 * 256, S, 768, 256, NP};
              pg8::StaticOrder so; so.init(S, 768, nb, vb);
              pg8::EpiStore E{(bf16_t*)(p.ws + WS_QABS), 768, nullptr};
              pg8::gemm_phase<pg8::EpiStore, pg8::StaticOrder, true, true>(lds, g, so, E); }
            job_mla_rows(p, l, vb * 8 + wid, nb * 8, lane);
            att::run_mixers(lds, (unsigned*)(p.ws + WS_CTL) + 64 * (11 + l), PROJ, p.pos, p.sinks + l * 8, (const float*)(p.ws + WS_MISC + MISC_BTAB), (const bf16_t*)(p.ws + WS_MEMKV) + (size_t)l * MEML * DM);
            __syncthreads();

#ifdef EXP_SPINPRE
            { const unsigned long long t1_ = __builtin_amdgcn_s_memrealtime(); while (__builtin_amdgcn_s_memrealtime() - t1_ < 4 * (t1_ - t0_)) __builtin_amdgcn_s_sleep(8); }
#endif
        }
        sub_barrier(rdy, (unsigned)(nblk - SCAN_WGS), !is_scan);
#ifdef EXP_SPINMLA
        const unsigned long long tq0_ = __builtin_amdgcn_s_memrealtime();
#endif
        mla::run_queue(lds, (unsigned*)(p.ws + WS_CTL) + 64 * (1 + l), (const bf16_t*)(p.ws + WS_QABS), (const bf16_t*)(p.ws + WS_KVLAT), PROJ, (const bf16_t*)(p.ws + WS_WUV) + (size_t)l * 512 * 512, (const float*)(p.ws + WS_MISC + MISC_RSQ), (const float*)(p.ws + WS_COS), (const float*)(p.ws + WS_SIN), QSCALE);
        if (l == 0) { __syncthreads(); const int t2_ = tidx(), w2_ = __builtin_amdgcn_readfirstlane(t2_ >> 6); job_win(p, 1, bidx() * 8 + w2_, (int)gridDim.x * 8, lds, w2_, t2_ & 63); }
#ifdef EXP_SPINMLA
        if (!is_scan) { const unsigned long long tq1_ = __builtin_amdgcn_s_memrealtime(); while (__builtin_amdgcn_s_memrealtime() - tq1_ < 4 * (tq1_ - tq0_)) __builtin_amdgcn_s_sleep(8); }
#endif
    } else if constexpr (KIND == 6) {
        job_gdn_final(p, l, gw, ngw, lane, wid, lds);
    } else if constexpr (KIND == 7) {
        pg8::Gemm g{PROJ + C_Z, (const bf16_t*)(p.ws + WS_WOUT), S, DM, MIXW, NP};
        pg8::StaticOrder so; so.init(S, DM, nblk, bid);
        pg8::EpiStore E{(bf16_t*)(p.ws + WS_Y), DM, nullptr};
        pg8::gemm_phase<pg8::EpiStore, pg8::StaticOrder, true, true>(lds, g, so, E);
    } else {
        job_norm_rows(p, l == 0 ? 1 : 2, gw, ngw, lane);
        if (l == 0) job_wout(p, 1, gw, ngw, lds, wid, lane);
    }
}
template <int KIND> __global__ void __launch_bounds__(NT_THREADS, 2) mk_kind(Params p, int l) {
    extern __shared__ __attribute__((aligned(16))) unsigned char lds_raw[];
    run_kind<KIND>(p, l, (LAS unsigned char*)lds_raw);
}

#ifndef MK_LAUNCHES_PER_PHASE
#define MK_LAUNCHES_PER_PHASE 0
#endif
#if !MK_LAUNCHES_PER_PHASE
#ifdef EXP_SPINKIND
#define SPIN_T0(K) unsigned long long t0_s = 0; if ((K) == EXP_SPINKIND) t0_s = __builtin_amdgcn_s_memrealtime();
#define SPIN_T1(K) if ((K) == EXP_SPINKIND) { const unsigned long long t1_s = __builtin_amdgcn_s_memrealtime(), d_s = t1_s - t0_s; while (__builtin_amdgcn_s_memrealtime() - t1_s < 4 * d_s) __builtin_amdgcn_s_sleep(8); }
#else
#define SPIN_T0(K)
#define SPIN_T1(K)
#endif
#ifdef EXP_DUPKINDS
#define DUP_PH(K, L) if ((EXP_DUPKINDS >> (K)) & 1) { GRID_BAR(); run_kind<K>(p, L, lds); }
#else
#define DUP_PH(K, L)
#endif
#define GRID_BAR() do { unsigned long long wi_ = (unsigned long long)p.ws; asm volatile("" : "+s"(wi_)); unsigned char* w_ = (unsigned char*)(__attribute__((address_space(1))) unsigned char*)wi_; XcdBarrier b_; b_.bar = (unsigned*)(w_ + WS_CTL) + 4096; b_.x = xb_xcc_id(); b_.st = (volatile LAS unsigned*)(lds + LDS_BYTES - 16); xcd_barrier(b_); } while (0)
#define PHASE(K, L, LAST) do { SPIN_T0(K) run_kind<K>(p, L, lds); DUP_PH(K, L) if (!(LAST)) GRID_BAR(); SPIN_T1(K) } while (0)
__global__ void __launch_bounds__(NT_THREADS, 2) mk_fwd(Params p) {
    extern __shared__ __attribute__((aligned(16))) unsigned char lds_raw[];
    LAS unsigned char* lds = (LAS unsigned char*)lds_raw;
    cg::grid_group grid = cg::this_grid();
    volatile LAS unsigned* bst = (volatile LAS unsigned*)(lds + LDS_BYTES - 16);
    if (tidx() < 4) bst[tidx()] = 0u;
    __syncthreads();
    (void)xcd_barrier_post((unsigned*)(p.ws + WS_CTL) + 4096, bst);
    if (p.ph_hi == 0x7fffffff) grid.sync();
    PHASE(0, 0, false);
#pragma unroll 1
    for (int l = 0; l < DEPTH; ++l) {
        PHASE(2, l, false); PHASE(3, l, false); PHASE(5, l, false);
        PHASE(6, l, false); PHASE(7, l, false); PHASE(8, l, l + 1 == DEPTH);
    }
}
#endif

#ifndef MK_LAUNCHES_PER_PHASE
#define MK_LAUNCHES_PER_PHASE 0
#endif
extern "C" void kernel_launch(void* const* d_in, const int* in_sizes, int n_in, void* d_out, int out_size, void* d_ws, size_t ws_size, hipStream_t stream) {
    static int grid = 0;
    if (grid == 0) {
        if (n_in != 19 || in_sizes[0] != S * DM || out_size != S * DM || ws_size < WS_END) { fprintf(stderr, "kernel_launch: unexpected shapes (n_in %d, in0 %d, out %d, ws %zu)\n", n_in, n_in > 0 ? in_sizes[0] : -1, out_size, ws_size); grid = -1; return; }
        int dev = 0, cus = 0, per_cu = 0;
        (void)hipGetDevice(&dev); (void)hipDeviceGetAttribute(&cus, hipDeviceAttributeMultiprocessorCount, dev);
#if !MK_LAUNCHES_PER_PHASE
        if (hipFuncSetAttribute((const void*)mk_fwd, hipFuncAttributeMaxDynamicSharedMemorySize, LDS_BYTES) != hipSuccess) { fprintf(stderr, "kernel_launch: hipFuncSetAttribute failed\n"); grid = -1; return; }
        if (hipOccupancyMaxActiveBlocksPerMultiprocessor(&per_cu, (const void*)mk_fwd, NT_THREADS, LDS_BYTES) != hipSuccess || per_cu < 1) { fprintf(stderr, "kernel_launch: occupancy query gave %d\n", per_cu); per_cu = 1; }
#else
#define SA(K) (void)hipFuncSetAttribute((const void*)mk_kind<K>, hipFuncAttributeMaxDynamicSharedMemorySize, LDS_BYTES)
        SA(0); SA(2); SA(3); SA(5); SA(6); SA(7); SA(8);
#undef SA
#endif
        (void)hipGetLastError();
        if (cus <= 0) cus = 256;
        grid = cus;
        fprintf(stderr, "kernel_launch: cus %d per_cu %d grid %d\n", cus, per_cu, grid);
    }
    if (grid < 0) return;
    Params p{};
    p.x = (const float*)d_in[0]; p.mem = (const float*)d_in[1]; p.pos = (const int*)d_in[2]; p.rel_bias = (const float*)d_in[3];
    p.norm_pre = (const float*)d_in[4]; p.norm_post = (const float*)d_in[5]; p.w_in = (const float*)d_in[6]; p.sinks = (const float*)d_in[7];
    p.conv_w = (const float*)d_in[8]; p.a_log = (const float*)d_in[9]; p.dt_bias = (const float*)d_in[10]; p.gdn_norm = (const float*)d_in[11];
    p.q_norm = (const float*)d_in[12]; p.kv_norm = (const float*)d_in[13]; p.w_uq = (const float*)d_in[14]; p.w_ukv = (const float*)d_in[15];
    p.mem_norm = (const float*)d_in[16]; p.w_mem = (const float*)d_in[17]; p.w_out = (const float*)d_in[18];
    p.out = (float*)d_out; p.ws = (unsigned char*)d_ws;
    if (hipMemsetAsync((char*)d_ws + WS_CTL, 0, 65536, stream) != hipSuccess) { fprintf(stderr, "kernel_launch: hipMemsetAsync failed\n"); return; }
#if MK_LAUNCHES_PER_PHASE
    p.ph_lo = 0; p.ph_hi = 0;
#define LK(K, L) hipLaunchKernelGGL(mk_kind<K>, dim3(grid), dim3(NT_THREADS), LDS_BYTES, stream, p, L)
    LK(0, 0);
    for (int l = 0; l < DEPTH; ++l) { LK(2, l); LK(3, l); LK(5, l); LK(6, l); LK(7, l); LK(8, l); }
#undef LK
#else
    p.ph_lo = 0; p.ph_hi = N_PHASES;
    void* args[] = {&p};
    hipError_t e = hipLaunchCooperativeKernel((const void*)mk_fwd, dim3(grid), dim3(NT_THREADS), args, LDS_BYTES, stream);
    if (e != hipSuccess) fprintf(stderr, "kernel_launch: cooperative launch failed: %s (grid %d)\n", hipGetErrorString(e), grid);
#endif
}
```

```cpp
#include <hip/hip_runtime.h>
#include <hip/hip_cooperative_groups.h>
#include <cstdint>
#include <cstdio>
namespace cg = cooperative_groups;

#define LAS __attribute__((address_space(3)))
typedef unsigned short bf16_t;
typedef short bf16x8 __attribute__((ext_vector_type(8)));
typedef short s16x4 __attribute__((ext_vector_type(4)));
typedef float f32x2 __attribute__((ext_vector_type(2)));
typedef float f32x4 __attribute__((ext_vector_type(4)));
typedef float f32x16 __attribute__((ext_vector_type(16)));
typedef unsigned u32x2 __attribute__((ext_vector_type(2)));
typedef unsigned u32x4 __attribute__((ext_vector_type(4)));
typedef __bf16 bf16x2_t __attribute__((ext_vector_type(2)));

constexpr int S = 16384, DM = 1024, MEML = 256, NP = 5376, DEPTH = 2, DIN = 5320, MIXW = 2048;
constexpr int C_Z = 0, C_AQ = 2048, C_AK = 2560, C_AV = 2688, C_DQ = 2816, C_BQKV = 3328, C_CQ = 4864, C_CKV = 5120, C_KR = 5248, C_BA = 5312, C_BB = 5316;
constexpr int C_OLAT = 2048;
constexpr float RMS_EPS = 1e-6f;
constexpr float LOG2E = 1.4426950408889634f;
constexpr int NT_THREADS = 512;

constexpr size_t MiB = 1u << 20;
constexpr size_t WS_CTL = 0, WS_COS = 1 * MiB, WS_SIN = 3 * MiB, WS_MEMKV = 5 * MiB, WS_MISC = 6 * MiB, WS_MEMN = 7 * MiB;
constexpr size_t WS_WIN = 8 * MiB, WS_WOUT = 19 * MiB, WS_WMEM = 23 * MiB, WS_WQ = 27 * MiB, WS_WUV = 28 * MiB, WS_HALO = 29 * MiB;
constexpr size_t WS_AQK = 32 * MiB, WS_U = 40 * MiB, WS_H = 56 * MiB, WS_PROJ = 88 * MiB, WS_END = 256 * MiB;
constexpr size_t WS_QABS = WS_H, WS_KVLAT = WS_H + 24 * MiB, WS_Y = WS_H;
constexpr size_t MISC_BTAB = 0, MISC_RSQ = 8192, MISC_EGL = 8192 + 65536;

constexpr int LDS_BYTES = 163840;

struct Params {
    const float* x; const float* mem; const int* pos; const float* rel_bias;
    const float* norm_pre; const float* norm_post; const float* w_in; const float* sinks;
    const float* conv_w; const float* a_log; const float* dt_bias; const float* gdn_norm;
    const float* q_norm; const float* kv_norm; const float* w_uq; const float* w_ukv;
    const float* mem_norm; const float* w_mem; const float* w_out;
    float* out; unsigned char* ws;
    int ph_lo, ph_hi;
};

__device__ __forceinline__ int tidx() { int t = threadIdx.x; asm volatile("" : "+v"(t)); return t; }
__device__ __forceinline__ int bidx() { int b = blockIdx.x; asm volatile("" : "+s"(b)); return b; }
__device__ __forceinline__ float bf2f(bf16_t v) { return __uint_as_float((unsigned)v << 16); }
__device__ __forceinline__ unsigned cvtpk(float lo, float hi) { f32x2 v = {lo, hi}; bf16x2_t b = __builtin_convertvector(v, bf16x2_t); return __builtin_bit_cast(unsigned, b); }
__device__ __forceinline__ bf16_t f2bf(float f) { return (bf16_t)(cvtpk(f, 0.f) & 0xffffu); }
__device__ __forceinline__ float lo_bf(unsigned w) { return __uint_as_float(w << 16); }
__device__ __forceinline__ float hi_bf(unsigned w) { return __uint_as_float(w & 0xffff0000u); }
__device__ __forceinline__ float silu_f(float v) { return v / (1.f + __expf(-v)); }
#define DPP_ROR(x, n) __builtin_amdgcn_update_dpp(0, (x), 0x120 + (n), 0xf, 0xf, false)
__device__ __forceinline__ float ror16_f(float v, int n) { const int x = __float_as_int(v); int r; switch (n) { case 1: r = DPP_ROR(x, 1); break; case 2: r = DPP_ROR(x, 2); break; case 4: r = DPP_ROR(x, 4); break; default: r = DPP_ROR(x, 8); break; } return __int_as_float(r); }
__device__ __forceinline__ unsigned xor8_u(unsigned v) { return (unsigned)DPP_ROR((int)v, 8); }
__device__ __forceinline__ float row16_sum(float v) { v += ror16_f(v, 1); v += ror16_f(v, 2); v += ror16_f(v, 4); v += ror16_f(v, 8); return v; }
__device__ __forceinline__ float wave_sum(float v) {
    v = row16_sum(v);
    v += __int_as_float(__builtin_amdgcn_ds_swizzle(__float_as_int(v), 0x401F));
    return __int_as_float(__builtin_amdgcn_readlane(__float_as_int(v), 0)) + __int_as_float(__builtin_amdgcn_readlane(__float_as_int(v), 32));
}
__device__ __forceinline__ int crow(int r, int hi) { return (r & 3) + 8 * (r >> 2) + 4 * hi; }
#define MFMA32(a, b, c) __builtin_amdgcn_mfma_f32_32x32x16_bf16((a), (b), (c), 0, 0, 0)
#define SBAR() __builtin_amdgcn_sched_barrier(0)
#define LDS_WAIT() asm volatile("s_waitcnt lgkmcnt(0)" ::: "memory")
__device__ __forceinline__ bf16x8 pack8(const float* v) { u32x4 w = {cvtpk(v[0], v[1]), cvtpk(v[2], v[3]), cvtpk(v[4], v[5]), cvtpk(v[6], v[7])}; return __builtin_bit_cast(bf16x8, w); }
__device__ __forceinline__ bf16x8 pack_step(const f32x16& x, int s) {
    u32x4 w = {cvtpk(x[8 * s + 0], x[8 * s + 1]), cvtpk(x[8 * s + 2], x[8 * s + 3]), cvtpk(x[8 * s + 4], x[8 * s + 5]), cvtpk(x[8 * s + 6], x[8 * s + 7])};
    return __builtin_bit_cast(bf16x8, w);
}

__device__ __forceinline__ int win_src(int n) {
    if (n < 512) return 768 + n;
    if (n < 1024) return 2824 + (n - 512);
    if (n < 1536) return 3784 + (n - 1024);
    if (n < 2048) return 4808 + (n - 1536);
    if (n < 2560) return n - 2048;
    if (n < 2688) return 512 + (n - 2560);
    if (n < 2816) return 640 + (n - 2688);
    if (n < 3328) return 4296 + (n - 2816);
    if (n < 4864) return 1280 + (n - 3328);
    if (n < 5120) return 3336 + (n - 4864);
    if (n < 5248) return 3592 + (n - 5120);
    if (n < 5312) return 3720 + (n - 5248);
    if (n < 5316) return 2816 + (n - 5312);
    if (n < 5320) return 2820 + (n - 5316);
    return -1;
}

__device__ __forceinline__ int t5_bucket(int n) {
    if (n < 16) return n < 0 ? 0 : n;
    if (n >= 128) return 31;
    const float v = __logf((float)n * 0.0625f) * (16.0f / 2.0794415416798357f);
    int b = 16 + (int)v; return b > 31 ? 31 : b;
}
__device__ __forceinline__ float inv_freq(int i) {
    const float t[32] = {1.000000000e+00f, 7.498942018e-01f, 5.623413324e-01f, 4.216965139e-01f, 3.162277639e-01f, 2.371373922e-01f, 1.778279394e-01f, 1.333521456e-01f,
                         1.000000015e-01f, 7.498941571e-02f, 5.623412877e-02f, 4.216964915e-02f, 3.162277862e-02f, 2.371373586e-02f, 1.778279431e-02f, 1.333521493e-02f,
                         9.999999776e-03f, 7.498942316e-03f, 5.623413250e-03f, 4.216964822e-03f, 3.162277862e-03f, 2.371373819e-03f, 1.778279431e-03f, 1.333521446e-03f,
                         1.000000047e-03f, 7.498941850e-04f, 5.623413017e-04f, 4.216965463e-04f, 3.162277862e-04f, 2.371373848e-04f, 1.778279402e-04f, 1.333521504e-04f};
    return t[i];
}
namespace pg8 {
#define PG8_LAS __attribute__((address_space(3)))
constexpr int BM = 256, BK = 64, HALF = 128, HTB = HALF * BK * 2  , STAGE_BYTES = 8 * HTB, NXCD = 8, WGM = 8;
__host__ __device__ __forceinline__ int lds_byte(int r, int c) { const int st = (r >> 4) * 2 + (c >> 5), rr = r & 15, cc = c & 31, ob = rr * 64 + cc * 2; return st * 1024 + (ob ^ (((ob >> 9) & 1) << 5)); }
__host__ __device__ __forceinline__ void stage_rc(int b, int& R, int& C) { const int st = b / 1024, sb = b % 1024, swz = sb ^ (((sb >> 9) & 1) << 5); R = (st >> 1) * 16 + swz / 64; C = (st & 1) * 32 + (swz % 64) / 2; }
__host__ __device__ __forceinline__ int perm32(int rho) { const int n = rho >> 4, i = rho & 15; return 8 * (i >> 2) + 4 * n + (i & 3); }
struct Unit { int pm, pn; };
struct Gemm { const bf16_t* A; const bf16_t* Bt; int M, N, K, lda; };
struct StaticOrder {
    int nM, nN, nwg, G, c;
    __device__ void init(int M, int N, int G_, int c_) { nM = M / BM; nN = N / BM; nwg = nM * nN; G = G_; c = c_; }
    __device__ bool next(int i, Unit& u) const {
        const long L = (long)i * G + c; if (L >= nwg) return false;
        int wgid = (int)L; { const int q = nwg / NXCD, r = nwg % NXCD, xcd = wgid % NXCD, off = wgid / NXCD; wgid = (xcd < r ? xcd * (q + 1) : r * (q + 1) + (xcd - r) * q) + off; }
        const int nig = WGM * nN, gid = wgid / nig, fm = gid * WGM, gsz = (nM - fm) < WGM ? (nM - fm) : WGM;
        u.pm = fm + ((wgid % nig) % gsz); u.pn = (wgid % nig) / gsz; return true;
    }
    __device__ __forceinline__ void a_ready(const Unit&) const {}
    __device__ __forceinline__ void done(const Unit&) const {}
};
struct EpiStore {
    static constexpr bool PERM = true, AFTER_DRAIN = false;
    bf16_t* O; int ldc; bf16_t* halo;
    __device__ __forceinline__ void operator()(const f32x4 (&acc)[2][2][4][2], const Unit& u, int wr, int wc, int fr, int fq) const {
        const int row0 = u.pm * BM + wr * 64 + fr, col0 = u.pn * BM + wc * 32 + 8 * fq;
        const bool hz = halo != nullptr && col0 >= C_BQKV && col0 < C_BQKV + 1536;
#pragma unroll
        for (int ai = 0; ai < 2; ++ai)
#pragma unroll
            for (int m = 0; m < 4; ++m) { const int row = row0 + ai * HALF + m * 16; bf16_t* rowp = O + (size_t)row * ldc + col0;
#pragma unroll
                for (int bj = 0; bj < 2; ++bj) { const f32x4 v0 = acc[ai][bj][m][0], v1 = acc[ai][bj][m][1];
                    u32x4 w; w.x = cvtpk(v0[0], v0[1]); w.y = cvtpk(v0[2], v0[3]); w.z = cvtpk(v1[0], v1[1]); w.w = cvtpk(v1[2], v1[3]);
                    *(u32x4*)(rowp + bj * HALF) = w;
                    if (m == 3 && hz && fr >= 13) *(u32x4*)(halo + ((size_t)(row >> 6) * 3 + (fr - 13)) * 1536 + (col0 + bj * HALF - C_BQKV)) = w; } }
    }
};
struct EpiGate {
    static constexpr bool PERM = true, AFTER_DRAIN = false;
    bf16_t* G; int ldc;
    __device__ __forceinline__ void operator()(const f32x4 (&acc)[2][2][4][2], const Unit& u, int wr, int wc, int fr, int fq) const {
        const int row0 = u.pm * BM + wr * 64 + fr, col0 = u.pn * BM + wc * 32 + 8 * fq;
#pragma unroll
        for (int ai = 0; ai < 2; ++ai)
#pragma unroll
            for (int m = 0; m < 4; ++m) { bf16_t* rowp = G + (size_t)(row0 + ai * HALF + m * 16) * ldc + col0;
#pragma unroll
                for (int bj = 0; bj < 2; ++bj) { const f32x4 v0 = acc[ai][bj][m][0], v1 = acc[ai][bj][m][1];
                    const u32x4 z = *(const u32x4*)(rowp + bj * HALF);
                    u32x4 w; w.x = cvtpk(v0[0] * silu_f(lo_bf(z.x)), v0[1] * silu_f(hi_bf(z.x))); w.y = cvtpk(v0[2] * silu_f(lo_bf(z.y)), v0[3] * silu_f(hi_bf(z.y)));
                    w.z = cvtpk(v1[0] * silu_f(lo_bf(z.z)), v1[1] * silu_f(hi_bf(z.z))); w.w = cvtpk(v1[2] * silu_f(lo_bf(z.w)), v1[3] * silu_f(hi_bf(z.w)));
                    *(u32x4*)(rowp + bj * HALF) = w; } }
    }
};
template <class Epi, class Sched, bool ALIGN_EPI = false, bool SP2 = false>
__device__ __forceinline__ void gemm_phase(PG8_LAS unsigned char* lds, const Gemm g, const Sched& S, const Epi& E) {
    const int tid = tidx(), wid = __builtin_amdgcn_readfirstlane(tid >> 6), lane = tid & 63, wr = wid >> 2, wc = wid & 3, fr = lane & 15, fq = lane >> 4;
    const int K = g.K, nt = K / BK;
    unsigned voffA[2], voffB[2];
#pragma unroll
    for (int i = 0; i < 2; ++i) { int R, C; stage_rc(tid * 16 + i * 8192, R, C); const int Rb = Epi::PERM ? ((R & ~31) + perm32(R & 31)) : R;
        voffA[i] = (unsigned)(R * g.lda + C) * 2u; voffB[i] = (unsigned)(Rb * K + C) * 2u; }
    const size_t kstep = (size_t)(BK * 2);
    const size_t hstepA = (size_t)HALF * g.lda * 2, hstepB = (size_t)HALF * K * 2;
    const size_t tstepA = 2 * hstepA, tstepB = 2 * hstepB;
    const unsigned ldsw = (unsigned)wid * 1024u;
    const int aoff = lds_byte(wr * 64 + fr, fq * 8), boff = lds_byte(wc * 32 + fr, fq * 8);
#define PG8_SA(b, h) (((b) * 2 + (h)) * HTB)
#define PG8_SB(b, h) ((4 + (b) * 2 + (h)) * HTB)
#define PG8_STAGE(bufoff, gbase, voff) do { _Pragma("unroll") for (int _i = 0; _i < 2; ++_i) \
        __builtin_amdgcn_global_load_lds((const unsigned*)((const char*)(gbase) + (voff)[_i]), (PG8_LAS unsigned*)(lds + (bufoff) + ldsw + _i * 8192), 16, 0, 0); } while (0)
#define PG8_LDA(dst, b, h) do { _Pragma("unroll") for (int m = 0; m < 4; ++m) _Pragma("unroll") for (int k = 0; k < 2; ++k) dst[m][k] = *(const PG8_LAS bf16x8*)(lds + PG8_SA(b, h) + aoff + m * 2048 + k * 1024); } while (0)
#define PG8_LDB(dst, b, h) do { _Pragma("unroll") for (int n = 0; n < 2; ++n) _Pragma("unroll") for (int k = 0; k < 2; ++k) dst[n][k] = *(const PG8_LAS bf16x8*)(lds + PG8_SB(b, h) + boff + n * 2048 + k * 1024); } while (0)
#define PG8_MMA(ai, bj, At, Bt) do { __builtin_amdgcn_s_setprio(1); _Pragma("unroll") for (int m = 0; m < 4; ++m) _Pragma("unroll") for (int n = 0; n < 2; ++n) _Pragma("unroll") for (int k = 0; k < 2; ++k) \
        acc[ai][bj][m][n] = __builtin_amdgcn_mfma_f32_16x16x32_bf16(Bt[n][k], At[m][k], acc[ai][bj][m][n], 0, 0, 0); __builtin_amdgcn_s_setprio(0); } while (0)
#define PG8_WAIT_V(n) asm volatile("s_waitcnt vmcnt(" #n ")" ::: "memory")
#define PG8_WAIT_L(n) asm volatile("s_waitcnt lgkmcnt(" #n ")" ::: "memory")
#define PG8_BAR __builtin_amdgcn_s_barrier()
#define PG8_SCHED __builtin_amdgcn_sched_barrier(0)
    Unit cur, nxt; int ui = 0;
    if (!S.next(0, cur)) return;
    f32x4 acc[2][2][4][2];
#pragma unroll
    for (int a = 0; a < 2; ++a)
#pragma unroll
        for (int b = 0; b < 2; ++b)
#pragma unroll
            for (int m = 0; m < 4; ++m)
#pragma unroll
                for (int n = 0; n < 2; ++n) acc[a][b][m][n] = (f32x4){0.f, 0.f, 0.f, 0.f};
    bf16x8 At[4][2], B0[2][2], B1[2][2];
    const char* cA = (const char*)g.A + (size_t)cur.pm * tstepA; const char* cB = (const char*)g.Bt + (size_t)cur.pn * tstepB;
    S.a_ready(cur);
    if constexpr (SP2) {
        PG8_STAGE(PG8_SB(0, 0), cB, voffB); PG8_STAGE(PG8_SB(0, 1), cB + hstepB, voffB); PG8_STAGE(PG8_SA(0, 0), cA, voffA); PG8_STAGE(PG8_SA(0, 1), cA + hstepA, voffA);
        if (wr == 1) PG8_BAR;
        PG8_WAIT_V(2); PG8_BAR;
        PG8_STAGE(PG8_SB(1, 0), cB + kstep, voffB); PG8_STAGE(PG8_SA(1, 0), cA + kstep, voffA); PG8_STAGE(PG8_SB(1, 1), cB + hstepB + kstep, voffB);
        PG8_WAIT_V(6); PG8_BAR;
    } else {
        PG8_STAGE(PG8_SB(0, 0), cB, voffB); PG8_STAGE(PG8_SA(0, 0), cA, voffA); PG8_STAGE(PG8_SB(0, 1), cB + hstepB, voffB); PG8_STAGE(PG8_SA(0, 1), cA + hstepA, voffA);
        if (wr == 1) PG8_BAR;
        PG8_WAIT_V(4); PG8_BAR;
        PG8_STAGE(PG8_SB(1, 0), cB + kstep, voffB); PG8_STAGE(PG8_SA(1, 0), cA + kstep, voffA); PG8_STAGE(PG8_SB(1, 1), cB + hstepB + kstep, voffB);
        PG8_WAIT_V(6); PG8_BAR;
    }
    for (;;) {
        const bool has_next = S.next(ui + 1, nxt);
        const char* nA = has_next ? (const char*)g.A + (size_t)nxt.pm * tstepA : cA; const char* nB = has_next ? (const char*)g.Bt + (size_t)nxt.pn * tstepB : cB;
        for (int t = 0; t < nt; t += 2) {
            const bool last = (t == nt - 2);
            const char* a1 = cA + (size_t)(t + 1) * kstep;
            const char* a2 = last ? nA : cA + (size_t)(t + 2) * kstep; const char* b2 = last ? nB : cB + (size_t)(t + 2) * kstep;
            const char* a3 = a2 + kstep; const char* b3 = b2 + kstep;
            if (last && has_next) S.a_ready(nxt);
            if constexpr (SP2) {
            PG8_LDB(B0, 0, 0); PG8_LDB(B1, 0, 1); PG8_SCHED; PG8_LDA(At, 0, 0); PG8_STAGE(PG8_SA(1, 1), a1 + hstepA, voffA);
            PG8_WAIT_V(8); PG8_WAIT_L(0); PG8_BAR; PG8_MMA(0, 0, At, B0); PG8_MMA(0, 1, At, B1); PG8_BAR; PG8_SCHED;
            PG8_LDA(At, 0, 1); PG8_STAGE(PG8_SB(0, 0), b2, voffB); PG8_STAGE(PG8_SB(0, 1), b2 + hstepB, voffB); PG8_STAGE(PG8_SA(0, 0), a2, voffA);
            PG8_WAIT_V(8); PG8_WAIT_L(0); PG8_BAR; PG8_MMA(1, 0, At, B0); PG8_MMA(1, 1, At, B1); PG8_BAR; PG8_SCHED;
            PG8_LDB(B0, 1, 0); PG8_LDB(B1, 1, 1); PG8_SCHED; PG8_LDA(At, 1, 0); PG8_STAGE(PG8_SA(0, 1), a2 + hstepA, voffA);
            PG8_WAIT_V(8); PG8_WAIT_L(0); PG8_BAR; PG8_MMA(0, 0, At, B0); PG8_MMA(0, 1, At, B1); PG8_BAR; PG8_SCHED;
            PG8_LDA(At, 1, 1); PG8_STAGE(PG8_SB(1, 0), b3, voffB); PG8_STAGE(PG8_SB(1, 1), b3 + hstepB, voffB); PG8_STAGE(PG8_SA(1, 0), a3, voffA);
            PG8_WAIT_V(8); PG8_WAIT_L(0); PG8_BAR; PG8_MMA(1, 0, At, B0); PG8_MMA(1, 1, At, B1); PG8_BAR; PG8_SCHED;
            } else {
            PG8_LDB(B0, 0, 0); PG8_SCHED; PG8_LDA(At, 0, 0); PG8_STAGE(PG8_SA(1, 1), a1 + hstepA, voffA);
            PG8_WAIT_L(8); PG8_BAR; PG8_WAIT_L(0); PG8_MMA(0, 0, At, B0); PG8_BAR; PG8_SCHED;
            PG8_LDB(B1, 0, 1); PG8_STAGE(PG8_SB(0, 0), b2, voffB);
            PG8_BAR; PG8_WAIT_L(0); PG8_MMA(0, 1, At, B1); PG8_BAR;
            PG8_LDA(At, 0, 1); PG8_STAGE(PG8_SA(0, 0), a2, voffA);
            PG8_BAR; PG8_WAIT_L(0); PG8_MMA(1, 0, At, B0); PG8_BAR; PG8_SCHED;
            PG8_STAGE(PG8_SB(0, 1), b2 + hstepB, voffB);
            PG8_WAIT_V(6); PG8_BAR; PG8_MMA(1, 1, At, B1); PG8_BAR;
            PG8_LDB(B0, 1, 0); PG8_SCHED; PG8_LDA(At, 1, 0); PG8_STAGE(PG8_SA(0, 1), a2 + hstepA, voffA);
            PG8_WAIT_L(8); PG8_BAR; PG8_WAIT_L(0); PG8_MMA(0, 0, At, B0); PG8_BAR; PG8_SCHED;
            PG8_LDB(B1, 1, 1); PG8_STAGE(PG8_SB(1, 0), b3, voffB);
            PG8_BAR; PG8_WAIT_L(0); PG8_MMA(0, 1, At, B1); PG8_BAR;
            PG8_LDA(At, 1, 1); PG8_STAGE(PG8_SA(1, 0), a3, voffA);
            PG8_BAR; PG8_WAIT_L(0); PG8_MMA(1, 0, At, B0); PG8_BAR; PG8_SCHED;
            PG8_STAGE(PG8_SB(1, 1), b3 + hstepB, voffB);
            PG8_WAIT_V(6); PG8_BAR; PG8_MMA(1, 1, At, B1); PG8_BAR;
            }
        }
        if constexpr (ALIGN_EPI) { if (wr == 0) PG8_BAR; }
        if constexpr (!Epi::AFTER_DRAIN) { E(acc, cur, wr, wc, fr, fq); S.done(cur); }
        if (!has_next) break;
#pragma unroll
        for (int a = 0; a < 2; ++a)
#pragma unroll
            for (int b = 0; b < 2; ++b)
#pragma unroll
                for (int m = 0; m < 4; ++m)
#pragma unroll
                    for (int n = 0; n < 2; ++n) acc[a][b][m][n] = (f32x4){0.f, 0.f, 0.f, 0.f};
        cur = nxt; cA = nA; cB = nB; ++ui;
        if constexpr (ALIGN_EPI) { if (wr == 1) PG8_BAR; }
    }
    PG8_WAIT_V(0);
    if constexpr (!ALIGN_EPI) { if (wr == 0) PG8_BAR; }
    PG8_BAR;
    if constexpr (Epi::AFTER_DRAIN) { E.fused(acc, cur, wr, wc, fr, fq, lds, wid, lane); S.done(cur); }
#undef PG8_SA
#undef PG8_SB
#undef PG8_STAGE
#undef PG8_LDA
#undef PG8_LDB
#undef PG8_MMA
#undef PG8_WAIT_V
#undef PG8_WAIT_L
#undef PG8_BAR
#undef PG8_SCHED
}
}
namespace att {
constexpr int KVBLK = 64;
constexpr int STG = 32768, L_WS = 65536, L_POSK = 67584, L_BTAB = 68096, L_UNIT = 72256, L_OST = 73728, OST_WAVE = 8704;
template <int DV> __device__ __forceinline__ int v_st(int k, int c) { const int kk = (k & ~0xC) | ((k & 4) << 1) | ((k & 8) >> 1); return ((kk >> 3) * (DV / 32) + (c >> 5)) * 512 + ((kk & 7) * 32 + (c & 31)) * 2; }
__device__ __forceinline__ int v_rd_base(int lane) { return ((lane & 3) << 3) | (((lane >> 2) & 3) << 6) | (((lane >> 4) & 1) << 5) | (((lane >> 5) & 1) << 8); }
__device__ __forceinline__ int koff(int row, int colB, int RB) { return row * RB + (colB ^ ((row & 7) << 4)); }

template <int DQK, int DV, int MODE>
__device__ __forceinline__ void attn_core(LAS unsigned char* lds, const bf16_t* qrow, const bf16_t* Kg, int ldk, const bf16_t* Vg, int ldv, int t_lo, int t_hi, float c2,
                                          int qidx, int head, const int* pos, float& m_reg, float& l_reg, f32x16 (&o)[DV / 32]) {
    constexpr int ND = DQK / 16, NV = DV / 32, RB = DQK * 2, NKC = (64 * (DQK / 8)) / NT_THREADS, NVC = (64 * (DV / 8)) / NT_THREADS, KB = 64 * RB;
    const int tid = tidx(), lane = tid & 63, r32 = lane & 31, hi = lane >> 5, wid = __builtin_amdgcn_readfirstlane(tid >> 6);
    bf16x8 qr[ND];
#pragma unroll
    for (int d0 = 0; d0 < ND; ++d0) qr[d0] = *(const bf16x8*)(qrow + d0 * 16 + hi * 8);
    LAS float* al_l = (LAS float*)(lds + L_WS) + wid * 64;
    LAS int* posk = (LAS int*)(lds + L_POSK); LAS float* btab = (LAS float*)(lds + L_BTAB);
    const unsigned vb0 = (unsigned)(uintptr_t)lds + (unsigned)KB + (unsigned)v_rd_base(lane);
    int posq = 0; if (MODE == 1) posq = pos[qidx];
    unsigned kdst[NKC], ksrc[NKC], vdst[NVC], vsrc[NVC];
#pragma unroll
    for (int i = 0; i < NKC; ++i) { const int c = tid + NT_THREADS * i, row = c / (DQK / 8), ch = c % (DQK / 8); kdst[i] = koff(row, ch * 16, RB); ksrc[i] = row * ldk + ch * 8; }
#pragma unroll
    for (int i = 0; i < NVC; ++i) { const int c = tid + NT_THREADS * i, row = c / (DV / 8), ch = c % (DV / 8); vdst[i] = KB + v_st<DV>(row, ch * 8); vsrc[i] = row * ldv + ch * 8; }
    u32x4 ks[NKC], vs[NVC]; int pkn = 0;
#define LOAD_TILE(t_) do { const size_t kb_ = (size_t)(t_) * KVBLK; _Pragma("unroll") for (int i = 0; i < NKC; ++i) ks[i] = *(const u32x4*)(Kg + kb_ * ldk + ksrc[i]); \
        _Pragma("unroll") for (int i = 0; i < NVC; ++i) vs[i] = *(const u32x4*)(Vg + kb_ * ldv + vsrc[i]); if (MODE == 1 && tid < 64) pkn = pos[(t_) * KVBLK + tid]; } while (0)
#define WRITE_TILE(st_) do { _Pragma("unroll") for (int i = 0; i < NKC; ++i) *(LAS u32x4*)(lds + (st_) * STG + kdst[i]) = ks[i]; \
        _Pragma("unroll") for (int i = 0; i < NVC; ++i) *(LAS u32x4*)(lds + (st_) * STG + vdst[i]) = vs[i]; if (MODE == 1 && tid < 64) posk[(st_) * 64 + tid] = pkn; } while (0)
    LOAD_TILE(t_lo); WRITE_TILE(0);
    __syncthreads();
#pragma unroll 1
    for (int t = t_lo; t < t_hi; ++t) {
        const int st = (t - t_lo) & 1, kbase = t * KVBLK;
        if (t + 1 < t_hi) LOAD_TILE(t + 1);
        const LAS unsigned char* K_lds = lds + st * STG;
        f32x16 p0 = {}, p1 = {};
#pragma unroll
        for (int d0 = 0; d0 < ND; ++d0) {
            const bf16x8 a0 = *(const LAS bf16x8*)(K_lds + koff(r32, (d0 * 16 + hi * 8) * 2, RB));
            const bf16x8 a1 = *(const LAS bf16x8*)(K_lds + koff(32 + r32, (d0 * 16 + hi * 8) * 2, RB));
            p0 = MFMA32(a0, qr[d0], p0); p1 = MFMA32(a1, qr[d0], p1);
        }
        if (MODE == 1) {
#pragma unroll
            for (int r = 0; r < 16; ++r) { const int kl = crow(r, hi);
                { const int kk = kbase + kl; int dist = posq - posk[st * 64 + kl]; dist = dist < 0 ? 0 : (dist > 128 ? 128 : dist);
                  const float b = btab[dist * 8 + head]; p0[r] = ((unsigned)(qidx - kk) < 128u) ? fmaf(p0[r], c2, b) : -__builtin_inff(); }
                { const int kk = kbase + kl + 32; int dist = posq - posk[st * 64 + kl + 32]; dist = dist < 0 ? 0 : (dist > 128 ? 128 : dist);
                  const float b = btab[dist * 8 + head]; p1[r] = ((unsigned)(qidx - kk) < 128u) ? fmaf(p1[r], c2, b) : -__builtin_inff(); } }
        } else {
#pragma unroll
            for (int r = 0; r < 16; ++r) { p0[r] *= c2; p1[r] *= c2; }
        }
        float pmax = p0[0];
#pragma unroll
        for (int r = 1; r < 16; ++r) pmax = fmaxf(pmax, p0[r]);
#pragma unroll
        for (int r = 0; r < 16; ++r) pmax = fmaxf(pmax, p1[r]);
        { auto rr = __builtin_amdgcn_permlane32_swap(__float_as_uint(pmax), __float_as_uint(pmax), false, false); pmax = fmaxf(__uint_as_float(rr[0]), __uint_as_float(rr[1])); }
        const float mn = fmaxf(m_reg, pmax); const float alpha = __builtin_amdgcn_exp2f(m_reg - mn); m_reg = mn;
        float ps = 0.f;
#pragma unroll
        for (int r = 0; r < 16; ++r) { p0[r] = __builtin_amdgcn_exp2f(p0[r] - mn); ps += p0[r]; }
#pragma unroll
        for (int r = 0; r < 16; ++r) { p1[r] = __builtin_amdgcn_exp2f(p1[r] - mn); ps += p1[r]; }
        { auto rr = __builtin_amdgcn_permlane32_swap(__float_as_uint(ps), __float_as_uint(ps), false, false); ps = __uint_as_float(rr[0]) + __uint_as_float(rr[1]); }
        l_reg = l_reg * alpha + ps;
        if (__any(alpha < 1.f)) {
            if (hi == 0) al_l[r32] = alpha;
            LDS_WAIT();
#pragma unroll
            for (int g = 0; g < 4; ++g) { const f32x4 a4 = *(const LAS f32x4*)(al_l + 8 * g + 4 * hi);
#pragma unroll
                for (int d = 0; d < NV; ++d) { o[d][4 * g + 0] *= a4[0]; o[d][4 * g + 1] *= a4[1]; o[d][4 * g + 2] *= a4[2]; o[d][4 * g + 3] *= a4[3]; } }
        }
        bf16x8 pa0, pa1, pa2, pa3;
#define PK4(P, B_, OUT) do { const unsigned a0_ = cvtpk(P[B_ + 0], P[B_ + 1]), a1_ = cvtpk(P[B_ + 2], P[B_ + 3]), b0_ = cvtpk(P[B_ + 4], P[B_ + 5]), b1_ = cvtpk(P[B_ + 6], P[B_ + 7]); \
        auto r0_ = __builtin_amdgcn_permlane32_swap(a0_, b0_, false, false); auto r1_ = __builtin_amdgcn_permlane32_swap(a1_, b1_, false, false); \
        u32x4 w_ = {r0_[0], r1_[0], r0_[1], r1_[1]}; OUT = __builtin_bit_cast(bf16x8, w_); } while (0)
        PK4(p0, 0, pa0); PK4(p0, 8, pa1); PK4(p1, 0, pa2); PK4(p1, 8, pa3);
#undef PK4
        const unsigned vba = vb0 + (unsigned)(st * STG);
#define TRRD(dst, off) asm volatile("ds_read_b64_tr_b16 %0, %1 offset:%2" : "=&v"(dst) : "v"(vba), "i"(off) : "memory")
#define PV_D0(d0) do { s16x4 l0, l1, l2, l3, h0, h1, h2, h3; constexpr int KS_ = NV * 1024, HF_ = NV * 512, b_ = (d0) * 512; \
        TRRD(l0, b_); TRRD(h0, b_ + HF_); TRRD(l1, b_ + KS_); TRRD(h1, b_ + KS_ + HF_); TRRD(l2, b_ + 2 * KS_); TRRD(h2, b_ + 2 * KS_ + HF_); TRRD(l3, b_ + 3 * KS_); TRRD(h3, b_ + 3 * KS_ + HF_); \
        asm volatile("s_waitcnt lgkmcnt(0)" ::: "memory"); SBAR(); \
        o[d0] = MFMA32(pa0, ((bf16x8){l0[0], l0[1], l0[2], l0[3], h0[0], h0[1], h0[2], h0[3]}), o[d0]); \
        o[d0] = MFMA32(pa1, ((bf16x8){l1[0], l1[1], l1[2], l1[3], h1[0], h1[1], h1[2], h1[3]}), o[d0]); \
        o[d0] = MFMA32(pa2, ((bf16x8){l2[0], l2[1], l2[2], l2[3], h2[0], h2[1], h2[2], h2[3]}), o[d0]); \
        o[d0] = MFMA32(pa3, ((bf16x8){l3[0], l3[1], l3[2], l3[3], h3[0], h3[1], h3[2], h3[3]}), o[d0]); } while (0)
        PV_D0(0); PV_D0(1);
        if constexpr (NV == 4) { PV_D0(2); PV_D0(3); }
#undef PV_D0
#undef TRRD
        if (t + 1 < t_hi) WRITE_TILE(st ^ 1);
        __syncthreads();
    }
#undef LOAD_TILE
#undef WRITE_TILE
}
template <int DV>
__device__ __forceinline__ void gated_store(LAS unsigned char* lds, float l_reg, const f32x16 (&o)[DV / 32], bf16_t* zp0) {
    constexpr int NV = DV / 32, OP = DV + 8, CPR = DV / 8;
    const int tid = tidx(), lane = tid & 63, r32 = lane & 31, hi = lane >> 5, wid = __builtin_amdgcn_readfirstlane(tid >> 6);
    LAS float* li_l = (LAS float*)(lds + L_WS) + wid * 64; LAS bf16_t* ost = (LAS bf16_t*)(lds + L_OST + wid * OST_WAVE);
    asm volatile("s_waitcnt lgkmcnt(0)" ::: "memory");
    if (hi == 0) li_l[r32] = l_reg;
    asm volatile("s_waitcnt lgkmcnt(0)" ::: "memory");
#pragma unroll
    for (int g = 0; g < 4; ++g) { const f32x4 a4 = *(const LAS f32x4*)(li_l + 8 * g + 4 * hi);
#pragma unroll
        for (int e = 0; e < 4; ++e) { const float rl = 1.f / a4[e]; const int row = 8 * g + 4 * hi + e;
#pragma unroll
            for (int d0 = 0; d0 < NV; ++d0) ost[row * OP + d0 * 32 + r32] = f2bf(o[d0][4 * g + e] * rl); } }
    asm volatile("s_waitcnt lgkmcnt(0)" ::: "memory");
#pragma unroll
    for (int i = 0; i < (32 * CPR) / 64; ++i) { const int id = lane + 64 * i, row = id / CPR, dc = id % CPR;
        const u32x4 v = *(const LAS u32x4*)(ost + row * OP + dc * 8); bf16_t* zp = zp0 + (size_t)row * NP + dc * 8; const u32x4 z = *(const u32x4*)zp;
        u32x4 w; w.x = cvtpk(lo_bf(v.x) * silu_f(lo_bf(z.x)), hi_bf(v.x) * silu_f(hi_bf(z.x))); w.y = cvtpk(lo_bf(v.y) * silu_f(lo_bf(z.y)), hi_bf(v.y) * silu_f(hi_bf(z.y)));
        w.z = cvtpk(lo_bf(v.z) * silu_f(lo_bf(z.z)), hi_bf(v.z) * silu_f(hi_bf(z.z))); w.w = cvtpk(lo_bf(v.w) * silu_f(lo_bf(z.w)), hi_bf(v.w) * silu_f(hi_bf(z.w)));
        *(u32x4*)zp = w; }
}
__device__ __forceinline__ void swa_unit(LAS unsigned char* lds, int qb, int hk, bf16_t* PROJ, const int* pos, const float* sinks  ) {
    const int tid = tidx(), lane = tid & 63, r32 = lane & 31, wid = __builtin_amdgcn_readfirstlane(tid >> 6);
    const int head = hk * 4 + (wid >> 1), q0 = qb * 64 + (wid & 1) * 32;
    const float sink = sinks[head] * LOG2E;
    float m = sink, l = 1.f; f32x16 o[2] = {};
    int t_lo = (qb * 64 - 128) / 64; if (t_lo < 0) t_lo = 0;
    attn_core<64, 64, 1>(lds, PROJ + (size_t)(q0 + r32) * NP + C_AQ + head * 64, PROJ + C_AK + hk * 64, NP, PROJ + C_AV + hk * 64, NP, t_lo, qb + 1, 0.125f * LOG2E, q0 + r32, head, pos, m, l, o);
    gated_store<64>(lds, l, o, PROJ + (size_t)q0 * NP + C_Z + head * 64);
}
__device__ __forceinline__ void cross_unit(LAS unsigned char* lds, int qb, int h, bf16_t* PROJ, const bf16_t* MEMKV  ) {
    const int tid = tidx(), lane = tid & 63, r32 = lane & 31, wid = __builtin_amdgcn_readfirstlane(tid >> 6);
    const int q0 = qb * 256 + wid * 32;
    float m = -1e30f, l = 0.f; f32x16 o[4] = {};
    attn_core<128, 128, 2>(lds, PROJ + (size_t)(q0 + r32) * NP + C_DQ + h * 128, MEMKV + h * 128, 1024, MEMKV + 512 + h * 128, 1024, 0, 4, 0.08838834764831845f * LOG2E, q0 + r32, 0, nullptr, m, l, o);
    gated_store<128>(lds, l, o, PROJ + (size_t)q0 * NP + C_Z + 1536 + h * 128);
}
__device__ __forceinline__ void run_mixers(LAS unsigned char* lds, unsigned* ctr, bf16_t* PROJ, const int* pos, const float* sinks, const float* btab_g, const bf16_t* MEMKV) {
    LAS int* ub = (LAS int*)(lds + L_UNIT);
    __syncthreads();
    for (int i = tidx(); i < 129 * 8; i += NT_THREADS) ((LAS float*)(lds + L_BTAB))[i] = btab_g[i];
    for (;;) {
        __syncthreads();
        if (tidx() == 0) *ub = (int)atomicAdd(ctr, 1u);
        __syncthreads();
        const int u = *ub;
        if (u >= 768) break;
        if (u < 256) cross_unit(lds, u >> 2, u & 3, PROJ, MEMKV); else swa_unit(lds, (u - 256) >> 1, (u - 256) & 1, PROJ, pos, sinks);
    }
}
}
namespace mla {
constexpr int ST_BYTES = 49152  , R_OFF = 32768, L_SCR = 147456  , L_UNIT = 149504, L_OLT = 67584  , L_OUT = 102400  ;
__device__ __forceinline__ unsigned off_a(unsigned row, unsigned ch) { return 2048u * (row >> 3) + 512u * (ch >> 2) + 64u * (row & 7) + 16u * ((ch & 3) ^ ((row >> 2) & 3)); }
__device__ __forceinline__ unsigned off_r(unsigned row, unsigned ch) { return 1024u * (row >> 3) + 512u * (ch >> 2) + 64u * (row & 7) + 16u * ((ch & 3) ^ ((row >> 2) & 3)); }

#ifdef EXP_MLASEC
#define MSEC(i) do { const unsigned long long t_ = __builtin_amdgcn_s_memrealtime(); macc[i] += t_ - mtm; mtm = t_; } while (0)
#define MSEC_ARGS , unsigned long long (&macc)[8], unsigned long long& mtm
#define MSEC_PASS , macc, mtm
#else
#define MSEC(i)
#define MSEC_ARGS
#define MSEC_PASS
#endif
template <int VAR, bool SAFE> __device__ __forceinline__ bool unit(LAS unsigned char* lds, int qb, int h, const bf16_t* QABS, const bf16_t* KVLAT, bf16_t* PROJ, const bf16_t* WUV, const float* rsq, const float* cosT, const float* sinT, float qscale MSEC_ARGS) {
    const int tid = tidx(), lane = tid & 63, r32 = lane & 31, hi = lane >> 5, wid = __builtin_amdgcn_readfirstlane(tid >> 6), kg = wid >> 2, g = wid & 3;
    const int q0 = qb * 128, qloc = 32 * g + r32, qidx = q0 + qloc;
    bf16x8 qr[12];
    { const bf16_t* qrow = QABS + (size_t)qidx * 768 + h * 192;
#pragma unroll
      for (int d0 = 0; d0 < 12; ++d0) qr[d0] = *(const bf16x8*)(qrow + d0 * 16 + hi * 8);
      const float sc = rsq[qidx] * qscale;
#pragma unroll
      for (int d0 = 0; d0 < 12; ++d0) { const u32x4 w = __builtin_bit_cast(u32x4, qr[d0]);
          float v[8] = {lo_bf(w.x) * sc, hi_bf(w.x) * sc, lo_bf(w.y) * sc, hi_bf(w.y) * sc, lo_bf(w.z) * sc, hi_bf(w.z) * sc, lo_bf(w.w) * sc, hi_bf(w.w) * sc};
          if (d0 >= 8) { const int i0 = (d0 - 8) * 8 + hi * 4; const f32x4 c = *(const f32x4*)(cosT + (size_t)qidx * 32 + i0), s = *(const f32x4*)(sinT + (size_t)qidx * 32 + i0);
#pragma unroll
              for (int jj = 0; jj < 4; ++jj) { const float t1 = v[2 * jj], t2 = v[2 * jj + 1]; v[2 * jj] = t1 * c[jj] - t2 * s[jj]; v[2 * jj + 1] = t1 * s[jj] + t2 * c[jj]; }
              SBAR(); }
          qr[d0] = pack8(v); } }
    SBAR();
    unsigned goff[6];
#pragma unroll
    for (int i = 0; i < 6; ++i) { const unsigned o_ = (unsigned)(wid * 6 + i) * 1024u + lane * 16u; unsigned key, cc;
        if (o_ < (unsigned)R_OFF) { const unsigned r = o_ & 2047u, k7 = (r & 511u) >> 6, x = (r & 63u) >> 4; key = (o_ >> 11) * 8u + k7; cc = (r >> 9) * 4u + (x ^ ((key >> 2) & 3u)); }
        else { const unsigned o2 = o_ - R_OFF, r = o2 & 1023u, k7 = (r & 511u) >> 6, x = (r & 63u) >> 4; key = (o2 >> 10) * 8u + k7; cc = 16u + (r >> 9) * 4u + (x ^ ((key >> 2) & 3u)); }
        goff[i] = (key * 192u + cc * 8u) * 2u; }
#define STAGE_TILE(t_, SB) do { const char* src_ = (const char*)KVLAT + (size_t)(t_) * (128 * 192 * 2); const unsigned la_ = (unsigned)(uintptr_t)lds + (SB) + wid * 6144; \
        _Pragma("unroll") for (int i = 0; i < 6; ++i) asm volatile("s_mov_b32 m0, %0\n\ts_nop 0\n\tglobal_load_lds_dwordx4 %1, %2" :: "s"(la_ + i * 1024), "v"(goff[i]), "s"(src_) : "memory", "m0"); } while (0)
    STAGE_TILE(0, 0);
    if (qb >= 1) STAGE_TILE(1, ST_BYTES);
    const unsigned y = (r32 >> 2) & 3, rowpart = 64u * (r32 & 7);
    const unsigned nb_e = 2048u * (8 * kg + (r32 >> 3)) + rowpart + 16u * ((unsigned)hi ^ y), nb_o = 2048u * (8 * kg + (r32 >> 3)) + rowpart + 16u * ((2u + hi) ^ y);
    const unsigned rb_e = R_OFF + 1024u * (8 * kg + (r32 >> 3)) + rowpart + 16u * ((unsigned)hi ^ y), rb_o = R_OFF + 1024u * (8 * kg + (r32 >> 3)) + rowpart + 16u * ((2u + hi) ^ y);
    const unsigned blk = (lane >> 4) & 1, q_ = (lane & 15) >> 2, p_ = lane & 3, xc = 2u * blk + (p_ >> 1);
    const unsigned tbo0 = 2048u * (8 * kg) + 64u * (4u * hi + q_) + 16u * (xc ^ (unsigned)hi) + 8u * (p_ & 1), tbo1 = 2048u * (8 * kg + 1) + 64u * (4u * hi + q_) + 16u * (xc ^ (2u + hi)) + 8u * (p_ & 1);
    LAS float* scr = (LAS float*)(lds + L_SCR) + wid * 64;
    float m_reg = -1e30f, l_reg = 0.f; f32x16 o[4] = {};
    bf16x8 paX0, paX1, paY0 = {}, paY1 = {};
    f32x16 pA, pB;
#define KADDR(s, hf) ((s) < 8 ? ((((s) & 1) ? no_ : ne_) + 512 * ((s) >> 1) + 8192 * (hf)) : ((((s) & 1) ? ro_ : re_) + 512 * (((s) - 8) >> 1) + 4096 * (hf)))
#define KRD1(dst, s, hf) dst = *(const LAS bf16x8*)KADDR(s, hf)
#define VRD1(L, H, d0, ka) do { L = __builtin_amdgcn_ds_read_tr16_b64_v4i16((LAS s16x4*)(t0a_ + 4096 * (ka) + 512 * (d0))); H = __builtin_amdgcn_ds_read_tr16_b64_v4i16((LAS s16x4*)(t1a_ + 4096 * (ka) + 512 * (d0))); } while (0)
#define VFR(L, H) ((bf16x8){L[0], L[1], L[2], L[3], H[0], H[1], H[2], H[3]})
#define QBASES(SB) const LAS unsigned char* ne_ = lds + (SB) + nb_e; const LAS unsigned char* no_ = lds + (SB) + nb_o; const LAS unsigned char* re_ = lds + (SB) + rb_e; const LAS unsigned char* ro_ = lds + (SB) + rb_o
#define PBASES(SB) LAS unsigned char* t0a_ = lds + (SB) + tbo0; LAS unsigned char* t1a_ = lds + (SB) + tbo1
#define QKQ_SERIAL(PN, SB, hf) do { QBASES(SB); PN = (f32x16){}; _Pragma("unroll") for (int s_ = 0; s_ < 12; ++s_) { bf16x8 k_; KRD1(k_, s_, hf); PN = MFMA32(k_, qr[s_], PN); } } while (0)
#define PVQ_SERIAL(SB, hf, PA0, PA1) do { PBASES(SB); _Pragma("unroll") for (int j_ = 0; j_ < 8; ++j_) { s16x4 l_, h_; VRD1(l_, h_, j_ >> 1, 2 * (hf) + (j_ & 1)); o[j_ >> 1] = MFMA32((j_ & 1) ? PA1 : PA0, VFR(l_, h_), o[j_ >> 1]); } } while (0)
#define ROWMAX16(P, out) do { float a_ = fmaxf(fmaxf(P[0], P[1]), P[2]), b_ = fmaxf(fmaxf(P[3], P[4]), P[5]), c_ = fmaxf(fmaxf(P[6], P[7]), P[8]), d_ = fmaxf(fmaxf(P[9], P[10]), P[11]), e_ = fmaxf(fmaxf(P[12], P[13]), P[14]); \
        a_ = fmaxf(fmaxf(a_, b_), P[15]); c_ = fmaxf(fmaxf(c_, d_), e_); out = fmaxf(a_, c_); } while (0)
#define HALVES_MAX(v) do { auto rr = __builtin_amdgcn_permlane32_swap(__float_as_uint(v), __float_as_uint(v), false, false); v = fmaxf(__uint_as_float(rr[0]), __uint_as_float(rr[1])); } while (0)
#define RESCALE_O(alpha_) do { if (hi == 0) scr[r32] = (alpha_); LDS_WAIT(); \
            _Pragma("unroll") for (int gg = 0; gg < 4; ++gg) { const f32x4 a4 = *(const LAS f32x4*)(scr + 8 * gg + 4 * hi); \
                _Pragma("unroll") for (int d = 0; d < 4; ++d) { o[d][4 * gg + 0] *= a4[0]; o[d][4 * gg + 1] *= a4[1]; o[d][4 * gg + 2] *= a4[2]; o[d][4 * gg + 3] *= a4[3]; } } } while (0)
#define DIAG_MASK() do { const int t2_ = tidx(); int ql_ = 32 * ((t2_ >> 6) & 3) + (t2_ & 31) - 64 * (t2_ >> 8) - 4 * ((t2_ >> 5) & 1); asm volatile("" : "+v"(ql_)); \
        _Pragma("unroll") for (int r = 0; r < 16; ++r) { const int kc_ = (r & 3) + 8 * (r >> 2); if (kc_ > ql_) pA[r] = -__builtin_inff(); if (kc_ + 32 > ql_) pB[r] = -__builtin_inff(); } } while (0)
    asm volatile("s_waitcnt vmcnt(0)" ::: "memory");
    __syncthreads();
    MSEC(0);
    if constexpr (!SAFE) {
#define SMC(i, PC, PE0, PE1) do { if ((i) < 16) { const float e_ = __builtin_amdgcn_exp2f(PC[i]); \
            if (((i) & 3) == 0) l0_ += e_; else if (((i) & 3) == 1) l1_ += e_; else if (((i) & 3) == 2) l2_ += e_; else l3_ += e_; \
            if (((i) & 1) == 0) ev_ = e_; else { const unsigned c_ = cvtpk(ev_, e_); if (((i) >> 1 & 3) == 0) c0_ = c_; else if (((i) >> 1 & 3) == 1) c1_ = c_; else if (((i) >> 1 & 3) == 2) c2_ = c_; else c3_ = c_; } \
            if ((i) == 7) { u32x4 w_ = {c0_, c1_, c2_, c3_}; PE0 = __builtin_bit_cast(bf16x8, w_); } if ((i) == 15) { u32x4 w_ = {c0_, c1_, c2_, c3_}; PE1 = __builtin_bit_cast(bf16x8, w_); } } } while (0)
#define SLOT_ISQ(i) (((i) < 16) ? (((i) & 1) == 0) : true)
#define SLOT_QS(i) (((i) < 16) ? ((i) >> 1) : ((i) - 8))
#define SLOT_PJ(i) ((i) >> 1)
#define RD_SLOT(i, HQ, HP) do { if ((i) < 20) { if (SLOT_ISQ(i)) { if (SLOT_QS(i) % 3 == 0) KRD1(kf0, SLOT_QS(i), HQ); else if (SLOT_QS(i) % 3 == 1) KRD1(kf1, SLOT_QS(i), HQ); else KRD1(kf2, SLOT_QS(i), HQ); } \
        else { if (SLOT_PJ(i) & 1) VRD1(vl1, vh1, SLOT_PJ(i) >> 1, 2 * (HP) + 1); else VRD1(vl0, vh0, SLOT_PJ(i) >> 1, 2 * (HP)); } } } while (0)
#define MM_SLOT(i, PN, PA0, PA1) do { if (SLOT_ISQ(i)) { if (SLOT_QS(i) % 3 == 0) PN = MFMA32(kf0, qr[SLOT_QS(i)], PN); else if (SLOT_QS(i) % 3 == 1) PN = MFMA32(kf1, qr[SLOT_QS(i)], PN); else PN = MFMA32(kf2, qr[SLOT_QS(i)], PN); } \
        else { if (SLOT_PJ(i) & 1) o[(SLOT_PJ(i) >> 1) & 3] = MFMA32(PA1, VFR(vl1, vh1), o[(SLOT_PJ(i) >> 1) & 3]); else o[(SLOT_PJ(i) >> 1) & 3] = MFMA32(PA0, VFR(vl0, vh0), o[(SLOT_PJ(i) >> 1) & 3]); } } while (0)
#define SLOT(i, PN, HQ, HP, PA0, PA1, PC, PE0, PE1) do { MM_SLOT(i, PN, PA0, PA1); RD_SLOT((i) + 2, HQ, HP); if (!(VAR & 2)) SMC(i, PC, PE0, PE1); SBAR(); } while (0)
#define ITER(PN, SBQ, HQ, SBP, HP, PA0, PA1, PC, PE0, PE1) do { QBASES(SBQ); PBASES(SBP); bf16x8 kf0, kf1, kf2; s16x4 vl0, vh0, vl1, vh1; float ev_ = 0.f; unsigned c0_ = 0, c1_ = 0, c2_ = 0, c3_ = 0; \
        PN = (f32x16){}; RD_SLOT(0, HQ, HP); RD_SLOT(1, HQ, HP); SBAR(); \
        SLOT(0, PN, HQ, HP, PA0, PA1, PC, PE0, PE1); SLOT(1, PN, HQ, HP, PA0, PA1, PC, PE0, PE1); SLOT(2, PN, HQ, HP, PA0, PA1, PC, PE0, PE1); SLOT(3, PN, HQ, HP, PA0, PA1, PC, PE0, PE1); \
        SLOT(4, PN, HQ, HP, PA0, PA1, PC, PE0, PE1); SLOT(5, PN, HQ, HP, PA0, PA1, PC, PE0, PE1); SLOT(6, PN, HQ, HP, PA0, PA1, PC, PE0, PE1); SLOT(7, PN, HQ, HP, PA0, PA1, PC, PE0, PE1); \
        SLOT(8, PN, HQ, HP, PA0, PA1, PC, PE0, PE1); SLOT(9, PN, HQ, HP, PA0, PA1, PC, PE0, PE1); SLOT(10, PN, HQ, HP, PA0, PA1, PC, PE0, PE1); SLOT(11, PN, HQ, HP, PA0, PA1, PC, PE0, PE1); \
        SLOT(12, PN, HQ, HP, PA0, PA1, PC, PE0, PE1); SLOT(13, PN, HQ, HP, PA0, PA1, PC, PE0, PE1); SLOT(14, PN, HQ, HP, PA0, PA1, PC, PE0, PE1); SLOT(15, PN, HQ, HP, PA0, PA1, PC, PE0, PE1); \
        SLOT(16, PN, HQ, HP, PA0, PA1, PC, PE0, PE1); SLOT(17, PN, HQ, HP, PA0, PA1, PC, PE0, PE1); SLOT(18, PN, HQ, HP, PA0, PA1, PC, PE0, PE1); SLOT(19, PN, HQ, HP, PA0, PA1, PC, PE0, PE1); } while (0)
    float l0_ = 0.f, l1_ = 0.f, l2_ = 0.f, l3_ = 0.f;
    unsigned s_prev = 2 * ST_BYTES, s_cur = 0, s_next = ST_BYTES;
    QKQ_SERIAL(pA, s_cur, 0);
#pragma unroll 1
    for (int t = 0; t < qb; ++t) {
        { const unsigned sp_ = t ? s_prev : s_cur; ITER(pB, s_cur, 1, sp_, 1, paY0, paY1, pA, paX0, paX1); }
        asm volatile("s_waitcnt vmcnt(0)" ::: "memory");
        if (!(VAR & 16)) __syncthreads();
        if (t + 2 <= qb && !(VAR & 8)) STAGE_TILE(t + 2, s_prev);
        ITER(pA, s_next, 0, s_cur, 0, paX0, paX1, pB, paY0, paY1);
        { const unsigned tmp_ = s_prev; s_prev = s_cur; s_cur = s_next; s_next = tmp_; }
    }
    if (qb > 0) PVQ_SERIAL(s_prev, 1, paY0, paY1);
    QKQ_SERIAL(pB, s_cur, 1);
    DIAG_MASK();
#pragma unroll
    for (int r = 0; r < 16; ++r) { pA[r] = __builtin_amdgcn_exp2f(pA[r]); pB[r] = __builtin_amdgcn_exp2f(pB[r]); l0_ += pA[r]; l1_ += pB[r]; }
    paX0 = pack_step(pA, 0); paX1 = pack_step(pA, 1); paY0 = pack_step(pB, 0); paY1 = pack_step(pB, 1);
    PVQ_SERIAL(s_cur, 0, paX0, paX1);
    PVQ_SERIAL(s_cur, 1, paY0, paY1);
    l_reg = (l0_ + l1_) + (l2_ + l3_); m_reg = 0.f;
#undef SMC
#undef SLOT_ISQ
#undef SLOT_QS
#undef SLOT_PJ
#undef RD_SLOT
#undef MM_SLOT
#undef SLOT
#undef ITER
    } else {
#pragma unroll 1
    for (int t = 0; t <= qb; ++t) {
        __syncthreads();
        STAGE_TILE(t, 0);
        asm volatile("s_waitcnt vmcnt(0)" ::: "memory");
        __syncthreads();
        QKQ_SERIAL(pA, 0, 0); QKQ_SERIAL(pB, 0, 1);
        if (t == qb) DIAG_MASK();
        float pm_, pm2_; ROWMAX16(pA, pm_); ROWMAX16(pB, pm2_); pm_ = fmaxf(pm_, pm2_); HALVES_MAX(pm_);
        const float mn_ = fmaxf(m_reg, pm_), al_ = __builtin_amdgcn_exp2f(m_reg - mn_); m_reg = mn_; float ps_ = 0.f;
#pragma unroll
        for (int r = 0; r < 16; ++r) { pA[r] = __builtin_amdgcn_exp2f(pA[r] - mn_); pB[r] = __builtin_amdgcn_exp2f(pB[r] - mn_); ps_ += pA[r] + pB[r]; }
        l_reg = l_reg * al_ + ps_;
        if (__any(al_ < 1.f)) RESCALE_O(al_);
        paX0 = pack_step(pA, 0); paX1 = pack_step(pA, 1); paY0 = pack_step(pB, 0); paY1 = pack_step(pB, 1);
        PVQ_SERIAL(0, 0, paX0, paX1);
        PVQ_SERIAL(0, 1, paY0, paY1);
    }
    }
    { auto rr = __builtin_amdgcn_permlane32_swap(__float_as_uint(l_reg), __float_as_uint(l_reg), false, false); l_reg = __uint_as_float(rr[0]) + __uint_as_float(rr[1]); }
    if (!(l_reg > 0.f)) m_reg = -1e30f;
    if (tidx() == 0) *(LAS int*)(lds + L_UNIT + 8) = 0;
    __syncthreads();
#undef KADDR
#undef KRD1
#undef VRD1
#undef VFR
#undef QBASES
#undef PBASES
#undef QKQ_SERIAL
#undef PVQ_SERIAL
#undef ROWMAX16
#undef HALVES_MAX
#undef RESCALE_O
#undef DIAG_MASK
    if (VAR != 0) { asm volatile("" :: "v"(o[0]), "v"(o[1]), "v"(o[2]), "v"(o[3]), "v"(m_reg), "v"(l_reg)); return false; }
#undef STAGE_TILE
    const int tid_e = tidx(), lane_e = tid_e & 63; const int wid_e = __builtin_amdgcn_readfirstlane(tid_e >> 6);
#define lane lane_e
#define r32 (lane_e & 31)
#define hi (lane_e >> 5)
#define kg (wid_e >> 2)
#define g (wid_e & 3)
    LAS float* scr_e = (LAS float*)(lds + L_SCR) + wid_e * 64;
#define scr scr_e
    LAS float* xo = (LAS float*)lds + g * 4096;
    LAS float* xm = (LAS float*)(lds + 65536) + g * 128;
    if (kg == 1) {
#pragma unroll
        for (int d0 = 0; d0 < 4; ++d0)
#pragma unroll
            for (int r = 0; r < 16; ++r) xo[(d0 * 16 + r) * 64 + lane] = o[d0][r];
        xm[lane] = m_reg; xm[64 + lane] = l_reg;
    }
    __syncthreads();
    float fA = 0.f, fB = 0.f, li = 0.f;
    if (kg == 0) {
        const float mB = xm[lane], lB = xm[64 + lane];
        const float m = fmaxf(m_reg, mB); fA = __builtin_amdgcn_exp2f(m_reg - m); fB = __builtin_amdgcn_exp2f(mB - m); const float ls = l_reg * fA + lB * fB; li = 1.f / ls;
#ifdef EXP_FORCE_SAFE
        if (!SAFE) *(LAS int*)(lds + L_UNIT + 8) = 1;
#else
        if (!SAFE && !(ls > 7.9e-31f && ls < 1.2e30f)) *(LAS int*)(lds + L_UNIT + 8) = 1;
#endif
    }
    if constexpr (!SAFE) { __syncthreads(); if (*(LAS int*)(lds + L_UNIT + 8)) { __syncthreads(); return true; } }
    if (kg == 0) {
        if (hi == 0) { scr[r32] = fA * li; scr[32 + r32] = fB * li; }
        LDS_WAIT();
        float sA[16], sB[16];
#pragma unroll
        for (int gg = 0; gg < 4; ++gg) { const f32x4 a4 = *(const LAS f32x4*)(scr + 8 * gg + 4 * hi), b4 = *(const LAS f32x4*)(scr + 32 + 8 * gg + 4 * hi);
            sA[4 * gg] = a4[0]; sA[4 * gg + 1] = a4[1]; sA[4 * gg + 2] = a4[2]; sA[4 * gg + 3] = a4[3]; sB[4 * gg] = b4[0]; sB[4 * gg + 1] = b4[1]; sB[4 * gg + 2] = b4[2]; sB[4 * gg + 3] = b4[3]; }
        LAS bf16_t* olt = (LAS bf16_t*)(lds + L_OLT + g * 8704); LAS bf16_t* ot = (LAS bf16_t*)(lds + L_OUT + g * 8704);
#pragma unroll
        for (int d0 = 0; d0 < 4; ++d0) {
#pragma unroll
            for (int r = 0; r < 16; ++r) olt[crow(r, hi) * 136 + d0 * 32 + r32] = f2bf(o[d0][r] * sA[r] + xo[(d0 * 16 + r) * 64 + lane] * sB[r]);
            SBAR(); }
        LDS_WAIT();
        bf16x8 af[8];
#pragma unroll
        for (int ks = 0; ks < 8; ++ks) af[ks] = *(const LAS bf16x8*)(olt + r32 * 136 + 16 * ks + 8 * hi);
        f32x16 y[4] = {};
        const bf16_t* wb = WUV + (size_t)(h * 128 + r32) * 512 + h * 128 + 8 * hi;
#pragma unroll
        for (int c = 0; c < 4; ++c)
#pragma unroll
            for (int ks = 0; ks < 8; ++ks) y[c] = MFMA32(af[ks], *(const bf16x8*)(wb + (size_t)(32 * c) * 512 + 16 * ks), y[c]);
#pragma unroll
        for (int r = 0; r < 16; ++r)
#pragma unroll
            for (int c = 0; c < 4; ++c) ot[crow(r, hi) * 136 + 32 * c + r32] = f2bf(y[c][r]);
        LDS_WAIT();
        bf16_t* zp0 = PROJ + (size_t)(q0 + 32 * g) * NP + C_Z + 1024 + h * 128;
#pragma unroll
        for (int i = 0; i < 8; ++i) { const int id = lane + 64 * i, row = id >> 4, dc = id & 15;
            const u32x4 v = *(const LAS u32x4*)(ot + row * 136 + dc * 8); bf16_t* zp = zp0 + (size_t)row * NP + dc * 8; const u32x4 z = *(const u32x4*)zp;
            u32x4 w; w.x = cvtpk(lo_bf(v.x) * silu_f(lo_bf(z.x)), hi_bf(v.x) * silu_f(hi_bf(z.x))); w.y = cvtpk(lo_bf(v.y) * silu_f(lo_bf(z.y)), hi_bf(v.y) * silu_f(hi_bf(z.y)));
            w.z = cvtpk(lo_bf(v.z) * silu_f(lo_bf(z.z)), hi_bf(v.z) * silu_f(hi_bf(z.z))); w.w = cvtpk(lo_bf(v.w) * silu_f(lo_bf(z.w)), hi_bf(v.w) * silu_f(hi_bf(z.w)));
            *(u32x4*)zp = w; }
    }
    __syncthreads();
    MSEC(6);
#undef lane
#undef r32
#undef hi
#undef kg
#undef g
#undef scr
    return false;
}
__device__ __forceinline__ void run_queue(LAS unsigned char* lds, unsigned* ctr, const bf16_t* QABS, const bf16_t* KVLAT, bf16_t* PROJ, const bf16_t* WUV, const float* rsq, const float* cosT, const float* sinT, float qscale) {
    LAS int* ub = (LAS int*)(lds + L_UNIT);
#ifdef EXP_MLASEC
    unsigned long long macc[8] = {0, 0, 0, 0, 0, 0, 0, 0}, mtm = __builtin_amdgcn_s_memrealtime();
#endif
    for (;;) {
        __syncthreads();
        if (tidx() == 0) *ub = (int)atomicAdd(ctr, 1u);
        __syncthreads();
        const int u = *ub;
        if (u >= 512) break;
        MSEC(7);
        if (unit<0, false>(lds, 127 - (u >> 2), u & 3, QABS, KVLAT, PROJ, WUV, rsq, cosT, sinT, qscale MSEC_PASS)) (void)unit<0, true>(lds, 127 - (u >> 2), u & 3, QABS, KVLAT, PROJ, WUV, rsq, cosT, sinT, qscale MSEC_PASS);
    }
#ifdef EXP_MLAVAR
    for (;;) {
        __syncthreads();
        if (tidx() == 0) *ub = (int)atomicAdd(ctr + 32, 1u);
        __syncthreads();
        const int u = *ub;
        if (u >= 512) break;
        (void)unit<EXP_MLAVAR, false>(lds, 127 - (u >> 2), u & 3, QABS, KVLAT, PROJ, WUV, rsq, cosT, sinT, qscale MSEC_PASS);
    }
#endif
#ifdef EXP_MLASEC
    { const unsigned long long t1_ = __builtin_amdgcn_s_memrealtime(); while (__builtin_amdgcn_s_memrealtime() - t1_ < 4 * macc[EXP_MLASEC]) __builtin_amdgcn_s_sleep(8); }
#endif
}
}
template <class Map>
__device__ __forceinline__ void transpose_tile(const float* W, int ldw, bf16_t* WT, int K, int n0, int k0, LAS float* tile, Map map, int lane) {
    { const int src = map(n0 + lane); float v[64];
#pragma unroll
      for (int k = 0; k < 64; ++k) v[k] = src >= 0 ? W[(size_t)(k0 + k) * ldw + src] : 0.f;
#pragma unroll
      for (int k = 0; k < 64; ++k) tile[k * 65 + lane] = v[k]; }
    LDS_WAIT();
    { const int kc = (lane & 7) * 8;
#pragma unroll
      for (int i = 0; i < 8; ++i) { const int n = (lane >> 3) + 8 * i; float v[8];
#pragma unroll
          for (int j = 0; j < 8; ++j) v[j] = tile[(kc + j) * 65 + n];
          u32x4 w = {cvtpk(v[0], v[1]), cvtpk(v[2], v[3]), cvtpk(v[4], v[5]), cvtpk(v[6], v[7])};
          *(u32x4*)(WT + (size_t)(n0 + n) * K + k0 + kc) = w; } }
    LDS_WAIT();
}
struct MapWin { __device__ int operator()(int n) const { return win_src(n); } };
struct MapId { __device__ int operator()(int n) const { return n; } };

__device__ __forceinline__ void job_win(const Params& p, int l, int gw, int ngw, LAS unsigned char* lds, int wid, int lane) {
    bf16_t* WT = (bf16_t*)(p.ws + WS_WIN); const float* W = p.w_in + (size_t)l * DM * DIN; LAS float* tile = (LAS float*)(lds + wid * 16640);
    for (int t = gw; t < (NP / 64) * (DM / 64); t += ngw) transpose_tile(W, DIN, WT, DM, (t / (DM / 64)) * 64, (t % (DM / 64)) * 64, tile, MapWin(), lane);
}
__device__ __forceinline__ void job_wout(const Params& p, int l, int gw, int ngw, LAS unsigned char* lds, int wid, int lane) {
    bf16_t* WT = (bf16_t*)(p.ws + WS_WOUT); const float* W = p.w_out + (size_t)l * MIXW * DM; LAS float* tile = (LAS float*)(lds + wid * 16640);
    for (int t = gw; t < (DM / 64) * (MIXW / 64); t += ngw) transpose_tile(W, DM, WT, MIXW, (t / (MIXW / 64)) * 64, (t % (MIXW / 64)) * 64, tile, MapId(), lane);
}
__device__ __forceinline__ void job_wmem(const Params& p, int gw, int ngw, LAS unsigned char* lds, int wid, int lane) {
    LAS float* tile = (LAS float*)(lds + wid * 16640);
    for (int t = gw; t < 2 * 16 * 16; t += ngw) { const int l = t >> 8, r = t & 255;
        transpose_tile(p.w_mem + (size_t)l * DM * DM, DM, (bf16_t*)(p.ws + WS_WMEM) + (size_t)l * DM * DM, DM, (r >> 4) * 64, (r & 15) * 64, tile, MapId(), lane); }
}
__device__ __forceinline__ void job_wq(const Params& p, int bid, int nblk, int gtid, int gn, LAS unsigned char* lds) {
    const int tid = tidx(); LAS float* At = (LAS float*)lds; LAS float* Bt = At + 64 * 129;
    for (int it = bid; it < 2 * 4 * 4 * 2; it += nblk) { const int l = it >> 5, h = (it >> 3) & 3, kt = (it >> 1) & 3, ct = it & 1;
        const float* uq = p.w_uq + (size_t)l * 256 * 768 + (size_t)(kt * 64) * 768 + h * 192; const float* ukv = p.w_ukv + (size_t)l * 128 * 1024 + (size_t)(ct * 64) * 1024 + h * 256;
        __syncthreads();
#pragma unroll
        for (int i = 0; i < 16; ++i) { const int e = tid + NT_THREADS * i, r = e >> 7, j = e & 127; At[r * 129 + j] = uq[(size_t)r * 768 + j]; Bt[r * 129 + j] = ukv[(size_t)r * 1024 + j]; }
        __syncthreads();
        const int kk = tid & 63, c0 = (tid >> 6) * 8; float acc[8] = {0.f, 0.f, 0.f, 0.f, 0.f, 0.f, 0.f, 0.f};
#pragma unroll 4
        for (int j = 0; j < 128; ++j) { const float a = At[kk * 129 + j];
#pragma unroll
            for (int e = 0; e < 8; ++e) acc[e] = fmaf(a, Bt[(c0 + e) * 129 + j], acc[e]); }
        const int k = kt * 64 + kk; const float g = p.q_norm[l * 256 + k]; bf16_t* wq = (bf16_t*)(p.ws + WS_WQ) + (size_t)l * 768 * 256;
#pragma unroll
        for (int e = 0; e < 8; ++e) wq[(size_t)(h * 192 + ct * 64 + c0 + e) * 256 + k] = f2bf(acc[e] * g);
    }
    for (int idx = gtid; idx < 2 * 4 * 64 * 256; idx += gn) {
        const int l = idx >> 16, r = idx & 65535, h = r >> 14, w = (r >> 8) & 63, k = r & 255, i = w >> 1, which = w & 1;
        ((bf16_t*)(p.ws + WS_WQ))[(size_t)l * 768 * 256 + (size_t)(h * 192 + 128 + w) * 256 + k] = f2bf(p.w_uq[(size_t)l * 256 * 768 + (size_t)k * 768 + h * 192 + 128 + i + 32 * which] * p.q_norm[l * 256 + k]);
    }
}
__device__ __forceinline__ void job_wuv(const Params& p, int gtid, int gn) {
    for (int idx = gtid; idx < 2 * 512 * 512; idx += gn) {
        const int l = idx / (512 * 512), r = idx % (512 * 512), n = r / 512, k = r % 512, h = n >> 7;
        const float v = (k >> 7) == h ? p.w_ukv[(size_t)l * 128 * 1024 + (size_t)(k & 127) * 1024 + h * 256 + 128 + (n & 127)] : 0.f;
        ((bf16_t*)(p.ws + WS_WUV))[idx] = f2bf(v);
    }
}
__device__ __forceinline__ void job_rope(const Params& p, int gtid, int gn) {
    float* cosT = (float*)(p.ws + WS_COS); float* sinT = (float*)(p.ws + WS_SIN);
    for (int idx = gtid; idx < S * 32; idx += gn) {
        const int s = idx >> 5, i = idx & 31;
        const float angf = (float)p.pos[s] * inv_freq(i);
        const double a = (double)angf; const double kq = __builtin_rint(a * 0.63661977236758134308);
        const double x = (a - kq * 1.5707963267948966192) - kq * 6.123233995736766036e-17;
        const double x2 = x * x;
        const double sn = x * (1.0 + x2 * (-1.0 / 6 + x2 * (1.0 / 120 + x2 * (-1.0 / 5040 + x2 * (1.0 / 362880 + x2 * (-1.0 / 39916800 + x2 * (1.0 / 6227020800.0)))))));
        const double cs = 1.0 + x2 * (-0.5 + x2 * (1.0 / 24 + x2 * (-1.0 / 720 + x2 * (1.0 / 40320 + x2 * (-1.0 / 3628800 + x2 * (1.0 / 479001600.0 + x2 * (-1.0 / 87178291200.0)))))));
        const int q = ((int)kq) & 3;
        const double c = (q == 0) ? cs : (q == 1) ? -sn : (q == 2) ? -cs : sn;
        const double sv = (q == 0) ? sn : (q == 1) ? cs : (q == 2) ? -sn : -cs;
        cosT[idx] = (float)c; sinT[idx] = (float)sv;
    }
}
__device__ __forceinline__ void job_btab(const Params& p, int gtid, int gn) {
    float* bt = (float*)(p.ws + WS_MISC + MISC_BTAB);
    for (int idx = gtid; idx < 129 * 8; idx += gn) { const int d = idx >> 3, h = idx & 7; bt[idx] = p.rel_bias[t5_bucket(d) * 8 + h] * LOG2E; }
}
__device__ __forceinline__ void rms_row_to_bf16(const float* xrow, const float* gain, bf16_t* orow, int lane) {
    f32x4 v[4]; float ss = 0.f;
#pragma unroll
    for (int j = 0; j < 4; ++j) { v[j] = *(const f32x4*)(xrow + 256 * j + 4 * lane); ss += (v[j].x * v[j].x + v[j].y * v[j].y) + (v[j].z * v[j].z + v[j].w * v[j].w); }
    const float rs = rsqrtf(wave_sum(ss) * (1.f / DM) + RMS_EPS);
#pragma unroll
    for (int j = 0; j < 4; ++j) { const f32x4 g = *(const f32x4*)(gain + 256 * j + 4 * lane);
        u32x2 w; w.x = cvtpk(v[j].x * rs * g.x, v[j].y * rs * g.y); w.y = cvtpk(v[j].z * rs * g.z, v[j].w * rs * g.w);
        *(u32x2*)(orow + 256 * j + 4 * lane) = w; }
}
__device__ __forceinline__ void job_memn(const Params& p, int gw, int ngw, int lane) {
    for (int r = gw; r < 2 * MEML; r += ngw) { const int l = r >> 8, m = r & 255;
        rms_row_to_bf16(p.mem + (size_t)m * DM, p.mem_norm + l * DM, (bf16_t*)(p.ws + WS_MEMN) + ((size_t)l * MEML + m) * DM, lane); }
}
__device__ __forceinline__ void job_norm_rows(const Params& p, int mode, int gw, int ngw, int lane) {
    bf16_t* H = (bf16_t*)(p.ws + WS_H); const bf16_t* Y = (const bf16_t*)(p.ws + WS_Y);
    for (int row = gw; row < S; row += ngw) {
        if (mode == 0) { rms_row_to_bf16(p.x + (size_t)row * DM, p.norm_pre, H + (size_t)row * DM, lane); continue; }
        const float* xin = (mode == 1 ? p.x : p.out) + (size_t)row * DM; const float* gpost = p.norm_post + (mode == 1 ? 0 : DM);
        float y[16]; float ss = 0.f;
#pragma unroll
        for (int j = 0; j < 4; ++j) { const u32x2 w = *(const u32x2*)(Y + (size_t)row * DM + 256 * j + 4 * lane);
            y[4 * j] = lo_bf(w.x); y[4 * j + 1] = hi_bf(w.x); y[4 * j + 2] = lo_bf(w.y); y[4 * j + 3] = hi_bf(w.y);
            ss += (y[4 * j] * y[4 * j] + y[4 * j + 1] * y[4 * j + 1]) + (y[4 * j + 2] * y[4 * j + 2] + y[4 * j + 3] * y[4 * j + 3]); }
        const float rs = rsqrtf(wave_sum(ss) * (1.f / DM) + RMS_EPS);
        f32x4 x1[4]; float s2 = 0.f;
#pragma unroll
        for (int j = 0; j < 4; ++j) { const f32x4 xv = *(const f32x4*)(xin + 256 * j + 4 * lane); const f32x4 g = *(const f32x4*)(gpost + 256 * j + 4 * lane);
            x1[j].x = xv.x + y[4 * j] * rs * g.x; x1[j].y = xv.y + y[4 * j + 1] * rs * g.y; x1[j].z = xv.z + y[4 * j + 2] * rs * g.z; x1[j].w = xv.w + y[4 * j + 3] * rs * g.w;
            *(f32x4*)(p.out + (size_t)row * DM + 256 * j + 4 * lane) = x1[j];
            s2 += (x1[j].x * x1[j].x + x1[j].y * x1[j].y) + (x1[j].z * x1[j].z + x1[j].w * x1[j].w); }
        if (mode == 1) { const float r2 = rsqrtf(wave_sum(s2) * (1.f / DM) + RMS_EPS); const float* gpre = p.norm_pre + DM;
#pragma unroll
            for (int j = 0; j < 4; ++j) { const f32x4 g = *(const f32x4*)(gpre + 256 * j + 4 * lane);
                u32x2 w; w.x = cvtpk(x1[j].x * r2 * g.x, x1[j].y * r2 * g.y); w.y = cvtpk(x1[j].z * r2 * g.z, x1[j].w * r2 * g.w);
                *(u32x2*)(H + (size_t)row * DM + 256 * j + 4 * lane) = w; } }
    }
}
__device__ __forceinline__ void job_mla_rows(const Params& p, int l, int gw, int ngw, int lane) {
    const bf16_t* PROJ = (const bf16_t*)(p.ws + WS_PROJ); bf16_t* KV = (bf16_t*)(p.ws + WS_KVLAT); float* RSQ = (float*)(p.ws + WS_MISC + MISC_RSQ);
    const float* cosT = (const float*)(p.ws + WS_COS); const float* sinT = (const float*)(p.ws + WS_SIN);
    const int rs_ = lane >> 4, j = lane & 15;
    for (int row = gw * 4 + rs_; row < S; row += ngw * 4) {
        const bf16_t* pr = PROJ + (size_t)row * NP;
        const u32x4 q0 = *(const u32x4*)(pr + C_CQ + j * 16), q1 = *(const u32x4*)(pr + C_CQ + j * 16 + 8), kv = *(const u32x4*)(pr + C_CKV + j * 8); const u32x2 kr = *(const u32x2*)(pr + C_KR + j * 4);
        f32x4 cs = {0.f, 0.f, 0.f, 0.f}, sn = {0.f, 0.f, 0.f, 0.f}; if (j < 8) { cs = *(const f32x4*)(cosT + (size_t)row * 32 + 4 * j); sn = *(const f32x4*)(sinT + (size_t)row * 32 + 4 * j); }
        float sq = 0.f, sk = 0.f;
        { const unsigned w[8] = {q0.x, q0.y, q0.z, q0.w, q1.x, q1.y, q1.z, q1.w};
#pragma unroll
          for (int e = 0; e < 8; ++e) { const float a = lo_bf(w[e]), b = hi_bf(w[e]); sq += a * a + b * b; } }
        float kvf[8] = {lo_bf(kv.x), hi_bf(kv.x), lo_bf(kv.y), hi_bf(kv.y), lo_bf(kv.z), hi_bf(kv.z), lo_bf(kv.w), hi_bf(kv.w)};
#pragma unroll
        for (int e = 0; e < 8; ++e) sk += kvf[e] * kvf[e];
        sq = row16_sum(sq); sk = row16_sum(sk);
        if (j == 0) RSQ[row] = rsqrtf(sq * (1.f / 256.f) + RMS_EPS);
        { const float rs = rsqrtf(sk * (1.f / 128.f) + RMS_EPS); const float* g = p.kv_norm + l * 128 + j * 8; const f32x4 g0 = *(const f32x4*)g, g1 = *(const f32x4*)(g + 4);
          u32x4 w; w.x = cvtpk(kvf[0] * rs * g0[0], kvf[1] * rs * g0[1]); w.y = cvtpk(kvf[2] * rs * g0[2], kvf[3] * rs * g0[3]); w.z = cvtpk(kvf[4] * rs * g1[0], kvf[5] * rs * g1[1]); w.w = cvtpk(kvf[6] * rs * g1[2], kvf[7] * rs * g1[3]);
          *(u32x4*)(KV + (size_t)row * 192 + j * 8) = w; }
        { const unsigned px = xor8_u(kr.x), py = xor8_u(kr.y);
          if (j < 8) { const float t1[4] = {lo_bf(kr.x), hi_bf(kr.x), lo_bf(kr.y), hi_bf(kr.y)}, t2[4] = {lo_bf(px), hi_bf(px), lo_bf(py), hi_bf(py)};
              u32x4 w; w.x = cvtpk(t1[0] * cs[0] - t2[0] * sn[0], t1[0] * sn[0] + t2[0] * cs[0]); w.y = cvtpk(t1[1] * cs[1] - t2[1] * sn[1], t1[1] * sn[1] + t2[1] * cs[1]);
              w.z = cvtpk(t1[2] * cs[2] - t2[2] * sn[2], t1[2] * sn[2] + t2[2] * cs[2]); w.w = cvtpk(t1[3] * cs[3] - t2[3] * sn[3], t1[3] * sn[3] + t2[3] * cs[3]);
              *(u32x4*)(KV + (size_t)row * 192 + 128 + 8 * j) = w; } }
    }
}
__device__ __forceinline__ void job_gdn_final(const Params& p, int l, int gw, int ngw, int lane, int wid, LAS unsigned char* lds) {
    bf16_t* PROJ = (bf16_t*)(p.ws + WS_PROJ); const bf16_t* U = (const bf16_t*)(p.ws + WS_U);
    LAS bf16_t* T = (LAS bf16_t*)(lds + wid * 17408);
    for (int it = gw; it < 1024; it += ngw) {
        const int n = it >> 2, h = it & 3; const bf16_t* ut = U + (size_t)it * 8192 + lane * 4;
#pragma unroll 4
        for (int j = 0; j < 32; ++j) { const u32x2 w = *(const u32x2*)(ut + j * 256);
            const int g = j & 3, ct = (j >> 2) & 1, sl = j >> 3, dv = 32 * sl + (lane & 31), c0 = 32 * ct + 8 * g + 4 * (lane >> 5);
            T[(c0 + 0) * 136 + dv] = (bf16_t)(w.x & 0xffffu); T[(c0 + 1) * 136 + dv] = (bf16_t)(w.x >> 16); T[(c0 + 2) * 136 + dv] = (bf16_t)(w.y & 0xffffu); T[(c0 + 3) * 136 + dv] = (bf16_t)(w.y >> 16); }
        LDS_WAIT();
#pragma unroll 2
        for (int i = 0; i < 16; ++i) { const int id = lane + 64 * i, c = id >> 4, dc = id & 15;
            const u32x4 v = *(const LAS u32x4*)(T + c * 136 + dc * 8);
            float x[8] = {lo_bf(v.x), hi_bf(v.x), lo_bf(v.y), hi_bf(v.y), lo_bf(v.z), hi_bf(v.z), lo_bf(v.w), hi_bf(v.w)};
            float ss = 0.f;
#pragma unroll
            for (int e = 0; e < 8; ++e) ss += x[e] * x[e];
            ss = row16_sum(ss);
            const float rs = rsqrtf(ss * (1.f / 128.f) + RMS_EPS);
            const float* gn = p.gdn_norm + l * 128 + dc * 8; const f32x4 g0 = *(const f32x4*)gn, g1 = *(const f32x4*)(gn + 4);
            bf16_t* zp = PROJ + (size_t)(n * 64 + c) * NP + C_Z + 512 + h * 128 + dc * 8; const u32x4 z = *(const u32x4*)zp;
            u32x4 o; o.x = cvtpk(x[0] * rs * g0[0] * silu_f(lo_bf(z.x)), x[1] * rs * g0[1] * silu_f(hi_bf(z.x))); o.y = cvtpk(x[2] * rs * g0[2] * silu_f(lo_bf(z.y)), x[3] * rs * g0[3] * silu_f(hi_bf(z.y)));
            o.z = cvtpk(x[4] * rs * g1[0] * silu_f(lo_bf(z.z)), x[5] * rs * g1[1] * silu_f(hi_bf(z.z))); o.w = cvtpk(x[6] * rs * g1[2] * silu_f(lo_bf(z.w)), x[7] * rs * g1[3] * silu_f(hi_bf(z.w)));
            *(u32x4*)zp = o; }
        LDS_WAIT();
    }
}
namespace gdn {
constexpr int L_QH = 0, L_KH = 17408, L_KBGT = 34816, L_KHDT = 53248, L_VBT = 71680, L_LF = 90112, L_TF = 107520, L_MB = 124928, L_GV = 129280, L_END = 130560;
constexpr int QP = 136, TP = 72, LP = 68;
__device__ __forceinline__ bf16_t* frag_ptr(bf16_t* PROJ, int n, int h, int f, int lane) {
    const int seg = 4 * f + (lane >> 4), part = seg >> 6, row = seg & 63;
    return PROJ + (size_t)(n * 64 + row) * NP + C_BQKV + part * 512 + h * 128 + (lane & 15) * 8;
}
__device__ __forceinline__ bf16x8 pack8f(const LAS float* q) { const f32x4 a = *(const LAS f32x4*)q, b = *(const LAS f32x4*)(q + 4); u32x4 w = {cvtpk(a[0], a[1]), cvtpk(a[2], a[3]), cvtpk(b[0], b[1]), cvtpk(b[2], b[3])}; return __builtin_bit_cast(bf16x8, w); }
__device__ __forceinline__ void prep_item(const Params& p, int l, int n, int h, LAS unsigned char* lds) {
    const int tid = tidx(), lane = tid & 63, r32 = lane & 31, hi = lane >> 5, wid = __builtin_amdgcn_readfirstlane(tid >> 6);
    bf16_t* PROJ = (bf16_t*)(p.ws + WS_PROJ); const bf16_t* HALO = (const bf16_t*)(p.ws + WS_HALO);
    bf16_t* AQKg = (bf16_t*)(p.ws + WS_AQK); bf16_t* Ug = (bf16_t*)(p.ws + WS_U); float* EGL = (float*)(p.ws + WS_MISC + MISC_EGL);
    LAS bf16_t* QH = (LAS bf16_t*)(lds + L_QH); LAS bf16_t* KH = (LAS bf16_t*)(lds + L_KH); LAS bf16_t* KBGT = (LAS bf16_t*)(lds + L_KBGT);
    LAS bf16_t* KHDT = (LAS bf16_t*)(lds + L_KHDT); LAS bf16_t* VBT = (LAS bf16_t*)(lds + L_VBT); LAS float* LF = (LAS float*)(lds + L_LF);
    LAS float* TF = (LAS float*)(lds + L_TF); LAS float* MB = (LAS float*)(lds + L_MB); LAS float* GC = (LAS float*)(lds + L_GV); LAS float* BETA = GC + 64; LAS float* EGC = GC + 128; LAS float* EGD = GC + 192;
    const int t0 = n * 64;
    const int g16 = tid & 15, row0 = tid >> 4;
#define S2_LOAD(part, XA, XB, WA, WB) do { const int cb_ = (part) * 512 + h * 128 + g16 * 8; \
        _Pragma("unroll") for (int j = 0; j < 4; ++j) { const int ta_ = t0 + row0 - 3 + j; XA[j] = (u32x4){0u, 0u, 0u, 0u}; \
            if (ta_ >= t0) XA[j] = *(const u32x4*)(PROJ + (size_t)ta_ * NP + C_BQKV + cb_); else if (n > 0) XA[j] = *(const u32x4*)(HALO + ((size_t)(n - 1) * 3 + (ta_ - (t0 - 3))) * 1536 + cb_); \
            XB[j] = *(const u32x4*)(PROJ + (size_t)(t0 + row0 + 29 + j) * NP + C_BQKV + cb_); \
            const float* cw_ = p.conv_w + ((size_t)l * 4 + j) * 1536 + cb_; WA[j] = *(const f32x4*)cw_; WB[j] = *(const f32x4*)(cw_ + 4); } } while (0)
    u32x4 xa[4], xb[4]; f32x4 wa[4], wb[4];
    S2_LOAD(0, xa, xb, wa, wb);
    __syncthreads();
    if (wid == 0) {
        const bf16_t* pr = PROJ + (size_t)(t0 + lane) * NP;
        const float xa_ = bf2f(pr[C_BA + h]) + p.dt_bias[l * 4 + h], xb_ = bf2f(pr[C_BB + h]);
        const float e = __expf(xa_); const float sp = xa_ > 20.f ? xa_ : (e < 1e-3f ? e * (1.f - e * (0.5f - e * (1.f / 3.f))) : logf(1.f + e));
        float gc = -__expf(p.a_log[l * 4 + h]) * sp;
#pragma unroll
        for (int o = 1; o < 64; o <<= 1) { const float t_ = __int_as_float(__builtin_amdgcn_ds_bpermute((lane - o) << 2, __float_as_int(gc))); if (lane >= o) gc += t_; }
        const float gl = __int_as_float(__builtin_amdgcn_readlane(__float_as_int(gc), 63));
        GC[lane] = gc; BETA[lane] = 1.f / (1.f + __expf(-xb_)); EGC[lane] = __expf(gc); EGD[lane] = __expf(gl - gc);
        if (lane == 0) EGL[n * 4 + h] = __expf(gl);
    }
    __syncthreads();
#define TSW(dk, j) ((dk) * 64 + (((((j) >> 3) ^ (((dk) >> 3) & 7)) << 3) | ((j) & 7)))
#define S2_ITEM(part, X, W0, W1, row) do { float a[8] = {0.f, 0.f, 0.f, 0.f, 0.f, 0.f, 0.f, 0.f}; \
        _Pragma("unroll") for (int j = 0; j < 4; ++j) { a[0] = fmaf(W0[j][0], lo_bf(X[j].x), a[0]); a[1] = fmaf(W0[j][1], hi_bf(X[j].x), a[1]); a[2] = fmaf(W0[j][2], lo_bf(X[j].y), a[2]); a[3] = fmaf(W0[j][3], hi_bf(X[j].y), a[3]); \
            a[4] = fmaf(W1[j][0], lo_bf(X[j].z), a[4]); a[5] = fmaf(W1[j][1], hi_bf(X[j].z), a[5]); a[6] = fmaf(W1[j][2], lo_bf(X[j].w), a[6]); a[7] = fmaf(W1[j][3], hi_bf(X[j].w), a[7]); } \
        float ss = 0.f; _Pragma("unroll") for (int e = 0; e < 8; ++e) { a[e] = silu_f(a[e]); ss += a[e] * a[e]; } \
        ss = row16_sum(ss); const float rn = rsqrtf(ss + 1e-6f); \
        if ((part) == 0) { const float sc = rn * 0.08838834764831845f; _Pragma("unroll") for (int e = 0; e < 8; ++e) a[e] *= sc; *(LAS bf16x8*)(QH + (row) * QP + g16 * 8) = pack8(a); } \
        else if ((part) == 1) { _Pragma("unroll") for (int e = 0; e < 8; ++e) a[e] *= rn; *(LAS bf16x8*)(KH + (row) * QP + g16 * 8) = pack8(a); const float s1 = BETA[row] * EGC[row], s2 = EGD[row]; \
            _Pragma("unroll") for (int e = 0; e < 8; ++e) { KBGT[TSW(g16 * 8 + e, row)] = f2bf(a[e] * s1); KHDT[TSW(g16 * 8 + e, row)] = f2bf(a[e] * s2); } } \
        else { const float b = BETA[row]; _Pragma("unroll") for (int e = 0; e < 8; ++e) VBT[TSW(g16 * 8 + e, row)] = f2bf(a[e] * b); } } while (0)
#ifdef EXP_DUPS2
#pragma unroll 1
    for (int rep_ = 0; rep_ < 2; ++rep_)
#endif
    { u32x4 ya[4], yb[4]; f32x4 va[4], vb[4];
      S2_LOAD(1, ya, yb, va, vb);
      S2_ITEM(0, xa, wa, wb, row0); S2_ITEM(0, xb, wa, wb, row0 + 32);
      S2_LOAD(2, xa, xb, wa, wb);
      S2_ITEM(1, ya, va, vb, row0); S2_ITEM(1, yb, va, vb, row0 + 32);
      S2_ITEM(2, xa, wa, wb, row0); S2_ITEM(2, xb, wa, wb, row0 + 32); }
#undef S2_LOAD
#undef S2_ITEM
    __syncthreads();
    if (wid < 3) { const int it = wid > 0, jt = wid > 1; f32x16 acc = {};
#pragma unroll
        for (int ks = 0; ks < 8; ++ks) { const bf16x8 a = *(const LAS bf16x8*)(KH + (32 * it + r32) * QP + 16 * ks + 8 * hi), b = *(const LAS bf16x8*)(KH + (32 * jt + r32) * QP + 16 * ks + 8 * hi);
            acc = MFMA32(a, b, acc); }
        const int j = 32 * jt + r32; const float gj = GC[j];
#pragma unroll
        for (int r = 0; r < 16; ++r) { const int i = 32 * it + crow(r, hi); LF[i * LP + j] = i > j ? BETA[i] * __expf(GC[i] - gj) * acc[r] : 0.f; }
    } else if (wid < 6) { const int w = wid - 3, ctp = w > 1, ct = w > 0; f32x16 acc = {};
#pragma unroll
        for (int ks = 0; ks < 8; ++ks) { const bf16x8 a = *(const LAS bf16x8*)(KH + (32 * ctp + r32) * QP + 16 * ks + 8 * hi), b = *(const LAS bf16x8*)(QH + (32 * ct + r32) * QP + 16 * ks + 8 * hi);
            acc = MFMA32(a, b, acc); }
        const int c = 32 * ct + r32; const float gcq = GC[c];
#pragma unroll
        for (int r = 0; r < 16; ++r) { const int cp = 32 * ctp + crow(r, hi); acc[r] = c >= cp ? acc[r] * __expf(gcq - GC[cp]) : 0.f; }
        bf16_t* dst = AQKg + (((size_t)(n * 4 + h) * 8 + (ct * 2 + ctp) * 2) * 64 + lane) * 8;
        *(bf16x8*)dst = pack_step(acc, 0); *(bf16x8*)(dst + 512) = pack_step(acc, 1);
    } else { const int w = wid - 6;
        if (w == 0) { const bf16x8 z = {0, 0, 0, 0, 0, 0, 0, 0}; bf16_t* dst = AQKg + (((size_t)(n * 4 + h) * 8 + 2) * 64 + lane) * 8; *(bf16x8*)dst = z; *(bf16x8*)(dst + 512) = z; }
#pragma unroll
        for (int ff = 0; ff < 8; ++ff) { const int f = w * 8 + ff, s = f & 1, mt = (f >> 1) & 3, ct = f >> 3, c = 32 * ct + r32, d0 = 32 * mt + 16 * s + 4 * hi; const float eg = EGC[c];
            const u32x2 lo = *(const LAS u32x2*)(QH + c * QP + d0), hw = *(const LAS u32x2*)(QH + c * QP + d0 + 8);
            u32x4 o; o.x = cvtpk(lo_bf(lo.x) * eg, hi_bf(lo.x) * eg); o.y = cvtpk(lo_bf(lo.y) * eg, hi_bf(lo.y) * eg); o.z = cvtpk(lo_bf(hw.x) * eg, hi_bf(hw.x) * eg); o.w = cvtpk(lo_bf(hw.y) * eg, hi_bf(hw.y) * eg);
            *(u32x4*)frag_ptr(PROJ, n, h, 16 + f, lane) = o; }
    }
    __syncthreads();
    if (wid == 0) {
#ifdef EXP_DUPS4
#pragma unroll 1
      for (int rep_ = 0; rep_ < 2; ++rep_)
#endif
      {
        unsigned lfb = (unsigned)(uintptr_t)LF, tfb = (unsigned)(uintptr_t)TF, mbb = (unsigned)(uintptr_t)MB; asm volatile("" : "+v"(lfb), "+v"(tfb), "+v"(mbb));
        const LAS float* LFv = (const LAS float*)(uintptr_t)lfb; LAS float* TFv = (LAS float*)(uintptr_t)tfb; LAS float* MBv = (LAS float*)(uintptr_t)mbb;
        { const int b = lane >> 4, c = lane & 15; const LAS float* Lb = LFv + (16 * b) * LP + 16 * b; LAS float* Tb = TFv + (16 * b) * LP + 16 * b + c; float t[16];
#pragma unroll
          for (int i = 0; i < 16; ++i) { float a0 = (c == i) ? 1.f : 0.f, a1 = 0.f;
#pragma unroll
              for (int q = 0; 4 * q < i; ++q) { const f32x4 lv = *(const LAS f32x4*)(Lb + i * LP + 4 * q);
#pragma unroll
                  for (int e = 0; e < 4; ++e) if (4 * q + e < i) { if (e & 1) a1 = fmaf(-lv[e], t[4 * q + e], a1); else a0 = fmaf(-lv[e], t[4 * q + e], a0); } }
              t[i] = a0 + a1; Tb[i * LP] = t[i]; } }
        const int r16 = lane & 15, k4 = lane >> 4;
#define BLK(P, b_, a_) ((P) + (16 * (b_)) * LP + 16 * (a_))
#define MM16(acc, X, Y) do { _Pragma("unroll") for (int ks = 0; ks < 4; ++ks) acc = __builtin_amdgcn_mfma_f32_16x16x4f32((X)[r16 * LP + 4 * ks + k4], (Y)[(4 * ks + k4) * LP + r16], acc, 0, 0, 0); } while (0)
#define ST16(Z, acc, sg) do { _Pragma("unroll") for (int r = 0; r < 4; ++r) (Z)[(4 * k4 + r) * LP + r16] = (sg) * acc[r]; } while (0)
#define TBLK(b_, a_, SUM) do { f32x4 m_ = {0.f, 0.f, 0.f, 0.f}; SUM; ST16(MBv, m_, 1.f); f32x4 t_ = {0.f, 0.f, 0.f, 0.f}; MM16(t_, BLK(TFv, b_, b_), MBv); ST16(BLK(TFv, b_, a_), t_, -1.f); } while (0)
        TBLK(1, 0, MM16(m_, BLK(LFv, 1, 0), BLK(TFv, 0, 0)));
        TBLK(2, 1, MM16(m_, BLK(LFv, 2, 1), BLK(TFv, 1, 1)));
        TBLK(3, 2, MM16(m_, BLK(LFv, 3, 2), BLK(TFv, 2, 2)));
        TBLK(2, 0, MM16(m_, BLK(LFv, 2, 0), BLK(TFv, 0, 0)); MM16(m_, BLK(LFv, 2, 1), BLK(TFv, 1, 0)));
        TBLK(3, 1, MM16(m_, BLK(LFv, 3, 1), BLK(TFv, 1, 1)); MM16(m_, BLK(LFv, 3, 2), BLK(TFv, 2, 1)));
        TBLK(3, 0, MM16(m_, BLK(LFv, 3, 0), BLK(TFv, 0, 0)); MM16(m_, BLK(LFv, 3, 1), BLK(TFv, 1, 0)); MM16(m_, BLK(LFv, 3, 2), BLK(TFv, 2, 0)));
#undef BLK
#undef MM16
#undef ST16
#undef TBLK
      }
    } else {
        if (wid == 1) {
#pragma unroll
            for (int i = 0; i < 24; ++i) { const int id = lane + 64 * i, blk = id >> 8, rr = (id >> 4) & 15, cc = id & 15;
                const int b = blk < 3 ? 0 : (blk < 5 ? 1 : 2), a = blk < 3 ? blk + 1 : (blk < 5 ? blk - 1 : 3);
                TF[(16 * b + rr) * LP + 16 * a + cc] = 0.f; }
        }
        for (int f = wid - 1; f < 16; f += 7) { const int s = f & 1, ctp = (f >> 1) & 1, mt = f >> 2, dk = 32 * mt + r32, c0 = 32 * ctp + 16 * s + 4 * hi;
            const u32x2 lo = *(const LAS u32x2*)(KHDT + TSW(dk, c0)), hw = *(const LAS u32x2*)(KHDT + TSW(dk, c0 + 8));
            u32x4 o = {lo.x, lo.y, hw.x, hw.y}; *(u32x4*)frag_ptr(PROJ, n, h, 32 + f, lane) = o; }
    }
    __syncthreads();
    { const int mt = wid >> 1, ct = wid & 1; f32x16 acc = {};
#pragma unroll
      for (int ks = 0; ks < 4; ++ks) { const bf16x8 a = *(const LAS bf16x8*)(KBGT + TSW(32 * mt + r32, 16 * ks + 8 * hi)), b = pack8f(TF + (32 * ct + r32) * LP + 16 * ks + 8 * hi);
          acc = MFMA32(a, b, acc); }
#pragma unroll
      for (int r = 0; r < 16; ++r) acc[r] = -acc[r];
      *(bf16x8*)frag_ptr(PROJ, n, h, (ct * 4 + mt) * 2, lane) = pack_step(acc, 0); *(bf16x8*)frag_ptr(PROJ, n, h, (ct * 4 + mt) * 2 + 1, lane) = pack_step(acc, 1); }
    { const int ct = wid >> 2, dt = wid & 3; f32x16 acc = {};
#pragma unroll
      for (int ks = 0; ks < 4; ++ks) { const bf16x8 a = pack8f(TF + (32 * ct + r32) * LP + 16 * ks + 8 * hi), b = *(const LAS bf16x8*)(VBT + TSW(32 * dt + r32, 16 * ks + 8 * hi));
          acc = MFMA32(a, b, acc); }
      bf16_t* up = Ug + (size_t)(n * 4 + h) * 8192 + (size_t)((dt * 2 + ct) * 4) * 256 + lane * 4;
#pragma unroll
      for (int g = 0; g < 4; ++g) { u32x2 w; w.x = cvtpk(acc[4 * g], acc[4 * g + 1]); w.y = cvtpk(acc[4 * g + 2], acc[4 * g + 3]); *(u32x2*)(up + g * 256) = w; } }
}
constexpr int SCAN_STAGE = 65536, SCAN_U = 57344, SCAN_EGL = 131072, SCAN_NP = 16;
__device__ __forceinline__ const u32x4* scan_src(const bf16_t* PROJ, const bf16_t* AQKg, const bf16_t* Ug, int n, int h, int half, int k, int ll) {
    if (k < 12) { const int piece = k * 256 + ll; return (const u32x4*)frag_ptr((bf16_t*)PROJ, n, h, piece >> 6, piece & 63); }
    if (k < 14) return (const u32x4*)(AQKg + ((size_t)(n * 4 + h) * 512 + (k - 12) * 256 + ll) * 8);
    return (const u32x4*)(Ug + (size_t)(n * 4 + h) * 8192 + half * 4096 + (size_t)((k - 14) * 256 + ll) * 8);
}
constexpr int SCAN_XCH = 131584, SCAN_XCH_SLICE = 12288;
template <int ROLE>
__device__ __forceinline__ void scan_compute(LAS unsigned char* lds, bf16_t* ub  , int sp, int lane) {
    constexpr int NCH = S / 64;
    LAS unsigned char* xs = lds + SCAN_XCH + sp * SCAN_XCH_SLICE + lane * 16;
    LAS unsigned char* xv = xs + 8192;
    f32x16 St[2] = {};
    bf16x8 Sb[4][2];
#pragma unroll
    for (int mt = 0; mt < 4; ++mt) { Sb[mt][0] = (bf16x8){0, 0, 0, 0, 0, 0, 0, 0}; Sb[mt][1] = Sb[mt][0]; }
    __syncthreads();
#ifdef EXP_SCANSEC
    unsigned long long acc_s[4] = {0, 0, 0, 0}, tm_ = __builtin_amdgcn_s_memrealtime();
#define SEC(i) do { const unsigned long long t_ = __builtin_amdgcn_s_memrealtime(); acc_s[i] += t_ - tm_; tm_ = t_; } while (0)
#else
#define SEC(i)
#endif
#pragma unroll 1
    for (int n = 0; n < NCH; ++n) {
        const LAS unsigned char* stg = lds + (n & 1) * SCAN_STAGE + lane * 16;
        const LAS unsigned char* us = lds + (n & 1) * SCAN_STAGE + SCAN_U + (sp * 8 + ROLE * 4) * 512 + lane * 8;
        const float egl = *(const LAS float*)(lds + SCAN_EGL + (n & 1) * 4);
        f32x16 vn, o = {};
#pragma unroll
        for (int g = 0; g < 4; ++g) { const u32x2 w = *(const LAS u32x2*)(us + g * 512); vn[4 * g] = lo_bf(w.x); vn[4 * g + 1] = hi_bf(w.x); vn[4 * g + 2] = lo_bf(w.y); vn[4 * g + 3] = hi_bf(w.y); }
        if (n > 0) {
#pragma unroll
            for (int j = 0; j < 2; ++j) { Sb[2 * (1 - ROLE) + j][0] = *(const LAS bf16x8*)(xs + ((2 * (1 - ROLE) + j) * 2) * 1024); Sb[2 * (1 - ROLE) + j][1] = *(const LAS bf16x8*)(xs + ((2 * (1 - ROLE) + j) * 2 + 1) * 1024); }
        }
#define FR(f) (*(const LAS bf16x8*)(stg + (f) * 1024))
#define RD1(B, mt) do { const int f_ = (ROLE * 4 + (mt)) * 2; B[0] = FR(f_); B[1] = FR(f_ + 1); B[2] = FR(16 + f_); B[3] = FR(16 + f_ + 1); } while (0)
#define MM1(B, mt) do { vn = MFMA32(B[0], Sb[mt][0], vn); o = MFMA32(B[2], Sb[mt][0], o); vn = MFMA32(B[1], Sb[mt][1], vn); o = MFMA32(B[3], Sb[mt][1], o); } while (0)
        bf16x8 fa[4], fb[4];
        RD1(fa, 0); RD1(fb, 1); SBAR();
        MM1(fa, 0); SBAR(); RD1(fa, 2); SBAR();
        MM1(fb, 1); SBAR(); RD1(fb, 3); SBAR();
        MM1(fa, 2); SBAR();
        bf16x8 kd[2][4];
#pragma unroll
        for (int j = 0; j < 2; ++j)
#pragma unroll
            for (int q = 0; q < 4; ++q) kd[j][q] = FR(32 + ((2 * ROLE + j) * 2) * 2 + q);
        SBAR(); MM1(fb, 3); SBAR();
#pragma unroll
        for (int j = 0; j < 2; ++j)
#pragma unroll
            for (int r = 0; r < 16; ++r) St[j][r] *= egl;
        bf16x8 Vb[2][2];
        Vb[ROLE][0] = pack_step(vn, 0); Vb[ROLE][1] = pack_step(vn, 1);
        *(LAS bf16x8*)(xv + (ROLE * 2) * 1024) = Vb[ROLE][0]; *(LAS bf16x8*)(xv + (ROLE * 2 + 1) * 1024) = Vb[ROLE][1];
        bf16x8 aq[4];
        if (ROLE == 0) { aq[0] = FR(48); aq[1] = FR(49); } else { aq[0] = FR(52); aq[1] = FR(53); aq[2] = FR(54); aq[3] = FR(55); }
        SEC(0);
        __syncthreads();
        SEC(1);
        Vb[1 - ROLE][0] = *(const LAS bf16x8*)(xv + ((1 - ROLE) * 2) * 1024); Vb[1 - ROLE][1] = *(const LAS bf16x8*)(xv + ((1 - ROLE) * 2 + 1) * 1024);
#pragma unroll
        for (int ctp = 0; ctp < 2; ++ctp)
#pragma unroll
            for (int s = 0; s < 2; ++s) {
                St[0] = MFMA32(kd[0][ctp * 2 + s], Vb[ctp][s], St[0]); St[1] = MFMA32(kd[1][ctp * 2 + s], Vb[ctp][s], St[1]);
                if (ROLE == 1) o = MFMA32(aq[ctp * 2 + s], Vb[ctp][s], o); else if (ctp == 0) o = MFMA32(aq[s], Vb[0][s], o);
            }
        { bf16_t* uc = ub + (size_t)n * (4 * 8192);
#pragma unroll
          for (int g = 0; g < 4; ++g) { u32x2 w; w.x = cvtpk(o[4 * g], o[4 * g + 1]); w.y = cvtpk(o[4 * g + 2], o[4 * g + 3]); *(u32x2*)(uc + g * 256) = w; } }
#pragma unroll
        for (int j = 0; j < 2; ++j) { Sb[2 * ROLE + j][0] = pack_step(St[j], 0); Sb[2 * ROLE + j][1] = pack_step(St[j], 1);
            *(LAS bf16x8*)(xs + ((2 * ROLE + j) * 2) * 1024) = Sb[2 * ROLE + j][0]; *(LAS bf16x8*)(xs + ((2 * ROLE + j) * 2 + 1) * 1024) = Sb[2 * ROLE + j][1]; }
#undef FR
#undef RD1
#undef MM1
        SEC(2);
        __syncthreads();
        SEC(3);
    }
#ifdef EXP_SCANSEC
    { const unsigned long long t1_ = __builtin_amdgcn_s_memrealtime(); while (__builtin_amdgcn_s_memrealtime() - t1_ < 4 * acc_s[EXP_SCANSEC]) __builtin_amdgcn_s_sleep(8); }
#endif
#undef SEC
}
__device__ __forceinline__ void scan_wg(const Params& p, int h, int half, LAS unsigned char* lds) {
    const int tid = tidx(), lane = tid & 63, wid = __builtin_amdgcn_readfirstlane(tid >> 6);
    const bf16_t* PROJ = (const bf16_t*)(p.ws + WS_PROJ); const bf16_t* AQKg = (const bf16_t*)(p.ws + WS_AQK); bf16_t* Ug = (bf16_t*)(p.ws + WS_U); const float* EGL = (const float*)(p.ws + WS_MISC + MISC_EGL);
    constexpr int NCH = S / 64;
    __syncthreads();
    if (wid >= 4) {
        const int ll = tid - 256; u32x4 sa[SCAN_NP], sb[SCAN_NP]; float ea, eb;
        const char* pf0 = (const char*)(PROJ + (size_t)(ll >> 4) * NP + C_BQKV + h * 128 + (ll & 15) * 8); const char* pa0 = (const char*)(AQKg + ((size_t)h * 512 + ll) * 8); const char* pu0 = (const char*)(Ug + (size_t)h * 8192 + half * 4096 + (size_t)ll * 8);
#define LD_H0(R, n_) do { const char* pf_ = pf0 + (size_t)(n_) * (64 * NP * 2); SBAR(); _Pragma("unroll") for (int k = 0; k < 8; ++k) R[k] = *(const u32x4*)(pf_ + (size_t)(k & 3) * (16 * NP * 2) + (k >> 2) * 1024); SBAR(); } while (0)
#define LD_H1(R, E, n_) do { E = EGL[(n_) * 4 + h]; const char* pf_ = pf0 + (size_t)(n_) * (64 * NP * 2); const char* pa_ = pa0 + (size_t)(n_) * (4 * 512 * 16); const char* pu_ = pu0 + (size_t)(n_) * (4 * 8192 * 2); SBAR(); \
        _Pragma("unroll") for (int k = 8; k < 12; ++k) R[k] = *(const u32x4*)(pf_ + (size_t)(k & 3) * (16 * NP * 2) + (k >> 2) * 1024); SBAR(); \
        R[12] = *(const u32x4*)pa_; R[13] = *(const u32x4*)(pa_ + 4096); R[14] = *(const u32x4*)pu_; R[15] = *(const u32x4*)(pu_ + 4096); SBAR(); } while (0)
#define WR_H0(R, n_) do { _Pragma("unroll") for (int k = 0; k < 8; ++k) *(LAS u32x4*)(lds + ((n_) & 1) * SCAN_STAGE + (k * 256 + ll) * 16) = R[k]; } while (0)
#define WR_H1(R, E, n_) do { *(LAS float*)(lds + SCAN_EGL + ((n_) & 1) * 4) = E; _Pragma("unroll") for (int k = 8; k < SCAN_NP; ++k) *(LAS u32x4*)(lds + ((n_) & 1) * SCAN_STAGE + (k * 256 + ll) * 16) = R[k]; } while (0)
#define LSTEP(R, E, n_) do { WR_H0(R, (n_) + 1); if ((n_) + 3 < NCH) LD_H0(R, (n_) + 3); __syncthreads(); WR_H1(R, E, (n_) + 1); if ((n_) + 3 < NCH) LD_H1(R, E, (n_) + 3); __syncthreads(); } while (0)
        LD_H0(sa, 0); LD_H1(sa, ea, 0); WR_H0(sa, 0); WR_H1(sa, ea, 0); LD_H0(sa, 1); LD_H1(sa, ea, 1); LD_H0(sb, 2); LD_H1(sb, eb, 2);
        __syncthreads();
#pragma unroll 1
        for (int n = 0; n < NCH - 2; n += 2) { LSTEP(sa, ea, n); LSTEP(sb, eb, n + 1); }
        WR_H0(sa, NCH - 1); __syncthreads(); WR_H1(sa, ea, NCH - 1); __syncthreads();
        __syncthreads(); __syncthreads();
#undef LSTEP
#undef LD_H0
#undef LD_H1
#undef WR_H0
#undef WR_H1
    } else {
        const int sp = wid >> 1, role = wid & 1, sl = 2 * half + sp;
        bf16_t* ub = Ug + (size_t)h * 8192 + (size_t)(sl * 8 + role * 4) * 256 + lane * 4;
        if (role == 0) scan_compute<0>(lds, ub, sp, lane); else scan_compute<1>(lds, ub, sp, lane);
    }
}
}
typedef __attribute__((address_space(1))) unsigned gu32;
#define XB_TMO      128
#define XB_XCNT(j)  (256  + 64 * (j))
#define XB_XSUB(j)  (1280 + 64 * (j))
#define XB_XGEN(j)  (2304 + 64 * (j))
#define XB_TOP      3328
#define XB_TOPGEN   3392
#define XCD_BAR_WORDS 3456
#define XB_SPIN_CAP (1u << 18)

__device__ __forceinline__ unsigned xb_ld(unsigned* p)              { return __hip_atomic_load(p, __ATOMIC_RELAXED, __HIP_MEMORY_SCOPE_AGENT); }
__device__ __forceinline__ unsigned xb_add(unsigned* p, unsigned v) { return __hip_atomic_fetch_add(p, v, __ATOMIC_RELAXED, __HIP_MEMORY_SCOPE_AGENT); }
__device__ __forceinline__ unsigned xb_xcc_id() { return (unsigned)__builtin_amdgcn_s_getreg((3 << 11) | 20) & 0xFu; }
#define XB_SPIN(cond, bar) do { unsigned _sp = 0; while (cond) { __builtin_amdgcn_s_sleep(1); \
    if ((++_sp & 255u) == 0u) { if (xb_ld(&(bar)[XB_TMO])) break; if (_sp > XB_SPIN_CAP) { atomicAdd(&(bar)[XB_TMO], 1u); break; } } } } while (0)

struct XcdBarrier {
    unsigned* bar; unsigned x;
    volatile LAS unsigned* st;
};

__device__ __forceinline__ XcdBarrier xcd_barrier_post(unsigned* bar, volatile LAS unsigned* st) {
    XcdBarrier b; b.bar = bar; b.x = xb_xcc_id(); b.st = st;
    if (tidx() == 0) (void)xb_add(&bar[XB_XCNT(b.x)], 1u);
    return b;
}
__device__ __forceinline__ void xcd_barrier_complete(unsigned* bar, unsigned x, unsigned& nloc, unsigned& nx) {
    const unsigned G = gridDim.x * gridDim.y * gridDim.z;
    unsigned sum, cnt, mine, sp = 0u;
    for (;;) {
        sum = 0u; cnt = 0u; mine = 0u;
#pragma unroll
        for (unsigned j = 0; j < 16; ++j) { const unsigned c = xb_ld(&bar[XB_XCNT(j)]); sum += c; cnt += (c > 0u) ? 1u : 0u; mine = (j == x) ? c : mine; }
        if (sum == G) break;
        __builtin_amdgcn_s_sleep(1);
        if ((++sp & 255u) == 0u) { if (xb_ld(&bar[XB_TMO])) break; if (sp > XB_SPIN_CAP) { atomicAdd(&bar[XB_TMO], 1u); break; } }
    }
    nloc = mine > 0u ? mine : 1u; nx = cnt > 0u ? cnt : 1u;
}

__device__ __forceinline__ void xcd_barrier(const XcdBarrier& b) {
    asm volatile("s_waitcnt vmcnt(0)" ::: "memory");
    __syncthreads();
    if (tidx() == 0) {
        unsigned* bar = b.bar;
        __builtin_amdgcn_s_waitcnt(0);
        unsigned nloc = b.st[0], nx = b.st[1];
        if (nloc == 0u) { xcd_barrier_complete(bar, b.x, nloc, nx); b.st[0] = nloc; b.st[1] = nx; }
        const unsigned old = xb_add(&bar[XB_XSUB(b.x)], 1u);
        const unsigned gen = old / nloc;
        if (old + 1u == (gen + 1u) * nloc) {
            __builtin_amdgcn_fence(__ATOMIC_RELEASE, "agent");
            asm volatile("s_waitcnt vmcnt(0)" ::: "memory");
            const unsigned og = xb_add(&bar[XB_TOP], 1u);
            const unsigned tg = og / nx;
            if (og + 1u == (tg + 1u) * nx) xb_add(&bar[XB_TOPGEN], 1u);
            else XB_SPIN(xb_ld(&bar[XB_TOPGEN]) == tg, bar);
            __builtin_amdgcn_fence(__ATOMIC_ACQUIRE, "agent");
            xb_add(&bar[XB_XGEN(b.x)], 1u);
            asm volatile("s_waitcnt vmcnt(0)" ::: "memory");
        } else {
            XB_SPIN(xb_ld(&bar[XB_XGEN(b.x)]) == gen, bar);
            __builtin_amdgcn_fence(__ATOMIC_ACQUIRE, "agent");
            asm volatile("s_waitcnt vmcnt(0)" ::: "memory");
        }
    }
    __syncthreads();
}


constexpr int N_PHASES = 2 + 7 * DEPTH;
constexpr int SCAN_WGS = 8;
constexpr float QSCALE = 0.07216878364870322f * LOG2E;

__device__ __forceinline__ void sub_barrier(unsigned* ctr, unsigned expected, bool arrive) {
    asm volatile("s_waitcnt vmcnt(0)" ::: "memory"); __syncthreads();
    if (tidx() == 0) {
        if (arrive) { __builtin_amdgcn_fence(__ATOMIC_RELEASE, "agent"); asm volatile("s_waitcnt vmcnt(0)" ::: "memory"); (void)__hip_atomic_fetch_add(ctr, 1u, __ATOMIC_RELAXED, __HIP_MEMORY_SCOPE_AGENT); }
        unsigned sp = 0; while (__hip_atomic_load(ctr, __ATOMIC_RELAXED, __HIP_MEMORY_SCOPE_AGENT) < expected) { __builtin_amdgcn_s_sleep(2); if (++sp > (1u << 22)) break; }
        __builtin_amdgcn_fence(__ATOMIC_ACQUIRE, "agent"); asm volatile("s_waitcnt vmcnt(0)" ::: "memory");
    }
    __syncthreads();
}
template <int KIND> __device__ __forceinline__ void run_kind(const Params& p_, int l, LAS unsigned char* lds) {
    Params p = p_;
    { unsigned long long w_ = (unsigned long long)p.ws; asm volatile("" : "+s"(w_)); p.ws = (unsigned char*)(__attribute__((address_space(1))) unsigned char*)w_; }
    const int tid = tidx(), lane = tid & 63, wid = __builtin_amdgcn_readfirstlane(tid >> 6);
    const int bid = bidx(), nblk = gridDim.x, gw = bid * 8 + wid, ngw = nblk * 8, gtid = bid * NT_THREADS + tid, gn = nblk * NT_THREADS;
    bf16_t* PROJ = (bf16_t*)(p.ws + WS_PROJ);
    if constexpr (KIND == 0) {
        job_win(p, 0, gw, ngw, lds, wid, lane); job_wout(p, 0, gw, ngw, lds, wid, lane); job_wmem(p, gw, ngw, lds, wid, lane);
        job_wq(p, bid, nblk, gtid, gn, lds); job_wuv(p, gtid, gn); job_rope(p, gtid, gn); job_btab(p, gtid, gn); job_memn(p, gw, ngw, lane);
        job_norm_rows(p, 0, gw, ngw, lane);
    } else if constexpr (KIND == 2) {
        { pg8::Gemm g{(const bf16_t*)(p.ws + WS_H), (const bf16_t*)(p.ws + WS_WIN), S, NP, DM, DM};
          pg8::StaticOrder so; so.init(S, NP, nblk, bid);
          pg8::EpiStore E{PROJ, NP, (bf16_t*)(p.ws + WS_HALO)};
          pg8::gemm_phase<pg8::EpiStore, pg8::StaticOrder, true, true>(lds, g, so, E); }
        if (l == 0) {
            for (int ll = 0; ll < 2; ++ll) {
                pg8::Gemm g{(const bf16_t*)(p.ws + WS_MEMN) + (size_t)ll * MEML * DM, (const bf16_t*)(p.ws + WS_WMEM) + (size_t)ll * DM * DM, MEML, DM, DM, DM};
                pg8::StaticOrder so; so.init(MEML, DM, nblk, (bid + 8 - 4 * ll) % nblk);
                pg8::EpiStore E{(bf16_t*)(p.ws + WS_MEMKV) + (size_t)ll * MEML * DM, DM, nullptr};
                pg8::gemm_phase<pg8::EpiStore, pg8::StaticOrder, true, true>(lds, g, so, E);
            }
        }
    } else if constexpr (KIND == 3) {
        for (int it = bid; it < 1024; it += nblk) gdn::prep_item(p, l, it >> 2, it & 3, lds);
    } else if constexpr (KIND == 5) {
        unsigned* rdy = (unsigned*)(p.ws + WS_CTL) + 64 * (9 + l);
        const bool is_scan = (bid & ~8) < 4;
#ifdef EXP_SPINSCAN
        if (is_scan) { const unsigned long long t0_ = __builtin_amdgcn_s_memrealtime(); gdn::scan_wg(p, bid & 3, bid >> 3, lds); const unsigned long long t1_ = __builtin_amdgcn_s_memrealtime();
            while (__builtin_amdgcn_s_memrealtime() - t1_ < 4 * (t1_ - t0_)) __builtin_amdgcn_s_sleep(8); }
#else
        if (is_scan) gdn::scan_wg(p, bid & 3, bid >> 3, lds);
#endif
        else { const int vb = bid < 8 ? bid - 4 : bid - 8, nb = nblk - SCAN_WGS;
#ifdef EXP_SPINPRE
            const unsigned long long t0_ = __builtin_amdgcn_s_memrealtime();
#endif
            { pg8::Gemm g{PROJ + C_CQ, (const bf16_t*)(p.ws + WS_WQ) + (size_t)l * 768 * 256, S, 768, 256, NP};
              pg8::StaticOrder so; so.init(S, 768, nb, vb);
              pg8::EpiStore E{(bf16_t*)(p.ws + WS_QABS), 768, nullptr};
              pg8::gemm_phase<pg8::EpiStore, pg8::StaticOrder, true, true>(lds, g, so, E); }
            job_mla_rows(p, l, vb * 8 + wid, nb * 8, lane);
            att::run_mixers(lds, (unsigned*)(p.ws + WS_CTL) + 64 * (11 + l), PROJ, p.pos, p.sinks + l * 8, (const float*)(p.ws + WS_MISC + MISC_BTAB), (const bf16_t*)(p.ws + WS_MEMKV) + (size_t)l * MEML * DM);
            __syncthreads();

#ifdef EXP_SPINPRE
            { const unsigned long long t1_ = __builtin_amdgcn_s_memrealtime(); while (__builtin_amdgcn_s_memrealtime() - t1_ < 4 * (t1_ - t0_)) __builtin_amdgcn_s_sleep(8); }
#endif
        }
        sub_barrier(rdy, (unsigned)(nblk - SCAN_WGS), !is_scan);
#ifdef EXP_SPINMLA
        const unsigned long long tq0_ = __builtin_amdgcn_s_memrealtime();
#endif
        mla::run_queue(lds, (unsigned*)(p.ws + WS_CTL) + 64 * (1 + l), (const bf16_t*)(p.ws + WS_QABS), (const bf16_t*)(p.ws + WS_KVLAT), PROJ, (const bf16_t*)(p.ws + WS_WUV) + (size_t)l * 512 * 512, (const float*)(p.ws + WS_MISC + MISC_RSQ), (const float*)(p.ws + WS_COS), (const float*)(p.ws + WS_SIN), QSCALE);
        if (l == 0) { __syncthreads(); const int t2_ = tidx(), w2_ = __builtin_amdgcn_readfirstlane(t2_ >> 6); job_win(p, 1, bidx() * 8 + w2_, (int)gridDim.x * 8, lds, w2_, t2_ & 63); }
#ifdef EXP_SPINMLA
        if (!is_scan) { const unsigned long long tq1_ = __builtin_amdgcn_s_memrealtime(); while (__builtin_amdgcn_s_memrealtime() - tq1_ < 4 * (tq1_ - tq0_)) __builtin_amdgcn_s_sleep(8); }
#endif
    } else if constexpr (KIND == 6) {
        job_gdn_final(p, l, gw, ngw, lane, wid, lds);
    } else if constexpr (KIND == 7) {
        pg8::Gemm g{PROJ + C_Z, (const bf16_t*)(p.ws + WS_WOUT), S, DM, MIXW, NP};
        pg8::StaticOrder so; so.init(S, DM, nblk, bid);
        pg8::EpiStore E{(bf16_t*)(p.ws + WS_Y), DM, nullptr};
        pg8::gemm_phase<pg8::EpiStore, pg8::StaticOrder, true, true>(lds, g, so, E);
    } else {
        job_norm_rows(p, l == 0 ? 1 : 2, gw, ngw, lane);
        if (l == 0) job_wout(p, 1, gw, ngw, lds, wid, lane);
    }
}
template <int KIND> __global__ void __launch_bounds__(NT_THREADS, 2) mk_kind(Params p, int l) {
    extern __shared__ __attribute__((aligned(16))) unsigned char lds_raw[];
    run_kind<KIND>(p, l, (LAS unsigned char*)lds_raw);
}

#ifndef MK_LAUNCHES_PER_PHASE
#define MK_LAUNCHES_PER_PHASE 0
#endif
#if !MK_LAUNCHES_PER_PHASE
#ifdef EXP_SPINKIND
#define SPIN_T0(K) unsigned long long t0_s = 0; if ((K) == EXP_SPINKIND) t0_s = __builtin_amdgcn_s_memrealtime();
#define SPIN_T1(K) if ((K) == EXP_SPINKIND) { const unsigned long long t1_s = __builtin_amdgcn_s_memrealtime(), d_s = t1_s - t0_s; while (__builtin_amdgcn_s_memrealtime() - t1_s < 4 * d_s) __builtin_amdgcn_s_sleep(8); }
#else
#define SPIN_T0(K)
#define SPIN_T1(K)
#endif
#ifdef EXP_DUPKINDS
#define DUP_PH(K, L) if ((EXP_DUPKINDS >> (K)) & 1) { GRID_BAR(); run_kind<K>(p, L, lds); }
#else
#define DUP_PH(K, L)
#endif
#define GRID_BAR() do { unsigned long long wi_ = (unsigned long long)p.ws; asm volatile("" : "+s"(wi_)); unsigned char* w_ = (unsigned char*)(__attribute__((address_space(1))) unsigned char*)wi_; XcdBarrier b_; b_.bar = (unsigned*)(w_ + WS_CTL) + 4096; b_.x = xb_xcc_id(); b_.st = (volatile LAS unsigned*)(lds + LDS_BYTES - 16); xcd_barrier(b_); } while (0)
#define PHASE(K, L, LAST) do { SPIN_T0(K) run_kind<K>(p, L, lds); DUP_PH(K, L) if (!(LAST)) GRID_BAR(); SPIN_T1(K) } while (0)
__global__ void __launch_bounds__(NT_THREADS, 2) mk_fwd(Params p) {
    extern __shared__ __attribute__((aligned(16))) unsigned char lds_raw[];
    LAS unsigned char* lds = (LAS unsigned char*)lds_raw;
    cg::grid_group grid = cg::this_grid();
    volatile LAS unsigned* bst = (volatile LAS unsigned*)(lds + LDS_BYTES - 16);
    if (tidx() < 4) bst[tidx()] = 0u;
    __syncthreads();
    (void)xcd_barrier_post((unsigned*)(p.ws + WS_CTL) + 4096, bst);
    if (p.ph_hi == 0x7fffffff) grid.sync();
    PHASE(0, 0, false);
#pragma unroll 1
    for (int l = 0; l < DEPTH; ++l) {
        PHASE(2, l, false); PHASE(3, l, false); PHASE(5, l, false);
        PHASE(6, l, false); PHASE(7, l, false); PHASE(8, l, l + 1 == DEPTH);
    }
}
#endif

#ifndef MK_LAUNCHES_PER_PHASE
#define MK_LAUNCHES_PER_PHASE 0
#endif
extern "C" void kernel_launch(void* const* d_in, const int* in_sizes, int n_in, void* d_out, int out_size, void* d_ws, size_t ws_size, hipStream_t stream) {
    static int grid = 0;
    if (grid == 0) {
        if (n_in != 19 || in_sizes[0] != S * DM || out_size != S * DM || ws_size < WS_END) { fprintf(stderr, "kernel_launch: unexpected shapes (n_in %d, in0 %d, out %d, ws %zu)\n", n_in, n_in > 0 ? in_sizes[0] : -1, out_size, ws_size); grid = -1; return; }
        int dev = 0, cus = 0, per_cu = 0;
        (void)hipGetDevice(&dev); (void)hipDeviceGetAttribute(&cus, hipDeviceAttributeMultiprocessorCount, dev);
#if !MK_LAUNCHES_PER_PHASE
        if (hipFuncSetAttribute((const void*)mk_fwd, hipFuncAttributeMaxDynamicSharedMemorySize, LDS_BYTES) != hipSuccess) { fprintf(stderr, "kernel_launch: hipFuncSetAttribute failed\n"); grid = -1; return; }
        if (hipOccupancyMaxActiveBlocksPerMultiprocessor(&per_cu, (const void*)mk_fwd, NT_THREADS, LDS_BYTES) != hipSuccess || per_cu < 1) { fprintf(stderr, "kernel_launch: occupancy query gave %d\n", per_cu); per_cu = 1; }
#else
#define SA(K) (void)hipFuncSetAttribute((const void*)mk_kind<K>, hipFuncAttributeMaxDynamicSharedMemorySize, LDS_BYTES)
        SA(0); SA(2); SA(3); SA(5); SA(6); SA(7); SA(8);
#undef SA
#endif
        (void)hipGetLastError();
        if (cus <= 0) cus = 256;
        grid = cus;
        fprintf(stderr, "kernel_launch: cus %d per_cu %d grid %d\n", cus, per_cu, grid);
    }
    if (grid < 0) return;
    Params p{};
    p.x = (const float*)d_in[0]; p.mem = (const float*)d_in[1]; p.pos = (const int*)d_in[2]; p.rel_bias = (const float*)d_in[3];
    p.norm_pre = (const float*)d_in[4]; p.norm_post = (const float*)d_in[5]; p.w_in = (const float*)d_in[6]; p.sinks = (const float*)d_in[7];
    p.conv_w = (const float*)d_in[8]; p.a_log = (const float*)d_in[9]; p.dt_bias = (const float*)d_in[10]; p.gdn_norm = (const float*)d_in[11];
    p.q_norm = (const float*)d_in[12]; p.kv_norm = (const float*)d_in[13]; p.w_uq = (const float*)d_in[14]; p.w_ukv = (const float*)d_in[15];
    p.mem_norm = (const float*)d_in[16]; p.w_mem = (const float*)d_in[17]; p.w_out = (const float*)d_in[18];
    p.out = (float*)d_out; p.ws = (unsigned char*)d_ws;
    if (hipMemsetAsync((char*)d_ws + WS_CTL, 0, 65536, stream) != hipSuccess) { fprintf(stderr, "kernel_launch: hipMemsetAsync failed\n"); return; }
#if MK_LAUNCHES_PER_PHASE
    p.ph_lo = 0; p.ph_hi = 0;
#define LK(K, L) hipLaunchKernelGGL(mk_kind<K>, dim3(grid), dim3(NT_THREADS), LDS_BYTES, stream, p, L)
    LK(0, 0);
    for (int l = 0; l < DEPTH; ++l) { LK(2, l); LK(3, l); LK(5, l); LK(6, l); LK(7, l); LK(8, l); }
#undef LK
#else
    p.ph_lo = 0; p.ph_hi = N_PHASES;
    void* args[] = {&p};
    hipError_t e = hipLaunchCooperativeKernel((const void*)mk_fwd, dim3(grid), dim3(NT_THREADS), args, LDS_BYTES, stream);
    if (e != hipSuccess) fprintf(stderr, "kernel_launch: cooperative launch failed: %s (grid %d)\n", hipGetErrorString(e), grid);
#endif
}
```

```cpp
#include <hip/hip_runtime.h>
#include <hip/hip_cooperative_groups.h>
#include <cstdint>
#include <cstdio>
namespace cg = cooperative_groups;

#define LAS __attribute__((address_space(3)))
typedef unsigned short bf16_t;
typedef short bf16x8 __attribute__((ext_vector_type(8)));
typedef short s16x4 __attribute__((ext_vector_type(4)));
typedef float f32x2 __attribute__((ext_vector_type(2)));
typedef float f32x4 __attribute__((ext_vector_type(4)));
typedef float f32x16 __attribute__((ext_vector_type(16)));
typedef unsigned u32x2 __attribute__((ext_vector_type(2)));
typedef unsigned u32x4 __attribute__((ext_vector_type(4)));
typedef __bf16 bf16x2_t __attribute__((ext_vector_type(2)));

constexpr int S = 16384, DM = 1024, MEML = 256, NP = 5376, DEPTH = 2, DIN = 5320, MIXW = 2048;
constexpr int C_Z = 0, C_AQ = 2048, C_AK = 2560, C_AV = 2688, C_DQ = 2816, C_BQKV = 3328, C_CQ = 4864, C_CKV = 5120, C_KR = 5248, C_BA = 5312, C_BB = 5316;
constexpr int C_OLAT = 2048;
constexpr float RMS_EPS = 1e-6f;
constexpr float LOG2E = 1.4426950408889634f;
constexpr int NT_THREADS = 512;

constexpr size_t MiB = 1u << 20;
constexpr size_t WS_CTL = 0, WS_COS = 1 * MiB, WS_SIN = 3 * MiB, WS_MEMKV = 5 * MiB, WS_MISC = 6 * MiB, WS_MEMN = 7 * MiB;
constexpr size_t WS_WIN = 8 * MiB, WS_WOUT = 19 * MiB, WS_WMEM = 23 * MiB, WS_WQ = 27 * MiB, WS_WUV = 28 * MiB, WS_HALO = 29 * MiB;
constexpr size_t WS_AQK = 32 * MiB, WS_U = 40 * MiB, WS_H = 56 * MiB, WS_PROJ = 88 * MiB, WS_END = 256 * MiB;
constexpr size_t WS_QABS = WS_H, WS_KVLAT = WS_H + 24 * MiB, WS_Y = WS_H;
constexpr size_t MISC_BTAB = 0, MISC_RSQ = 8192, MISC_EGL = 8192 + 65536;

constexpr int LDS_BYTES = 163840;

struct Params {
    const float* x; const float* mem; const int* pos; const float* rel_bias;
    const float* norm_pre; const float* norm_post; const float* w_in; const float* sinks;
    const float* conv_w; const float* a_log; const float* dt_bias; const float* gdn_norm;
    const float* q_norm; const float* kv_norm; const float* w_uq; const float* w_ukv;
    const float* mem_norm; const float* w_mem; const float* w_out;
    float* out; unsigned char* ws;
    int ph_lo, ph_hi;
};

__device__ __forceinline__ int tidx() { int t = threadIdx.x; asm volatile("" : "+v"(t)); return t; }
__device__ __forceinline__ int bidx() { int b = blockIdx.x; asm volatile("" : "+s"(b)); return b; }
__device__ __forceinline__ float bf2f(bf16_t v) { return __uint_as_float((unsigned)v << 16); }
__device__ __forceinline__ unsigned cvtpk(float lo, float hi) { f32x2 v = {lo, hi}; bf16x2_t b = __builtin_convertvector(v, bf16x2_t); return __builtin_bit_cast(unsigned, b); }
__device__ __forceinline__ bf16_t f2bf(float f) { return (bf16_t)(cvtpk(f, 0.f) & 0xffffu); }
__device__ __forceinline__ float lo_bf(unsigned w) { return __uint_as_float(w << 16); }
__device__ __forceinline__ float hi_bf(unsigned w) { return __uint_as_float(w & 0xffff0000u); }
__device__ __forceinline__ float silu_f(float v) { return v / (1.f + __expf(-v)); }
#define DPP_ROR(x, n) __builtin_amdgcn_update_dpp(0, (x), 0x120 + (n), 0xf, 0xf, false)
__device__ __forceinline__ float ror16_f(float v, int n) { const int x = __float_as_int(v); int r; switch (n) { case 1: r = DPP_ROR(x, 1); break; case 2: r = DPP_ROR(x, 2); break; case 4: r = DPP_ROR(x, 4); break; default: r = DPP_ROR(x, 8); break; } return __int_as_float(r); }
__device__ __forceinline__ unsigned xor8_u(unsigned v) { return (unsigned)DPP_ROR((int)v, 8); }
__device__ __forceinline__ float row16_sum(float v) { v += ror16_f(v, 1); v += ror16_f(v, 2); v += ror16_f(v, 4); v += ror16_f(v, 8); return v; }
__device__ __forceinline__ float wave_sum(float v) {
    v = row16_sum(v);
    v += __int_as_float(__builtin_amdgcn_ds_swizzle(__float_as_int(v), 0x401F));
    return __int_as_float(__builtin_amdgcn_readlane(__float_as_int(v), 0)) + __int_as_float(__builtin_amdgcn_readlane(__float_as_int(v), 32));
}
__device__ __forceinline__ int crow(int r, int hi) { return (r & 3) + 8 * (r >> 2) + 4 * hi; }
#define MFMA32(a, b, c) __builtin_amdgcn_mfma_f32_32x32x16_bf16((a), (b), (c), 0, 0, 0)
#define SBAR() __builtin_amdgcn_sched_barrier(0)
#define LDS_WAIT() asm volatile("s_waitcnt lgkmcnt(0)" ::: "memory")
__device__ __forceinline__ bf16x8 pack8(const float* v) { u32x4 w = {cvtpk(v[0], v[1]), cvtpk(v[2], v[3]), cvtpk(v[4], v[5]), cvtpk(v[6], v[7])}; return __builtin_bit_cast(bf16x8, w); }
__device__ __forceinline__ bf16x8 pack_step(const f32x16& x, int s) {
    u32x4 w = {cvtpk(x[8 * s + 0], x[8 * s + 1]), cvtpk(x[8 * s + 2], x[8 * s + 3]), cvtpk(x[8 * s + 4], x[8 * s + 5]), cvtpk(x[8 * s + 6], x[8 * s + 7])};
    return __builtin_bit_cast(bf16x8, w);
}

__device__ __forceinline__ int win_src(int n) {
    if (n < 512) return 768 + n;
    if (n < 1024) return 2824 + (n - 512);
    if (n < 1536) return 3784 + (n - 1024);
    if (n < 2048) return 4808 + (n - 1536);
    if (n < 2560) return n - 2048;
    if (n < 2688) return 512 + (n - 2560);
    if (n < 2816) return 640 + (n - 2688);
    if (n < 3328) return 4296 + (n - 2816);
    if (n < 4864) return 1280 + (n - 3328);
    if (n < 5120) return 3336 + (n - 4864);
    if (n < 5248) return 3592 + (n - 5120);
    if (n < 5312) return 3720 + (n - 5248);
    if (n < 5316) return 2816 + (n - 5312);
    if (n < 5320) return 2820 + (n - 5316);
    return -1;
}

__device__ __forceinline__ int t5_bucket(int n) {
    if (n < 16) return n < 0 ? 0 : n;
    if (n >= 128) return 31;
    const float v = __logf((float)n * 0.0625f) * (16.0f / 2.0794415416798357f);
    int b = 16 + (int)v; return b > 31 ? 31 : b;
}
__device__ __forceinline__ float inv_freq(int i) {
    const float t[32] = {1.000000000e+00f, 7.498942018e-01f, 5.623413324e-01f, 4.216965139e-01f, 3.162277639e-01f, 2.371373922e-01f, 1.778279394e-01f, 1.333521456e-01f,
                         1.000000015e-01f, 7.498941571e-02f, 5.623412877e-02f, 4.216964915e-02f, 3.162277862e-02f, 2.371373586e-02f, 1.778279431e-02f, 1.333521493e-02f,
                         9.999999776e-03f, 7.498942316e-03f, 5.623413250e-03f, 4.216964822e-03f, 3.162277862e-03f, 2.371373819e-03f, 1.778279431e-03f, 1.333521446e-03f,
                         1.000000047e-03f, 7.498941850e-04f, 5.623413017e-04f, 4.216965463e-04f, 3.162277862e-04f, 2.371373848e-04f, 1.778279402e-04f, 1.333521504e-04f};
    return t[i];
}
namespace pg8 {
#define PG8_LAS __attribute__((address_space(3)))
constexpr int BM = 256, BK = 64, HALF = 128, HTB = HALF * BK * 2  , STAGE_BYTES = 8 * HTB, NXCD = 8, WGM = 8;
__host__ __device__ __forceinline__ int lds_byte(int r, int c) { const int st = (r >> 4) * 2 + (c >> 5), rr = r & 15, cc = c & 31, ob = rr * 64 + cc * 2; return st * 1024 + (ob ^ (((ob >> 9) & 1) << 5)); }
__host__ __device__ __forceinline__ void stage_rc(int b, int& R, int& C) { const int st = b / 1024, sb = b % 1024, swz = sb ^ (((sb >> 9) & 1) << 5); R = (st >> 1) * 16 + swz / 64; C = (st & 1) * 32 + (swz % 64) / 2; }
__host__ __device__ __forceinline__ int perm32(int rho) { const int n = rho >> 4, i = rho & 15; return 8 * (i >> 2) + 4 * n + (i & 3); }
struct Unit { int pm, pn; };
struct Gemm { const bf16_t* A; const bf16_t* Bt; int M, N, K, lda; };
struct StaticOrder {
    int nM, nN, nwg, G, c;
    __device__ void init(int M, int N, int G_, int c_) { nM = M / BM; nN = N / BM; nwg = nM * nN; G = G_; c = c_; }
    __device__ bool next(int i, Unit& u) const {
        const long L = (long)i * G + c; if (L >= nwg) return false;
        int wgid = (int)L; { const int q = nwg / NXCD, r = nwg % NXCD, xcd = wgid % NXCD, off = wgid / NXCD; wgid = (xcd < r ? xcd * (q + 1) : r * (q + 1) + (xcd - r) * q) + off; }
        const int nig = WGM * nN, gid = wgid / nig, fm = gid * WGM, gsz = (nM - fm) < WGM ? (nM - fm) : WGM;
        u.pm = fm + ((wgid % nig) % gsz); u.pn = (wgid % nig) / gsz; return true;
    }
    __device__ __forceinline__ void a_ready(const Unit&) const {}
    __device__ __forceinline__ void done(const Unit&) const {}
};
struct EpiStore {
    static constexpr bool PERM = true, AFTER_DRAIN = false;
    bf16_t* O; int ldc; bf16_t* halo;
    __device__ __forceinline__ void operator()(const f32x4 (&acc)[2][2][4][2], const Unit& u, int wr, int wc, int fr, int fq) const {
        const int row0 = u.pm * BM + wr * 64 + fr, col0 = u.pn * BM + wc * 32 + 8 * fq;
        const bool hz = halo != nullptr && col0 >= C_BQKV && col0 < C_BQKV + 1536;
#pragma unroll
        for (int ai = 0; ai < 2; ++ai)
#pragma unroll
            for (int m = 0; m < 4; ++m) { const int row = row0 + ai * HALF + m * 16; bf16_t* rowp = O + (size_t)row * ldc + col0;
#pragma unroll
                for (int bj = 0; bj < 2; ++bj) { const f32x4 v0 = acc[ai][bj][m][0], v1 = acc[ai][bj][m][1];
                    u32x4 w; w.x = cvtpk(v0[0], v0[1]); w.y = cvtpk(v0[2], v0[3]); w.z = cvtpk(v1[0], v1[1]); w.w = cvtpk(v1[2], v1[3]);
                    *(u32x4*)(rowp + bj * HALF) = w;
                    if (m == 3 && hz && fr >= 13) *(u32x4*)(halo + ((size_t)(row >> 6) * 3 + (fr - 13)) * 1536 + (col0 + bj * HALF - C_BQKV)) = w; } }
    }
};
struct EpiGate {
    static constexpr bool PERM = true, AFTER_DRAIN = false;
    bf16_t* G; int ldc;
    __device__ __forceinline__ void operator()(const f32x4 (&acc)[2][2][4][2], const Unit& u, int wr, int wc, int fr, int fq) const {
        const int row0 = u.pm * BM + wr * 64 + fr, col0 = u.pn * BM + wc * 32 + 8 * fq;
#pragma unroll
        for (int ai = 0; ai < 2; ++ai)
#pragma unroll
            for (int m = 0; m < 4; ++m) { bf16_t* rowp = G + (size_t)(row0 + ai * HALF + m * 16) * ldc + col0;
#pragma unroll
                for (int bj = 0; bj < 2; ++bj) { const f32x4 v0 = acc[ai][bj][m][0], v1 = acc[ai][bj][m][1];
                    const u32x4 z = *(const u32x4*)(rowp + bj * HALF);
                    u32x4 w; w.x = cvtpk(v0[0] * silu_f(lo_bf(z.x)), v0[1] * silu_f(hi_bf(z.x))); w.y = cvtpk(v0[2] * silu_f(lo_bf(z.y)), v0[3] * silu_f(hi_bf(z.y)));
                    w.z = cvtpk(v1[0] * silu_f(lo_bf(z.z)), v1[1] * silu_f(hi_bf(z.z))); w.w = cvtpk(v1[2] * silu_f(lo_bf(z.w)), v1[3] * silu_f(hi_bf(z.w)));
                    *(u32x4*)(rowp + bj * HALF) = w; } }
    }
};
template <class Epi, class Sched, bool ALIGN_EPI = false, bool SP2 = false>
__device__ __forceinline__ void gemm_phase(PG8_LAS unsigned char* lds, const Gemm g, const Sched& S, const Epi& E) {
    const int tid = tidx(), wid = __builtin_amdgcn_readfirstlane(tid >> 6), lane = tid & 63, wr = wid >> 2, wc = wid & 3, fr = lane & 15, fq = lane >> 4;
    const int K = g.K, nt = K / BK;
    unsigned voffA[2], voffB[2];
#pragma unroll
    for (int i = 0; i < 2; ++i) { int R, C; stage_rc(tid * 16 + i * 8192, R, C); const int Rb = Epi::PERM ? ((R & ~31) + perm32(R & 31)) : R;
        voffA[i] = (unsigned)(R * g.lda + C) * 2u; voffB[i] = (unsigned)(Rb * K + C) * 2u; }
    const size_t kstep = (size_t)(BK * 2);
    const size_t hstepA = (size_t)HALF * g.lda * 2, hstepB = (size_t)HALF * K * 2;
    const size_t tstepA = 2 * hstepA, tstepB = 2 * hstepB;
    const unsigned ldsw = (unsigned)wid * 1024u;
    const int aoff = lds_byte(wr * 64 + fr, fq * 8), boff = lds_byte(wc * 32 + fr, fq * 8);
#define PG8_SA(b, h) (((b) * 2 + (h)) * HTB)
#define PG8_SB(b, h) ((4 + (b) * 2 + (h)) * HTB)
#define PG8_STAGE(bufoff, gbase, voff) do { _Pragma("unroll") for (int _i = 0; _i < 2; ++_i) \
        __builtin_amdgcn_global_load_lds((const unsigned*)((const char*)(gbase) + (voff)[_i]), (PG8_LAS unsigned*)(lds + (bufoff) + ldsw + _i * 8192), 16, 0, 0); } while (0)
#define PG8_LDA(dst, b, h) do { _Pragma("unroll") for (int m = 0; m < 4; ++m) _Pragma("unroll") for (int k = 0; k < 2; ++k) dst[m][k] = *(const PG8_LAS bf16x8*)(lds + PG8_SA(b, h) + aoff + m * 2048 + k * 1024); } while (0)
#define PG8_LDB(dst, b, h) do { _Pragma("unroll") for (int n = 0; n < 2; ++n) _Pragma("unroll") for (int k = 0; k < 2; ++k) dst[n][k] = *(const PG8_LAS bf16x8*)(lds + PG8_SB(b, h) + boff + n * 2048 + k * 1024); } while (0)
#define PG8_MMA(ai, bj, At, Bt) do { __builtin_amdgcn_s_setprio(1); _Pragma("unroll") for (int m = 0; m < 4; ++m) _Pragma("unroll") for (int n = 0; n < 2; ++n) _Pragma("unroll") for (int k = 0; k < 2; ++k) \
        acc[ai][bj][m][n] = __builtin_amdgcn_mfma_f32_16x16x32_bf16(Bt[n][k], At[m][k], acc[ai][bj][m][n], 0, 0, 0); __builtin_amdgcn_s_setprio(0); } while (0)
#define PG8_WAIT_V(n) asm volatile("s_waitcnt vmcnt(" #n ")" ::: "memory")
#define PG8_WAIT_L(n) asm volatile("s_waitcnt lgkmcnt(" #n ")" ::: "memory")
#define PG8_BAR __builtin_amdgcn_s_barrier()
#define PG8_SCHED __builtin_amdgcn_sched_barrier(0)
    Unit cur, nxt; int ui = 0;
    if (!S.next(0, cur)) return;
    f32x4 acc[2][2][4][2];
#pragma unroll
    for (int a = 0; a < 2; ++a)
#pragma unroll
        for (int b = 0; b < 2; ++b)
#pragma unroll
            for (int m = 0; m < 4; ++m)
#pragma unroll
                for (int n = 0; n < 2; ++n) acc[a][b][m][n] = (f32x4){0.f, 0.f, 0.f, 0.f};
    bf16x8 At[4][2], B0[2][2], B1[2][2];
    const char* cA = (const char*)g.A + (size_t)cur.pm * tstepA; const char* cB = (const char*)g.Bt + (size_t)cur.pn * tstepB;
    S.a_ready(cur);
    if constexpr (SP2) {
        PG8_STAGE(PG8_SB(0, 0), cB, voffB); PG8_STAGE(PG8_SB(0, 1), cB + hstepB, voffB); PG8_STAGE(PG8_SA(0, 0), cA, voffA); PG8_STAGE(PG8_SA(0, 1), cA + hstepA, voffA);
        if (wr == 1) PG8_BAR;
        PG8_WAIT_V(2); PG8_BAR;
        PG8_STAGE(PG8_SB(1, 0), cB + kstep, voffB); PG8_STAGE(PG8_SA(1, 0), cA + kstep, voffA); PG8_STAGE(PG8_SB(1, 1), cB + hstepB + kstep, voffB);
        PG8_WAIT_V(6); PG8_BAR;
    } else {
        PG8_STAGE(PG8_SB(0, 0), cB, voffB); PG8_STAGE(PG8_SA(0, 0), cA, voffA); PG8_STAGE(PG8_SB(0, 1), cB + hstepB, voffB); PG8_STAGE(PG8_SA(0, 1), cA + hstepA, voffA);
        if (wr == 1) PG8_BAR;
        PG8_WAIT_V(4); PG8_BAR;
        PG8_STAGE(PG8_SB(1, 0), cB + kstep, voffB); PG8_STAGE(PG8_SA(1, 0), cA + kstep, voffA); PG8_STAGE(PG8_SB(1, 1), cB + hstepB + kstep, voffB);
        PG8_WAIT_V(6); PG8_BAR;
    }
    for (;;) {
        const bool has_next = S.next(ui + 1, nxt);
        const char* nA = has_next ? (const char*)g.A + (size_t)nxt.pm * tstepA : cA; const char* nB = has_next ? (const char*)g.Bt + (size_t)nxt.pn * tstepB : cB;
        for (int t = 0; t < nt; t += 2) {
            const bool last = (t == nt - 2);
            const char* a1 = cA + (size_t)(t + 1) * kstep;
            const char* a2 = last ? nA : cA + (size_t)(t + 2) * kstep; const char* b2 = last ? nB : cB + (size_t)(t + 2) * kstep;
            const char* a3 = a2 + kstep; const char* b3 = b2 + kstep;
            if (last && has_next) S.a_ready(nxt);
            if constexpr (SP2) {
            PG8_LDB(B0, 0, 0); PG8_LDB(B1, 0, 1); PG8_SCHED; PG8_LDA(At, 0, 0); PG8_STAGE(PG8_SA(1, 1), a1 + hstepA, voffA);
            PG8_WAIT_V(8); PG8_WAIT_L(0); PG8_BAR; PG8_MMA(0, 0, At, B0); PG8_MMA(0, 1, At, B1); PG8_BAR; PG8_SCHED;
            PG8_LDA(At, 0, 1); PG8_STAGE(PG8_SB(0, 0), b2, voffB); PG8_STAGE(PG8_SB(0, 1), b2 + hstepB, voffB); PG8_STAGE(PG8_SA(0, 0), a2, voffA);
            PG8_WAIT_V(8); PG8_WAIT_L(0); PG8_BAR; PG8_MMA(1, 0, At, B0); PG8_MMA(1, 1, At, B1); PG8_BAR; PG8_SCHED;
            PG8_LDB(B0, 1, 0); PG8_LDB(B1, 1, 1); PG8_SCHED; PG8_LDA(At, 1, 0); PG8_STAGE(PG8_SA(0, 1), a2 + hstepA, voffA);
            PG8_WAIT_V(8); PG8_WAIT_L(0); PG8_BAR; PG8_MMA(0, 0, At, B0); PG8_MMA(0, 1, At, B1); PG8_BAR; PG8_SCHED;
            PG8_LDA(At, 1, 1); PG8_STAGE(PG8_SB(1, 0), b3, voffB); PG8_STAGE(PG8_SB(1, 1), b3 + hstepB, voffB); PG8_STAGE(PG8_SA(1, 0), a3, voffA);
            PG8_WAIT_V(8); PG8_WAIT_L(0); PG8_BAR; PG8_MMA(1, 0, At, B0); PG8_MMA(1, 1, At, B1); PG8_BAR; PG8_SCHED;
            } else {
            PG8_LDB(B0, 0, 0); PG8_SCHED; PG8_LDA(At, 0, 0); PG8_STAGE(PG8_SA(1, 1), a1 + hstepA, voffA);
            PG8_WAIT_L(8); PG8_BAR; PG8_WAIT_L(0); PG8_MMA(0, 0, At, B0); PG8_BAR; PG8_SCHED;
            PG8_LDB(B1, 0, 1); PG8_STAGE(PG8_SB(0, 0), b2, voffB);
            PG8_BAR; PG8_WAIT_L(0); PG8_MMA(0, 1, At, B1); PG8_BAR;
            PG8_LDA(At, 0, 1); PG8_STAGE(PG8_SA(0, 0), a2, voffA);
            PG8_BAR; PG8_WAIT_L(0); PG8_MMA(1, 0, At, B0); PG8_BAR; PG8_SCHED;
            PG8_STAGE(PG8_SB(0, 1), b2 + hstepB, voffB);
            PG8_WAIT_V(6); PG8_BAR; PG8_MMA(1, 1, At, B1); PG8_BAR;
            PG8_LDB(B0, 1, 0); PG8_SCHED; PG8_LDA(At, 1, 0); PG8_STAGE(PG8_SA(0, 1), a2 + hstepA, voffA);
            PG8_WAIT_L(8); PG8_BAR; PG8_WAIT_L(0); PG8_MMA(0, 0, At, B0); PG8_BAR; PG8_SCHED;
            PG8_LDB(B1, 1, 1); PG8_STAGE(PG8_SB(1, 0), b3, voffB);
            PG8_BAR; PG8_WAIT_L(0); PG8_MMA(0, 1, At, B1); PG8_BAR;
            PG8_LDA(At, 1, 1); PG8_STAGE(PG8_SA(1, 0), a3, voffA);
            PG8_BAR; PG8_WAIT_L(0); PG8_MMA(1, 0, At, B0); PG8_BAR; PG8_SCHED;
            PG8_STAGE(PG8_SB(1, 1), b3 + hstepB, voffB);
            PG8_WAIT_V(6); PG8_BAR; PG8_MMA(1, 1, At, B1); PG8_BAR;
            }
        }
        if constexpr (ALIGN_EPI) { if (wr == 0) PG8_BAR; }
        if constexpr (!Epi::AFTER_DRAIN) { E(acc, cur, wr, wc, fr, fq); S.done(cur); }
        if (!has_next) break;
#pragma unroll
        for (int a = 0; a < 2; ++a)
#pragma unroll
            for (int b = 0; b < 2; ++b)
#pragma unroll
                for (int m = 0; m < 4; ++m)
#pragma unroll
                    for (int n = 0; n < 2; ++n) acc[a][b][m][n] = (f32x4){0.f, 0.f, 0.f, 0.f};
        cur = nxt; cA = nA; cB = nB; ++ui;
        if constexpr (ALIGN_EPI) { if (wr == 1) PG8_BAR; }
    }
    PG8_WAIT_V(0);
    if constexpr (!ALIGN_EPI) { if (wr == 0) PG8_BAR; }
    PG8_BAR;
    if constexpr (Epi::AFTER_DRAIN) { E.fused(acc, cur, wr, wc, fr, fq, lds, wid, lane); S.done(cur); }
#undef PG8_SA
#undef PG8_SB
#undef PG8_STAGE
#undef PG8_LDA
#undef PG8_LDB
#undef PG8_MMA
#undef PG8_WAIT_V
#undef PG8_WAIT_L
#undef PG8_BAR
#undef PG8_SCHED
}
}
namespace att {
constexpr int KVBLK = 64;
constexpr int STG = 32768, L_WS = 65536, L_POSK = 67584, L_BTAB = 68096, L_UNIT = 72256, L_OST = 73728, OST_WAVE = 8704;
template <int DV> __device__ __forceinline__ int v_st(int k, int c) { const int kk = (k & ~0xC) | ((k & 4) << 1) | ((k & 8) >> 1); return ((kk >> 3) * (DV / 32) + (c >> 5)) * 512 + ((kk & 7) * 32 + (c & 31)) * 2; }
__device__ __forceinline__ int v_rd_base(int lane) { return ((lane & 3) << 3) | (((lane >> 2) & 3) << 6) | (((lane >> 4) & 1) << 5) | (((lane >> 5) & 1) << 8); }
__device__ __forceinline__ int koff(int row, int colB, int RB) { return row * RB + (colB ^ ((row & 7) << 4)); }

template <int DQK, int DV, int MODE>
__device__ __forceinline__ void attn_core(LAS unsigned char* lds, const bf16_t* qrow, const bf16_t* Kg, int ldk, const bf16_t* Vg, int ldv, int t_lo, int t_hi, float c2,
                                          int qidx, int head, const int* pos, float& m_reg, float& l_reg, f32x16 (&o)[DV / 32]) {
    constexpr int ND = DQK / 16, NV = DV / 32, RB = DQK * 2, NKC = (64 * (DQK / 8)) / NT_THREADS, NVC = (64 * (DV / 8)) / NT_THREADS, KB = 64 * RB;
    const int tid = tidx(), lane = tid & 63, r32 = lane & 31, hi = lane >> 5, wid = __builtin_amdgcn_readfirstlane(tid >> 6);
    bf16x8 qr[ND];
#pragma unroll
    for (int d0 = 0; d0 < ND; ++d0) qr[d0] = *(const bf16x8*)(qrow + d0 * 16 + hi * 8);
    LAS float* al_l = (LAS float*)(lds + L_WS) + wid * 64;
    LAS int* posk = (LAS int*)(lds + L_POSK); LAS float* btab = (LAS float*)(lds + L_BTAB);
    const unsigned vb0 = (unsigned)(uintptr_t)lds + (unsigned)KB + (unsigned)v_rd_base(lane);
    int posq = 0; if (MODE == 1) posq = pos[qidx];
    unsigned kdst[NKC], ksrc[NKC], vdst[NVC], vsrc[NVC];
#pragma unroll
    for (int i = 0; i < NKC; ++i) { const int c = tid + NT_THREADS * i, row = c / (DQK / 8), ch = c % (DQK / 8); kdst[i] = koff(row, ch * 16, RB); ksrc[i] = row * ldk + ch * 8; }
#pragma unroll
    for (int i = 0; i < NVC; ++i) { const int c = tid + NT_THREADS * i, row = c / (DV / 8), ch = c % (DV / 8); vdst[i] = KB + v_st<DV>(row, ch * 8); vsrc[i] = row * ldv + ch * 8; }
    u32x4 ks[NKC], vs[NVC]; int pkn = 0;
#define LOAD_TILE(t_) do { const size_t kb_ = (size_t)(t_) * KVBLK; _Pragma("unroll") for (int i = 0; i < NKC; ++i) ks[i] = *(const u32x4*)(Kg + kb_ * ldk + ksrc[i]); \
        _Pragma("unroll") for (int i = 0; i < NVC; ++i) vs[i] = *(const u32x4*)(Vg + kb_ * ldv + vsrc[i]); if (MODE == 1 && tid < 64) pkn = pos[(t_) * KVBLK + tid]; } while (0)
#define WRITE_TILE(st_) do { _Pragma("unroll") for (int i = 0; i < NKC; ++i) *(LAS u32x4*)(lds + (st_) * STG + kdst[i]) = ks[i]; \
        _Pragma("unroll") for (int i = 0; i < NVC; ++i) *(LAS u32x4*)(lds + (st_) * STG + vdst[i]) = vs[i]; if (MODE == 1 && tid < 64) posk[(st_) * 64 + tid] = pkn; } while (0)
    LOAD_TILE(t_lo); WRITE_TILE(0);
    __syncthreads();
#pragma unroll 1
    for (int t = t_lo; t < t_hi; ++t) {
        const int st = (t - t_lo) & 1, kbase = t * KVBLK;
        if (t + 1 < t_hi) LOAD_TILE(t + 1);
        const LAS unsigned char* K_lds = lds + st * STG;
        f32x16 p0 = {}, p1 = {};
#pragma unroll
        for (int d0 = 0; d0 < ND; ++d0) {
            const bf16x8 a0 = *(const LAS bf16x8*)(K_lds + koff(r32, (d0 * 16 + hi * 8) * 2, RB));
            const bf16x8 a1 = *(const LAS bf16x8*)(K_lds + koff(32 + r32, (d0 * 16 + hi * 8) * 2, RB));
            p0 = MFMA32(a0, qr[d0], p0); p1 = MFMA32(a1, qr[d0], p1);
        }
        if (MODE == 1) {
#pragma unroll
            for (int r = 0; r < 16; ++r) { const int kl = crow(r, hi);
                { const int kk = kbase + kl; int dist = posq - posk[st * 64 + kl]; dist = dist < 0 ? 0 : (dist > 128 ? 128 : dist);
                  const float b = btab[dist * 8 + head]; p0[r] = ((unsigned)(qidx - kk) < 128u) ? fmaf(p0[r], c2, b) : -__builtin_inff(); }
                { const int kk = kbase + kl + 32; int dist = posq - posk[st * 64 + kl + 32]; dist = dist < 0 ? 0 : (dist > 128 ? 128 : dist);
                  const float b = btab[dist * 8 + head]; p1[r] = ((unsigned)(qidx - kk) < 128u) ? fmaf(p1[r], c2, b) : -__builtin_inff(); } }
        } else {
#pragma unroll
            for (int r = 0; r < 16; ++r) { p0[r] *= c2; p1[r] *= c2; }
        }
        float pmax = p0[0];
#pragma unroll
        for (int r = 1; r < 16; ++r) pmax = fmaxf(pmax, p0[r]);
#pragma unroll
        for (int r = 0; r < 16; ++r) pmax = fmaxf(pmax, p1[r]);
        { auto rr = __builtin_amdgcn_permlane32_swap(__float_as_uint(pmax), __float_as_uint(pmax), false, false); pmax = fmaxf(__uint_as_float(rr[0]), __uint_as_float(rr[1])); }
        const float mn = fmaxf(m_reg, pmax); const float alpha = __builtin_amdgcn_exp2f(m_reg - mn); m_reg = mn;
        float ps = 0.f;
#pragma unroll
        for (int r = 0; r < 16; ++r) { p0[r] = __builtin_amdgcn_exp2f(p0[r] - mn); ps += p0[r]; }
#pragma unroll
        for (int r = 0; r < 16; ++r) { p1[r] = __builtin_amdgcn_exp2f(p1[r] - mn); ps += p1[r]; }
        { auto rr = __builtin_amdgcn_permlane32_swap(__float_as_uint(ps), __float_as_uint(ps), false, false); ps = __uint_as_float(rr[0]) + __uint_as_float(rr[1]); }
        l_reg = l_reg * alpha + ps;
        if (__any(alpha < 1.f)) {
            if (hi == 0) al_l[r32] = alpha;
            LDS_WAIT();
#pragma unroll
            for (int g = 0; g < 4; ++g) { const f32x4 a4 = *(const LAS f32x4*)(al_l + 8 * g + 4 * hi);
#pragma unroll
                for (int d = 0; d < NV; ++d) { o[d][4 * g + 0] *= a4[0]; o[d][4 * g + 1] *= a4[1]; o[d][4 * g + 2] *= a4[2]; o[d][4 * g + 3] *= a4[3]; } }
        }
        bf16x8 pa0, pa1, pa2, pa3;
#define PK4(P, B_, OUT) do { const unsigned a0_ = cvtpk(P[B_ + 0], P[B_ + 1]), a1_ = cvtpk(P[B_ + 2], P[B_ + 3]), b0_ = cvtpk(P[B_ + 4], P[B_ + 5]), b1_ = cvtpk(P[B_ + 6], P[B_ + 7]); \
        auto r0_ = __builtin_amdgcn_permlane32_swap(a0_, b0_, false, false); auto r1_ = __builtin_amdgcn_permlane32_swap(a1_, b1_, false, false); \
        u32x4 w_ = {r0_[0], r1_[0], r0_[1], r1_[1]}; OUT = __builtin_bit_cast(bf16x8, w_); } while (0)
        PK4(p0, 0, pa0); PK4(p0, 8, pa1); PK4(p1, 0, pa2); PK4(p1, 8, pa3);
#undef PK4
        const unsigned vba = vb0 + (unsigned)(st * STG);
#define TRRD(dst, off) asm volatile("ds_read_b64_tr_b16 %0, %1 offset:%2" : "=&v"(dst) : "v"(vba), "i"(off) : "memory")
#define PV_D0(d0) do { s16x4 l0, l1, l2, l3, h0, h1, h2, h3; constexpr int KS_ = NV * 1024, HF_ = NV * 512, b_ = (d0) * 512; \
        TRRD(l0, b_); TRRD(h0, b_ + HF_); TRRD(l1, b_ + KS_); TRRD(h1, b_ + KS_ + HF_); TRRD(l2, b_ + 2 * KS_); TRRD(h2, b_ + 2 * KS_ + HF_); TRRD(l3, b_ + 3 * KS_); TRRD(h3, b_ + 3 * KS_ + HF_); \
        asm volatile("s_waitcnt lgkmcnt(0)" ::: "memory"); SBAR(); \
        o[d0] = MFMA32(pa0, ((bf16x8){l0[0], l0[1], l0[2], l0[3], h0[0], h0[1], h0[2], h0[3]}), o[d0]); \
        o[d0] = MFMA32(pa1, ((bf16x8){l1[0], l1[1], l1[2], l1[3], h1[0], h1[1], h1[2], h1[3]}), o[d0]); \
        o[d0] = MFMA32(pa2, ((bf16x8){l2[0], l2[1], l2[2], l2[3], h2[0], h2[1], h2[2], h2[3]}), o[d0]); \
        o[d0] = MFMA32(pa3, ((bf16x8){l3[0], l3[1], l3[2], l3[3], h3[0], h3[1], h3[2], h3[3]}), o[d0]); } while (0)
        PV_D0(0); PV_D0(1);
        if constexpr (NV == 4) { PV_D0(2); PV_D0(3); }
#undef PV_D0
#undef TRRD
        if (t + 1 < t_hi) WRITE_TILE(st ^ 1);
        __syncthreads();
    }
#undef LOAD_TILE
#undef WRITE_TILE
}
template <int DV>
__device__ __forceinline__ void gated_store(LAS unsigned char* lds, float l_reg, const f32x16 (&o)[DV / 32], bf16_t* zp0) {
    constexpr int NV = DV / 32, OP = DV + 8, CPR = DV / 8;
    const int tid = tidx(), lane = tid & 63, r32 = lane & 31, hi = lane >> 5, wid = __builtin_amdgcn_readfirstlane(tid >> 6);
    LAS float* li_l = (LAS float*)(lds + L_WS) + wid * 64; LAS bf16_t* ost = (LAS bf16_t*)(lds + L_OST + wid * OST_WAVE);
    asm volatile("s_waitcnt lgkmcnt(0)" ::: "memory");
    if (hi == 0) li_l[r32] = l_reg;
    asm volatile("s_waitcnt lgkmcnt(0)" ::: "memory");
#pragma unroll
    for (int g = 0; g < 4; ++g) { const f32x4 a4 = *(const LAS f32x4*)(li_l + 8 * g + 4 * hi);
#pragma unroll
        for (int e = 0; e < 4; ++e) { const float rl = 1.f / a4[e]; const int row = 8 * g + 4 * hi + e;
#pragma unroll
            for (int d0 = 0; d0 < NV; ++d0) ost[row * OP + d0 * 32 + r32] = f2bf(o[d0][4 * g + e] * rl); } }
    asm volatile("s_waitcnt lgkmcnt(0)" ::: "memory");
#pragma unroll
    for (int i = 0; i < (32 * CPR) / 64; ++i) { const int id = lane + 64 * i, row = id / CPR, dc = id % CPR;
        const u32x4 v = *(const LAS u32x4*)(ost + row * OP + dc * 8); bf16_t* zp = zp0 + (size_t)row * NP + dc * 8; const u32x4 z = *(const u32x4*)zp;
        u32x4 w; w.x = cvtpk(lo_bf(v.x) * silu_f(lo_bf(z.x)), hi_bf(v.x) * silu_f(hi_bf(z.x))); w.y = cvtpk(lo_bf(v.y) * silu_f(lo_bf(z.y)), hi_bf(v.y) * silu_f(hi_bf(z.y)));
        w.z = cvtpk(lo_bf(v.z) * silu_f(lo_bf(z.z)), hi_bf(v.z) * silu_f(hi_bf(z.z))); w.w = cvtpk(lo_bf(v.w) * silu_f(lo_bf(z.w)), hi_bf(v.w) * silu_f(hi_bf(z.w)));
        *(u32x4*)zp = w; }
}
__device__ __forceinline__ void swa_unit(LAS unsigned char* lds, int qb, int hk, bf16_t* PROJ, const int* pos, const float* sinks  ) {
    const int tid = tidx(), lane = tid & 63, r32 = lane & 31, wid = __builtin_amdgcn_readfirstlane(tid >> 6);
    const int head = hk * 4 + (wid >> 1), q0 = qb * 64 + (wid & 1) * 32;
    const float sink = sinks[head] * LOG2E;
    float m = sink, l = 1.f; f32x16 o[2] = {};
    int t_lo = (qb * 64 - 128) / 64; if (t_lo < 0) t_lo = 0;
#ifdef EXP_DUPSWA
    attn_core<64, 64, 1>(lds, PROJ + (size_t)(q0 + r32) * NP + C_AQ + head * 64, PROJ + C_AK + hk * 64, NP, PROJ + C_AV + hk * 64, NP, t_lo, qb + 1, 0.125f * LOG2E, q0 + r32, head, pos, m, l, o);
    m = sink; l = 1.f; o[0] = (f32x16){}; o[1] = (f32x16){}; __syncthreads();
#endif
    attn_core<64, 64, 1>(lds, PROJ + (size_t)(q0 + r32) * NP + C_AQ + head * 64, PROJ + C_AK + hk * 64, NP, PROJ + C_AV + hk * 64, NP, t_lo, qb + 1, 0.125f * LOG2E, q0 + r32, head, pos, m, l, o);
    gated_store<64>(lds, l, o, PROJ + (size_t)q0 * NP + C_Z + head * 64);
}
__device__ __forceinline__ void cross_unit(LAS unsigned char* lds, int qb, int h, bf16_t* PROJ, const bf16_t* MEMKV  ) {
    const int tid = tidx(), lane = tid & 63, r32 = lane & 31, wid = __builtin_amdgcn_readfirstlane(tid >> 6);
    const int q0 = qb * 256 + wid * 32;
    float m = -1e30f, l = 0.f; f32x16 o[4] = {};
#ifdef EXP_DUPCROSS
    attn_core<128, 128, 2>(lds, PROJ + (size_t)(q0 + r32) * NP + C_DQ + h * 128, MEMKV + h * 128, 1024, MEMKV + 512 + h * 128, 1024, 0, 4, 0.08838834764831845f * LOG2E, q0 + r32, 0, nullptr, m, l, o);
    m = -1e30f; l = 0.f; o[0] = (f32x16){}; o[1] = (f32x16){}; o[2] = (f32x16){}; o[3] = (f32x16){}; __syncthreads();
#endif
    attn_core<128, 128, 2>(lds, PROJ + (size_t)(q0 + r32) * NP + C_DQ + h * 128, MEMKV + h * 128, 1024, MEMKV + 512 + h * 128, 1024, 0, 4, 0.08838834764831845f * LOG2E, q0 + r32, 0, nullptr, m, l, o);
    gated_store<128>(lds, l, o, PROJ + (size_t)q0 * NP + C_Z + 1536 + h * 128);
}
__device__ __forceinline__ void run_mixers(LAS unsigned char* lds, unsigned* ctr, bf16_t* PROJ, const int* pos, const float* sinks, const float* btab_g, const bf16_t* MEMKV) {
    LAS int* ub = (LAS int*)(lds + L_UNIT);
    __syncthreads();
    for (int i = tidx(); i < 129 * 8; i += NT_THREADS) ((LAS float*)(lds + L_BTAB))[i] = btab_g[i];
    for (;;) {
        __syncthreads();
        if (tidx() == 0) *ub = (int)atomicAdd(ctr, 1u);
        __syncthreads();
        const int u = *ub;
        if (u >= 768) break;
        if (u < 256) cross_unit(lds, u >> 2, u & 3, PROJ, MEMKV); else swa_unit(lds, (u - 256) >> 1, (u - 256) & 1, PROJ, pos, sinks);
    }
}
}
namespace mla {
constexpr int ST_BYTES = 49152  , R_OFF = 32768, L_SCR = 147456  , L_UNIT = 149504, L_OLT = 67584  , L_OUT = 102400  ;
__device__ __forceinline__ unsigned off_a(unsigned row, unsigned ch) { return 2048u * (row >> 3) + 512u * (ch >> 2) + 64u * (row & 7) + 16u * ((ch & 3) ^ ((row >> 2) & 3)); }
__device__ __forceinline__ unsigned off_r(unsigned row, unsigned ch) { return 1024u * (row >> 3) + 512u * (ch >> 2) + 64u * (row & 7) + 16u * ((ch & 3) ^ ((row >> 2) & 3)); }

#ifdef EXP_MLASEC
#define MSEC(i) do { const unsigned long long t_ = __builtin_amdgcn_s_memrealtime(); macc[i] += t_ - mtm; mtm = t_; } while (0)
#define MSEC_ARGS , unsigned long long (&macc)[8], unsigned long long& mtm
#define MSEC_PASS , macc, mtm
#else
#define MSEC(i)
#define MSEC_ARGS
#define MSEC_PASS
#endif
template <int VAR, bool SAFE> __device__ __forceinline__ bool unit(LAS unsigned char* lds, int qb, int h, const bf16_t* QABS, const bf16_t* KVLAT, bf16_t* PROJ, const bf16_t* WUV, const float* rsq, const float* cosT, const float* sinT, float qscale MSEC_ARGS) {
    const int tid = tidx(), lane = tid & 63, r32 = lane & 31, hi = lane >> 5, wid = __builtin_amdgcn_readfirstlane(tid >> 6), kg = wid >> 2, g = wid & 3;
    const int q0 = qb * 128, qloc = 32 * g + r32, qidx = q0 + qloc;
    bf16x8 qr[12];
    { const bf16_t* qrow = QABS + (size_t)qidx * 768 + h * 192;
#pragma unroll
      for (int d0 = 0; d0 < 12; ++d0) qr[d0] = *(const bf16x8*)(qrow + d0 * 16 + hi * 8);
      const float sc = rsq[qidx] * qscale;
#pragma unroll
      for (int d0 = 0; d0 < 12; ++d0) { const u32x4 w = __builtin_bit_cast(u32x4, qr[d0]);
          float v[8] = {lo_bf(w.x) * sc, hi_bf(w.x) * sc, lo_bf(w.y) * sc, hi_bf(w.y) * sc, lo_bf(w.z) * sc, hi_bf(w.z) * sc, lo_bf(w.w) * sc, hi_bf(w.w) * sc};
          if (d0 >= 8) { const int i0 = (d0 - 8) * 8 + hi * 4; const f32x4 c = *(const f32x4*)(cosT + (size_t)qidx * 32 + i0), s = *(const f32x4*)(sinT + (size_t)qidx * 32 + i0);
#pragma unroll
              for (int jj = 0; jj < 4; ++jj) { const float t1 = v[2 * jj], t2 = v[2 * jj + 1]; v[2 * jj] = t1 * c[jj] - t2 * s[jj]; v[2 * jj + 1] = t1 * s[jj] + t2 * c[jj]; }
              SBAR(); }
          qr[d0] = pack8(v); } }
    SBAR();
    unsigned goff[6];
#pragma unroll
    for (int i = 0; i < 6; ++i) { const unsigned o_ = (unsigned)(wid * 6 + i) * 1024u + lane * 16u; unsigned key, cc;
        if (o_ < (unsigned)R_OFF) { const unsigned r = o_ & 2047u, k7 = (r & 511u) >> 6, x = (r & 63u) >> 4; key = (o_ >> 11) * 8u + k7; cc = (r >> 9) * 4u + (x ^ ((key >> 2) & 3u)); }
        else { const unsigned o2 = o_ - R_OFF, r = o2 & 1023u, k7 = (r & 511u) >> 6, x = (r & 63u) >> 4; key = (o2 >> 10) * 8u + k7; cc = 16u + (r >> 9) * 4u + (x ^ ((key >> 2) & 3u)); }
        goff[i] = (key * 192u + cc * 8u) * 2u; }
#define STAGE_TILE(t_, SB) do { const char* src_ = (const char*)KVLAT + (size_t)(t_) * (128 * 192 * 2); const unsigned la_ = (unsigned)(uintptr_t)lds + (SB) + wid * 6144; \
        _Pragma("unroll") for (int i = 0; i < 6; ++i) asm volatile("s_mov_b32 m0, %0\n\ts_nop 0\n\tglobal_load_lds_dwordx4 %1, %2" :: "s"(la_ + i * 1024), "v"(goff[i]), "s"(src_) : "memory", "m0"); } while (0)
    STAGE_TILE(0, 0);
    if (qb >= 1) STAGE_TILE(1, ST_BYTES);
    const unsigned y = (r32 >> 2) & 3, rowpart = 64u * (r32 & 7);
    const unsigned nb_e = 2048u * (8 * kg + (r32 >> 3)) + rowpart + 16u * ((unsigned)hi ^ y), nb_o = 2048u * (8 * kg + (r32 >> 3)) + rowpart + 16u * ((2u + hi) ^ y);
    const unsigned rb_e = R_OFF + 1024u * (8 * kg + (r32 >> 3)) + rowpart + 16u * ((unsigned)hi ^ y), rb_o = R_OFF + 1024u * (8 * kg + (r32 >> 3)) + rowpart + 16u * ((2u + hi) ^ y);
    const unsigned blk = (lane >> 4) & 1, q_ = (lane & 15) >> 2, p_ = lane & 3, xc = 2u * blk + (p_ >> 1);
    const unsigned tbo0 = 2048u * (8 * kg) + 64u * (4u * hi + q_) + 16u * (xc ^ (unsigned)hi) + 8u * (p_ & 1), tbo1 = 2048u * (8 * kg + 1) + 64u * (4u * hi + q_) + 16u * (xc ^ (2u + hi)) + 8u * (p_ & 1);
    LAS float* scr = (LAS float*)(lds + L_SCR) + wid * 64;
    float m_reg = -1e30f, l_reg = 0.f; f32x16 o[4] = {};
    bf16x8 paX0, paX1, paY0 = {}, paY1 = {};
    f32x16 pA, pB;
#define KADDR(s, hf) ((s) < 8 ? ((((s) & 1) ? no_ : ne_) + 512 * ((s) >> 1) + 8192 * (hf)) : ((((s) & 1) ? ro_ : re_) + 512 * (((s) - 8) >> 1) + 4096 * (hf)))
#define KRD1(dst, s, hf) dst = *(const LAS bf16x8*)KADDR(s, hf)
#define VRD1(L, H, d0, ka) do { L = __builtin_amdgcn_ds_read_tr16_b64_v4i16((LAS s16x4*)(t0a_ + 4096 * (ka) + 512 * (d0))); H = __builtin_amdgcn_ds_read_tr16_b64_v4i16((LAS s16x4*)(t1a_ + 4096 * (ka) + 512 * (d0))); } while (0)
#define VFR(L, H) ((bf16x8){L[0], L[1], L[2], L[3], H[0], H[1], H[2], H[3]})
#define QBASES(SB) const LAS unsigned char* ne_ = lds + (SB) + nb_e; const LAS unsigned char* no_ = lds + (SB) + nb_o; const LAS unsigned char* re_ = lds + (SB) + rb_e; const LAS unsigned char* ro_ = lds + (SB) + rb_o
#define PBASES(SB) LAS unsigned char* t0a_ = lds + (SB) + tbo0; LAS unsigned char* t1a_ = lds + (SB) + tbo1
#define QKQ_SERIAL(PN, SB, hf) do { QBASES(SB); PN = (f32x16){}; _Pragma("unroll") for (int s_ = 0; s_ < 12; ++s_) { bf16x8 k_; KRD1(k_, s_, hf); PN = MFMA32(k_, qr[s_], PN); } } while (0)
#define PVQ_SERIAL(SB, hf, PA0, PA1) do { PBASES(SB); _Pragma("unroll") for (int j_ = 0; j_ < 8; ++j_) { s16x4 l_, h_; VRD1(l_, h_, j_ >> 1, 2 * (hf) + (j_ & 1)); o[j_ >> 1] = MFMA32((j_ & 1) ? PA1 : PA0, VFR(l_, h_), o[j_ >> 1]); } } while (0)
#define ROWMAX16(P, out) do { float a_ = fmaxf(fmaxf(P[0], P[1]), P[2]), b_ = fmaxf(fmaxf(P[3], P[4]), P[5]), c_ = fmaxf(fmaxf(P[6], P[7]), P[8]), d_ = fmaxf(fmaxf(P[9], P[10]), P[11]), e_ = fmaxf(fmaxf(P[12], P[13]), P[14]); \
        a_ = fmaxf(fmaxf(a_, b_), P[15]); c_ = fmaxf(fmaxf(c_, d_), e_); out = fmaxf(a_, c_); } while (0)
#define HALVES_MAX(v) do { auto rr = __builtin_amdgcn_permlane32_swap(__float_as_uint(v), __float_as_uint(v), false, false); v = fmaxf(__uint_as_float(rr[0]), __uint_as_float(rr[1])); } while (0)
#define RESCALE_O(alpha_) do { if (hi == 0) scr[r32] = (alpha_); LDS_WAIT(); \
            _Pragma("unroll") for (int gg = 0; gg < 4; ++gg) { const f32x4 a4 = *(const LAS f32x4*)(scr + 8 * gg + 4 * hi); \
                _Pragma("unroll") for (int d = 0; d < 4; ++d) { o[d][4 * gg + 0] *= a4[0]; o[d][4 * gg + 1] *= a4[1]; o[d][4 * gg + 2] *= a4[2]; o[d][4 * gg + 3] *= a4[3]; } } } while (0)
#define DIAG_MASK() do { const int t2_ = tidx(); int ql_ = 32 * ((t2_ >> 6) & 3) + (t2_ & 31) - 64 * (t2_ >> 8) - 4 * ((t2_ >> 5) & 1); asm volatile("" : "+v"(ql_)); \
        _Pragma("unroll") for (int r = 0; r < 16; ++r) { const int kc_ = (r & 3) + 8 * (r >> 2); if (kc_ > ql_) pA[r] = -__builtin_inff(); if (kc_ + 32 > ql_) pB[r] = -__builtin_inff(); } } while (0)
    asm volatile("s_waitcnt vmcnt(0)" ::: "memory");
    __syncthreads();
    MSEC(0);
    if constexpr (!SAFE) {
#define SMC(i, PC, PE0, PE1) do { if ((i) < 16) { const float e_ = __builtin_amdgcn_exp2f(PC[i]); \
            if (((i) & 3) == 0) l0_ += e_; else if (((i) & 3) == 1) l1_ += e_; else if (((i) & 3) == 2) l2_ += e_; else l3_ += e_; \
            if (((i) & 1) == 0) ev_ = e_; else { const unsigned c_ = cvtpk(ev_, e_); if (((i) >> 1 & 3) == 0) c0_ = c_; else if (((i) >> 1 & 3) == 1) c1_ = c_; else if (((i) >> 1 & 3) == 2) c2_ = c_; else c3_ = c_; } \
            if ((i) == 7) { u32x4 w_ = {c0_, c1_, c2_, c3_}; PE0 = __builtin_bit_cast(bf16x8, w_); } if ((i) == 15) { u32x4 w_ = {c0_, c1_, c2_, c3_}; PE1 = __builtin_bit_cast(bf16x8, w_); } } } while (0)
#define SLOT_ISQ(i) (((i) < 16) ? (((i) & 1) == 0) : true)
#define SLOT_QS(i) (((i) < 16) ? ((i) >> 1) : ((i) - 8))
#define SLOT_PJ(i) ((i) >> 1)
#define RD_SLOT(i, HQ, HP) do { if ((i) < 20) { if (SLOT_ISQ(i)) { if (SLOT_QS(i) % 3 == 0) KRD1(kf0, SLOT_QS(i), HQ); else if (SLOT_QS(i) % 3 == 1) KRD1(kf1, SLOT_QS(i), HQ); else KRD1(kf2, SLOT_QS(i), HQ); } \
        else { if (SLOT_PJ(i) & 1) VRD1(vl1, vh1, SLOT_PJ(i) >> 1, 2 * (HP) + 1); else VRD1(vl0, vh0, SLOT_PJ(i) >> 1, 2 * (HP)); } } } while (0)
#define MM_SLOT(i, PN, PA0, PA1) do { if (SLOT_ISQ(i)) { if (SLOT_QS(i) % 3 == 0) PN = MFMA32(kf0, qr[SLOT_QS(i)], PN); else if (SLOT_QS(i) % 3 == 1) PN = MFMA32(kf1, qr[SLOT_QS(i)], PN); else PN = MFMA32(kf2, qr[SLOT_QS(i)], PN); } \
        else { if (SLOT_PJ(i) & 1) o[(SLOT_PJ(i) >> 1) & 3] = MFMA32(PA1, VFR(vl1, vh1), o[(SLOT_PJ(i) >> 1) & 3]); else o[(SLOT_PJ(i) >> 1) & 3] = MFMA32(PA0, VFR(vl0, vh0), o[(SLOT_PJ(i) >> 1) & 3]); } } while (0)
#define SLOT(i, PN, HQ, HP, PA0, PA1, PC, PE0, PE1) do { MM_SLOT(i, PN, PA0, PA1); RD_SLOT((i) + 2, HQ, HP); if (!(VAR & 2)) SMC(i, PC, PE0, PE1); SBAR(); } while (0)
#define ITER(PN, SBQ, HQ, SBP, HP, PA0, PA1, PC, PE0, PE1) do { QBASES(SBQ); PBASES(SBP); bf16x8 kf0, kf1, kf2; s16x4 vl0, vh0, vl1, vh1; float ev_ = 0.f; unsigned c0_ = 0, c1_ = 0, c2_ = 0, c3_ = 0; \
        PN = (f32x16){}; RD_SLOT(0, HQ, HP); RD_SLOT(1, HQ, HP); SBAR(); \
        SLOT(0, PN, HQ, HP, PA0, PA1, PC, PE0, PE1); SLOT(1, PN, HQ, HP, PA0, PA1, PC, PE0, PE1); SLOT(2, PN, HQ, HP, PA0, PA1, PC, PE0, PE1); SLOT(3, PN, HQ, HP, PA0, PA1, PC, PE0, PE1); \
        SLOT(4, PN, HQ, HP, PA0, PA1, PC, PE0, PE1); SLOT(5, PN, HQ, HP, PA0, PA1, PC, PE0, PE1); SLOT(6, PN, HQ, HP, PA0, PA1, PC, PE0, PE1); SLOT(7, PN, HQ, HP, PA0, PA1, PC, PE0, PE1); \
        SLOT(8, PN, HQ, HP, PA0, PA1, PC, PE0, PE1); SLOT(9, PN, HQ, HP, PA0, PA1, PC, PE0, PE1); SLOT(10, PN, HQ, HP, PA0, PA1, PC, PE0, PE1); SLOT(11, PN, HQ, HP, PA0, PA1, PC, PE0, PE1); \
        SLOT(12, PN, HQ, HP, PA0, PA1, PC, PE0, PE1); SLOT(13, PN, HQ, HP, PA0, PA1, PC, PE0, PE1); SLOT(14, PN, HQ, HP, PA0, PA1, PC, PE0, PE1); SLOT(15, PN, HQ, HP, PA0, PA1, PC, PE0, PE1); \
        SLOT(16, PN, HQ, HP, PA0, PA1, PC, PE0, PE1); SLOT(17, PN, HQ, HP, PA0, PA1, PC, PE0, PE1); SLOT(18, PN, HQ, HP, PA0, PA1, PC, PE0, PE1); SLOT(19, PN, HQ, HP, PA0, PA1, PC, PE0, PE1); } while (0)
    float l0_ = 0.f, l1_ = 0.f, l2_ = 0.f, l3_ = 0.f;
    unsigned s_prev = 2 * ST_BYTES, s_cur = 0, s_next = ST_BYTES;
    QKQ_SERIAL(pA, s_cur, 0);
#pragma unroll 1
    for (int t = 0; t < qb; ++t) {
        { const unsigned sp_ = t ? s_prev : s_cur; ITER(pB, s_cur, 1, sp_, 1, paY0, paY1, pA, paX0, paX1); }
        asm volatile("s_waitcnt vmcnt(0)" ::: "memory");
        if (!(VAR & 16)) __syncthreads();
        if (t + 2 <= qb && !(VAR & 8)) STAGE_TILE(t + 2, s_prev);
        ITER(pA, s_next, 0, s_cur, 0, paX0, paX1, pB, paY0, paY1);
        { const unsigned tmp_ = s_prev; s_prev = s_cur; s_cur = s_next; s_next = tmp_; }
    }
    if (qb > 0) PVQ_SERIAL(s_prev, 1, paY0, paY1);
    QKQ_SERIAL(pB, s_cur, 1);
    DIAG_MASK();
#pragma unroll
    for (int r = 0; r < 16; ++r) { pA[r] = __builtin_amdgcn_exp2f(pA[r]); pB[r] = __builtin_amdgcn_exp2f(pB[r]); l0_ += pA[r]; l1_ += pB[r]; }
    paX0 = pack_step(pA, 0); paX1 = pack_step(pA, 1); paY0 = pack_step(pB, 0); paY1 = pack_step(pB, 1);
    PVQ_SERIAL(s_cur, 0, paX0, paX1);
    PVQ_SERIAL(s_cur, 1, paY0, paY1);
    l_reg = (l0_ + l1_) + (l2_ + l3_); m_reg = 0.f;
#undef SMC
#undef SLOT_ISQ
#undef SLOT_QS
#undef SLOT_PJ
#undef RD_SLOT
#undef MM_SLOT
#undef SLOT
#undef ITER
    } else {
#pragma unroll 1
    for (int t = 0; t <= qb; ++t) {
        __syncthreads();
        STAGE_TILE(t, 0);
        asm volatile("s_waitcnt vmcnt(0)" ::: "memory");
        __syncthreads();
        QKQ_SERIAL(pA, 0, 0); QKQ_SERIAL(pB, 0, 1);
        if (t == qb) DIAG_MASK();
        float pm_, pm2_; ROWMAX16(pA, pm_); ROWMAX16(pB, pm2_); pm_ = fmaxf(pm_, pm2_); HALVES_MAX(pm_);
        const float mn_ = fmaxf(m_reg, pm_), al_ = __builtin_amdgcn_exp2f(m_reg - mn_); m_reg = mn_; float ps_ = 0.f;
#pragma unroll
        for (int r = 0; r < 16; ++r) { pA[r] = __builtin_amdgcn_exp2f(pA[r] - mn_); pB[r] = __builtin_amdgcn_exp2f(pB[r] - mn_); ps_ += pA[r] + pB[r]; }
        l_reg = l_reg * al_ + ps_;
        if (__any(al_ < 1.f)) RESCALE_O(al_);
        paX0 = pack_step(pA, 0); paX1 = pack_step(pA, 1); paY0 = pack_step(pB, 0); paY1 = pack_step(pB, 1);
        PVQ_SERIAL(0, 0, paX0, paX1);
        PVQ_SERIAL(0, 1, paY0, paY1);
    }
    }
    { auto rr = __builtin_amdgcn_permlane32_swap(__float_as_uint(l_reg), __float_as_uint(l_reg), false, false); l_reg = __uint_as_float(rr[0]) + __uint_as_float(rr[1]); }
    if (!(l_reg > 0.f)) m_reg = -1e30f;
    if (tidx() == 0) *(LAS int*)(lds + L_UNIT + 8) = 0;
    __syncthreads();
#undef KADDR
#undef KRD1
#undef VRD1
#undef VFR
#undef QBASES
#undef PBASES
#undef QKQ_SERIAL
#undef PVQ_SERIAL
#undef ROWMAX16
#undef HALVES_MAX
#undef RESCALE_O
#undef DIAG_MASK
    if (VAR != 0) { asm volatile("" :: "v"(o[0]), "v"(o[1]), "v"(o[2]), "v"(o[3]), "v"(m_reg), "v"(l_reg)); return false; }
#undef STAGE_TILE
    const int tid_e = tidx(), lane_e = tid_e & 63; const int wid_e = __builtin_amdgcn_readfirstlane(tid_e >> 6);
#define lane lane_e
#define r32 (lane_e & 31)
#define hi (lane_e >> 5)
#define kg (wid_e >> 2)
#define g (wid_e & 3)
    LAS float* scr_e = (LAS float*)(lds + L_SCR) + wid_e * 64;
#define scr scr_e
    LAS float* xo = (LAS float*)lds + g * 4096;
    LAS float* xm = (LAS float*)(lds + 65536) + g * 128;
    if (kg == 1) {
#pragma unroll
        for (int d0 = 0; d0 < 4; ++d0)
#pragma unroll
            for (int r = 0; r < 16; ++r) xo[(d0 * 16 + r) * 64 + lane] = o[d0][r];
        xm[lane] = m_reg; xm[64 + lane] = l_reg;
    }
    __syncthreads();
    float fA = 0.f, fB = 0.f, li = 0.f;
    if (kg == 0) {
        const float mB = xm[lane], lB = xm[64 + lane];
        const float m = fmaxf(m_reg, mB); fA = __builtin_amdgcn_exp2f(m_reg - m); fB = __builtin_amdgcn_exp2f(mB - m); const float ls = l_reg * fA + lB * fB; li = 1.f / ls;
#ifdef EXP_FORCE_SAFE
        if (!SAFE) *(LAS int*)(lds + L_UNIT + 8) = 1;
#else
        if (!SAFE && !(ls > 7.9e-31f && ls < 1.2e30f)) *(LAS int*)(lds + L_UNIT + 8) = 1;
#endif
    }
    if constexpr (!SAFE) { __syncthreads(); if (*(LAS int*)(lds + L_UNIT + 8)) { __syncthreads(); return true; } }
    if (kg == 0) {
        if (hi == 0) { scr[r32] = fA * li; scr[32 + r32] = fB * li; }
        LDS_WAIT();
        float sA[16], sB[16];
#pragma unroll
        for (int gg = 0; gg < 4; ++gg) { const f32x4 a4 = *(const LAS f32x4*)(scr + 8 * gg + 4 * hi), b4 = *(const LAS f32x4*)(scr + 32 + 8 * gg + 4 * hi);
            sA[4 * gg] = a4[0]; sA[4 * gg + 1] = a4[1]; sA[4 * gg + 2] = a4[2]; sA[4 * gg + 3] = a4[3]; sB[4 * gg] = b4[0]; sB[4 * gg + 1] = b4[1]; sB[4 * gg + 2] = b4[2]; sB[4 * gg + 3] = b4[3]; }
        LAS bf16_t* olt = (LAS bf16_t*)(lds + L_OLT + g * 8704); LAS bf16_t* ot = (LAS bf16_t*)(lds + L_OUT + g * 8704);
#pragma unroll
        for (int d0 = 0; d0 < 4; ++d0) {
#pragma unroll
            for (int r = 0; r < 16; ++r) olt[crow(r, hi) * 136 + d0 * 32 + r32] = f2bf(o[d0][r] * sA[r] + xo[(d0 * 16 + r) * 64 + lane] * sB[r]);
            SBAR(); }
        LDS_WAIT();
        bf16x8 af[8];
#pragma unroll
        for (int ks = 0; ks < 8; ++ks) af[ks] = *(const LAS bf16x8*)(olt + r32 * 136 + 16 * ks + 8 * hi);
        f32x16 y[4] = {};
        const bf16_t* wb = WUV + (size_t)(h * 128 + r32) * 512 + h * 128 + 8 * hi;
#pragma unroll
        for (int c = 0; c < 4; ++c)
#pragma unroll
            for (int ks = 0; ks < 8; ++ks) y[c] = MFMA32(af[ks], *(const bf16x8*)(wb + (size_t)(32 * c) * 512 + 16 * ks), y[c]);
#pragma unroll
        for (int r = 0; r < 16; ++r)
#pragma unroll
            for (int c = 0; c < 4; ++c) ot[crow(r, hi) * 136 + 32 * c + r32] = f2bf(y[c][r]);
        LDS_WAIT();
        bf16_t* zp0 = PROJ + (size_t)(q0 + 32 * g) * NP + C_Z + 1024 + h * 128;
#pragma unroll
        for (int i = 0; i < 8; ++i) { const int id = lane + 64 * i, row = id >> 4, dc = id & 15;
            const u32x4 v = *(const LAS u32x4*)(ot + row * 136 + dc * 8); bf16_t* zp = zp0 + (size_t)row * NP + dc * 8; const u32x4 z = *(const u32x4*)zp;
            u32x4 w; w.x = cvtpk(lo_bf(v.x) * silu_f(lo_bf(z.x)), hi_bf(v.x) * silu_f(hi_bf(z.x))); w.y = cvtpk(lo_bf(v.y) * silu_f(lo_bf(z.y)), hi_bf(v.y) * silu_f(hi_bf(z.y)));
            w.z = cvtpk(lo_bf(v.z) * silu_f(lo_bf(z.z)), hi_bf(v.z) * silu_f(hi_bf(z.z))); w.w = cvtpk(lo_bf(v.w) * silu_f(lo_bf(z.w)), hi_bf(v.w) * silu_f(hi_bf(z.w)));
            *(u32x4*)zp = w; }
    }
    __syncthreads();
    MSEC(6);
#undef lane
#undef r32
#undef hi
#undef kg
#undef g
#undef scr
    return false;
}
__device__ __forceinline__ void run_queue(LAS unsigned char* lds, unsigned* ctr, const bf16_t* QABS, const bf16_t* KVLAT, bf16_t* PROJ, const bf16_t* WUV, const float* rsq, const float* cosT, const float* sinT, float qscale) {
    LAS int* ub = (LAS int*)(lds + L_UNIT);
#ifdef EXP_MLASEC
    unsigned long long macc[8] = {0, 0, 0, 0, 0, 0, 0, 0}, mtm = __builtin_amdgcn_s_memrealtime();
#endif
    for (;;) {
        __syncthreads();
        if (tidx() == 0) *ub = (int)atomicAdd(ctr, 1u);
        __syncthreads();
        const int u = *ub;
        if (u >= 512) break;
        MSEC(7);
        if (unit<0, false>(lds, 127 - (u >> 2), u & 3, QABS, KVLAT, PROJ, WUV, rsq, cosT, sinT, qscale MSEC_PASS)) (void)unit<0, true>(lds, 127 - (u >> 2), u & 3, QABS, KVLAT, PROJ, WUV, rsq, cosT, sinT, qscale MSEC_PASS);
    }
#ifdef EXP_MLAVAR
    for (;;) {
        __syncthreads();
        if (tidx() == 0) *ub = (int)atomicAdd(ctr + 32, 1u);
        __syncthreads();
        const int u = *ub;
        if (u >= 512) break;
        (void)unit<EXP_MLAVAR, false>(lds, 127 - (u >> 2), u & 3, QABS, KVLAT, PROJ, WUV, rsq, cosT, sinT, qscale MSEC_PASS);
    }
#endif
#ifdef EXP_MLASEC
    { const unsigned long long t1_ = __builtin_amdgcn_s_memrealtime(); while (__builtin_amdgcn_s_memrealtime() - t1_ < 4 * macc[EXP_MLASEC]) __builtin_amdgcn_s_sleep(8); }
#endif
}
}
template <class Map>
__device__ __forceinline__ void transpose_tile(const float* W, int ldw, bf16_t* WT, int K, int n0, int k0, LAS float* tile, Map map, int lane) {
    { const int src = map(n0 + lane); float v[64];
#pragma unroll
      for (int k = 0; k < 64; ++k) v[k] = src >= 0 ? W[(size_t)(k0 + k) * ldw + src] : 0.f;
#pragma unroll
      for (int k = 0; k < 64; ++k) tile[k * 65 + lane] = v[k]; }
    LDS_WAIT();
    { const int kc = (lane & 7) * 8;
#pragma unroll
      for (int i = 0; i < 8; ++i) { const int n = (lane >> 3) + 8 * i; float v[8];
#pragma unroll
          for (int j = 0; j < 8; ++j) v[j] = tile[(kc + j) * 65 + n];
          u32x4 w = {cvtpk(v[0], v[1]), cvtpk(v[2], v[3]), cvtpk(v[4], v[5]), cvtpk(v[6], v[7])};
          *(u32x4*)(WT + (size_t)(n0 + n) * K + k0 + kc) = w; } }
    LDS_WAIT();
}
struct MapWin { __device__ int operator()(int n) const { return win_src(n); } };
struct MapId { __device__ int operator()(int n) const { return n; } };

__device__ __forceinline__ void job_win(const Params& p, int l, int gw, int ngw, LAS unsigned char* lds, int wid, int lane) {
    bf16_t* WT = (bf16_t*)(p.ws + WS_WIN); const float* W = p.w_in + (size_t)l * DM * DIN; LAS float* tile = (LAS float*)(lds + wid * 16640);
    for (int t = gw; t < (NP / 64) * (DM / 64); t += ngw) transpose_tile(W, DIN, WT, DM, (t / (DM / 64)) * 64, (t % (DM / 64)) * 64, tile, MapWin(), lane);
}
__device__ __forceinline__ void job_wout(const Params& p, int l, int gw, int ngw, LAS unsigned char* lds, int wid, int lane) {
    bf16_t* WT = (bf16_t*)(p.ws + WS_WOUT); const float* W = p.w_out + (size_t)l * MIXW * DM; LAS float* tile = (LAS float*)(lds + wid * 16640);
    for (int t = gw; t < (DM / 64) * (MIXW / 64); t += ngw) transpose_tile(W, DM, WT, MIXW, (t / (MIXW / 64)) * 64, (t % (MIXW / 64)) * 64, tile, MapId(), lane);
}
__device__ __forceinline__ void job_wmem(const Params& p, int gw, int ngw, LAS unsigned char* lds, int wid, int lane) {
    LAS float* tile = (LAS float*)(lds + wid * 16640);
    for (int t = gw; t < 2 * 16 * 16; t += ngw) { const int l = t >> 8, r = t & 255;
        transpose_tile(p.w_mem + (size_t)l * DM * DM, DM, (bf16_t*)(p.ws + WS_WMEM) + (size_t)l * DM * DM, DM, (r >> 4) * 64, (r & 15) * 64, tile, MapId(), lane); }
}
__device__ __forceinline__ void job_wq(const Params& p, int bid, int nblk, int gtid, int gn, LAS unsigned char* lds) {
    const int tid = tidx(); LAS float* At = (LAS float*)lds; LAS float* Bt = At + 64 * 129;
    for (int it = bid; it < 2 * 4 * 4 * 2; it += nblk) { const int l = it >> 5, h = (it >> 3) & 3, kt = (it >> 1) & 3, ct = it & 1;
        const float* uq = p.w_uq + (size_t)l * 256 * 768 + (size_t)(kt * 64) * 768 + h * 192; const float* ukv = p.w_ukv + (size_t)l * 128 * 1024 + (size_t)(ct * 64) * 1024 + h * 256;
        __syncthreads();
#pragma unroll
        for (int i = 0; i < 16; ++i) { const int e = tid + NT_THREADS * i, r = e >> 7, j = e & 127; At[r * 129 + j] = uq[(size_t)r * 768 + j]; Bt[r * 129 + j] = ukv[(size_t)r * 1024 + j]; }
        __syncthreads();
        const int kk = tid & 63, c0 = (tid >> 6) * 8; float acc[8] = {0.f, 0.f, 0.f, 0.f, 0.f, 0.f, 0.f, 0.f};
#pragma unroll 4
        for (int j = 0; j < 128; ++j) { const float a = At[kk * 129 + j];
#pragma unroll
            for (int e = 0; e < 8; ++e) acc[e] = fmaf(a, Bt[(c0 + e) * 129 + j], acc[e]); }
        const int k = kt * 64 + kk; const float g = p.q_norm[l * 256 + k]; bf16_t* wq = (bf16_t*)(p.ws + WS_WQ) + (size_t)l * 768 * 256;
#pragma unroll
        for (int e = 0; e < 8; ++e) wq[(size_t)(h * 192 + ct * 64 + c0 + e) * 256 + k] = f2bf(acc[e] * g);
    }
    for (int idx = gtid; idx < 2 * 4 * 64 * 256; idx += gn) {
        const int l = idx >> 16, r = idx & 65535, h = r >> 14, w = (r >> 8) & 63, k = r & 255, i = w >> 1, which = w & 1;
        ((bf16_t*)(p.ws + WS_WQ))[(size_t)l * 768 * 256 + (size_t)(h * 192 + 128 + w) * 256 + k] = f2bf(p.w_uq[(size_t)l * 256 * 768 + (size_t)k * 768 + h * 192 + 128 + i + 32 * which] * p.q_norm[l * 256 + k]);
    }
}
__device__ __forceinline__ void job_wuv(const Params& p, int gtid, int gn) {
    for (int idx = gtid; idx < 2 * 512 * 512; idx += gn) {
        const int l = idx / (512 * 512), r = idx % (512 * 512), n = r / 512, k = r % 512, h = n >> 7;
        const float v = (k >> 7) == h ? p.w_ukv[(size_t)l * 128 * 1024 + (size_t)(k & 127) * 1024 + h * 256 + 128 + (n & 127)] : 0.f;
        ((bf16_t*)(p.ws + WS_WUV))[idx] = f2bf(v);
    }
}
__device__ __forceinline__ void job_rope(const Params& p, int gtid, int gn) {
    float* cosT = (float*)(p.ws + WS_COS); float* sinT = (float*)(p.ws + WS_SIN);
    for (int idx = gtid; idx < S * 32; idx += gn) {
        const int s = idx >> 5, i = idx & 31;
        const float angf = (float)p.pos[s] * inv_freq(i);
        const double a = (double)angf; const double kq = __builtin_rint(a * 0.63661977236758134308);
        const double x = (a - kq * 1.5707963267948966192) - kq * 6.123233995736766036e-17;
        const double x2 = x * x;
        const double sn = x * (1.0 + x2 * (-1.0 / 6 + x2 * (1.0 / 120 + x2 * (-1.0 / 5040 + x2 * (1.0 / 362880 + x2 * (-1.0 / 39916800 + x2 * (1.0 / 6227020800.0)))))));
        const double cs = 1.0 + x2 * (-0.5 + x2 * (1.0 / 24 + x2 * (-1.0 / 720 + x2 * (1.0 / 40320 + x2 * (-1.0 / 3628800 + x2 * (1.0 / 479001600.0 + x2 * (-1.0 / 87178291200.0)))))));
        const int q = ((int)kq) & 3;
        const double c = (q == 0) ? cs : (q == 1) ? -sn : (q == 2) ? -cs : sn;
        const double sv = (q == 0) ? sn : (q == 1) ? cs : (q == 2) ? -sn : -cs;
        cosT[idx] = (float)c; sinT[idx] = (float)sv;
    }
}
__device__ __forceinline__ void job_btab(const Params& p, int gtid, int gn) {
    float* bt = (float*)(p.ws + WS_MISC + MISC_BTAB);
    for (int idx = gtid; idx < 129 * 8; idx += gn) { const int d = idx >> 3, h = idx & 7; bt[idx] = p.rel_bias[t5_bucket(d) * 8 + h] * LOG2E; }
}
__device__ __forceinline__ void rms_row_to_bf16(const float* xrow, const float* gain, bf16_t* orow, int lane) {
    f32x4 v[4]; float ss = 0.f;
#pragma unroll
    for (int j = 0; j < 4; ++j) { v[j] = *(const f32x4*)(xrow + 256 * j + 4 * lane); ss += (v[j].x * v[j].x + v[j].y * v[j].y) + (v[j].z * v[j].z + v[j].w * v[j].w); }
    const float rs = rsqrtf(wave_sum(ss) * (1.f / DM) + RMS_EPS);
#pragma unroll
    for (int j = 0; j < 4; ++j) { const f32x4 g = *(const f32x4*)(gain + 256 * j + 4 * lane);
        u32x2 w; w.x = cvtpk(v[j].x * rs * g.x, v[j].y * rs * g.y); w.y = cvtpk(v[j].z * rs * g.z, v[j].w * rs * g.w);
        *(u32x2*)(orow + 256 * j + 4 * lane) = w; }
}
__device__ __forceinline__ void job_memn(const Params& p, int gw, int ngw, int lane) {
    for (int r = gw; r < 2 * MEML; r += ngw) { const int l = r >> 8, m = r & 255;
        rms_row_to_bf16(p.mem + (size_t)m * DM, p.mem_norm + l * DM, (bf16_t*)(p.ws + WS_MEMN) + ((size_t)l * MEML + m) * DM, lane); }
}
__device__ __forceinline__ void job_norm_rows(const Params& p, int mode, int gw, int ngw, int lane) {
    bf16_t* H = (bf16_t*)(p.ws + WS_H); const bf16_t* Y = (const bf16_t*)(p.ws + WS_Y);
    for (int row = gw; row < S; row += ngw) {
        if (mode == 0) { rms_row_to_bf16(p.x + (size_t)row * DM, p.norm_pre, H + (size_t)row * DM, lane); continue; }
        const float* xin = (mode == 1 ? p.x : p.out) + (size_t)row * DM; const float* gpost = p.norm_post + (mode == 1 ? 0 : DM);
        float y[16]; float ss = 0.f;
#pragma unroll
        for (int j = 0; j < 4; ++j) { const u32x2 w = *(const u32x2*)(Y + (size_t)row * DM + 256 * j + 4 * lane);
            y[4 * j] = lo_bf(w.x); y[4 * j + 1] = hi_bf(w.x); y[4 * j + 2] = lo_bf(w.y); y[4 * j + 3] = hi_bf(w.y);
            ss += (y[4 * j] * y[4 * j] + y[4 * j + 1] * y[4 * j + 1]) + (y[4 * j + 2] * y[4 * j + 2] + y[4 * j + 3] * y[4 * j + 3]); }
        const float rs = rsqrtf(wave_sum(ss) * (1.f / DM) + RMS_EPS);
        f32x4 x1[4]; float s2 = 0.f;
#pragma unroll
        for (int j = 0; j < 4; ++j) { const f32x4 xv = *(const f32x4*)(xin + 256 * j + 4 * lane); const f32x4 g = *(const f32x4*)(gpost + 256 * j + 4 * lane);
            x1[j].x = xv.x + y[4 * j] * rs * g.x; x1[j].y = xv.y + y[4 * j + 1] * rs * g.y; x1[j].z = xv.z + y[4 * j + 2] * rs * g.z; x1[j].w = xv.w + y[4 * j + 3] * rs * g.w;
            *(f32x4*)(p.out + (size_t)row * DM + 256 * j + 4 * lane) = x1[j];
            s2 += (x1[j].x * x1[j].x + x1[j].y * x1[j].y) + (x1[j].z * x1[j].z + x1[j].w * x1[j].w); }
        if (mode == 1) { const float r2 = rsqrtf(wave_sum(s2) * (1.f / DM) + RMS_EPS); const float* gpre = p.norm_pre + DM;
#pragma unroll
            for (int j = 0; j < 4; ++j) { const f32x4 g = *(const f32x4*)(gpre + 256 * j + 4 * lane);
                u32x2 w; w.x = cvtpk(x1[j].x * r2 * g.x, x1[j].y * r2 * g.y); w.y = cvtpk(x1[j].z * r2 * g.z, x1[j].w * r2 * g.w);
                *(u32x2*)(H + (size_t)row * DM + 256 * j + 4 * lane) = w; } }
    }
}
__device__ __forceinline__ void job_mla_rows(const Params& p, int l, int gw, int ngw, int lane) {
    const bf16_t* PROJ = (const bf16_t*)(p.ws + WS_PROJ); bf16_t* KV = (bf16_t*)(p.ws + WS_KVLAT); float* RSQ = (float*)(p.ws + WS_MISC + MISC_RSQ);
    const float* cosT = (const float*)(p.ws + WS_COS); const float* sinT = (const float*)(p.ws + WS_SIN);
    const int rs_ = lane >> 4, j = lane & 15;
    for (int row = gw * 4 + rs_; row < S; row += ngw * 4) {
        const bf16_t* pr = PROJ + (size_t)row * NP;
        const u32x4 q0 = *(const u32x4*)(pr + C_CQ + j * 16), q1 = *(const u32x4*)(pr + C_CQ + j * 16 + 8), kv = *(const u32x4*)(pr + C_CKV + j * 8); const u32x2 kr = *(const u32x2*)(pr + C_KR + j * 4);
        f32x4 cs = {0.f, 0.f, 0.f, 0.f}, sn = {0.f, 0.f, 0.f, 0.f}; if (j < 8) { cs = *(const f32x4*)(cosT + (size_t)row * 32 + 4 * j); sn = *(const f32x4*)(sinT + (size_t)row * 32 + 4 * j); }
        float sq = 0.f, sk = 0.f;
        { const unsigned w[8] = {q0.x, q0.y, q0.z, q0.w, q1.x, q1.y, q1.z, q1.w};
#pragma unroll
          for (int e = 0; e < 8; ++e) { const float a = lo_bf(w[e]), b = hi_bf(w[e]); sq += a * a + b * b; } }
        float kvf[8] = {lo_bf(kv.x), hi_bf(kv.x), lo_bf(kv.y), hi_bf(kv.y), lo_bf(kv.z), hi_bf(kv.z), lo_bf(kv.w), hi_bf(kv.w)};
#pragma unroll
        for (int e = 0; e < 8; ++e) sk += kvf[e] * kvf[e];
        sq = row16_sum(sq); sk = row16_sum(sk);
        if (j == 0) RSQ[row] = rsqrtf(sq * (1.f / 256.f) + RMS_EPS);
        { const float rs = rsqrtf(sk * (1.f / 128.f) + RMS_EPS); const float* g = p.kv_norm + l * 128 + j * 8; const f32x4 g0 = *(const f32x4*)g, g1 = *(const f32x4*)(g + 4);
          u32x4 w; w.x = cvtpk(kvf[0] * rs * g0[0], kvf[1] * rs * g0[1]); w.y = cvtpk(kvf[2] * rs * g0[2], kvf[3] * rs * g0[3]); w.z = cvtpk(kvf[4] * rs * g1[0], kvf[5] * rs * g1[1]); w.w = cvtpk(kvf[6] * rs * g1[2], kvf[7] * rs * g1[3]);
          *(u32x4*)(KV + (size_t)row * 192 + j * 8) = w; }
        { const unsigned px = xor8_u(kr.x), py = xor8_u(kr.y);
          if (j < 8) { const float t1[4] = {lo_bf(kr.x), hi_bf(kr.x), lo_bf(kr.y), hi_bf(kr.y)}, t2[4] = {lo_bf(px), hi_bf(px), lo_bf(py), hi_bf(py)};
              u32x4 w; w.x = cvtpk(t1[0] * cs[0] - t2[0] * sn[0], t1[0] * sn[0] + t2[0] * cs[0]); w.y = cvtpk(t1[1] * cs[1] - t2[1] * sn[1], t1[1] * sn[1] + t2[1] * cs[1]);
              w.z = cvtpk(t1[2] * cs[2] - t2[2] * sn[2], t1[2] * sn[2] + t2[2] * cs[2]); w.w = cvtpk(t1[3] * cs[3] - t2[3] * sn[3], t1[3] * sn[3] + t2[3] * cs[3]);
              *(u32x4*)(KV + (size_t)row * 192 + 128 + 8 * j) = w; } }
    }
}
__device__ __forceinline__ void job_gdn_final(const Params& p, int l, int gw, int ngw, int lane, int wid, LAS unsigned char* lds) {
    bf16_t* PROJ = (bf16_t*)(p.ws + WS_PROJ); const bf16_t* U = (const bf16_t*)(p.ws + WS_U);
    LAS bf16_t* T = (LAS bf16_t*)(lds + wid * 17408);
    for (int it = gw; it < 1024; it += ngw) {
        const int n = it >> 2, h = it & 3; const bf16_t* ut = U + (size_t)it * 8192 + lane * 4;
#pragma unroll 4
        for (int j = 0; j < 32; ++j) { const u32x2 w = *(const u32x2*)(ut + j * 256);
            const int g = j & 3, ct = (j >> 2) & 1, sl = j >> 3, dv = 32 * sl + (lane & 31), c0 = 32 * ct + 8 * g + 4 * (lane >> 5);
            T[(c0 + 0) * 136 + dv] = (bf16_t)(w.x & 0xffffu); T[(c0 + 1) * 136 + dv] = (bf16_t)(w.x >> 16); T[(c0 + 2) * 136 + dv] = (bf16_t)(w.y & 0xffffu); T[(c0 + 3) * 136 + dv] = (bf16_t)(w.y >> 16); }
        LDS_WAIT();
#pragma unroll 2
        for (int i = 0; i < 16; ++i) { const int id = lane + 64 * i, c = id >> 4, dc = id & 15;
            const u32x4 v = *(const LAS u32x4*)(T + c * 136 + dc * 8);
            float x[8] = {lo_bf(v.x), hi_bf(v.x), lo_bf(v.y), hi_bf(v.y), lo_bf(v.z), hi_bf(v.z), lo_bf(v.w), hi_bf(v.w)};
            float ss = 0.f;
#pragma unroll
            for (int e = 0; e < 8; ++e) ss += x[e] * x[e];
            ss = row16_sum(ss);
            const float rs = rsqrtf(ss * (1.f / 128.f) + RMS_EPS);
            const float* gn = p.gdn_norm + l * 128 + dc * 8; const f32x4 g0 = *(const f32x4*)gn, g1 = *(const f32x4*)(gn + 4);
            bf16_t* zp = PROJ + (size_t)(n * 64 + c) * NP + C_Z + 512 + h * 128 + dc * 8; const u32x4 z = *(const u32x4*)zp;
            u32x4 o; o.x = cvtpk(x[0] * rs * g0[0] * silu_f(lo_bf(z.x)), x[1] * rs * g0[1] * silu_f(hi_bf(z.x))); o.y = cvtpk(x[2] * rs * g0[2] * silu_f(lo_bf(z.y)), x[3] * rs * g0[3] * silu_f(hi_bf(z.y)));
            o.z = cvtpk(x[4] * rs * g1[0] * silu_f(lo_bf(z.z)), x[5] * rs * g1[1] * silu_f(hi_bf(z.z))); o.w = cvtpk(x[6] * rs * g1[2] * silu_f(lo_bf(z.w)), x[7] * rs * g1[3] * silu_f(hi_bf(z.w)));
            *(u32x4*)zp = o; }
        LDS_WAIT();
    }
}
namespace gdn {
constexpr int L_QH = 0, L_KH = 17408, L_KBGT = 34816, L_KHDT = 53248, L_VBT = 71680, L_LF = 90112, L_TF = 107520, L_MB = 124928, L_GV = 129280, L_END = 130560;
constexpr int QP = 136, TP = 72, LP = 68;
__device__ __forceinline__ bf16_t* frag_ptr(bf16_t* PROJ, int n, int h, int f, int lane) {
    const int seg = 4 * f + (lane >> 4), part = seg >> 6, row = seg & 63;
    return PROJ + (size_t)(n * 64 + row) * NP + C_BQKV + part * 512 + h * 128 + (lane & 15) * 8;
}
__device__ __forceinline__ bf16x8 pack8f(const LAS float* q) { const f32x4 a = *(const LAS f32x4*)q, b = *(const LAS f32x4*)(q + 4); u32x4 w = {cvtpk(a[0], a[1]), cvtpk(a[2], a[3]), cvtpk(b[0], b[1]), cvtpk(b[2], b[3])}; return __builtin_bit_cast(bf16x8, w); }
__device__ __forceinline__ void prep_item(const Params& p, int l, int n, int h, LAS unsigned char* lds) {
    const int tid = tidx(), lane = tid & 63, r32 = lane & 31, hi = lane >> 5, wid = __builtin_amdgcn_readfirstlane(tid >> 6);
    bf16_t* PROJ = (bf16_t*)(p.ws + WS_PROJ); const bf16_t* HALO = (const bf16_t*)(p.ws + WS_HALO);
    bf16_t* AQKg = (bf16_t*)(p.ws + WS_AQK); bf16_t* Ug = (bf16_t*)(p.ws + WS_U); float* EGL = (float*)(p.ws + WS_MISC + MISC_EGL);
    LAS bf16_t* QH = (LAS bf16_t*)(lds + L_QH); LAS bf16_t* KH = (LAS bf16_t*)(lds + L_KH); LAS bf16_t* KBGT = (LAS bf16_t*)(lds + L_KBGT);
    LAS bf16_t* KHDT = (LAS bf16_t*)(lds + L_KHDT); LAS bf16_t* VBT = (LAS bf16_t*)(lds + L_VBT); LAS float* LF = (LAS float*)(lds + L_LF);
    LAS float* TF = (LAS float*)(lds + L_TF); LAS float* MB = (LAS float*)(lds + L_MB); LAS float* GC = (LAS float*)(lds + L_GV); LAS float* BETA = GC + 64; LAS float* EGC = GC + 128; LAS float* EGD = GC + 192;
    const int t0 = n * 64;
    const int g16 = tid & 15, row0 = tid >> 4;
#define S2_LOAD(part, XA, XB, WA, WB) do { const int cb_ = (part) * 512 + h * 128 + g16 * 8; \
        _Pragma("unroll") for (int j = 0; j < 4; ++j) { const int ta_ = t0 + row0 - 3 + j; XA[j] = (u32x4){0u, 0u, 0u, 0u}; \
            if (ta_ >= t0) XA[j] = *(const u32x4*)(PROJ + (size_t)ta_ * NP + C_BQKV + cb_); else if (n > 0) XA[j] = *(const u32x4*)(HALO + ((size_t)(n - 1) * 3 + (ta_ - (t0 - 3))) * 1536 + cb_); \
            XB[j] = *(const u32x4*)(PROJ + (size_t)(t0 + row0 + 29 + j) * NP + C_BQKV + cb_); \
            const float* cw_ = p.conv_w + ((size_t)l * 4 + j) * 1536 + cb_; WA[j] = *(const f32x4*)cw_; WB[j] = *(const f32x4*)(cw_ + 4); } } while (0)
    u32x4 xa[4], xb[4]; f32x4 wa[4], wb[4];
    S2_LOAD(0, xa, xb, wa, wb);
    __syncthreads();
    if (wid == 0) {
        const bf16_t* pr = PROJ + (size_t)(t0 + lane) * NP;
        const float xa_ = bf2f(pr[C_BA + h]) + p.dt_bias[l * 4 + h], xb_ = bf2f(pr[C_BB + h]);
        const float e = __expf(xa_); const float sp = xa_ > 20.f ? xa_ : (e < 1e-3f ? e * (1.f - e * (0.5f - e * (1.f / 3.f))) : logf(1.f + e));
        float gc = -__expf(p.a_log[l * 4 + h]) * sp;
#pragma unroll
        for (int o = 1; o < 64; o <<= 1) { const float t_ = __int_as_float(__builtin_amdgcn_ds_bpermute((lane - o) << 2, __float_as_int(gc))); if (lane >= o) gc += t_; }
        const float gl = __int_as_float(__builtin_amdgcn_readlane(__float_as_int(gc), 63));
        GC[lane] = gc; BETA[lane] = 1.f / (1.f + __expf(-xb_)); EGC[lane] = __expf(gc); EGD[lane] = __expf(gl - gc);
        if (lane == 0) EGL[n * 4 + h] = __expf(gl);
    }
    __syncthreads();
#define TSW(dk, j) ((dk) * 64 + (((((j) >> 3) ^ (((dk) >> 3) & 7)) << 3) | ((j) & 7)))
#define S2_ITEM(part, X, W0, W1, row) do { float a[8] = {0.f, 0.f, 0.f, 0.f, 0.f, 0.f, 0.f, 0.f}; \
        _Pragma("unroll") for (int j = 0; j < 4; ++j) { a[0] = fmaf(W0[j][0], lo_bf(X[j].x), a[0]); a[1] = fmaf(W0[j][1], hi_bf(X[j].x), a[1]); a[2] = fmaf(W0[j][2], lo_bf(X[j].y), a[2]); a[3] = fmaf(W0[j][3], hi_bf(X[j].y), a[3]); \
            a[4] = fmaf(W1[j][0], lo_bf(X[j].z), a[4]); a[5] = fmaf(W1[j][1], hi_bf(X[j].z), a[5]); a[6] = fmaf(W1[j][2], lo_bf(X[j].w), a[6]); a[7] = fmaf(W1[j][3], hi_bf(X[j].w), a[7]); } \
        float ss = 0.f; _Pragma("unroll") for (int e = 0; e < 8; ++e) { a[e] = silu_f(a[e]); ss += a[e] * a[e]; } \
        ss = row16_sum(ss); const float rn = rsqrtf(ss + 1e-6f); \
        if ((part) == 0) { const float sc = rn * 0.08838834764831845f; _Pragma("unroll") for (int e = 0; e < 8; ++e) a[e] *= sc; *(LAS bf16x8*)(QH + (row) * QP + g16 * 8) = pack8(a); } \
        else if ((part) == 1) { _Pragma("unroll") for (int e = 0; e < 8; ++e) a[e] *= rn; *(LAS bf16x8*)(KH + (row) * QP + g16 * 8) = pack8(a); const float s1 = BETA[row] * EGC[row], s2 = EGD[row]; \
            _Pragma("unroll") for (int e = 0; e < 8; ++e) { KBGT[TSW(g16 * 8 + e, row)] = f2bf(a[e] * s1); KHDT[TSW(g16 * 8 + e, row)] = f2bf(a[e] * s2); } } \
        else { const float b = BETA[row]; _Pragma("unroll") for (int e = 0; e < 8; ++e) VBT[TSW(g16 * 8 + e, row)] = f2bf(a[e] * b); } } while (0)
#ifdef EXP_DUPS2
#pragma unroll 1
    for (int rep_ = 0; rep_ < 2; ++rep_)
#endif
    { u32x4 ya[4], yb[4]; f32x4 va[4], vb[4];
      S2_LOAD(1, ya, yb, va, vb);
      S2_ITEM(0, xa, wa, wb, row0); S2_ITEM(0, xb, wa, wb, row0 + 32);
      S2_LOAD(2, xa, xb, wa, wb);
      S2_ITEM(1, ya, va, vb, row0); S2_ITEM(1, yb, va, vb, row0 + 32);
      S2_ITEM(2, xa, wa, wb, row0); S2_ITEM(2, xb, wa, wb, row0 + 32); }
#undef S2_LOAD
#undef S2_ITEM
    __syncthreads();
    if (wid < 3) { const int it = wid > 0, jt = wid > 1; f32x16 acc = {};
#pragma unroll
        for (int ks = 0; ks < 8; ++ks) { const bf16x8 a = *(const LAS bf16x8*)(KH + (32 * it + r32) * QP + 16 * ks + 8 * hi), b = *(const LAS bf16x8*)(KH + (32 * jt + r32) * QP + 16 * ks + 8 * hi);
            acc = MFMA32(a, b, acc); }
        const int j = 32 * jt + r32; const float gj = GC[j];
#pragma unroll
        for (int r = 0; r < 16; ++r) { const int i = 32 * it + crow(r, hi); LF[i * LP + j] = i > j ? BETA[i] * __expf(GC[i] - gj) * acc[r] : 0.f; }
    } else if (wid < 6) { const int w = wid - 3, ctp = w > 1, ct = w > 0; f32x16 acc = {};
#pragma unroll
        for (int ks = 0; ks < 8; ++ks) { const bf16x8 a = *(const LAS bf16x8*)(KH + (32 * ctp + r32) * QP + 16 * ks + 8 * hi), b = *(const LAS bf16x8*)(QH + (32 * ct + r32) * QP + 16 * ks + 8 * hi);
            acc = MFMA32(a, b, acc); }
        const int c = 32 * ct + r32; const float gcq = GC[c];
#pragma unroll
        for (int r = 0; r < 16; ++r) { const int cp = 32 * ctp + crow(r, hi); acc[r] = c >= cp ? acc[r] * __expf(gcq - GC[cp]) : 0.f; }
        bf16_t* dst = AQKg + (((size_t)(n * 4 + h) * 8 + (ct * 2 + ctp) * 2) * 64 + lane) * 8;
        *(bf16x8*)dst = pack_step(acc, 0); *(bf16x8*)(dst + 512) = pack_step(acc, 1);
    } else { const int w = wid - 6;
        if (w == 0) { const bf16x8 z = {0, 0, 0, 0, 0, 0, 0, 0}; bf16_t* dst = AQKg + (((size_t)(n * 4 + h) * 8 + 2) * 64 + lane) * 8; *(bf16x8*)dst = z; *(bf16x8*)(dst + 512) = z; }
#pragma unroll
        for (int ff = 0; ff < 8; ++ff) { const int f = w * 8 + ff, s = f & 1, mt = (f >> 1) & 3, ct = f >> 3, c = 32 * ct + r32, d0 = 32 * mt + 16 * s + 4 * hi; const float eg = EGC[c];
            const u32x2 lo = *(const LAS u32x2*)(QH + c * QP + d0), hw = *(const LAS u32x2*)(QH + c * QP + d0 + 8);
            u32x4 o; o.x = cvtpk(lo_bf(lo.x) * eg, hi_bf(lo.x) * eg); o.y = cvtpk(lo_bf(lo.y) * eg, hi_bf(lo.y) * eg); o.z = cvtpk(lo_bf(hw.x) * eg, hi_bf(hw.x) * eg); o.w = cvtpk(lo_bf(hw.y) * eg, hi_bf(hw.y) * eg);
            *(u32x4*)frag_ptr(PROJ, n, h, 16 + f, lane) = o; }
    }
    __syncthreads();
    if (wid == 0) {
#ifdef EXP_DUPS4
#pragma unroll 1
      for (int rep_ = 0; rep_ < 2; ++rep_)
#endif
      {
        unsigned lfb = (unsigned)(uintptr_t)LF, tfb = (unsigned)(uintptr_t)TF, mbb = (unsigned)(uintptr_t)MB; asm volatile("" : "+v"(lfb), "+v"(tfb), "+v"(mbb));
        const LAS float* LFv = (const LAS float*)(uintptr_t)lfb; LAS float* TFv = (LAS float*)(uintptr_t)tfb; LAS float* MBv = (LAS float*)(uintptr_t)mbb;
        { const int b = lane >> 4, c = lane & 15; const LAS float* Lb = LFv + (16 * b) * LP + 16 * b; LAS float* Tb = TFv + (16 * b) * LP + 16 * b + c; float t[16];
#pragma unroll
          for (int i = 0; i < 16; ++i) { float a0 = (c == i) ? 1.f : 0.f, a1 = 0.f;
#pragma unroll
              for (int q = 0; 4 * q < i; ++q) { const f32x4 lv = *(const LAS f32x4*)(Lb + i * LP + 4 * q);
#pragma unroll
                  for (int e = 0; e < 4; ++e) if (4 * q + e < i) { if (e & 1) a1 = fmaf(-lv[e], t[4 * q + e], a1); else a0 = fmaf(-lv[e], t[4 * q + e], a0); } }
              t[i] = a0 + a1; Tb[i * LP] = t[i]; } }
        const int r16 = lane & 15, k4 = lane >> 4;
#define BLK(P, b_, a_) ((P) + (16 * (b_)) * LP + 16 * (a_))
#define MM16(acc, X, Y) do { _Pragma("unroll") for (int ks = 0; ks < 4; ++ks) acc = __builtin_amdgcn_mfma_f32_16x16x4f32((X)[r16 * LP + 4 * ks + k4], (Y)[(4 * ks + k4) * LP + r16], acc, 0, 0, 0); } while (0)
#define ST16(Z, acc, sg) do { _Pragma("unroll") for (int r = 0; r < 4; ++r) (Z)[(4 * k4 + r) * LP + r16] = (sg) * acc[r]; } while (0)
#define TBLK(b_, a_, SUM) do { f32x4 m_ = {0.f, 0.f, 0.f, 0.f}; SUM; ST16(MBv, m_, 1.f); f32x4 t_ = {0.f, 0.f, 0.f, 0.f}; MM16(t_, BLK(TFv, b_, b_), MBv); ST16(BLK(TFv, b_, a_), t_, -1.f); } while (0)
        TBLK(1, 0, MM16(m_, BLK(LFv, 1, 0), BLK(TFv, 0, 0)));
        TBLK(2, 1, MM16(m_, BLK(LFv, 2, 1), BLK(TFv, 1, 1)));
        TBLK(3, 2, MM16(m_, BLK(LFv, 3, 2), BLK(TFv, 2, 2)));
        TBLK(2, 0, MM16(m_, BLK(LFv, 2, 0), BLK(TFv, 0, 0)); MM16(m_, BLK(LFv, 2, 1), BLK(TFv, 1, 0)));
        TBLK(3, 1, MM16(m_, BLK(LFv, 3, 1), BLK(TFv, 1, 1)); MM16(m_, BLK(LFv, 3, 2), BLK(TFv, 2, 1)));
        TBLK(3, 0, MM16(m_, BLK(LFv, 3, 0), BLK(TFv, 0, 0)); MM16(m_, BLK(LFv, 3, 1), BLK(TFv, 1, 0)); MM16(m_, BLK(LFv, 3, 2), BLK(TFv, 2, 0)));
#undef BLK
#undef MM16
#undef ST16
#undef TBLK
      }
    } else {
        if (wid == 1) {
#pragma unroll
            for (int i = 0; i < 24; ++i) { const int id = lane + 64 * i, blk = id >> 8, rr = (id >> 4) & 15, cc = id & 15;
                const int b = blk < 3 ? 0 : (blk < 5 ? 1 : 2), a = blk < 3 ? blk + 1 : (blk < 5 ? blk - 1 : 3);
                TF[(16 * b + rr) * LP + 16 * a + cc] = 0.f; }
        }
        for (int f = wid - 1; f < 16; f += 7) { const int s = f & 1, ctp = (f >> 1) & 1, mt = f >> 2, dk = 32 * mt + r32, c0 = 32 * ctp + 16 * s + 4 * hi;
            const u32x2 lo = *(const LAS u32x2*)(KHDT + TSW(dk, c0)), hw = *(const LAS u32x2*)(KHDT + TSW(dk, c0 + 8));
            u32x4 o = {lo.x, lo.y, hw.x, hw.y}; *(u32x4*)frag_ptr(PROJ, n, h, 32 + f, lane) = o; }
    }
    __syncthreads();
    { const int mt = wid >> 1, ct = wid & 1; f32x16 acc = {};
#pragma unroll
      for (int ks = 0; ks < 4; ++ks) { const bf16x8 a = *(const LAS bf16x8*)(KBGT + TSW(32 * mt + r32, 16 * ks + 8 * hi)), b = pack8f(TF + (32 * ct + r32) * LP + 16 * ks + 8 * hi);
          acc = MFMA32(a, b, acc); }
#pragma unroll
      for (int r = 0; r < 16; ++r) acc[r] = -acc[r];
      *(bf16x8*)frag_ptr(PROJ, n, h, (ct * 4 + mt) * 2, lane) = pack_step(acc, 0); *(bf16x8*)frag_ptr(PROJ, n, h, (ct * 4 + mt) * 2 + 1, lane) = pack_step(acc, 1); }
    { const int ct = wid >> 2, dt = wid & 3; f32x16 acc = {};
#pragma unroll
      for (int ks = 0; ks < 4; ++ks) { const bf16x8 a = pack8f(TF + (32 * ct + r32) * LP + 16 * ks + 8 * hi), b = *(const LAS bf16x8*)(VBT + TSW(32 * dt + r32, 16 * ks + 8 * hi));
          acc = MFMA32(a, b, acc); }
      bf16_t* up = Ug + (size_t)(n * 4 + h) * 8192 + (size_t)((dt * 2 + ct) * 4) * 256 + lane * 4;
#pragma unroll
      for (int g = 0; g < 4; ++g) { u32x2 w; w.x = cvtpk(acc[4 * g], acc[4 * g + 1]); w.y = cvtpk(acc[4 * g + 2], acc[4 * g + 3]); *(u32x2*)(up + g * 256) = w; } }
}
constexpr int SCAN_STAGE = 65536, SCAN_U = 57344, SCAN_EGL = 131072, SCAN_NP = 16;
__device__ __forceinline__ const u32x4* scan_src(const bf16_t* PROJ, const bf16_t* AQKg, const bf16_t* Ug, int n, int h, int half, int k, int ll) {
    if (k < 12) { const int piece = k * 256 + ll; return (const u32x4*)frag_ptr((bf16_t*)PROJ, n, h, piece >> 6, piece & 63); }
    if (k < 14) return (const u32x4*)(AQKg + ((size_t)(n * 4 + h) * 512 + (k - 12) * 256 + ll) * 8);
    return (const u32x4*)(Ug + (size_t)(n * 4 + h) * 8192 + half * 4096 + (size_t)((k - 14) * 256 + ll) * 8);
}
constexpr int SCAN_XCH = 131584, SCAN_XCH_SLICE = 12288;
template <int ROLE>
__device__ __forceinline__ void scan_compute(LAS unsigned char* lds, bf16_t* ub  , int sp, int lane) {
    constexpr int NCH = S / 64;
    LAS unsigned char* xs = lds + SCAN_XCH + sp * SCAN_XCH_SLICE + lane * 16;
    LAS unsigned char* xv = xs + 8192;
    f32x16 St[2] = {};
    bf16x8 Sb[4][2];
#pragma unroll
    for (int mt = 0; mt < 4; ++mt) { Sb[mt][0] = (bf16x8){0, 0, 0, 0, 0, 0, 0, 0}; Sb[mt][1] = Sb[mt][0]; }
    __syncthreads();
#ifdef EXP_SCANSEC
    unsigned long long acc_s[4] = {0, 0, 0, 0}, tm_ = __builtin_amdgcn_s_memrealtime();
#define SEC(i) do { const unsigned long long t_ = __builtin_amdgcn_s_memrealtime(); acc_s[i] += t_ - tm_; tm_ = t_; } while (0)
#else
#define SEC(i)
#endif
#pragma unroll 1
    for (int n = 0; n < NCH; ++n) {
        const LAS unsigned char* stg = lds + (n & 1) * SCAN_STAGE + lane * 16;
        const LAS unsigned char* us = lds + (n & 1) * SCAN_STAGE + SCAN_U + (sp * 8 + ROLE * 4) * 512 + lane * 8;
        const float egl = *(const LAS float*)(lds + SCAN_EGL + (n & 1) * 4);
        f32x16 vn, o = {};
#pragma unroll
        for (int g = 0; g < 4; ++g) { const u32x2 w = *(const LAS u32x2*)(us + g * 512); vn[4 * g] = lo_bf(w.x); vn[4 * g + 1] = hi_bf(w.x); vn[4 * g + 2] = lo_bf(w.y); vn[4 * g + 3] = hi_bf(w.y); }
        if (n > 0) {
#pragma unroll
            for (int j = 0; j < 2; ++j) { Sb[2 * (1 - ROLE) + j][0] = *(const LAS bf16x8*)(xs + ((2 * (1 - ROLE) + j) * 2) * 1024); Sb[2 * (1 - ROLE) + j][1] = *(const LAS bf16x8*)(xs + ((2 * (1 - ROLE) + j) * 2 + 1) * 1024); }
        }
#define FR(f) (*(const LAS bf16x8*)(stg + (f) * 1024))
#define RD1(B, mt) do { const int f_ = (ROLE * 4 + (mt)) * 2; B[0] = FR(f_); B[1] = FR(f_ + 1); B[2] = FR(16 + f_); B[3] = FR(16 + f_ + 1); } while (0)
#define MM1(B, mt) do { vn = MFMA32(B[0], Sb[mt][0], vn); o = MFMA32(B[2], Sb[mt][0], o); vn = MFMA32(B[1], Sb[mt][1], vn); o = MFMA32(B[3], Sb[mt][1], o); } while (0)
        bf16x8 fa[4], fb[4];
        RD1(fa, 0); RD1(fb, 1); SBAR();
        MM1(fa, 0); SBAR(); RD1(fa, 2); SBAR();
        MM1(fb, 1); SBAR(); RD1(fb, 3); SBAR();
        MM1(fa, 2); SBAR();
        bf16x8 kd[2][4];
#pragma unroll
        for (int j = 0; j < 2; ++j)
#pragma unroll
            for (int q = 0; q < 4; ++q) kd[j][q] = FR(32 + ((2 * ROLE + j) * 2) * 2 + q);
        SBAR(); MM1(fb, 3); SBAR();
#pragma unroll
        for (int j = 0; j < 2; ++j)
#pragma unroll
            for (int r = 0; r < 16; ++r) St[j][r] *= egl;
        bf16x8 Vb[2][2];
        Vb[ROLE][0] = pack_step(vn, 0); Vb[ROLE][1] = pack_step(vn, 1);
        *(LAS bf16x8*)(xv + (ROLE * 2) * 1024) = Vb[ROLE][0]; *(LAS bf16x8*)(xv + (ROLE * 2 + 1) * 1024) = Vb[ROLE][1];
        bf16x8 aq[4];
        if (ROLE == 0) { aq[0] = FR(48); aq[1] = FR(49); } else { aq[0] = FR(52); aq[1] = FR(53); aq[2] = FR(54); aq[3] = FR(55); }
        SEC(0);
        __syncthreads();
        SEC(1);
        Vb[1 - ROLE][0] = *(const LAS bf16x8*)(xv + ((1 - ROLE) * 2) * 1024); Vb[1 - ROLE][1] = *(const LAS bf16x8*)(xv + ((1 - ROLE) * 2 + 1) * 1024);
#pragma unroll
        for (int ctp = 0; ctp < 2; ++ctp)
#pragma unroll
            for (int s = 0; s < 2; ++s) {
                St[0] = MFMA32(kd[0][ctp * 2 + s], Vb[ctp][s], St[0]); St[1] = MFMA32(kd[1][ctp * 2 + s], Vb[ctp][s], St[1]);
                if (ROLE == 1) o = MFMA32(aq[ctp * 2 + s], Vb[ctp][s], o); else if (ctp == 0) o = MFMA32(aq[s], Vb[0][s], o);
            }
        { bf16_t* uc = ub + (size_t)n * (4 * 8192);
#pragma unroll
          for (int g = 0; g < 4; ++g) { u32x2 w; w.x = cvtpk(o[4 * g], o[4 * g + 1]); w.y = cvtpk(o[4 * g + 2], o[4 * g + 3]); *(u32x2*)(uc + g * 256) = w; } }
#pragma unroll
        for (int j = 0; j < 2; ++j) { Sb[2 * ROLE + j][0] = pack_step(St[j], 0); Sb[2 * ROLE + j][1] = pack_step(St[j], 1);
            *(LAS bf16x8*)(xs + ((2 * ROLE + j) * 2) * 1024) = Sb[2 * ROLE + j][0]; *(LAS bf16x8*)(xs + ((2 * ROLE + j) * 2 + 1) * 1024) = Sb[2 * ROLE + j][1]; }
#undef FR
#undef RD1
#undef MM1
        SEC(2);
        __syncthreads();
        SEC(3);
    }
#ifdef EXP_SCANSEC
    { const unsigned long long t1_ = __builtin_amdgcn_s_memrealtime(); while (__builtin_amdgcn_s_memrealtime() - t1_ < 4 * acc_s[EXP_SCANSEC]) __builtin_amdgcn_s_sleep(8); }
#endif
#undef SEC
}
__device__ __forceinline__ void scan_wg(const Params& p, int h, int half, LAS unsigned char* lds) {
    const int tid = tidx(), lane = tid & 63, wid = __builtin_amdgcn_readfirstlane(tid >> 6);
    const bf16_t* PROJ = (const bf16_t*)(p.ws + WS_PROJ); const bf16_t* AQKg = (const bf16_t*)(p.ws + WS_AQK); bf16_t* Ug = (bf16_t*)(p.ws + WS_U); const float* EGL = (const float*)(p.ws + WS_MISC + MISC_EGL);
    constexpr int NCH = S / 64;
    __syncthreads();
    if (wid >= 4) {
        const int ll = tid - 256; u32x4 sa[SCAN_NP], sb[SCAN_NP]; float ea, eb;
        const char* pf0 = (const char*)(PROJ + (size_t)(ll >> 4) * NP + C_BQKV + h * 128 + (ll & 15) * 8); const char* pa0 = (const char*)(AQKg + ((size_t)h * 512 + ll) * 8); const char* pu0 = (const char*)(Ug + (size_t)h * 8192 + half * 4096 + (size_t)ll * 8);
#define LD_H0(R, n_) do { const char* pf_ = pf0 + (size_t)(n_) * (64 * NP * 2); SBAR(); _Pragma("unroll") for (int k = 0; k < 8; ++k) R[k] = *(const u32x4*)(pf_ + (size_t)(k & 3) * (16 * NP * 2) + (k >> 2) * 1024); SBAR(); } while (0)
#define LD_H1(R, E, n_) do { E = EGL[(n_) * 4 + h]; const char* pf_ = pf0 + (size_t)(n_) * (64 * NP * 2); const char* pa_ = pa0 + (size_t)(n_) * (4 * 512 * 16); const char* pu_ = pu0 + (size_t)(n_) * (4 * 8192 * 2); SBAR(); \
        _Pragma("unroll") for (int k = 8; k < 12; ++k) R[k] = *(const u32x4*)(pf_ + (size_t)(k & 3) * (16 * NP * 2) + (k >> 2) * 1024); SBAR(); \
        R[12] = *(const u32x4*)pa_; R[13] = *(const u32x4*)(pa_ + 4096); R[14] = *(const u32x4*)pu_; R[15] = *(const u32x4*)(pu_ + 4096); SBAR(); } while (0)
#define WR_H0(R, n_) do { _Pragma("unroll") for (int k = 0; k < 8; ++k) *(LAS u32x4*)(lds + ((n_) & 1) * SCAN_STAGE + (k * 256 + ll) * 16) = R[k]; } while (0)
#define WR_H1(R, E, n_) do { *(LAS float*)(lds + SCAN_EGL + ((n_) & 1) * 4) = E; _Pragma("unroll") for (int k = 8; k < SCAN_NP; ++k) *(LAS u32x4*)(lds + ((n_) & 1) * SCAN_STAGE + (k * 256 + ll) * 16) = R[k]; } while (0)
#define LSTEP(R, E, n_) do { WR_H0(R, (n_) + 1); if ((n_) + 3 < NCH) LD_H0(R, (n_) + 3); __syncthreads(); WR_H1(R, E, (n_) + 1); if ((n_) + 3 < NCH) LD_H1(R, E, (n_) + 3); __syncthreads(); } while (0)
        LD_H0(sa, 0); LD_H1(sa, ea, 0); WR_H0(sa, 0); WR_H1(sa, ea, 0); LD_H0(sa, 1); LD_H1(sa, ea, 1); LD_H0(sb, 2); LD_H1(sb, eb, 2);
        __syncthreads();
#pragma unroll 1
        for (int n = 0; n < NCH - 2; n += 2) { LSTEP(sa, ea, n); LSTEP(sb, eb, n + 1); }
        WR_H0(sa, NCH - 1); __syncthreads(); WR_H1(sa, ea, NCH - 1); __syncthreads();
        __syncthreads(); __syncthreads();
#undef LSTEP
#undef LD_H0
#undef LD_H1
#undef WR_H0
#undef WR_H1
    } else {
        const int sp = wid >> 1, role = wid & 1, sl = 2 * half + sp;
        bf16_t* ub = Ug + (size_t)h * 8192 + (size_t)(sl * 8 + role * 4) * 256 + lane * 4;
        if (role == 0) scan_compute<0>(lds, ub, sp, lane); else scan_compute<1>(lds, ub, sp, lane);
    }
}
}
typedef __attribute__((address_space(1))) unsigned gu32;
#define XB_TMO      128
#define XB_XCNT(j)  (256  + 64 * (j))
#define XB_XSUB(j)  (1280 + 64 * (j))
#define XB_XGEN(j)  (2304 + 64 * (j))
#define XB_TOP      3328
#define XB_TOPGEN   3392
#define XCD_BAR_WORDS 3456
#define XB_SPIN_CAP (1u << 18)

__device__ __forceinline__ unsigned xb_ld(unsigned* p)              { return __hip_atomic_load(p, __ATOMIC_RELAXED, __HIP_MEMORY_SCOPE_AGENT); }
__device__ __forceinline__ unsigned xb_add(unsigned* p, unsigned v) { return __hip_atomic_fetch_add(p, v, __ATOMIC_RELAXED, __HIP_MEMORY_SCOPE_AGENT); }
__device__ __forceinline__ unsigned xb_xcc_id() { return (unsigned)__builtin_amdgcn_s_getreg((3 << 11) | 20) & 0xFu; }
#define XB_SPIN(cond, bar) do { unsigned _sp = 0; while (cond) { __builtin_amdgcn_s_sleep(1); \
    if ((++_sp & 255u) == 0u) { if (xb_ld(&(bar)[XB_TMO])) break; if (_sp > XB_SPIN_CAP) { atomicAdd(&(bar)[XB_TMO], 1u); break; } } } } while (0)

struct XcdBarrier {
    unsigned* bar; unsigned x;
    volatile LAS unsigned* st;
};

__device__ __forceinline__ XcdBarrier xcd_barrier_post(unsigned* bar, volatile LAS unsigned* st) {
    XcdBarrier b; b.bar = bar; b.x = xb_xcc_id(); b.st = st;
    if (tidx() == 0) (void)xb_add(&bar[XB_XCNT(b.x)], 1u);
    return b;
}
__device__ __forceinline__ void xcd_barrier_complete(unsigned* bar, unsigned x, unsigned& nloc, unsigned& nx) {
    const unsigned G = gridDim.x * gridDim.y * gridDim.z;
    unsigned sum, cnt, mine, sp = 0u;
    for (;;) {
        sum = 0u; cnt = 0u; mine = 0u;
#pragma unroll
        for (unsigned j = 0; j < 16; ++j) { const unsigned c = xb_ld(&bar[XB_XCNT(j)]); sum += c; cnt += (c > 0u) ? 1u : 0u; mine = (j == x) ? c : mine; }
        if (sum == G) break;
        __builtin_amdgcn_s_sleep(1);
        if ((++sp & 255u) == 0u) { if (xb_ld(&bar[XB_TMO])) break; if (sp > XB_SPIN_CAP) { atomicAdd(&bar[XB_TMO], 1u); break; } }
    }
    nloc = mine > 0u ? mine : 1u; nx = cnt > 0u ? cnt : 1u;
}

__device__ __forceinline__ void xcd_barrier(const XcdBarrier& b) {
    asm volatile("s_waitcnt vmcnt(0)" ::: "memory");
    __syncthreads();
    if (tidx() == 0) {
        unsigned* bar = b.bar;
        __builtin_amdgcn_s_waitcnt(0);
        unsigned nloc = b.st[0], nx = b.st[1];
        if (nloc == 0u) { xcd_barrier_complete(bar, b.x, nloc, nx); b.st[0] = nloc; b.st[1] = nx; }
        const unsigned old = xb_add(&bar[XB_XSUB(b.x)], 1u);
        const unsigned gen = old / nloc;
        if (old + 1u == (gen + 1u) * nloc) {
            __builtin_amdgcn_fence(__ATOMIC_RELEASE, "agent");
            asm volatile("s_waitcnt vmcnt(0)" ::: "memory");
            const unsigned og = xb_add(&bar[XB_TOP], 1u);
            const unsigned tg = og / nx;
            if (og + 1u == (tg + 1u) * nx) xb_add(&bar[XB_TOPGEN], 1u);
            else XB_SPIN(xb_ld(&bar[XB_TOPGEN]) == tg, bar);
            __builtin_amdgcn_fence(__ATOMIC_ACQUIRE, "agent");
            xb_add(&bar[XB_XGEN(b.x)], 1u);
            asm volatile("s_waitcnt vmcnt(0)" ::: "memory");
        } else {
            XB_SPIN(xb_ld(&bar[XB_XGEN(b.x)]) == gen, bar);
            __builtin_amdgcn_fence(__ATOMIC_ACQUIRE, "agent");
            asm volatile("s_waitcnt vmcnt(0)" ::: "memory");
        }
    }
    __syncthreads();
}


constexpr int N_PHASES = 2 + 7 * DEPTH;
constexpr int SCAN_WGS = 8;
constexpr float QSCALE = 0.07216878364870322f * LOG2E;

__device__ __forceinline__ void sub_barrier(unsigned* ctr, unsigned expected, bool arrive) {
    asm volatile("s_waitcnt vmcnt(0)" ::: "memory"); __syncthreads();
    if (tidx() == 0) {
        if (arrive) { __builtin_amdgcn_fence(__ATOMIC_RELEASE, "agent"); asm volatile("s_waitcnt vmcnt(0)" ::: "memory"); (void)__hip_atomic_fetch_add(ctr, 1u, __ATOMIC_RELAXED, __HIP_MEMORY_SCOPE_AGENT); }
        unsigned sp = 0; while (__hip_atomic_load(ctr, __ATOMIC_RELAXED, __HIP_MEMORY_SCOPE_AGENT) < expected) { __builtin_amdgcn_s_sleep(2); if (++sp > (1u << 22)) break; }
        __builtin_amdgcn_fence(__ATOMIC_ACQUIRE, "agent"); asm volatile("s_waitcnt vmcnt(0)" ::: "memory");
    }
    __syncthreads();
}
__device__ __forceinline__ void sub_arrive(unsigned* ctr) {
    asm volatile("s_waitcnt vmcnt(0)" ::: "memory"); __syncthreads();
    if (tidx() == 0) { __builtin_amdgcn_fence(__ATOMIC_RELEASE, "agent"); asm volatile("s_waitcnt vmcnt(0)" ::: "memory"); (void)__hip_atomic_fetch_add(ctr, 1u, __ATOMIC_RELAXED, __HIP_MEMORY_SCOPE_AGENT); }
}
template <int KIND> __device__ __forceinline__ void run_kind(const Params& p_, int l, LAS unsigned char* lds) {
    Params p = p_;
    { unsigned long long w_ = (unsigned long long)p.ws; asm volatile("" : "+s"(w_)); p.ws = (unsigned char*)(__attribute__((address_space(1))) unsigned char*)w_; }
    const int tid = tidx(), lane = tid & 63, wid = __builtin_amdgcn_readfirstlane(tid >> 6);
    const int bid = bidx(), nblk = gridDim.x, gw = bid * 8 + wid, ngw = nblk * 8, gtid = bid * NT_THREADS + tid, gn = nblk * NT_THREADS;
    bf16_t* PROJ = (bf16_t*)(p.ws + WS_PROJ);
    if constexpr (KIND == 0) {
        job_win(p, 0, gw, ngw, lds, wid, lane); job_wout(p, 0, gw, ngw, lds, wid, lane); job_wmem(p, gw, ngw, lds, wid, lane);
        job_wq(p, bid, nblk, gtid, gn, lds); job_wuv(p, gtid, gn); job_rope(p, gtid, gn); job_btab(p, gtid, gn); job_memn(p, gw, ngw, lane);
        job_norm_rows(p, 0, gw, ngw, lane);
    } else if constexpr (KIND == 2) {
        { pg8::Gemm g{(const bf16_t*)(p.ws + WS_H), (const bf16_t*)(p.ws + WS_WIN), S, NP, DM, DM};
          pg8::StaticOrder so; so.init(S, NP, nblk, bid);
          pg8::EpiStore E{PROJ, NP, (bf16_t*)(p.ws + WS_HALO)};
          pg8::gemm_phase<pg8::EpiStore, pg8::StaticOrder, true, true>(lds, g, so, E); }
        if (l == 0) {
            for (int ll = 0; ll < 2; ++ll) {
                pg8::Gemm g{(const bf16_t*)(p.ws + WS_MEMN) + (size_t)ll * MEML * DM, (const bf16_t*)(p.ws + WS_WMEM) + (size_t)ll * DM * DM, MEML, DM, DM, DM};
                pg8::StaticOrder so; so.init(MEML, DM, nblk, (bid + 8 - 4 * ll) % nblk);
                pg8::EpiStore E{(bf16_t*)(p.ws + WS_MEMKV) + (size_t)ll * MEML * DM, DM, nullptr};
                pg8::gemm_phase<pg8::EpiStore, pg8::StaticOrder, true, true>(lds, g, so, E);
            }
        }
    } else if constexpr (KIND == 3) {
        for (int it = bid; it < 1024; it += nblk) gdn::prep_item(p, l, it >> 2, it & 3, lds);
    } else if constexpr (KIND == 5) {
        unsigned* rdy = (unsigned*)(p.ws + WS_CTL) + 64 * (9 + l);
        const bool is_scan = (bid & ~8) < 4;
#ifdef EXP_SPINSCAN
        if (is_scan) { const unsigned long long t0_ = __builtin_amdgcn_s_memrealtime(); gdn::scan_wg(p, bid & 3, bid >> 3, lds); const unsigned long long t1_ = __builtin_amdgcn_s_memrealtime();
            while (__builtin_amdgcn_s_memrealtime() - t1_ < 4 * (t1_ - t0_)) __builtin_amdgcn_s_sleep(8); }
#else
        if (is_scan) gdn::scan_wg(p, bid & 3, bid >> 3, lds);
#endif
        else { const int vb = bid < 8 ? bid - 4 : bid - 8, nb = nblk - SCAN_WGS;
#ifdef EXP_SPINPART
            unsigned long long tp_ = __builtin_amdgcn_s_memrealtime();
#endif
#ifdef EXP_SPINPRE
            const unsigned long long t0_ = __builtin_amdgcn_s_memrealtime();
#endif
            { pg8::Gemm g{PROJ + C_CQ, (const bf16_t*)(p.ws + WS_WQ) + (size_t)l * 768 * 256, S, 768, 256, NP};
              pg8::StaticOrder so; so.init(S, 768, nb, vb);
              pg8::EpiStore E{(bf16_t*)(p.ws + WS_QABS), 768, nullptr};
              pg8::gemm_phase<pg8::EpiStore, pg8::StaticOrder, true, true>(lds, g, so, E); }
#ifdef EXP_SPINPART
#define SPART(i) { __syncthreads(); const unsigned long long tn_ = __builtin_amdgcn_s_memrealtime(); if (EXP_SPINPART == (i)) { while (__builtin_amdgcn_s_memrealtime() - tn_ < 4 * (tn_ - tp_)) __builtin_amdgcn_s_sleep(8); } tp_ = __builtin_amdgcn_s_memrealtime(); }
#else
#define SPART(i)
#endif
            SPART(1)
            job_mla_rows(p, l, vb * 8 + wid, nb * 8, lane);
            sub_arrive(rdy);
            SPART(2)
            att::run_mixers(lds, (unsigned*)(p.ws + WS_CTL) + 64 * (11 + l), PROJ, p.pos, p.sinks + l * 8, (const float*)(p.ws + WS_MISC + MISC_BTAB), (const bf16_t*)(p.ws + WS_MEMKV) + (size_t)l * MEML * DM);
            __syncthreads();
            SPART(3)

#ifdef EXP_SPINPRE
            { const unsigned long long t1_ = __builtin_amdgcn_s_memrealtime(); while (__builtin_amdgcn_s_memrealtime() - t1_ < 4 * (t1_ - t0_)) __builtin_amdgcn_s_sleep(8); }
#endif
        }
        sub_barrier(rdy, (unsigned)(nblk - SCAN_WGS), false);
#ifdef EXP_SPINMLA
        const unsigned long long tq0_ = __builtin_amdgcn_s_memrealtime();
#endif
        mla::run_queue(lds, (unsigned*)(p.ws + WS_CTL) + 64 * (1 + l), (const bf16_t*)(p.ws + WS_QABS), (const bf16_t*)(p.ws + WS_KVLAT), PROJ, (const bf16_t*)(p.ws + WS_WUV) + (size_t)l * 512 * 512, (const float*)(p.ws + WS_MISC + MISC_RSQ), (const float*)(p.ws + WS_COS), (const float*)(p.ws + WS_SIN), QSCALE);
        if (l == 0) { __syncthreads(); const int t2_ = tidx(), w2_ = __builtin_amdgcn_readfirstlane(t2_ >> 6); job_win(p, 1, bidx() * 8 + w2_, (int)gridDim.x * 8, lds, w2_, t2_ & 63); }
#ifdef EXP_SPINMLA
        if (!is_scan) { const unsigned long long tq1_ = __builtin_amdgcn_s_memrealtime(); while (__builtin_amdgcn_s_memrealtime() - tq1_ < 4 * (tq1_ - tq0_)) __builtin_amdgcn_s_sleep(8); }
#endif
    } else if constexpr (KIND == 6) {
        job_gdn_final(p, l, gw, ngw, lane, wid, lds);
    } else if constexpr (KIND == 7) {
        pg8::Gemm g{PROJ + C_Z, (const bf16_t*)(p.ws + WS_WOUT), S, DM, MIXW, NP};
        pg8::StaticOrder so; so.init(S, DM, nblk, bid);
        pg8::EpiStore E{(bf16_t*)(p.ws + WS_Y), DM, nullptr};
        pg8::gemm_phase<pg8::EpiStore, pg8::StaticOrder, true, true>(lds, g, so, E);
    } else {
        job_norm_rows(p, l == 0 ? 1 : 2, gw, ngw, lane);
        if (l == 0) job_wout(p, 1, gw, ngw, lds, wid, lane);
    }
}
template <int KIND> __global__ void __launch_bounds__(NT_THREADS, 2) mk_kind(Params p, int l) {
    extern __shared__ __attribute__((aligned(16))) unsigned char lds_raw[];
    run_kind<KIND>(p, l, (LAS unsigned char*)lds_raw);
}

#ifndef MK_LAUNCHES_PER_PHASE
#define MK_LAUNCHES_PER_PHASE 0
#endif
#if !MK_LAUNCHES_PER_PHASE
#ifdef EXP_SPINKIND
#define SPIN_T0(K) unsigned long long t0_s = 0; if ((K) == EXP_SPINKIND) t0_s = __builtin_amdgcn_s_memrealtime();
#define SPIN_T1(K) if ((K) == EXP_SPINKIND) { const unsigned long long t1_s = __builtin_amdgcn_s_memrealtime(), d_s = t1_s - t0_s; while (__builtin_amdgcn_s_memrealtime() - t1_s < 4 * d_s) __builtin_amdgcn_s_sleep(8); }
#else
#define SPIN_T0(K)
#define SPIN_T1(K)
#endif
#ifdef EXP_DUPKINDS
#define DUP_PH(K, L) if ((EXP_DUPKINDS >> (K)) & 1) { GRID_BAR(); run_kind<K>(p, L, lds); }
#else
#define DUP_PH(K, L)
#endif
#define GRID_BAR() do { unsigned long long wi_ = (unsigned long long)p.ws; asm volatile("" : "+s"(wi_)); unsigned char* w_ = (unsigned char*)(__attribute__((address_space(1))) unsigned char*)wi_; XcdBarrier b_; b_.bar = (unsigned*)(w_ + WS_CTL) + 4096; b_.x = xb_xcc_id(); b_.st = (volatile LAS unsigned*)(lds + LDS_BYTES - 16); xcd_barrier(b_); } while (0)
#define PHASE(K, L, LAST) do { SPIN_T0(K) run_kind<K>(p, L, lds); DUP_PH(K, L) if (!(LAST)) GRID_BAR(); SPIN_T1(K) } while (0)
__global__ void __launch_bounds__(NT_THREADS, 2) mk_fwd(Params p) {
    extern __shared__ __attribute__((aligned(16))) unsigned char lds_raw[];
    LAS unsigned char* lds = (LAS unsigned char*)lds_raw;
    cg::grid_group grid = cg::this_grid();
    volatile LAS unsigned* bst = (volatile LAS unsigned*)(lds + LDS_BYTES - 16);
    if (tidx() < 4) bst[tidx()] = 0u;
    __syncthreads();
    (void)xcd_barrier_post((unsigned*)(p.ws + WS_CTL) + 4096, bst);
    if (p.ph_hi == 0x7fffffff) grid.sync();
    PHASE(0, 0, false);
#pragma unroll 1
    for (int l = 0; l < DEPTH; ++l) {
        PHASE(2, l, false); PHASE(3, l, false); PHASE(5, l, false);
        PHASE(6, l, false); PHASE(7, l, false); PHASE(8, l, l + 1 == DEPTH);
    }
}
#endif

#ifndef MK_LAUNCHES_PER_PHASE
#define MK_LAUNCHES_PER_PHASE 0
#endif
extern "C" void kernel_launch(void* const* d_in, const int* in_sizes, int n_in, void* d_out, int out_size, void* d_ws, size_t ws_size, hipStream_t stream) {
    static int grid = 0;
    if (grid == 0) {
        if (n_in != 19 || in_sizes[0] != S * DM || out_size != S * DM || ws_size < WS_END) { fprintf(stderr, "kernel_launch: unexpected shapes (n_in %d, in0 %d, out %d, ws %zu)\n", n_in, n_in > 0 ? in_sizes[0] : -1, out_size, ws_size); grid = -1; return; }
        int dev = 0, cus = 0, per_cu = 0;
        (void)hipGetDevice(&dev); (void)hipDeviceGetAttribute(&cus, hipDeviceAttributeMultiprocessorCount, dev);
#if !MK_LAUNCHES_PER_PHASE
        if (hipFuncSetAttribute((const void*)mk_fwd, hipFuncAttributeMaxDynamicSharedMemorySize, LDS_BYTES) != hipSuccess) { fprintf(stderr, "kernel_launch: hipFuncSetAttribute failed\n"); grid = -1; return; }
        if (hipOccupancyMaxActiveBlocksPerMultiprocessor(&per_cu, (const void*)mk_fwd, NT_THREADS, LDS_BYTES) != hipSuccess || per_cu < 1) { fprintf(stderr, "kernel_launch: occupancy query gave %d\n", per_cu); per_cu = 1; }
#else
#define SA(K) (void)hipFuncSetAttribute((const void*)mk_kind<K>, hipFuncAttributeMaxDynamicSharedMemorySize, LDS_BYTES)
        SA(0); SA(2); SA(3); SA(5); SA(6); SA(7); SA(8);
#undef SA
#endif
        (void)hipGetLastError();
        if (cus <= 0) cus = 256;
        grid = cus;
        fprintf(stderr, "kernel_launch: cus %d per_cu %d grid %d\n", cus, per_cu, grid);
    }
    if (grid < 0) return;
    Params p{};
    p.x = (const float*)d_in[0]; p.mem = (const float*)d_in[1]; p.pos = (const int*)d_in[2]; p.rel_bias = (const float*)d_in[3];
    p.norm_pre = (const float*)d_in[4]; p.norm_post = (const float*)d_in[5]; p.w_in = (const float*)d_in[6]; p.sinks = (const float*)d_in[7];
    p.conv_w = (const float*)d_in[8]; p.a_log = (const float*)d_in[9]; p.dt_bias = (const float*)d_in[10]; p.gdn_norm = (const float*)d_in[11];
    p.q_norm = (const float*)d_in[12]; p.kv_norm = (const float*)d_in[13]; p.w_uq = (const float*)d_in[14]; p.w_ukv = (const float*)d_in[15];
    p.mem_norm = (const float*)d_in[16]; p.w_mem = (const float*)d_in[17]; p.w_out = (const float*)d_in[18];
    p.out = (float*)d_out; p.ws = (unsigned char*)d_ws;
    if (hipMemsetAsync((char*)d_ws + WS_CTL, 0, 65536, stream) != hipSuccess) { fprintf(stderr, "kernel_launch: hipMemsetAsync failed\n"); return; }
#if MK_LAUNCHES_PER_PHASE
    p.ph_lo = 0; p.ph_hi = 0;
#define LK(K, L) hipLaunchKernelGGL(mk_kind<K>, dim3(grid), dim3(NT_THREADS), LDS_BYTES, stream, p, L)
    LK(0, 0);
    for (int l = 0; l < DEPTH; ++l) { LK(2, l); LK(3, l); LK(5, l); LK(6, l); LK(7, l); LK(8, l); }
#undef LK
#else
    p.ph_lo = 0; p.ph_hi = N_PHASES;
    void* args[] = {&p};
    hipError_t e = hipLaunchCooperativeKernel((const void*)mk_fwd, dim3(grid), dim3(NT_THREADS), args, LDS_BYTES, stream);
    if (e != hipSuccess) fprintf(stderr, "kernel_launch: cooperative launch failed: %s (grid %d)\n", hipGetErrorString(e), grid);
#endif
}
```

```cpp
#include <hip/hip_runtime.h>
#include <hip/hip_cooperative_groups.h>
#include <cstdint>
#include <cstdio>
namespace cg = cooperative_groups;

#define LAS __attribute__((address_space(3)))
typedef unsigned short bf16_t;
typedef short bf16x8 __attribute__((ext_vector_type(8)));
typedef short s16x4 __attribute__((ext_vector_type(4)));
typedef float f32x2 __attribute__((ext_vector_type(2)));
typedef float f32x4 __attribute__((ext_vector_type(4)));
typedef float f32x16 __attribute__((ext_vector_type(16)));
typedef unsigned u32x2 __attribute__((ext_vector_type(2)));
typedef unsigned u32x4 __attribute__((ext_vector_type(4)));
typedef __bf16 bf16x2_t __attribute__((ext_vector_type(2)));

constexpr int S = 16384, DM = 1024, MEML = 256, NP = 5376, DEPTH = 2, DIN = 5320, MIXW = 2048;
constexpr int C_Z = 0, C_AQ = 2048, C_AK = 2560, C_AV = 2688, C_DQ = 2816, C_BQKV = 3328, C_CQ = 4864, C_CKV = 5120, C_KR = 5248, C_BA = 5312, C_BB = 5316;
constexpr int C_OLAT = 2048;
constexpr float RMS_EPS = 1e-6f;
constexpr float LOG2E = 1.4426950408889634f;
constexpr int NT_THREADS = 512;

constexpr size_t MiB = 1u << 20;
constexpr size_t WS_CTL = 0, WS_COS = 1 * MiB, WS_SIN = 3 * MiB, WS_MEMKV = 5 * MiB, WS_MISC = 6 * MiB, WS_MEMN = 7 * MiB;
constexpr size_t WS_WIN = 8 * MiB, WS_WOUT = 19 * MiB, WS_WMEM = 23 * MiB, WS_WQ = 27 * MiB, WS_WUV = 28 * MiB, WS_HALO = 29 * MiB;
constexpr size_t WS_AQK = 32 * MiB, WS_U = 40 * MiB, WS_H = 56 * MiB, WS_PROJ = 88 * MiB, WS_END = 256 * MiB;
constexpr size_t WS_QABS = WS_H, WS_KVLAT = WS_H + 24 * MiB, WS_Y = WS_H;
constexpr size_t MISC_BTAB = 0, MISC_RSQ = 8192, MISC_EGL = 8192 + 65536;

constexpr int LDS_BYTES = 163840;

struct Params {
    const float* x; const float* mem; const int* pos; const float* rel_bias;
    const float* norm_pre; const float* norm_post; const float* w_in; const float* sinks;
    const float* conv_w; const float* a_log; const float* dt_bias; const float* gdn_norm;
    const float* q_norm; const float* kv_norm; const float* w_uq; const float* w_ukv;
    const float* mem_norm; const float* w_mem; const float* w_out;
    float* out; unsigned char* ws;
    int ph_lo, ph_hi;
};

__device__ __forceinline__ int tidx() { int t = threadIdx.x; asm volatile("" : "+v"(t)); return t; }
__device__ __forceinline__ int bidx() { int b = blockIdx.x; asm volatile("" : "+s"(b)); return b; }
__device__ __forceinline__ float bf2f(bf16_t v) { return __uint_as_float((unsigned)v << 16); }
__device__ __forceinline__ unsigned cvtpk(float lo, float hi) { f32x2 v = {lo, hi}; bf16x2_t b = __builtin_convertvector(v, bf16x2_t); return __builtin_bit_cast(unsigned, b); }
__device__ __forceinline__ bf16_t f2bf(float f) { return (bf16_t)(cvtpk(f, 0.f) & 0xffffu); }
__device__ __forceinline__ float lo_bf(unsigned w) { return __uint_as_float(w << 16); }
__device__ __forceinline__ float hi_bf(unsigned w) { return __uint_as_float(w & 0xffff0000u); }
__device__ __forceinline__ float silu_f(float v) { return v / (1.f + __expf(-v)); }
#define DPP_ROR(x, n) __builtin_amdgcn_update_dpp(0, (x), 0x120 + (n), 0xf, 0xf, false)
__device__ __forceinline__ float ror16_f(float v, int n) { const int x = __float_as_int(v); int r; switch (n) { case 1: r = DPP_ROR(x, 1); break; case 2: r = DPP_ROR(x, 2); break; case 4: r = DPP_ROR(x, 4); break; default: r = DPP_ROR(x, 8); break; } return __int_as_float(r); }
__device__ __forceinline__ unsigned xor8_u(unsigned v) { return (unsigned)DPP_ROR((int)v, 8); }
__device__ __forceinline__ float row16_sum(float v) { v += ror16_f(v, 1); v += ror16_f(v, 2); v += ror16_f(v, 4); v += ror16_f(v, 8); return v; }
__device__ __forceinline__ float wave_sum(float v) {
    v = row16_sum(v);
    v += __int_as_float(__builtin_amdgcn_ds_swizzle(__float_as_int(v), 0x401F));
    return __int_as_float(__builtin_amdgcn_readlane(__float_as_int(v), 0)) + __int_as_float(__builtin_amdgcn_readlane(__float_as_int(v), 32));
}
__device__ __forceinline__ int crow(int r, int hi) { return (r & 3) + 8 * (r >> 2) + 4 * hi; }
#define MFMA32(a, b, c) __builtin_amdgcn_mfma_f32_32x32x16_bf16((a), (b), (c), 0, 0, 0)
#define SBAR() __builtin_amdgcn_sched_barrier(0)
#define LDS_WAIT() asm volatile("s_waitcnt lgkmcnt(0)" ::: "memory")
__device__ __forceinline__ bf16x8 pack8(const float* v) { u32x4 w = {cvtpk(v[0], v[1]), cvtpk(v[2], v[3]), cvtpk(v[4], v[5]), cvtpk(v[6], v[7])}; return __builtin_bit_cast(bf16x8, w); }
__device__ __forceinline__ bf16x8 pack_step(const f32x16& x, int s) {
    u32x4 w = {cvtpk(x[8 * s + 0], x[8 * s + 1]), cvtpk(x[8 * s + 2], x[8 * s + 3]), cvtpk(x[8 * s + 4], x[8 * s + 5]), cvtpk(x[8 * s + 6], x[8 * s + 7])};
    return __builtin_bit_cast(bf16x8, w);
}

__device__ __forceinline__ int win_src(int n) {
    if (n < 512) return 768 + n;
    if (n < 1024) return 2824 + (n - 512);
    if (n < 1536) return 3784 + (n - 1024);
    if (n < 2048) return 4808 + (n - 1536);
    if (n < 2560) return n - 2048;
    if (n < 2688) return 512 + (n - 2560);
    if (n < 2816) return 640 + (n - 2688);
    if (n < 3328) return 4296 + (n - 2816);
    if (n < 4864) return 1280 + (n - 3328);
    if (n < 5120) return 3336 + (n - 4864);
    if (n < 5248) return 3592 + (n - 5120);
    if (n < 5312) return 3720 + (n - 5248);
    if (n < 5316) return 2816 + (n - 5312);
    if (n < 5320) return 2820 + (n - 5316);
    return -1;
}

__device__ __forceinline__ int t5_bucket(int n) {
    if (n < 16) return n < 0 ? 0 : n;
    if (n >= 128) return 31;
    const float v = __logf((float)n * 0.0625f) * (16.0f / 2.0794415416798357f);
    int b = 16 + (int)v; return b > 31 ? 31 : b;
}
__device__ __forceinline__ float inv_freq(int i) {
    const float t[32] = {1.000000000e+00f, 7.498942018e-01f, 5.623413324e-01f, 4.216965139e-01f, 3.162277639e-01f, 2.371373922e-01f, 1.778279394e-01f, 1.333521456e-01f,
                         1.000000015e-01f, 7.498941571e-02f, 5.623412877e-02f, 4.216964915e-02f, 3.162277862e-02f, 2.371373586e-02f, 1.778279431e-02f, 1.333521493e-02f,
                         9.999999776e-03f, 7.498942316e-03f, 5.623413250e-03f, 4.216964822e-03f, 3.162277862e-03f, 2.371373819e-03f, 1.778279431e-03f, 1.333521446e-03f,
                         1.000000047e-03f, 7.498941850e-04f, 5.623413017e-04f, 4.216965463e-04f, 3.162277862e-04f, 2.371373848e-04f, 1.778279402e-04f, 1.333521504e-04f};
    return t[i];
}
namespace pg8 {
#define PG8_LAS __attribute__((address_space(3)))
constexpr int BM = 256, BK = 64, HALF = 128, HTB = HALF * BK * 2  , STAGE_BYTES = 8 * HTB, NXCD = 8, WGM = 8;
__host__ __device__ __forceinline__ int lds_byte(int r, int c) { const int st = (r >> 4) * 2 + (c >> 5), rr = r & 15, cc = c & 31, ob = rr * 64 + cc * 2; return st * 1024 + (ob ^ (((ob >> 9) & 1) << 5)); }
__host__ __device__ __forceinline__ void stage_rc(int b, int& R, int& C) { const int st = b / 1024, sb = b % 1024, swz = sb ^ (((sb >> 9) & 1) << 5); R = (st >> 1) * 16 + swz / 64; C = (st & 1) * 32 + (swz % 64) / 2; }
__host__ __device__ __forceinline__ int perm32(int rho) { const int n = rho >> 4, i = rho & 15; return 8 * (i >> 2) + 4 * n + (i & 3); }
struct Unit { int pm, pn; };
struct Gemm { const bf16_t* A; const bf16_t* Bt; int M, N, K, lda; };
struct StaticOrder {
    int nM, nN, nwg, G, c;
    __device__ void init(int M, int N, int G_, int c_) { nM = M / BM; nN = N / BM; nwg = nM * nN; G = G_; c = c_; }
    __device__ bool next(int i, Unit& u) const {
        const long L = (long)i * G + c; if (L >= nwg) return false;
        int wgid = (int)L; { const int q = nwg / NXCD, r = nwg % NXCD, xcd = wgid % NXCD, off = wgid / NXCD; wgid = (xcd < r ? xcd * (q + 1) : r * (q + 1) + (xcd - r) * q) + off; }
        const int nig = WGM * nN, gid = wgid / nig, fm = gid * WGM, gsz = (nM - fm) < WGM ? (nM - fm) : WGM;
        u.pm = fm + ((wgid % nig) % gsz); u.pn = (wgid % nig) / gsz; return true;
    }
    __device__ __forceinline__ void a_ready(const Unit&) const {}
    __device__ __forceinline__ void done(const Unit&) const {}
};
struct EpiStore {
    static constexpr bool PERM = true, AFTER_DRAIN = false;
    bf16_t* O; int ldc; bf16_t* halo;
    __device__ __forceinline__ void operator()(const f32x4 (&acc)[2][2][4][2], const Unit& u, int wr, int wc, int fr, int fq) const {
        const int row0 = u.pm * BM + wr * 64 + fr, col0 = u.pn * BM + wc * 32 + 8 * fq;
        const bool hz = halo != nullptr && col0 >= C_BQKV && col0 < C_BQKV + 1536;
#pragma unroll
        for (int ai = 0; ai < 2; ++ai)
#pragma unroll
            for (int m = 0; m < 4; ++m) { const int row = row0 + ai * HALF + m * 16; bf16_t* rowp = O + (size_t)row * ldc + col0;
#pragma unroll
                for (int bj = 0; bj < 2; ++bj) { const f32x4 v0 = acc[ai][bj][m][0], v1 = acc[ai][bj][m][1];
                    u32x4 w; w.x = cvtpk(v0[0], v0[1]); w.y = cvtpk(v0[2], v0[3]); w.z = cvtpk(v1[0], v1[1]); w.w = cvtpk(v1[2], v1[3]);
                    *(u32x4*)(rowp + bj * HALF) = w;
                    if (m == 3 && hz && fr >= 13) *(u32x4*)(halo + ((size_t)(row >> 6) * 3 + (fr - 13)) * 1536 + (col0 + bj * HALF - C_BQKV)) = w; } }
    }
};
struct EpiGate {
    static constexpr bool PERM = true, AFTER_DRAIN = false;
    bf16_t* G; int ldc;
    __device__ __forceinline__ void operator()(const f32x4 (&acc)[2][2][4][2], const Unit& u, int wr, int wc, int fr, int fq) const {
        const int row0 = u.pm * BM + wr * 64 + fr, col0 = u.pn * BM + wc * 32 + 8 * fq;
#pragma unroll
        for (int ai = 0; ai < 2; ++ai)
#pragma unroll
            for (int m = 0; m < 4; ++m) { bf16_t* rowp = G + (size_t)(row0 + ai * HALF + m * 16) * ldc + col0;
#pragma unroll
                for (int bj = 0; bj < 2; ++bj) { const f32x4 v0 = acc[ai][bj][m][0], v1 = acc[ai][bj][m][1];
                    const u32x4 z = *(const u32x4*)(rowp + bj * HALF);
                    u32x4 w; w.x = cvtpk(v0[0] * silu_f(lo_bf(z.x)), v0[1] * silu_f(hi_bf(z.x))); w.y = cvtpk(v0[2] * silu_f(lo_bf(z.y)), v0[3] * silu_f(hi_bf(z.y)));
                    w.z = cvtpk(v1[0] * silu_f(lo_bf(z.z)), v1[1] * silu_f(hi_bf(z.z))); w.w = cvtpk(v1[2] * silu_f(lo_bf(z.w)), v1[3] * silu_f(hi_bf(z.w)));
                    *(u32x4*)(rowp + bj * HALF) = w; } }
    }
};
template <class Epi, class Sched, bool ALIGN_EPI = false, bool SP2 = false>
__device__ __forceinline__ void gemm_phase(PG8_LAS unsigned char* lds, const Gemm g, const Sched& S, const Epi& E) {
    const int tid = tidx(), wid = __builtin_amdgcn_readfirstlane(tid >> 6), lane = tid & 63, wr = wid >> 2, wc = wid & 3, fr = lane & 15, fq = lane >> 4;
    const int K = g.K, nt = K / BK;
    unsigned voffA[2], voffB[2];
#pragma unroll
    for (int i = 0; i < 2; ++i) { int R, C; stage_rc(tid * 16 + i * 8192, R, C); const int Rb = Epi::PERM ? ((R & ~31) + perm32(R & 31)) : R;
        voffA[i] = (unsigned)(R * g.lda + C) * 2u; voffB[i] = (unsigned)(Rb * K + C) * 2u; }
    const size_t kstep = (size_t)(BK * 2);
    const size_t hstepA = (size_t)HALF * g.lda * 2, hstepB = (size_t)HALF * K * 2;
    const size_t tstepA = 2 * hstepA, tstepB = 2 * hstepB;
    const unsigned ldsw = (unsigned)wid * 1024u;
    const int aoff = lds_byte(wr * 64 + fr, fq * 8), boff = lds_byte(wc * 32 + fr, fq * 8);
#define PG8_SA(b, h) (((b) * 2 + (h)) * HTB)
#define PG8_SB(b, h) ((4 + (b) * 2 + (h)) * HTB)
#define PG8_STAGE(bufoff, gbase, voff) do { _Pragma("unroll") for (int _i = 0; _i < 2; ++_i) \
        __builtin_amdgcn_global_load_lds((const unsigned*)((const char*)(gbase) + (voff)[_i]), (PG8_LAS unsigned*)(lds + (bufoff) + ldsw + _i * 8192), 16, 0, 0); } while (0)
#define PG8_LDA(dst, b, h) do { _Pragma("unroll") for (int m = 0; m < 4; ++m) _Pragma("unroll") for (int k = 0; k < 2; ++k) dst[m][k] = *(const PG8_LAS bf16x8*)(lds + PG8_SA(b, h) + aoff + m * 2048 + k * 1024); } while (0)
#define PG8_LDB(dst, b, h) do { _Pragma("unroll") for (int n = 0; n < 2; ++n) _Pragma("unroll") for (int k = 0; k < 2; ++k) dst[n][k] = *(const PG8_LAS bf16x8*)(lds + PG8_SB(b, h) + boff + n * 2048 + k * 1024); } while (0)
#define PG8_MMA(ai, bj, At, Bt) do { __builtin_amdgcn_s_setprio(1); _Pragma("unroll") for (int m = 0; m < 4; ++m) _Pragma("unroll") for (int n = 0; n < 2; ++n) _Pragma("unroll") for (int k = 0; k < 2; ++k) \
        acc[ai][bj][m][n] = __builtin_amdgcn_mfma_f32_16x16x32_bf16(Bt[n][k], At[m][k], acc[ai][bj][m][n], 0, 0, 0); __builtin_amdgcn_s_setprio(0); } while (0)
#define PG8_WAIT_V(n) asm volatile("s_waitcnt vmcnt(" #n ")" ::: "memory")
#define PG8_WAIT_L(n) asm volatile("s_waitcnt lgkmcnt(" #n ")" ::: "memory")
#define PG8_BAR __builtin_amdgcn_s_barrier()
#define PG8_SCHED __builtin_amdgcn_sched_barrier(0)
    Unit cur, nxt; int ui = 0;
    if (!S.next(0, cur)) return;
    f32x4 acc[2][2][4][2];
#pragma unroll
    for (int a = 0; a < 2; ++a)
#pragma unroll
        for (int b = 0; b < 2; ++b)
#pragma unroll
            for (int m = 0; m < 4; ++m)
#pragma unroll
                for (int n = 0; n < 2; ++n) acc[a][b][m][n] = (f32x4){0.f, 0.f, 0.f, 0.f};
    bf16x8 At[4][2], B0[2][2], B1[2][2];
    const char* cA = (const char*)g.A + (size_t)cur.pm * tstepA; const char* cB = (const char*)g.Bt + (size_t)cur.pn * tstepB;
    S.a_ready(cur);
    if constexpr (SP2) {
        PG8_STAGE(PG8_SB(0, 0), cB, voffB); PG8_STAGE(PG8_SB(0, 1), cB + hstepB, voffB); PG8_STAGE(PG8_SA(0, 0), cA, voffA); PG8_STAGE(PG8_SA(0, 1), cA + hstepA, voffA);
        if (wr == 1) PG8_BAR;
        PG8_WAIT_V(2); PG8_BAR;
        PG8_STAGE(PG8_SB(1, 0), cB + kstep, voffB); PG8_STAGE(PG8_SA(1, 0), cA + kstep, voffA); PG8_STAGE(PG8_SB(1, 1), cB + hstepB + kstep, voffB);
        PG8_WAIT_V(6); PG8_BAR;
    } else {
        PG8_STAGE(PG8_SB(0, 0), cB, voffB); PG8_STAGE(PG8_SA(0, 0), cA, voffA); PG8_STAGE(PG8_SB(0, 1), cB + hstepB, voffB); PG8_STAGE(PG8_SA(0, 1), cA + hstepA, voffA);
        if (wr == 1) PG8_BAR;
        PG8_WAIT_V(4); PG8_BAR;
        PG8_STAGE(PG8_SB(1, 0), cB + kstep, voffB); PG8_STAGE(PG8_SA(1, 0), cA + kstep, voffA); PG8_STAGE(PG8_SB(1, 1), cB + hstepB + kstep, voffB);
        PG8_WAIT_V(6); PG8_BAR;
    }
    for (;;) {
        const bool has_next = S.next(ui + 1, nxt);
        const char* nA = has_next ? (const char*)g.A + (size_t)nxt.pm * tstepA : cA; const char* nB = has_next ? (const char*)g.Bt + (size_t)nxt.pn * tstepB : cB;
        for (int t = 0; t < nt; t += 2) {
            const bool last = (t == nt - 2);
            const char* a1 = cA + (size_t)(t + 1) * kstep;
            const char* a2 = last ? nA : cA + (size_t)(t + 2) * kstep; const char* b2 = last ? nB : cB + (size_t)(t + 2) * kstep;
            const char* a3 = a2 + kstep; const char* b3 = b2 + kstep;
            if (last && has_next) S.a_ready(nxt);
            if constexpr (SP2) {
            PG8_LDB(B0, 0, 0); PG8_LDB(B1, 0, 1); PG8_SCHED; PG8_LDA(At, 0, 0); PG8_STAGE(PG8_SA(1, 1), a1 + hstepA, voffA);
            PG8_WAIT_V(8); PG8_WAIT_L(0); PG8_BAR; PG8_MMA(0, 0, At, B0); PG8_MMA(0, 1, At, B1); PG8_BAR; PG8_SCHED;
            PG8_LDA(At, 0, 1); PG8_STAGE(PG8_SB(0, 0), b2, voffB); PG8_STAGE(PG8_SB(0, 1), b2 + hstepB, voffB); PG8_STAGE(PG8_SA(0, 0), a2, voffA);
            PG8_WAIT_V(8); PG8_WAIT_L(0); PG8_BAR; PG8_MMA(1, 0, At, B0); PG8_MMA(1, 1, At, B1); PG8_BAR; PG8_SCHED;
            PG8_LDB(B0, 1, 0); PG8_LDB(B1, 1, 1); PG8_SCHED; PG8_LDA(At, 1, 0); PG8_STAGE(PG8_SA(0, 1), a2 + hstepA, voffA);
            PG8_WAIT_V(8); PG8_WAIT_L(0); PG8_BAR; PG8_MMA(0, 0, At, B0); PG8_MMA(0, 1, At, B1); PG8_BAR; PG8_SCHED;
            PG8_LDA(At, 1, 1); PG8_STAGE(PG8_SB(1, 0), b3, voffB); PG8_STAGE(PG8_SB(1, 1), b3 + hstepB, voffB); PG8_STAGE(PG8_SA(1, 0), a3, voffA);
            PG8_WAIT_V(8); PG8_WAIT_L(0); PG8_BAR; PG8_MMA(1, 0, At, B0); PG8_MMA(1, 1, At, B1); PG8_BAR; PG8_SCHED;
            } else {
            PG8_LDB(B0, 0, 0); PG8_SCHED; PG8_LDA(At, 0, 0); PG8_STAGE(PG8_SA(1, 1), a1 + hstepA, voffA);
            PG8_WAIT_L(8); PG8_BAR; PG8_WAIT_L(0); PG8_MMA(0, 0, At, B0); PG8_BAR; PG8_SCHED;
            PG8_LDB(B1, 0, 1); PG8_STAGE(PG8_SB(0, 0), b2, voffB);
            PG8_BAR; PG8_WAIT_L(0); PG8_MMA(0, 1, At, B1); PG8_BAR;
            PG8_LDA(At, 0, 1); PG8_STAGE(PG8_SA(0, 0), a2, voffA);
            PG8_BAR; PG8_WAIT_L(0); PG8_MMA(1, 0, At, B0); PG8_BAR; PG8_SCHED;
            PG8_STAGE(PG8_SB(0, 1), b2 + hstepB, voffB);
            PG8_WAIT_V(6); PG8_BAR; PG8_MMA(1, 1, At, B1); PG8_BAR;
            PG8_LDB(B0, 1, 0); PG8_SCHED; PG8_LDA(At, 1, 0); PG8_STAGE(PG8_SA(0, 1), a2 + hstepA, voffA);
            PG8_WAIT_L(8); PG8_BAR; PG8_WAIT_L(0); PG8_MMA(0, 0, At, B0); PG8_BAR; PG8_SCHED;
            PG8_LDB(B1, 1, 1); PG8_STAGE(PG8_SB(1, 0), b3, voffB);
            PG8_BAR; PG8_WAIT_L(0); PG8_MMA(0, 1, At, B1); PG8_BAR;
            PG8_LDA(At, 1, 1); PG8_STAGE(PG8_SA(1, 0), a3, voffA);
            PG8_BAR; PG8_WAIT_L(0); PG8_MMA(1, 0, At, B0); PG8_BAR; PG8_SCHED;
            PG8_STAGE(PG8_SB(1, 1), b3 + hstepB, voffB);
            PG8_WAIT_V(6); PG8_BAR; PG8_MMA(1, 1, At, B1); PG8_BAR;
            }
        }
        if constexpr (ALIGN_EPI) { if (wr == 0) PG8_BAR; }
        if constexpr (!Epi::AFTER_DRAIN) { E(acc, cur, wr, wc, fr, fq); S.done(cur); }
        if (!has_next) break;
#pragma unroll
        for (int a = 0; a < 2; ++a)
#pragma unroll
            for (int b = 0; b < 2; ++b)
#pragma unroll
                for (int m = 0; m < 4; ++m)
#pragma unroll
                    for (int n = 0; n < 2; ++n) acc[a][b][m][n] = (f32x4){0.f, 0.f, 0.f, 0.f};
        cur = nxt; cA = nA; cB = nB; ++ui;
        if constexpr (ALIGN_EPI) { if (wr == 1) PG8_BAR; }
    }
    PG8_WAIT_V(0);
    if constexpr (!ALIGN_EPI) { if (wr == 0) PG8_BAR; }
    PG8_BAR;
    if constexpr (Epi::AFTER_DRAIN) { E.fused(acc, cur, wr, wc, fr, fq, lds, wid, lane); S.done(cur); }
#undef PG8_SA
#undef PG8_SB
#undef PG8_STAGE
#undef PG8_LDA
#undef PG8_LDB
#undef PG8_MMA
#undef PG8_WAIT_V
#undef PG8_WAIT_L
#undef PG8_BAR
#undef PG8_SCHED
}
}
namespace att {
constexpr int KVBLK = 64;
constexpr int STG = 32768, L_WS = 65536, L_POSK = 67584, L_BTAB = 68096, L_UNIT = 72256, L_OST = 73728, OST_WAVE = 8704;
template <int DV> __device__ __forceinline__ int v_st(int k, int c) { const int kk = (k & ~0xC) | ((k & 4) << 1) | ((k & 8) >> 1); return ((kk >> 3) * (DV / 32) + (c >> 5)) * 512 + ((kk & 7) * 32 + (c & 31)) * 2; }
__device__ __forceinline__ int v_rd_base(int lane) { return ((lane & 3) << 3) | (((lane >> 2) & 3) << 6) | (((lane >> 4) & 1) << 5) | (((lane >> 5) & 1) << 8); }
__device__ __forceinline__ int koff(int row, int colB, int RB) { return row * RB + (colB ^ ((row & 7) << 4)); }

template <int DQK, int DV, int MODE>
__device__ __forceinline__ void attn_core(LAS unsigned char* lds, const bf16_t* qrow, const bf16_t* Kg, int ldk, const bf16_t* Vg, int ldv, int t_lo, int t_hi, float c2,
                                          int qidx, int head, const int* pos, float& m_reg, float& l_reg, f32x16 (&o)[DV / 32]) {
    constexpr int ND = DQK / 16, NV = DV / 32, RB = DQK * 2, NKC = (64 * (DQK / 8)) / NT_THREADS, NVC = (64 * (DV / 8)) / NT_THREADS, KB = 64 * RB;
    const int tid = tidx(), lane = tid & 63, r32 = lane & 31, hi = lane >> 5, wid = __builtin_amdgcn_readfirstlane(tid >> 6);
    bf16x8 qr[ND];
#pragma unroll
    for (int d0 = 0; d0 < ND; ++d0) qr[d0] = *(const bf16x8*)(qrow + d0 * 16 + hi * 8);
    LAS float* al_l = (LAS float*)(lds + L_WS) + wid * 64;
    LAS int* posk = (LAS int*)(lds + L_POSK); LAS float* btab = (LAS float*)(lds + L_BTAB);
    const unsigned vb0 = (unsigned)(uintptr_t)lds + (unsigned)KB + (unsigned)v_rd_base(lane);
    int posq = 0; if (MODE == 1) posq = pos[qidx];
    unsigned kdst[NKC], ksrc[NKC], vdst[NVC], vsrc[NVC];
#pragma unroll
    for (int i = 0; i < NKC; ++i) { const int c = tid + NT_THREADS * i, row = c / (DQK / 8), ch = c % (DQK / 8); kdst[i] = koff(row, ch * 16, RB); ksrc[i] = row * ldk + ch * 8; }
#pragma unroll
    for (int i = 0; i < NVC; ++i) { const int c = tid + NT_THREADS * i, row = c / (DV / 8), ch = c % (DV / 8); vdst[i] = KB + v_st<DV>(row, ch * 8); vsrc[i] = row * ldv + ch * 8; }
    u32x4 ks[NKC], vs[NVC]; int pkn = 0;
#define LOAD_TILE(t_) do { const size_t kb_ = (size_t)(t_) * KVBLK; _Pragma("unroll") for (int i = 0; i < NKC; ++i) ks[i] = *(const u32x4*)(Kg + kb_ * ldk + ksrc[i]); \
        _Pragma("unroll") for (int i = 0; i < NVC; ++i) vs[i] = *(const u32x4*)(Vg + kb_ * ldv + vsrc[i]); if (MODE == 1 && tid < 64) pkn = pos[(t_) * KVBLK + tid]; } while (0)
#define WRITE_TILE(st_) do { _Pragma("unroll") for (int i = 0; i < NKC; ++i) *(LAS u32x4*)(lds + (st_) * STG + kdst[i]) = ks[i]; \
        _Pragma("unroll") for (int i = 0; i < NVC; ++i) *(LAS u32x4*)(lds + (st_) * STG + vdst[i]) = vs[i]; if (MODE == 1 && tid < 64) posk[(st_) * 64 + tid] = pkn; } while (0)
    LOAD_TILE(t_lo); WRITE_TILE(0);
    __syncthreads();
#pragma unroll 1
    for (int t = t_lo; t < t_hi; ++t) {
        const int st = (t - t_lo) & 1, kbase = t * KVBLK;
        if (t + 1 < t_hi) LOAD_TILE(t + 1);
        const LAS unsigned char* K_lds = lds + st * STG;
        f32x16 p0 = {}, p1 = {};
#pragma unroll
        for (int d0 = 0; d0 < ND; ++d0) {
            const bf16x8 a0 = *(const LAS bf16x8*)(K_lds + koff(r32, (d0 * 16 + hi * 8) * 2, RB));
            const bf16x8 a1 = *(const LAS bf16x8*)(K_lds + koff(32 + r32, (d0 * 16 + hi * 8) * 2, RB));
            p0 = MFMA32(a0, qr[d0], p0); p1 = MFMA32(a1, qr[d0], p1);
        }
        if (MODE == 1) {
#pragma unroll
            for (int r = 0; r < 16; ++r) { const int kl = crow(r, hi);
                { const int kk = kbase + kl; int dist = posq - posk[st * 64 + kl]; dist = dist < 0 ? 0 : (dist > 128 ? 128 : dist);
                  const float b = btab[dist * 8 + head]; p0[r] = ((unsigned)(qidx - kk) < 128u) ? fmaf(p0[r], c2, b) : -__builtin_inff(); }
                { const int kk = kbase + kl + 32; int dist = posq - posk[st * 64 + kl + 32]; dist = dist < 0 ? 0 : (dist > 128 ? 128 : dist);
                  const float b = btab[dist * 8 + head]; p1[r] = ((unsigned)(qidx - kk) < 128u) ? fmaf(p1[r], c2, b) : -__builtin_inff(); } }
        } else {
#pragma unroll
            for (int r = 0; r < 16; ++r) { p0[r] *= c2; p1[r] *= c2; }
        }
        float pmax = p0[0];
#pragma unroll
        for (int r = 1; r < 16; ++r) pmax = fmaxf(pmax, p0[r]);
#pragma unroll
        for (int r = 0; r < 16; ++r) pmax = fmaxf(pmax, p1[r]);
        { auto rr = __builtin_amdgcn_permlane32_swap(__float_as_uint(pmax), __float_as_uint(pmax), false, false); pmax = fmaxf(__uint_as_float(rr[0]), __uint_as_float(rr[1])); }
        const float mn = fmaxf(m_reg, pmax); const float alpha = __builtin_amdgcn_exp2f(m_reg - mn); m_reg = mn;
        float ps = 0.f;
#pragma unroll
        for (int r = 0; r < 16; ++r) { p0[r] = __builtin_amdgcn_exp2f(p0[r] - mn); ps += p0[r]; }
#pragma unroll
        for (int r = 0; r < 16; ++r) { p1[r] = __builtin_amdgcn_exp2f(p1[r] - mn); ps += p1[r]; }
        { auto rr = __builtin_amdgcn_permlane32_swap(__float_as_uint(ps), __float_as_uint(ps), false, false); ps = __uint_as_float(rr[0]) + __uint_as_float(rr[1]); }
        l_reg = l_reg * alpha + ps;
        if (__any(alpha < 1.f)) {
            if (hi == 0) al_l[r32] = alpha;
            LDS_WAIT();
#pragma unroll
            for (int g = 0; g < 4; ++g) { const f32x4 a4 = *(const LAS f32x4*)(al_l + 8 * g + 4 * hi);
#pragma unroll
                for (int d = 0; d < NV; ++d) { o[d][4 * g + 0] *= a4[0]; o[d][4 * g + 1] *= a4[1]; o[d][4 * g + 2] *= a4[2]; o[d][4 * g + 3] *= a4[3]; } }
        }
        bf16x8 pa0, pa1, pa2, pa3;
#define PK4(P, B_, OUT) do { const unsigned a0_ = cvtpk(P[B_ + 0], P[B_ + 1]), a1_ = cvtpk(P[B_ + 2], P[B_ + 3]), b0_ = cvtpk(P[B_ + 4], P[B_ + 5]), b1_ = cvtpk(P[B_ + 6], P[B_ + 7]); \
        auto r0_ = __builtin_amdgcn_permlane32_swap(a0_, b0_, false, false); auto r1_ = __builtin_amdgcn_permlane32_swap(a1_, b1_, false, false); \
        u32x4 w_ = {r0_[0], r1_[0], r0_[1], r1_[1]}; OUT = __builtin_bit_cast(bf16x8, w_); } while (0)
        PK4(p0, 0, pa0); PK4(p0, 8, pa1); PK4(p1, 0, pa2); PK4(p1, 8, pa3);
#undef PK4
        const unsigned vba = vb0 + (unsigned)(st * STG);
#define TRRD(dst, off) asm volatile("ds_read_b64_tr_b16 %0, %1 offset:%2" : "=&v"(dst) : "v"(vba), "i"(off) : "memory")
#define PV_D0(d0) do { s16x4 l0, l1, l2, l3, h0, h1, h2, h3; constexpr int KS_ = NV * 1024, HF_ = NV * 512, b_ = (d0) * 512; \
        TRRD(l0, b_); TRRD(h0, b_ + HF_); TRRD(l1, b_ + KS_); TRRD(h1, b_ + KS_ + HF_); TRRD(l2, b_ + 2 * KS_); TRRD(h2, b_ + 2 * KS_ + HF_); TRRD(l3, b_ + 3 * KS_); TRRD(h3, b_ + 3 * KS_ + HF_); \
        asm volatile("s_waitcnt lgkmcnt(0)" ::: "memory"); SBAR(); \
        o[d0] = MFMA32(pa0, ((bf16x8){l0[0], l0[1], l0[2], l0[3], h0[0], h0[1], h0[2], h0[3]}), o[d0]); \
        o[d0] = MFMA32(pa1, ((bf16x8){l1[0], l1[1], l1[2], l1[3], h1[0], h1[1], h1[2], h1[3]}), o[d0]); \
        o[d0] = MFMA32(pa2, ((bf16x8){l2[0], l2[1], l2[2], l2[3], h2[0], h2[1], h2[2], h2[3]}), o[d0]); \
        o[d0] = MFMA32(pa3, ((bf16x8){l3[0], l3[1], l3[2], l3[3], h3[0], h3[1], h3[2], h3[3]}), o[d0]); } while (0)
        PV_D0(0); PV_D0(1);
        if constexpr (NV == 4) { PV_D0(2); PV_D0(3); }
#undef PV_D0
#undef TRRD
        if (t + 1 < t_hi) WRITE_TILE(st ^ 1);
        __syncthreads();
    }
#undef LOAD_TILE
#undef WRITE_TILE
}
template <int DV>
__device__ __forceinline__ void gated_store(LAS unsigned char* lds, float l_reg, const f32x16 (&o)[DV / 32], bf16_t* zp0) {
    constexpr int NV = DV / 32, OP = DV + 8, CPR = DV / 8;
    const int tid = tidx(), lane = tid & 63, r32 = lane & 31, hi = lane >> 5, wid = __builtin_amdgcn_readfirstlane(tid >> 6);
    LAS float* li_l = (LAS float*)(lds + L_WS) + wid * 64; LAS bf16_t* ost = (LAS bf16_t*)(lds + L_OST + wid * OST_WAVE);
    asm volatile("s_waitcnt lgkmcnt(0)" ::: "memory");
    if (hi == 0) li_l[r32] = l_reg;
    asm volatile("s_waitcnt lgkmcnt(0)" ::: "memory");
#pragma unroll
    for (int g = 0; g < 4; ++g) { const f32x4 a4 = *(const LAS f32x4*)(li_l + 8 * g + 4 * hi);
#pragma unroll
        for (int e = 0; e < 4; ++e) { const float rl = 1.f / a4[e]; const int row = 8 * g + 4 * hi + e;
#pragma unroll
            for (int d0 = 0; d0 < NV; ++d0) ost[row * OP + d0 * 32 + r32] = f2bf(o[d0][4 * g + e] * rl); } }
    asm volatile("s_waitcnt lgkmcnt(0)" ::: "memory");
#pragma unroll
    for (int i = 0; i < (32 * CPR) / 64; ++i) { const int id = lane + 64 * i, row = id / CPR, dc = id % CPR;
        const u32x4 v = *(const LAS u32x4*)(ost + row * OP + dc * 8); bf16_t* zp = zp0 + (size_t)row * NP + dc * 8; const u32x4 z = *(const u32x4*)zp;
        u32x4 w; w.x = cvtpk(lo_bf(v.x) * silu_f(lo_bf(z.x)), hi_bf(v.x) * silu_f(hi_bf(z.x))); w.y = cvtpk(lo_bf(v.y) * silu_f(lo_bf(z.y)), hi_bf(v.y) * silu_f(hi_bf(z.y)));
        w.z = cvtpk(lo_bf(v.z) * silu_f(lo_bf(z.z)), hi_bf(v.z) * silu_f(hi_bf(z.z))); w.w = cvtpk(lo_bf(v.w) * silu_f(lo_bf(z.w)), hi_bf(v.w) * silu_f(hi_bf(z.w)));
        *(u32x4*)zp = w; }
}
__device__ __forceinline__ void swa_unit(LAS unsigned char* lds, int qb, int hk, bf16_t* PROJ, const int* pos, const float* sinks  ) {
    const int tid = tidx(), lane = tid & 63, r32 = lane & 31, wid = __builtin_amdgcn_readfirstlane(tid >> 6);
    const int head = hk * 4 + (wid >> 1), q0 = qb * 64 + (wid & 1) * 32;
    const float sink = sinks[head] * LOG2E;
    float m = sink, l = 1.f; f32x16 o[2] = {};
    int t_lo = (qb * 64 - 128) / 64; if (t_lo < 0) t_lo = 0;
#ifdef EXP_DUPSWA
    attn_core<64, 64, 1>(lds, PROJ + (size_t)(q0 + r32) * NP + C_AQ + head * 64, PROJ + C_AK + hk * 64, NP, PROJ + C_AV + hk * 64, NP, t_lo, qb + 1, 0.125f * LOG2E, q0 + r32, head, pos, m, l, o);
    m = sink; l = 1.f; o[0] = (f32x16){}; o[1] = (f32x16){}; __syncthreads();
#endif
    attn_core<64, 64, 1>(lds, PROJ + (size_t)(q0 + r32) * NP + C_AQ + head * 64, PROJ + C_AK + hk * 64, NP, PROJ + C_AV + hk * 64, NP, t_lo, qb + 1, 0.125f * LOG2E, q0 + r32, head, pos, m, l, o);
    gated_store<64>(lds, l, o, PROJ + (size_t)q0 * NP + C_Z + head * 64);
}
__device__ __forceinline__ void cross_unit(LAS unsigned char* lds, int qb, int h, bf16_t* PROJ, const bf16_t* MEMKV  ) {
    const int tid = tidx(), lane = tid & 63, r32 = lane & 31, wid = __builtin_amdgcn_readfirstlane(tid >> 6);
    const int q0 = qb * 256 + wid * 32;
    float m = -1e30f, l = 0.f; f32x16 o[4] = {};
#ifdef EXP_DUPCROSS
    attn_core<128, 128, 2>(lds, PROJ + (size_t)(q0 + r32) * NP + C_DQ + h * 128, MEMKV + h * 128, 1024, MEMKV + 512 + h * 128, 1024, 0, 4, 0.08838834764831845f * LOG2E, q0 + r32, 0, nullptr, m, l, o);
    m = -1e30f; l = 0.f; o[0] = (f32x16){}; o[1] = (f32x16){}; o[2] = (f32x16){}; o[3] = (f32x16){}; __syncthreads();
#endif
    attn_core<128, 128, 2>(lds, PROJ + (size_t)(q0 + r32) * NP + C_DQ + h * 128, MEMKV + h * 128, 1024, MEMKV + 512 + h * 128, 1024, 0, 4, 0.08838834764831845f * LOG2E, q0 + r32, 0, nullptr, m, l, o);
    gated_store<128>(lds, l, o, PROJ + (size_t)q0 * NP + C_Z + 1536 + h * 128);
}
__device__ __forceinline__ void run_mixers(LAS unsigned char* lds, unsigned* ctr, bf16_t* PROJ, const int* pos, const float* sinks, const float* btab_g, const bf16_t* MEMKV) {
    LAS int* ub = (LAS int*)(lds + L_UNIT);
    __syncthreads();
    for (int i = tidx(); i < 129 * 8; i += NT_THREADS) ((LAS float*)(lds + L_BTAB))[i] = btab_g[i];
    for (;;) {
        __syncthreads();
        if (tidx() == 0) *ub = (int)atomicAdd(ctr, 1u);
        __syncthreads();
        const int u = *ub;
        if (u >= 768) break;
        if (u < 256) cross_unit(lds, u >> 2, u & 3, PROJ, MEMKV); else swa_unit(lds, (u - 256) >> 1, (u - 256) & 1, PROJ, pos, sinks);
    }
}
}
namespace mla {
constexpr int ST_BYTES = 49152  , R_OFF = 32768, L_SCR = 147456  , L_UNIT = 149504, L_OLT = 67584  , L_OUT = 102400  ;
__device__ __forceinline__ unsigned off_a(unsigned row, unsigned ch) { return 2048u * (row >> 3) + 512u * (ch >> 2) + 64u * (row & 7) + 16u * ((ch & 3) ^ ((row >> 2) & 3)); }
__device__ __forceinline__ unsigned off_r(unsigned row, unsigned ch) { return 1024u * (row >> 3) + 512u * (ch >> 2) + 64u * (row & 7) + 16u * ((ch & 3) ^ ((row >> 2) & 3)); }

#ifdef EXP_MLASEC
#define MSEC(i) do { const unsigned long long t_ = __builtin_amdgcn_s_memrealtime(); macc[i] += t_ - mtm; mtm = t_; } while (0)
#define MSEC_ARGS , unsigned long long (&macc)[8], unsigned long long& mtm
#define MSEC_PASS , macc, mtm
#else
#define MSEC(i)
#define MSEC_ARGS
#define MSEC_PASS
#endif
template <int VAR, bool SAFE> __device__ __forceinline__ bool unit(LAS unsigned char* lds, int qb, int h, const bf16_t* QABS, const bf16_t* KVLAT, bf16_t* PROJ, const bf16_t* WUV, const float* rsq, const float* cosT, const float* sinT, float qscale MSEC_ARGS) {
    const int tid = tidx(), lane = tid & 63, r32 = lane & 31, hi = lane >> 5, wid = __builtin_amdgcn_readfirstlane(tid >> 6), kg = wid >> 2, g = wid & 3;
    const int q0 = qb * 128, qloc = 32 * g + r32, qidx = q0 + qloc;
    bf16x8 qr[12];
    { const bf16_t* qrow = QABS + (size_t)qidx * 768 + h * 192;
#pragma unroll
      for (int d0 = 0; d0 < 12; ++d0) qr[d0] = *(const bf16x8*)(qrow + d0 * 16 + hi * 8);
      const float sc = rsq[qidx] * qscale;
#pragma unroll
      for (int d0 = 0; d0 < 12; ++d0) { const u32x4 w = __builtin_bit_cast(u32x4, qr[d0]);
          float v[8] = {lo_bf(w.x) * sc, hi_bf(w.x) * sc, lo_bf(w.y) * sc, hi_bf(w.y) * sc, lo_bf(w.z) * sc, hi_bf(w.z) * sc, lo_bf(w.w) * sc, hi_bf(w.w) * sc};
          if (d0 >= 8) { const int i0 = (d0 - 8) * 8 + hi * 4; const f32x4 c = *(const f32x4*)(cosT + (size_t)qidx * 32 + i0), s = *(const f32x4*)(sinT + (size_t)qidx * 32 + i0);
#pragma unroll
              for (int jj = 0; jj < 4; ++jj) { const float t1 = v[2 * jj], t2 = v[2 * jj + 1]; v[2 * jj] = t1 * c[jj] - t2 * s[jj]; v[2 * jj + 1] = t1 * s[jj] + t2 * c[jj]; }
              SBAR(); }
          qr[d0] = pack8(v); } }
    SBAR();
    unsigned goff[6];
#pragma unroll
    for (int i = 0; i < 6; ++i) { const unsigned o_ = (unsigned)(wid * 6 + i) * 1024u + lane * 16u; unsigned key, cc;
        if (o_ < (unsigned)R_OFF) { const unsigned r = o_ & 2047u, k7 = (r & 511u) >> 6, x = (r & 63u) >> 4; key = (o_ >> 11) * 8u + k7; cc = (r >> 9) * 4u + (x ^ ((key >> 2) & 3u)); }
        else { const unsigned o2 = o_ - R_OFF, r = o2 & 1023u, k7 = (r & 511u) >> 6, x = (r & 63u) >> 4; key = (o2 >> 10) * 8u + k7; cc = 16u + (r >> 9) * 4u + (x ^ ((key >> 2) & 3u)); }
        goff[i] = (key * 192u + cc * 8u) * 2u; }
#define STAGE_TILE(t_, SB) do { const char* src_ = (const char*)KVLAT + (size_t)(t_) * (128 * 192 * 2); const unsigned la_ = (unsigned)(uintptr_t)lds + (SB) + wid * 6144; \
        _Pragma("unroll") for (int i = 0; i < 6; ++i) asm volatile("s_mov_b32 m0, %0\n\ts_nop 0\n\tglobal_load_lds_dwordx4 %1, %2" :: "s"(la_ + i * 1024), "v"(goff[i]), "s"(src_) : "memory", "m0"); } while (0)
    STAGE_TILE(0, 0);
    if (qb >= 1) STAGE_TILE(1, ST_BYTES);
    const unsigned y = (r32 >> 2) & 3, rowpart = 64u * (r32 & 7);
    const unsigned nb_e = 2048u * (8 * kg + (r32 >> 3)) + rowpart + 16u * ((unsigned)hi ^ y), nb_o = 2048u * (8 * kg + (r32 >> 3)) + rowpart + 16u * ((2u + hi) ^ y);
    const unsigned rb_e = R_OFF + 1024u * (8 * kg + (r32 >> 3)) + rowpart + 16u * ((unsigned)hi ^ y), rb_o = R_OFF + 1024u * (8 * kg + (r32 >> 3)) + rowpart + 16u * ((2u + hi) ^ y);
    const unsigned blk = (lane >> 4) & 1, q_ = (lane & 15) >> 2, p_ = lane & 3, xc = 2u * blk + (p_ >> 1);
    const unsigned tbo0 = 2048u * (8 * kg) + 64u * (4u * hi + q_) + 16u * (xc ^ (unsigned)hi) + 8u * (p_ & 1), tbo1 = 2048u * (8 * kg + 1) + 64u * (4u * hi + q_) + 16u * (xc ^ (2u + hi)) + 8u * (p_ & 1);
    LAS float* scr = (LAS float*)(lds + L_SCR) + wid * 64;
    float m_reg = -1e30f, l_reg = 0.f; f32x16 o[4] = {};
    bf16x8 paX0, paX1, paY0 = {}, paY1 = {};
    f32x16 pA, pB;
#define KADDR(s, hf) ((s) < 8 ? ((((s) & 1) ? no_ : ne_) + 512 * ((s) >> 1) + 8192 * (hf)) : ((((s) & 1) ? ro_ : re_) + 512 * (((s) - 8) >> 1) + 4096 * (hf)))
#define KRD1(dst, s, hf) dst = *(const LAS bf16x8*)KADDR(s, hf)
#define VRD1(L, H, d0, ka) do { L = __builtin_amdgcn_ds_read_tr16_b64_v4i16((LAS s16x4*)(t0a_ + 4096 * (ka) + 512 * (d0))); H = __builtin_amdgcn_ds_read_tr16_b64_v4i16((LAS s16x4*)(t1a_ + 4096 * (ka) + 512 * (d0))); } while (0)
#define VFR(L, H) ((bf16x8){L[0], L[1], L[2], L[3], H[0], H[1], H[2], H[3]})
#define QBASES(SB) const LAS unsigned char* ne_ = lds + (SB) + nb_e; const LAS unsigned char* no_ = lds + (SB) + nb_o; const LAS unsigned char* re_ = lds + (SB) + rb_e; const LAS unsigned char* ro_ = lds + (SB) + rb_o
#define PBASES(SB) LAS unsigned char* t0a_ = lds + (SB) + tbo0; LAS unsigned char* t1a_ = lds + (SB) + tbo1
#define QKQ_SERIAL(PN, SB, hf) do { QBASES(SB); PN = (f32x16){}; _Pragma("unroll") for (int s_ = 0; s_ < 12; ++s_) { bf16x8 k_; KRD1(k_, s_, hf); PN = MFMA32(k_, qr[s_], PN); } } while (0)
#define PVQ_SERIAL(SB, hf, PA0, PA1) do { PBASES(SB); _Pragma("unroll") for (int j_ = 0; j_ < 8; ++j_) { s16x4 l_, h_; VRD1(l_, h_, j_ >> 1, 2 * (hf) + (j_ & 1)); o[j_ >> 1] = MFMA32((j_ & 1) ? PA1 : PA0, VFR(l_, h_), o[j_ >> 1]); } } while (0)
#define ROWMAX16(P, out) do { float a_ = fmaxf(fmaxf(P[0], P[1]), P[2]), b_ = fmaxf(fmaxf(P[3], P[4]), P[5]), c_ = fmaxf(fmaxf(P[6], P[7]), P[8]), d_ = fmaxf(fmaxf(P[9], P[10]), P[11]), e_ = fmaxf(fmaxf(P[12], P[13]), P[14]); \
        a_ = fmaxf(fmaxf(a_, b_), P[15]); c_ = fmaxf(fmaxf(c_, d_), e_); out = fmaxf(a_, c_); } while (0)
#define HALVES_MAX(v) do { auto rr = __builtin_amdgcn_permlane32_swap(__float_as_uint(v), __float_as_uint(v), false, false); v = fmaxf(__uint_as_float(rr[0]), __uint_as_float(rr[1])); } while (0)
#define RESCALE_O(alpha_) do { if (hi == 0) scr[r32] = (alpha_); LDS_WAIT(); \
            _Pragma("unroll") for (int gg = 0; gg < 4; ++gg) { const f32x4 a4 = *(const LAS f32x4*)(scr + 8 * gg + 4 * hi); \
                _Pragma("unroll") for (int d = 0; d < 4; ++d) { o[d][4 * gg + 0] *= a4[0]; o[d][4 * gg + 1] *= a4[1]; o[d][4 * gg + 2] *= a4[2]; o[d][4 * gg + 3] *= a4[3]; } } } while (0)
#define DIAG_MASK() do { const int t2_ = tidx(); int ql_ = 32 * ((t2_ >> 6) & 3) + (t2_ & 31) - 64 * (t2_ >> 8) - 4 * ((t2_ >> 5) & 1); asm volatile("" : "+v"(ql_)); \
        _Pragma("unroll") for (int r = 0; r < 16; ++r) { const int kc_ = (r & 3) + 8 * (r >> 2); if (kc_ > ql_) pA[r] = -__builtin_inff(); if (kc_ + 32 > ql_) pB[r] = -__builtin_inff(); } } while (0)
    asm volatile("s_waitcnt vmcnt(0)" ::: "memory");
    __syncthreads();
    MSEC(0);
    if constexpr (!SAFE) {
#define SMC(i, PC, PE0, PE1) do { if ((i) < 16) { const float e_ = __builtin_amdgcn_exp2f(PC[i]); \
            if (((i) & 3) == 0) l0_ += e_; else if (((i) & 3) == 1) l1_ += e_; else if (((i) & 3) == 2) l2_ += e_; else l3_ += e_; \
            if (((i) & 1) == 0) ev_ = e_; else { const unsigned c_ = cvtpk(ev_, e_); if (((i) >> 1 & 3) == 0) c0_ = c_; else if (((i) >> 1 & 3) == 1) c1_ = c_; else if (((i) >> 1 & 3) == 2) c2_ = c_; else c3_ = c_; } \
            if ((i) == 7) { u32x4 w_ = {c0_, c1_, c2_, c3_}; PE0 = __builtin_bit_cast(bf16x8, w_); } if ((i) == 15) { u32x4 w_ = {c0_, c1_, c2_, c3_}; PE1 = __builtin_bit_cast(bf16x8, w_); } } } while (0)
#define SLOT_ISQ(i) (((i) < 16) ? (((i) & 1) == 0) : true)
#define SLOT_QS(i) (((i) < 16) ? ((i) >> 1) : ((i) - 8))
#define SLOT_PJ(i) ((i) >> 1)
#define RD_SLOT(i, HQ, HP) do { if ((i) < 20) { if (SLOT_ISQ(i)) { if (SLOT_QS(i) % 3 == 0) KRD1(kf0, SLOT_QS(i), HQ); else if (SLOT_QS(i) % 3 == 1) KRD1(kf1, SLOT_QS(i), HQ); else KRD1(kf2, SLOT_QS(i), HQ); } \
        else { if (SLOT_PJ(i) & 1) VRD1(vl1, vh1, SLOT_PJ(i) >> 1, 2 * (HP) + 1); else VRD1(vl0, vh0, SLOT_PJ(i) >> 1, 2 * (HP)); } } } while (0)
#define MM_SLOT(i, PN, PA0, PA1) do { if (SLOT_ISQ(i)) { if (SLOT_QS(i) % 3 == 0) PN = MFMA32(kf0, qr[SLOT_QS(i)], PN); else if (SLOT_QS(i) % 3 == 1) PN = MFMA32(kf1, qr[SLOT_QS(i)], PN); else PN = MFMA32(kf2, qr[SLOT_QS(i)], PN); } \
        else { if (SLOT_PJ(i) & 1) o[(SLOT_PJ(i) >> 1) & 3] = MFMA32(PA1, VFR(vl1, vh1), o[(SLOT_PJ(i) >> 1) & 3]); else o[(SLOT_PJ(i) >> 1) & 3] = MFMA32(PA0, VFR(vl0, vh0), o[(SLOT_PJ(i) >> 1) & 3]); } } while (0)
#define SLOT(i, PN, HQ, HP, PA0, PA1, PC, PE0, PE1) do { MM_SLOT(i, PN, PA0, PA1); RD_SLOT((i) + 2, HQ, HP); if (!(VAR & 2)) SMC(i, PC, PE0, PE1); SBAR(); } while (0)
#define ITER(PN, SBQ, HQ, SBP, HP, PA0, PA1, PC, PE0, PE1) do { QBASES(SBQ); PBASES(SBP); bf16x8 kf0, kf1, kf2; s16x4 vl0, vh0, vl1, vh1; float ev_ = 0.f; unsigned c0_ = 0, c1_ = 0, c2_ = 0, c3_ = 0; \
        PN = (f32x16){}; RD_SLOT(0, HQ, HP); RD_SLOT(1, HQ, HP); SBAR(); \
        SLOT(0, PN, HQ, HP, PA0, PA1, PC, PE0, PE1); SLOT(1, PN, HQ, HP, PA0, PA1, PC, PE0, PE1); SLOT(2, PN, HQ, HP, PA0, PA1, PC, PE0, PE1); SLOT(3, PN, HQ, HP, PA0, PA1, PC, PE0, PE1); \
        SLOT(4, PN, HQ, HP, PA0, PA1, PC, PE0, PE1); SLOT(5, PN, HQ, HP, PA0, PA1, PC, PE0, PE1); SLOT(6, PN, HQ, HP, PA0, PA1, PC, PE0, PE1); SLOT(7, PN, HQ, HP, PA0, PA1, PC, PE0, PE1); \
        SLOT(8, PN, HQ, HP, PA0, PA1, PC, PE0, PE1); SLOT(9, PN, HQ, HP, PA0, PA1, PC, PE0, PE1); SLOT(10, PN, HQ, HP, PA0, PA1, PC, PE0, PE1); SLOT(11, PN, HQ, HP, PA0, PA1, PC, PE0, PE1); \
        SLOT(12, PN, HQ, HP, PA0, PA1, PC, PE0, PE1); SLOT(13, PN, HQ, HP, PA0, PA1, PC, PE0, PE1); SLOT(14, PN, HQ, HP, PA0, PA1, PC, PE0, PE1); SLOT(15, PN, HQ, HP, PA0, PA1, PC, PE0, PE1); \
        SLOT(16, PN, HQ, HP, PA0, PA1, PC, PE0, PE1); SLOT(17, PN, HQ, HP, PA0, PA1, PC, PE0, PE1); SLOT(18, PN, HQ, HP, PA0, PA1, PC, PE0, PE1); SLOT(19, PN, HQ, HP, PA0, PA1, PC, PE0, PE1); } while (0)
    float l0_ = 0.f, l1_ = 0.f, l2_ = 0.f, l3_ = 0.f;
    unsigned s_prev = 2 * ST_BYTES, s_cur = 0, s_next = ST_BYTES;
    QKQ_SERIAL(pA, s_cur, 0);
#pragma unroll 1
    for (int t = 0; t < qb; ++t) {
        { const unsigned sp_ = t ? s_prev : s_cur; ITER(pB, s_cur, 1, sp_, 1, paY0, paY1, pA, paX0, paX1); }
        asm volatile("s_waitcnt vmcnt(0)" ::: "memory");
        if (!(VAR & 16)) __syncthreads();
        if (t + 2 <= qb && !(VAR & 8)) STAGE_TILE(t + 2, s_prev);
        ITER(pA, s_next, 0, s_cur, 0, paX0, paX1, pB, paY0, paY1);
        { const unsigned tmp_ = s_prev; s_prev = s_cur; s_cur = s_next; s_next = tmp_; }
    }
    if (qb > 0) PVQ_SERIAL(s_prev, 1, paY0, paY1);
    QKQ_SERIAL(pB, s_cur, 1);
    DIAG_MASK();
#pragma unroll
    for (int r = 0; r < 16; ++r) { pA[r] = __builtin_amdgcn_exp2f(pA[r]); pB[r] = __builtin_amdgcn_exp2f(pB[r]); l0_ += pA[r]; l1_ += pB[r]; }
    paX0 = pack_step(pA, 0); paX1 = pack_step(pA, 1); paY0 = pack_step(pB, 0); paY1 = pack_step(pB, 1);
    PVQ_SERIAL(s_cur, 0, paX0, paX1);
    PVQ_SERIAL(s_cur, 1, paY0, paY1);
    l_reg = (l0_ + l1_) + (l2_ + l3_); m_reg = 0.f;
#undef SMC
#undef SLOT_ISQ
#undef SLOT_QS
#undef SLOT_PJ
#undef RD_SLOT
#undef MM_SLOT
#undef SLOT
#undef ITER
    } else {
#pragma unroll 1
    for (int t = 0; t <= qb; ++t) {
        __syncthreads();
        STAGE_TILE(t, 0);
        asm volatile("s_waitcnt vmcnt(0)" ::: "memory");
        __syncthreads();
        QKQ_SERIAL(pA, 0, 0); QKQ_SERIAL(pB, 0, 1);
        if (t == qb) DIAG_MASK();
        float pm_, pm2_; ROWMAX16(pA, pm_); ROWMAX16(pB, pm2_); pm_ = fmaxf(pm_, pm2_); HALVES_MAX(pm_);
        const float mn_ = fmaxf(m_reg, pm_), al_ = __builtin_amdgcn_exp2f(m_reg - mn_); m_reg = mn_; float ps_ = 0.f;
#pragma unroll
        for (int r = 0; r < 16; ++r) { pA[r] = __builtin_amdgcn_exp2f(pA[r] - mn_); pB[r] = __builtin_amdgcn_exp2f(pB[r] - mn_); ps_ += pA[r] + pB[r]; }
        l_reg = l_reg * al_ + ps_;
        if (__any(al_ < 1.f)) RESCALE_O(al_);
        paX0 = pack_step(pA, 0); paX1 = pack_step(pA, 1); paY0 = pack_step(pB, 0); paY1 = pack_step(pB, 1);
        PVQ_SERIAL(0, 0, paX0, paX1);
        PVQ_SERIAL(0, 1, paY0, paY1);
    }
    }
    { auto rr = __builtin_amdgcn_permlane32_swap(__float_as_uint(l_reg), __float_as_uint(l_reg), false, false); l_reg = __uint_as_float(rr[0]) + __uint_as_float(rr[1]); }
    if (!(l_reg > 0.f)) m_reg = -1e30f;
    if (tidx() == 0) *(LAS int*)(lds + L_UNIT + 8) = 0;
    __syncthreads();
#undef KADDR
#undef KRD1
#undef VRD1
#undef VFR
#undef QBASES
#undef PBASES
#undef QKQ_SERIAL
#undef PVQ_SERIAL
#undef ROWMAX16
#undef HALVES_MAX
#undef RESCALE_O
#undef DIAG_MASK
    if (VAR != 0) { asm volatile("" :: "v"(o[0]), "v"(o[1]), "v"(o[2]), "v"(o[3]), "v"(m_reg), "v"(l_reg)); return false; }
#undef STAGE_TILE
    const int tid_e = tidx(), lane_e = tid_e & 63; const int wid_e = __builtin_amdgcn_readfirstlane(tid_e >> 6);
#define lane lane_e
#define r32 (lane_e & 31)
#define hi (lane_e >> 5)
#define kg (wid_e >> 2)
#define g (wid_e & 3)
    LAS float* scr_e = (LAS float*)(lds + L_SCR) + wid_e * 64;
#define scr scr_e
    LAS float* xo = (LAS float*)lds + g * 4096;
    LAS float* xm = (LAS float*)(lds + 65536) + g * 128;
    if (kg == 1) {
#pragma unroll
        for (int d0 = 0; d0 < 4; ++d0)
#pragma unroll
            for (int r = 0; r < 16; ++r) xo[(d0 * 16 + r) * 64 + lane] = o[d0][r];
        xm[lane] = m_reg; xm[64 + lane] = l_reg;
    }
    __syncthreads();
    float fA = 0.f, fB = 0.f, li = 0.f;
    if (kg == 0) {
        const float mB = xm[lane], lB = xm[64 + lane];
        const float m = fmaxf(m_reg, mB); fA = __builtin_amdgcn_exp2f(m_reg - m); fB = __builtin_amdgcn_exp2f(mB - m); const float ls = l_reg * fA + lB * fB; li = 1.f / ls;
#ifdef EXP_FORCE_SAFE
        if (!SAFE) *(LAS int*)(lds + L_UNIT + 8) = 1;
#else
        if (!SAFE && !(ls > 7.9e-31f && ls < 1.2e30f)) *(LAS int*)(lds + L_UNIT + 8) = 1;
#endif
    }
    if constexpr (!SAFE) { __syncthreads(); if (*(LAS int*)(lds + L_UNIT + 8)) { __syncthreads(); return true; } }
    if (kg == 0) {
        if (hi == 0) { scr[r32] = fA * li; scr[32 + r32] = fB * li; }
        LDS_WAIT();
        float sA[16], sB[16];
#pragma unroll
        for (int gg = 0; gg < 4; ++gg) { const f32x4 a4 = *(const LAS f32x4*)(scr + 8 * gg + 4 * hi), b4 = *(const LAS f32x4*)(scr + 32 + 8 * gg + 4 * hi);
            sA[4 * gg] = a4[0]; sA[4 * gg + 1] = a4[1]; sA[4 * gg + 2] = a4[2]; sA[4 * gg + 3] = a4[3]; sB[4 * gg] = b4[0]; sB[4 * gg + 1] = b4[1]; sB[4 * gg + 2] = b4[2]; sB[4 * gg + 3] = b4[3]; }
        LAS bf16_t* olt = (LAS bf16_t*)(lds + L_OLT + g * 8704); LAS bf16_t* ot = (LAS bf16_t*)(lds + L_OUT + g * 8704);
#pragma unroll
        for (int d0 = 0; d0 < 4; ++d0) {
#pragma unroll
            for (int r = 0; r < 16; ++r) olt[crow(r, hi) * 136 + d0 * 32 + r32] = f2bf(o[d0][r] * sA[r] + xo[(d0 * 16 + r) * 64 + lane] * sB[r]);
            SBAR(); }
        LDS_WAIT();
        bf16x8 af[8];
#pragma unroll
        for (int ks = 0; ks < 8; ++ks) af[ks] = *(const LAS bf16x8*)(olt + r32 * 136 + 16 * ks + 8 * hi);
        f32x16 y[4] = {};
        const bf16_t* wb = WUV + (size_t)(h * 128 + r32) * 512 + h * 128 + 8 * hi;
#pragma unroll
        for (int c = 0; c < 4; ++c)
#pragma unroll
            for (int ks = 0; ks < 8; ++ks) y[c] = MFMA32(af[ks], *(const bf16x8*)(wb + (size_t)(32 * c) * 512 + 16 * ks), y[c]);
#pragma unroll
        for (int r = 0; r < 16; ++r)
#pragma unroll
            for (int c = 0; c < 4; ++c) ot[crow(r, hi) * 136 + 32 * c + r32] = f2bf(y[c][r]);
        LDS_WAIT();
        bf16_t* zp0 = PROJ + (size_t)(q0 + 32 * g) * NP + C_Z + 1024 + h * 128;
#pragma unroll
        for (int i = 0; i < 8; ++i) { const int id = lane + 64 * i, row = id >> 4, dc = id & 15;
            const u32x4 v = *(const LAS u32x4*)(ot + row * 136 + dc * 8); bf16_t* zp = zp0 + (size_t)row * NP + dc * 8; const u32x4 z = *(const u32x4*)zp;
            u32x4 w; w.x = cvtpk(lo_bf(v.x) * silu_f(lo_bf(z.x)), hi_bf(v.x) * silu_f(hi_bf(z.x))); w.y = cvtpk(lo_bf(v.y) * silu_f(lo_bf(z.y)), hi_bf(v.y) * silu_f(hi_bf(z.y)));
            w.z = cvtpk(lo_bf(v.z) * silu_f(lo_bf(z.z)), hi_bf(v.z) * silu_f(hi_bf(z.z))); w.w = cvtpk(lo_bf(v.w) * silu_f(lo_bf(z.w)), hi_bf(v.w) * silu_f(hi_bf(z.w)));
            *(u32x4*)zp = w; }
    }
    __syncthreads();
    MSEC(6);
#undef lane
#undef r32
#undef hi
#undef kg
#undef g
#undef scr
    return false;
}
__device__ __forceinline__ void run_queue(LAS unsigned char* lds, unsigned* ctr, const bf16_t* QABS, const bf16_t* KVLAT, bf16_t* PROJ, const bf16_t* WUV, const float* rsq, const float* cosT, const float* sinT, float qscale) {
    LAS int* ub = (LAS int*)(lds + L_UNIT);
#ifdef EXP_MLASEC
    unsigned long long macc[8] = {0, 0, 0, 0, 0, 0, 0, 0}, mtm = __builtin_amdgcn_s_memrealtime();
#endif
    for (;;) {
        __syncthreads();
        if (tidx() == 0) *ub = (int)atomicAdd(ctr, 1u);
        __syncthreads();
        const int u = *ub;
        if (u >= 512) break;
        MSEC(7);
        if (unit<0, false>(lds, 127 - (u >> 2), u & 3, QABS, KVLAT, PROJ, WUV, rsq, cosT, sinT, qscale MSEC_PASS)) (void)unit<0, true>(lds, 127 - (u >> 2), u & 3, QABS, KVLAT, PROJ, WUV, rsq, cosT, sinT, qscale MSEC_PASS);
    }
#ifdef EXP_MLAVAR
    for (;;) {
        __syncthreads();
        if (tidx() == 0) *ub = (int)atomicAdd(ctr + 32, 1u);
        __syncthreads();
        const int u = *ub;
        if (u >= 512) break;
        (void)unit<EXP_MLAVAR, false>(lds, 127 - (u >> 2), u & 3, QABS, KVLAT, PROJ, WUV, rsq, cosT, sinT, qscale MSEC_PASS);
    }
#endif
#ifdef EXP_MLASEC
    { const unsigned long long t1_ = __builtin_amdgcn_s_memrealtime(); while (__builtin_amdgcn_s_memrealtime() - t1_ < 4 * macc[EXP_MLASEC]) __builtin_amdgcn_s_sleep(8); }
#endif
}
}
template <class Map>
__device__ __forceinline__ void transpose_tile(const float* W, int ldw, bf16_t* WT, int K, int n0, int k0, LAS float* tile, Map map, int lane) {
    { const int src = map(n0 + lane); float v[64];
#pragma unroll
      for (int k = 0; k < 64; ++k) v[k] = src >= 0 ? W[(size_t)(k0 + k) * ldw + src] : 0.f;
#pragma unroll
      for (int k = 0; k < 64; ++k) tile[k * 65 + lane] = v[k]; }
    LDS_WAIT();
    { const int kc = (lane & 7) * 8;
#pragma unroll
      for (int i = 0; i < 8; ++i) { const int n = (lane >> 3) + 8 * i; float v[8];
#pragma unroll
          for (int j = 0; j < 8; ++j) v[j] = tile[(kc + j) * 65 + n];
          u32x4 w = {cvtpk(v[0], v[1]), cvtpk(v[2], v[3]), cvtpk(v[4], v[5]), cvtpk(v[6], v[7])};
          *(u32x4*)(WT + (size_t)(n0 + n) * K + k0 + kc) = w; } }
    LDS_WAIT();
}
struct MapWin { __device__ int operator()(int n) const { return win_src(n); } };
struct MapId { __device__ int operator()(int n) const { return n; } };

__device__ __forceinline__ void job_win(const Params& p, int l, int gw, int ngw, LAS unsigned char* lds, int wid, int lane) {
    bf16_t* WT = (bf16_t*)(p.ws + WS_WIN); const float* W = p.w_in + (size_t)l * DM * DIN; LAS float* tile = (LAS float*)(lds + wid * 16640);
    for (int t = gw; t < (NP / 64) * (DM / 64); t += ngw) transpose_tile(W, DIN, WT, DM, (t / (DM / 64)) * 64, (t % (DM / 64)) * 64, tile, MapWin(), lane);
}
__device__ __forceinline__ void job_wout(const Params& p, int l, int gw, int ngw, LAS unsigned char* lds, int wid, int lane) {
    bf16_t* WT = (bf16_t*)(p.ws + WS_WOUT); const float* W = p.w_out + (size_t)l * MIXW * DM; LAS float* tile = (LAS float*)(lds + wid * 16640);
    for (int t = gw; t < (DM / 64) * (MIXW / 64); t += ngw) transpose_tile(W, DM, WT, MIXW, (t / (MIXW / 64)) * 64, (t % (MIXW / 64)) * 64, tile, MapId(), lane);
}
__device__ __forceinline__ void job_wmem(const Params& p, int gw, int ngw, LAS unsigned char* lds, int wid, int lane) {
    LAS float* tile = (LAS float*)(lds + wid * 16640);
    for (int t = gw; t < 2 * 16 * 16; t += ngw) { const int l = t >> 8, r = t & 255;
        transpose_tile(p.w_mem + (size_t)l * DM * DM, DM, (bf16_t*)(p.ws + WS_WMEM) + (size_t)l * DM * DM, DM, (r >> 4) * 64, (r & 15) * 64, tile, MapId(), lane); }
}
__device__ __forceinline__ void job_wq(const Params& p, int bid, int nblk, int gtid, int gn, LAS unsigned char* lds) {
    const int tid = tidx(); LAS float* At = (LAS float*)lds; LAS float* Bt = At + 64 * 129;
    for (int it = bid; it < 2 * 4 * 4 * 2; it += nblk) { const int l = it >> 5, h = (it >> 3) & 3, kt = (it >> 1) & 3, ct = it & 1;
        const float* uq = p.w_uq + (size_t)l * 256 * 768 + (size_t)(kt * 64) * 768 + h * 192; const float* ukv = p.w_ukv + (size_t)l * 128 * 1024 + (size_t)(ct * 64) * 1024 + h * 256;
        __syncthreads();
#pragma unroll
        for (int i = 0; i < 16; ++i) { const int e = tid + NT_THREADS * i, r = e >> 7, j = e & 127; At[r * 129 + j] = uq[(size_t)r * 768 + j]; Bt[r * 129 + j] = ukv[(size_t)r * 1024 + j]; }
        __syncthreads();
        const int kk = tid & 63, c0 = (tid >> 6) * 8; float acc[8] = {0.f, 0.f, 0.f, 0.f, 0.f, 0.f, 0.f, 0.f};
#pragma unroll 4
        for (int j = 0; j < 128; ++j) { const float a = At[kk * 129 + j];
#pragma unroll
            for (int e = 0; e < 8; ++e) acc[e] = fmaf(a, Bt[(c0 + e) * 129 + j], acc[e]); }
        const int k = kt * 64 + kk; const float g = p.q_norm[l * 256 + k]; bf16_t* wq = (bf16_t*)(p.ws + WS_WQ) + (size_t)l * 768 * 256;
#pragma unroll
        for (int e = 0; e < 8; ++e) wq[(size_t)(h * 192 + ct * 64 + c0 + e) * 256 + k] = f2bf(acc[e] * g);
    }
    for (int idx = gtid; idx < 2 * 4 * 64 * 256; idx += gn) {
        const int l = idx >> 16, r = idx & 65535, h = r >> 14, w = (r >> 8) & 63, k = r & 255, i = w >> 1, which = w & 1;
        ((bf16_t*)(p.ws + WS_WQ))[(size_t)l * 768 * 256 + (size_t)(h * 192 + 128 + w) * 256 + k] = f2bf(p.w_uq[(size_t)l * 256 * 768 + (size_t)k * 768 + h * 192 + 128 + i + 32 * which] * p.q_norm[l * 256 + k]);
    }
}
__device__ __forceinline__ void job_wuv(const Params& p, int gtid, int gn) {
    for (int idx = gtid; idx < 2 * 512 * 512; idx += gn) {
        const int l = idx / (512 * 512), r = idx % (512 * 512), n = r / 512, k = r % 512, h = n >> 7;
        const float v = (k >> 7) == h ? p.w_ukv[(size_t)l * 128 * 1024 + (size_t)(k & 127) * 1024 + h * 256 + 128 + (n & 127)] : 0.f;
        ((bf16_t*)(p.ws + WS_WUV))[idx] = f2bf(v);
    }
}
__device__ __forceinline__ void job_rope(const Params& p, int gtid, int gn) {
    float* cosT = (float*)(p.ws + WS_COS); float* sinT = (float*)(p.ws + WS_SIN);
    for (int idx = gtid; idx < S * 32; idx += gn) {
        const int s = idx >> 5, i = idx & 31;
        const float angf = (float)p.pos[s] * inv_freq(i);
        const double a = (double)angf; const double kq = __builtin_rint(a * 0.63661977236758134308);
        const double x = (a - kq * 1.5707963267948966192) - kq * 6.123233995736766036e-17;
        const double x2 = x * x;
        const double sn = x * (1.0 + x2 * (-1.0 / 6 + x2 * (1.0 / 120 + x2 * (-1.0 / 5040 + x2 * (1.0 / 362880 + x2 * (-1.0 / 39916800 + x2 * (1.0 / 6227020800.0)))))));
        const double cs = 1.0 + x2 * (-0.5 + x2 * (1.0 / 24 + x2 * (-1.0 / 720 + x2 * (1.0 / 40320 + x2 * (-1.0 / 3628800 + x2 * (1.0 / 479001600.0 + x2 * (-1.0 / 87178291200.0)))))));
        const int q = ((int)kq) & 3;
        const double c = (q == 0) ? cs : (q == 1) ? -sn : (q == 2) ? -cs : sn;
        const double sv = (q == 0) ? sn : (q == 1) ? cs : (q == 2) ? -sn : -cs;
        cosT[idx] = (float)c; sinT[idx] = (float)sv;
    }
}
__device__ __forceinline__ void job_btab(const Params& p, int gtid, int gn) {
    float* bt = (float*)(p.ws + WS_MISC + MISC_BTAB);
    for (int idx = gtid; idx < 129 * 8; idx += gn) { const int d = idx >> 3, h = idx & 7; bt[idx] = p.rel_bias[t5_bucket(d) * 8 + h] * LOG2E; }
}
__device__ __forceinline__ void rms_row_to_bf16(const float* xrow, const float* gain, bf16_t* orow, int lane) {
    f32x4 v[4]; float ss = 0.f;
#pragma unroll
    for (int j = 0; j < 4; ++j) { v[j] = *(const f32x4*)(xrow + 256 * j + 4 * lane); ss += (v[j].x * v[j].x + v[j].y * v[j].y) + (v[j].z * v[j].z + v[j].w * v[j].w); }
    const float rs = rsqrtf(wave_sum(ss) * (1.f / DM) + RMS_EPS);
#pragma unroll
    for (int j = 0; j < 4; ++j) { const f32x4 g = *(const f32x4*)(gain + 256 * j + 4 * lane);
        u32x2 w; w.x = cvtpk(v[j].x * rs * g.x, v[j].y * rs * g.y); w.y = cvtpk(v[j].z * rs * g.z, v[j].w * rs * g.w);
        *(u32x2*)(orow + 256 * j + 4 * lane) = w; }
}
__device__ __forceinline__ void job_memn(const Params& p, int gw, int ngw, int lane) {
    for (int r = gw; r < 2 * MEML; r += ngw) { const int l = r >> 8, m = r & 255;
        rms_row_to_bf16(p.mem + (size_t)m * DM, p.mem_norm + l * DM, (bf16_t*)(p.ws + WS_MEMN) + ((size_t)l * MEML + m) * DM, lane); }
}
__device__ __forceinline__ void job_norm_rows(const Params& p, int mode, int gw, int ngw, int lane) {
    bf16_t* H = (bf16_t*)(p.ws + WS_H); const bf16_t* Y = (const bf16_t*)(p.ws + WS_Y);
    for (int row = gw; row < S; row += ngw) {
        if (mode == 0) { rms_row_to_bf16(p.x + (size_t)row * DM, p.norm_pre, H + (size_t)row * DM, lane); continue; }
        const float* xin = (mode == 1 ? p.x : p.out) + (size_t)row * DM; const float* gpost = p.norm_post + (mode == 1 ? 0 : DM);
        float y[16]; float ss = 0.f;
#pragma unroll
        for (int j = 0; j < 4; ++j) { const u32x2 w = *(const u32x2*)(Y + (size_t)row * DM + 256 * j + 4 * lane);
            y[4 * j] = lo_bf(w.x); y[4 * j + 1] = hi_bf(w.x); y[4 * j + 2] = lo_bf(w.y); y[4 * j + 3] = hi_bf(w.y);
            ss += (y[4 * j] * y[4 * j] + y[4 * j + 1] * y[4 * j + 1]) + (y[4 * j + 2] * y[4 * j + 2] + y[4 * j + 3] * y[4 * j + 3]); }
        const float rs = rsqrtf(wave_sum(ss) * (1.f / DM) + RMS_EPS);
        f32x4 x1[4]; float s2 = 0.f;
#pragma unroll
        for (int j = 0; j < 4; ++j) { const f32x4 xv = *(const f32x4*)(xin + 256 * j + 4 * lane); const f32x4 g = *(const f32x4*)(gpost + 256 * j + 4 * lane);
            x1[j].x = xv.x + y[4 * j] * rs * g.x; x1[j].y = xv.y + y[4 * j + 1] * rs * g.y; x1[j].z = xv.z + y[4 * j + 2] * rs * g.z; x1[j].w = xv.w + y[4 * j + 3] * rs * g.w;
            *(f32x4*)(p.out + (size_t)row * DM + 256 * j + 4 * lane) = x1[j];
            s2 += (x1[j].x * x1[j].x + x1[j].y * x1[j].y) + (x1[j].z * x1[j].z + x1[j].w * x1[j].w); }
        if (mode == 1) { const float r2 = rsqrtf(wave_sum(s2) * (1.f / DM) + RMS_EPS); const float* gpre = p.norm_pre + DM;
#pragma unroll
            for (int j = 0; j < 4; ++j) { const f32x4 g = *(const f32x4*)(gpre + 256 * j + 4 * lane);
                u32x2 w; w.x = cvtpk(x1[j].x * r2 * g.x, x1[j].y * r2 * g.y); w.y = cvtpk(x1[j].z * r2 * g.z, x1[j].w * r2 * g.w);
                *(u32x2*)(H + (size_t)row * DM + 256 * j + 4 * lane) = w; } }
    }
}
__device__ __forceinline__ void job_mla_rows(const Params& p, int l, int gw, int ngw, int lane) {
    const bf16_t* PROJ = (const bf16_t*)(p.ws + WS_PROJ); bf16_t* KV = (bf16_t*)(p.ws + WS_KVLAT); float* RSQ = (float*)(p.ws + WS_MISC + MISC_RSQ);
    const float* cosT = (const float*)(p.ws + WS_COS); const float* sinT = (const float*)(p.ws + WS_SIN);
    const int rs_ = lane >> 4, j = lane & 15;
    for (int row = gw * 4 + rs_; row < S; row += ngw * 4) {
        const bf16_t* pr = PROJ + (size_t)row * NP;
        const u32x4 q0 = *(const u32x4*)(pr + C_CQ + j * 16), q1 = *(const u32x4*)(pr + C_CQ + j * 16 + 8), kv = *(const u32x4*)(pr + C_CKV + j * 8); const u32x2 kr = *(const u32x2*)(pr + C_KR + j * 4);
        f32x4 cs = {0.f, 0.f, 0.f, 0.f}, sn = {0.f, 0.f, 0.f, 0.f}; if (j < 8) { cs = *(const f32x4*)(cosT + (size_t)row * 32 + 4 * j); sn = *(const f32x4*)(sinT + (size_t)row * 32 + 4 * j); }
        float sq = 0.f, sk = 0.f;
        { const unsigned w[8] = {q0.x, q0.y, q0.z, q0.w, q1.x, q1.y, q1.z, q1.w};
#pragma unroll
          for (int e = 0; e < 8; ++e) { const float a = lo_bf(w[e]), b = hi_bf(w[e]); sq += a * a + b * b; } }
        float kvf[8] = {lo_bf(kv.x), hi_bf(kv.x), lo_bf(kv.y), hi_bf(kv.y), lo_bf(kv.z), hi_bf(kv.z), lo_bf(kv.w), hi_bf(kv.w)};
#pragma unroll
        for (int e = 0; e < 8; ++e) sk += kvf[e] * kvf[e];
        sq = row16_sum(sq); sk = row16_sum(sk);
        if (j == 0) RSQ[row] = rsqrtf(sq * (1.f / 256.f) + RMS_EPS);
        { const float rs = rsqrtf(sk * (1.f / 128.f) + RMS_EPS); const float* g = p.kv_norm + l * 128 + j * 8; const f32x4 g0 = *(const f32x4*)g, g1 = *(const f32x4*)(g + 4);
          u32x4 w; w.x = cvtpk(kvf[0] * rs * g0[0], kvf[1] * rs * g0[1]); w.y = cvtpk(kvf[2] * rs * g0[2], kvf[3] * rs * g0[3]); w.z = cvtpk(kvf[4] * rs * g1[0], kvf[5] * rs * g1[1]); w.w = cvtpk(kvf[6] * rs * g1[2], kvf[7] * rs * g1[3]);
          *(u32x4*)(KV + (size_t)row * 192 + j * 8) = w; }
        { const unsigned px = xor8_u(kr.x), py = xor8_u(kr.y);
          if (j < 8) { const float t1[4] = {lo_bf(kr.x), hi_bf(kr.x), lo_bf(kr.y), hi_bf(kr.y)}, t2[4] = {lo_bf(px), hi_bf(px), lo_bf(py), hi_bf(py)};
              u32x4 w; w.x = cvtpk(t1[0] * cs[0] - t2[0] * sn[0], t1[0] * sn[0] + t2[0] * cs[0]); w.y = cvtpk(t1[1] * cs[1] - t2[1] * sn[1], t1[1] * sn[1] + t2[1] * cs[1]);
              w.z = cvtpk(t1[2] * cs[2] - t2[2] * sn[2], t1[2] * sn[2] + t2[2] * cs[2]); w.w = cvtpk(t1[3] * cs[3] - t2[3] * sn[3], t1[3] * sn[3] + t2[3] * cs[3]);
              *(u32x4*)(KV + (size_t)row * 192 + 128 + 8 * j) = w; } }
    }
}
__device__ __forceinline__ void job_gdn_final(const Params& p, int l, int gw, int ngw, int lane, int wid, LAS unsigned char* lds) {
    bf16_t* PROJ = (bf16_t*)(p.ws + WS_PROJ); const bf16_t* U = (const bf16_t*)(p.ws + WS_U);
    LAS bf16_t* T = (LAS bf16_t*)(lds + wid * 17408);
    for (int it2 = gw; it2 < 2048; it2 += ngw) {
        const int it = it2 >> 1, ct = it2 & 1, n = it >> 2, h = it & 3; const bf16_t* ut = U + (size_t)it * 8192 + lane * 4;
#pragma unroll 4
        for (int jj = 0; jj < 16; ++jj) { const int j = 8 * (jj >> 2) + 4 * ct + (jj & 3); const u32x2 w = *(const u32x2*)(ut + j * 256);
            const int g = j & 3, sl = j >> 3, dv = 32 * sl + (lane & 31), c0 = 32 * ct + 8 * g + 4 * (lane >> 5);
            T[(c0 + 0) * 136 + dv] = (bf16_t)(w.x & 0xffffu); T[(c0 + 1) * 136 + dv] = (bf16_t)(w.x >> 16); T[(c0 + 2) * 136 + dv] = (bf16_t)(w.y & 0xffffu); T[(c0 + 3) * 136 + dv] = (bf16_t)(w.y >> 16); }
        LDS_WAIT();
#pragma unroll 2
        for (int i = 0; i < 8; ++i) { const int id = lane + 64 * i, c = 32 * ct + (id >> 4), dc = id & 15;
            const u32x4 v = *(const LAS u32x4*)(T + c * 136 + dc * 8);
            float x[8] = {lo_bf(v.x), hi_bf(v.x), lo_bf(v.y), hi_bf(v.y), lo_bf(v.z), hi_bf(v.z), lo_bf(v.w), hi_bf(v.w)};
            float ss = 0.f;
#pragma unroll
            for (int e = 0; e < 8; ++e) ss += x[e] * x[e];
            ss = row16_sum(ss);
            const float rs = rsqrtf(ss * (1.f / 128.f) + RMS_EPS);
            const float* gn = p.gdn_norm + l * 128 + dc * 8; const f32x4 g0 = *(const f32x4*)gn, g1 = *(const f32x4*)(gn + 4);
            bf16_t* zp = PROJ + (size_t)(n * 64 + c) * NP + C_Z + 512 + h * 128 + dc * 8; const u32x4 z = *(const u32x4*)zp;
            u32x4 o; o.x = cvtpk(x[0] * rs * g0[0] * silu_f(lo_bf(z.x)), x[1] * rs * g0[1] * silu_f(hi_bf(z.x))); o.y = cvtpk(x[2] * rs * g0[2] * silu_f(lo_bf(z.y)), x[3] * rs * g0[3] * silu_f(hi_bf(z.y)));
            o.z = cvtpk(x[4] * rs * g1[0] * silu_f(lo_bf(z.z)), x[5] * rs * g1[1] * silu_f(hi_bf(z.z))); o.w = cvtpk(x[6] * rs * g1[2] * silu_f(lo_bf(z.w)), x[7] * rs * g1[3] * silu_f(hi_bf(z.w)));
            *(u32x4*)zp = o; }
        LDS_WAIT();
    }
}
namespace gdn {
constexpr int L_QH = 0, L_KH = 17408, L_KBGT = 34816, L_KHDT = 53248, L_VBT = 71680, L_LF = 90112, L_TF = 107520, L_MB = 124928, L_GV = 129280, L_END = 130560;
constexpr int QP = 136, TP = 72, LP = 68;
__device__ __forceinline__ bf16_t* frag_ptr(bf16_t* PROJ, int n, int h, int f, int lane) {
    const int seg = 4 * f + (lane >> 4), part = seg >> 6, row = seg & 63;
    return PROJ + (size_t)(n * 64 + row) * NP + C_BQKV + part * 512 + h * 128 + (lane & 15) * 8;
}
__device__ __forceinline__ bf16x8 pack8f(const LAS float* q) { const f32x4 a = *(const LAS f32x4*)q, b = *(const LAS f32x4*)(q + 4); u32x4 w = {cvtpk(a[0], a[1]), cvtpk(a[2], a[3]), cvtpk(b[0], b[1]), cvtpk(b[2], b[3])}; return __builtin_bit_cast(bf16x8, w); }
__device__ __forceinline__ void prep_item(const Params& p, int l, int n, int h, LAS unsigned char* lds) {
    const int tid = tidx(), lane = tid & 63, r32 = lane & 31, hi = lane >> 5, wid = __builtin_amdgcn_readfirstlane(tid >> 6);
    bf16_t* PROJ = (bf16_t*)(p.ws + WS_PROJ); const bf16_t* HALO = (const bf16_t*)(p.ws + WS_HALO);
    bf16_t* AQKg = (bf16_t*)(p.ws + WS_AQK); bf16_t* Ug = (bf16_t*)(p.ws + WS_U); float* EGL = (float*)(p.ws + WS_MISC + MISC_EGL);
    LAS bf16_t* QH = (LAS bf16_t*)(lds + L_QH); LAS bf16_t* KH = (LAS bf16_t*)(lds + L_KH); LAS bf16_t* KBGT = (LAS bf16_t*)(lds + L_KBGT);
    LAS bf16_t* KHDT = (LAS bf16_t*)(lds + L_KHDT); LAS bf16_t* VBT = (LAS bf16_t*)(lds + L_VBT); LAS float* LF = (LAS float*)(lds + L_LF);
    LAS float* TF = (LAS float*)(lds + L_TF); LAS float* MB = (LAS float*)(lds + L_MB); LAS float* GC = (LAS float*)(lds + L_GV); LAS float* BETA = GC + 64; LAS float* EGC = GC + 128; LAS float* EGD = GC + 192;
    const int t0 = n * 64;
    const int g16 = tid & 15, row0 = tid >> 4;
#define S2_LOAD(part, XA, XB, WA, WB) do { const int cb_ = (part) * 512 + h * 128 + g16 * 8; \
        _Pragma("unroll") for (int j = 0; j < 4; ++j) { const int ta_ = t0 + row0 - 3 + j; XA[j] = (u32x4){0u, 0u, 0u, 0u}; \
            if (ta_ >= t0) XA[j] = *(const u32x4*)(PROJ + (size_t)ta_ * NP + C_BQKV + cb_); else if (n > 0) XA[j] = *(const u32x4*)(HALO + ((size_t)(n - 1) * 3 + (ta_ - (t0 - 3))) * 1536 + cb_); \
            XB[j] = *(const u32x4*)(PROJ + (size_t)(t0 + row0 + 29 + j) * NP + C_BQKV + cb_); \
            const float* cw_ = p.conv_w + ((size_t)l * 4 + j) * 1536 + cb_; WA[j] = *(const f32x4*)cw_; WB[j] = *(const f32x4*)(cw_ + 4); } } while (0)
    u32x4 xa[4], xb[4]; f32x4 wa[4], wb[4];
    S2_LOAD(0, xa, xb, wa, wb);
    __syncthreads();
    if (wid == 0) {
        const bf16_t* pr = PROJ + (size_t)(t0 + lane) * NP;
        const float xa_ = bf2f(pr[C_BA + h]) + p.dt_bias[l * 4 + h], xb_ = bf2f(pr[C_BB + h]);
        const float e = __expf(xa_); const float sp = xa_ > 20.f ? xa_ : (e < 1e-3f ? e * (1.f - e * (0.5f - e * (1.f / 3.f))) : logf(1.f + e));
        float gc = -__expf(p.a_log[l * 4 + h]) * sp;
#pragma unroll
        for (int o = 1; o < 64; o <<= 1) { const float t_ = __int_as_float(__builtin_amdgcn_ds_bpermute((lane - o) << 2, __float_as_int(gc))); if (lane >= o) gc += t_; }
        const float gl = __int_as_float(__builtin_amdgcn_readlane(__float_as_int(gc), 63));
        GC[lane] = gc; BETA[lane] = 1.f / (1.f + __expf(-xb_)); EGC[lane] = __expf(gc); EGD[lane] = __expf(gl - gc);
        if (lane == 0) EGL[n * 4 + h] = __expf(gl);
    }
    __syncthreads();
#define TSW(dk, j) ((dk) * 64 + (((((j) >> 3) ^ (((dk) >> 3) & 7)) << 3) | ((j) & 7)))
#define S2_ITEM(part, X, W0, W1, row) do { float a[8] = {0.f, 0.f, 0.f, 0.f, 0.f, 0.f, 0.f, 0.f}; \
        _Pragma("unroll") for (int j = 0; j < 4; ++j) { a[0] = fmaf(W0[j][0], lo_bf(X[j].x), a[0]); a[1] = fmaf(W0[j][1], hi_bf(X[j].x), a[1]); a[2] = fmaf(W0[j][2], lo_bf(X[j].y), a[2]); a[3] = fmaf(W0[j][3], hi_bf(X[j].y), a[3]); \
            a[4] = fmaf(W1[j][0], lo_bf(X[j].z), a[4]); a[5] = fmaf(W1[j][1], hi_bf(X[j].z), a[5]); a[6] = fmaf(W1[j][2], lo_bf(X[j].w), a[6]); a[7] = fmaf(W1[j][3], hi_bf(X[j].w), a[7]); } \
        float ss = 0.f; _Pragma("unroll") for (int e = 0; e < 8; ++e) { a[e] = silu_f(a[e]); ss += a[e] * a[e]; } \
        ss = row16_sum(ss); const float rn = rsqrtf(ss + 1e-6f); \
        if ((part) == 0) { const float sc = rn * 0.08838834764831845f; _Pragma("unroll") for (int e = 0; e < 8; ++e) a[e] *= sc; *(LAS bf16x8*)(QH + (row) * QP + g16 * 8) = pack8(a); } \
        else if ((part) == 1) { _Pragma("unroll") for (int e = 0; e < 8; ++e) a[e] *= rn; *(LAS bf16x8*)(KH + (row) * QP + g16 * 8) = pack8(a); const float s1 = BETA[row] * EGC[row], s2 = EGD[row]; \
            _Pragma("unroll") for (int e = 0; e < 8; ++e) { KBGT[TSW(g16 * 8 + e, row)] = f2bf(a[e] * s1); KHDT[TSW(g16 * 8 + e, row)] = f2bf(a[e] * s2); } } \
        else { const float b = BETA[row]; _Pragma("unroll") for (int e = 0; e < 8; ++e) VBT[TSW(g16 * 8 + e, row)] = f2bf(a[e] * b); } } while (0)
#ifdef EXP_DUPS2
#pragma unroll 1
    for (int rep_ = 0; rep_ < 2; ++rep_)
#endif
    { u32x4 ya[4], yb[4]; f32x4 va[4], vb[4];
      S2_LOAD(1, ya, yb, va, vb);
      S2_ITEM(0, xa, wa, wb, row0); S2_ITEM(0, xb, wa, wb, row0 + 32);
      S2_LOAD(2, xa, xb, wa, wb);
      S2_ITEM(1, ya, va, vb, row0); S2_ITEM(1, yb, va, vb, row0 + 32);
      S2_ITEM(2, xa, wa, wb, row0); S2_ITEM(2, xb, wa, wb, row0 + 32); }
#undef S2_LOAD
#undef S2_ITEM
    __syncthreads();
    if (wid < 3) { const int it = wid > 0, jt = wid > 1; f32x16 acc = {};
#pragma unroll
        for (int ks = 0; ks < 8; ++ks) { const bf16x8 a = *(const LAS bf16x8*)(KH + (32 * it + r32) * QP + 16 * ks + 8 * hi), b = *(const LAS bf16x8*)(KH + (32 * jt + r32) * QP + 16 * ks + 8 * hi);
            acc = MFMA32(a, b, acc); }
        const int j = 32 * jt + r32; const float gj = GC[j];
#pragma unroll
        for (int r = 0; r < 16; ++r) { const int i = 32 * it + crow(r, hi); LF[i * LP + j] = i > j ? BETA[i] * __expf(GC[i] - gj) * acc[r] : 0.f; }
    } else if (wid < 6) { const int w = wid - 3, ctp = w > 1, ct = w > 0; f32x16 acc = {};
#pragma unroll
        for (int ks = 0; ks < 8; ++ks) { const bf16x8 a = *(const LAS bf16x8*)(KH + (32 * ctp + r32) * QP + 16 * ks + 8 * hi), b = *(const LAS bf16x8*)(QH + (32 * ct + r32) * QP + 16 * ks + 8 * hi);
            acc = MFMA32(a, b, acc); }
        const int c = 32 * ct + r32; const float gcq = GC[c];
#pragma unroll
        for (int r = 0; r < 16; ++r) { const int cp = 32 * ctp + crow(r, hi); acc[r] = c >= cp ? acc[r] * __expf(gcq - GC[cp]) : 0.f; }
        bf16_t* dst = AQKg + (((size_t)(n * 4 + h) * 8 + (ct * 2 + ctp) * 2) * 64 + lane) * 8;
        *(bf16x8*)dst = pack_step(acc, 0); *(bf16x8*)(dst + 512) = pack_step(acc, 1);
    } else { const int w = wid - 6;
        if (w == 0) { const bf16x8 z = {0, 0, 0, 0, 0, 0, 0, 0}; bf16_t* dst = AQKg + (((size_t)(n * 4 + h) * 8 + 2) * 64 + lane) * 8; *(bf16x8*)dst = z; *(bf16x8*)(dst + 512) = z; }
#pragma unroll
        for (int ff = 0; ff < 8; ++ff) { const int f = w * 8 + ff, s = f & 1, mt = (f >> 1) & 3, ct = f >> 3, c = 32 * ct + r32, d0 = 32 * mt + 16 * s + 4 * hi; const float eg = EGC[c];
            const u32x2 lo = *(const LAS u32x2*)(QH + c * QP + d0), hw = *(const LAS u32x2*)(QH + c * QP + d0 + 8);
            u32x4 o; o.x = cvtpk(lo_bf(lo.x) * eg, hi_bf(lo.x) * eg); o.y = cvtpk(lo_bf(lo.y) * eg, hi_bf(lo.y) * eg); o.z = cvtpk(lo_bf(hw.x) * eg, hi_bf(hw.x) * eg); o.w = cvtpk(lo_bf(hw.y) * eg, hi_bf(hw.y) * eg);
            *(u32x4*)frag_ptr(PROJ, n, h, 16 + f, lane) = o; }
    }
    __syncthreads();
    if (wid == 0) {
#ifdef EXP_DUPS4
#pragma unroll 1
      for (int rep_ = 0; rep_ < 2; ++rep_)
#endif
      {
        unsigned lfb = (unsigned)(uintptr_t)LF, tfb = (unsigned)(uintptr_t)TF, mbb = (unsigned)(uintptr_t)MB; asm volatile("" : "+v"(lfb), "+v"(tfb), "+v"(mbb));
        const LAS float* LFv = (const LAS float*)(uintptr_t)lfb; LAS float* TFv = (LAS float*)(uintptr_t)tfb; LAS float* MBv = (LAS float*)(uintptr_t)mbb;
        { const int b = lane >> 4, c = lane & 15; const LAS float* Lb = LFv + (16 * b) * LP + 16 * b; LAS float* Tb = TFv + (16 * b) * LP + 16 * b + c; float t[16];
#pragma unroll
          for (int i = 0; i < 16; ++i) { float a0 = (c == i) ? 1.f : 0.f, a1 = 0.f;
#pragma unroll
              for (int q = 0; 4 * q < i; ++q) { const f32x4 lv = *(const LAS f32x4*)(Lb + i * LP + 4 * q);
#pragma unroll
                  for (int e = 0; e < 4; ++e) if (4 * q + e < i) { if (e & 1) a1 = fmaf(-lv[e], t[4 * q + e], a1); else a0 = fmaf(-lv[e], t[4 * q + e], a0); } }
              t[i] = a0 + a1; Tb[i * LP] = t[i]; } }
        const int r16 = lane & 15, k4 = lane >> 4;
#define BLK(P, b_, a_) ((P) + (16 * (b_)) * LP + 16 * (a_))
#define MM16(acc, X, Y) do { _Pragma("unroll") for (int ks = 0; ks < 4; ++ks) acc = __builtin_amdgcn_mfma_f32_16x16x4f32((X)[r16 * LP + 4 * ks + k4], (Y)[(4 * ks + k4) * LP + r16], acc, 0, 0, 0); } while (0)
#define ST16(Z, acc, sg) do { _Pragma("unroll") for (int r = 0; r < 4; ++r) (Z)[(4 * k4 + r) * LP + r16] = (sg) * acc[r]; } while (0)
#define TBLK(b_, a_, SUM) do { f32x4 m_ = {0.f, 0.f, 0.f, 0.f}; SUM; ST16(MBv, m_, 1.f); f32x4 t_ = {0.f, 0.f, 0.f, 0.f}; MM16(t_, BLK(TFv, b_, b_), MBv); ST16(BLK(TFv, b_, a_), t_, -1.f); } while (0)
        TBLK(1, 0, MM16(m_, BLK(LFv, 1, 0), BLK(TFv, 0, 0)));
        TBLK(2, 1, MM16(m_, BLK(LFv, 2, 1), BLK(TFv, 1, 1)));
        TBLK(3, 2, MM16(m_, BLK(LFv, 3, 2), BLK(TFv, 2, 2)));
        TBLK(2, 0, MM16(m_, BLK(LFv, 2, 0), BLK(TFv, 0, 0)); MM16(m_, BLK(LFv, 2, 1), BLK(TFv, 1, 0)));
        TBLK(3, 1, MM16(m_, BLK(LFv, 3, 1), BLK(TFv, 1, 1)); MM16(m_, BLK(LFv, 3, 2), BLK(TFv, 2, 1)));
        TBLK(3, 0, MM16(m_, BLK(LFv, 3, 0), BLK(TFv, 0, 0)); MM16(m_, BLK(LFv, 3, 1), BLK(TFv, 1, 0)); MM16(m_, BLK(LFv, 3, 2), BLK(TFv, 2, 0)));
#undef BLK
#undef MM16
#undef ST16
#undef TBLK
      }
    } else {
        if (wid == 1) {
#pragma unroll
            for (int i = 0; i < 24; ++i) { const int id = lane + 64 * i, blk = id >> 8, rr = (id >> 4) & 15, cc = id & 15;
                const int b = blk < 3 ? 0 : (blk < 5 ? 1 : 2), a = blk < 3 ? blk + 1 : (blk < 5 ? blk - 1 : 3);
                TF[(16 * b + rr) * LP + 16 * a + cc] = 0.f; }
        }
        for (int f = wid - 1; f < 16; f += 7) { const int s = f & 1, ctp = (f >> 1) & 1, mt = f >> 2, dk = 32 * mt + r32, c0 = 32 * ctp + 16 * s + 4 * hi;
            const u32x2 lo = *(const LAS u32x2*)(KHDT + TSW(dk, c0)), hw = *(const LAS u32x2*)(KHDT + TSW(dk, c0 + 8));
            u32x4 o = {lo.x, lo.y, hw.x, hw.y}; *(u32x4*)frag_ptr(PROJ, n, h, 32 + f, lane) = o; }
    }
    __syncthreads();
    { const int mt = wid >> 1, ct = wid & 1; f32x16 acc = {};
#pragma unroll
      for (int ks = 0; ks < 4; ++ks) { const bf16x8 a = *(const LAS bf16x8*)(KBGT + TSW(32 * mt + r32, 16 * ks + 8 * hi)), b = pack8f(TF + (32 * ct + r32) * LP + 16 * ks + 8 * hi);
          acc = MFMA32(a, b, acc); }
#pragma unroll
      for (int r = 0; r < 16; ++r) acc[r] = -acc[r];
      *(bf16x8*)frag_ptr(PROJ, n, h, (ct * 4 + mt) * 2, lane) = pack_step(acc, 0); *(bf16x8*)frag_ptr(PROJ, n, h, (ct * 4 + mt) * 2 + 1, lane) = pack_step(acc, 1); }
    { const int ct = wid >> 2, dt = wid & 3; f32x16 acc = {};
#pragma unroll
      for (int ks = 0; ks < 4; ++ks) { const bf16x8 a = pack8f(TF + (32 * ct + r32) * LP + 16 * ks + 8 * hi), b = *(const LAS bf16x8*)(VBT + TSW(32 * dt + r32, 16 * ks + 8 * hi));
          acc = MFMA32(a, b, acc); }
      bf16_t* up = Ug + (size_t)(n * 4 + h) * 8192 + (size_t)((dt * 2 + ct) * 4) * 256 + lane * 4;
#pragma unroll
      for (int g = 0; g < 4; ++g) { u32x2 w; w.x = cvtpk(acc[4 * g], acc[4 * g + 1]); w.y = cvtpk(acc[4 * g + 2], acc[4 * g + 3]); *(u32x2*)(up + g * 256) = w; } }
}
constexpr int SCAN_STAGE = 65536, SCAN_U = 57344, SCAN_EGL = 131072, SCAN_NP = 16;
__device__ __forceinline__ const u32x4* scan_src(const bf16_t* PROJ, const bf16_t* AQKg, const bf16_t* Ug, int n, int h, int half, int k, int ll) {
    if (k < 12) { const int piece = k * 256 + ll; return (const u32x4*)frag_ptr((bf16_t*)PROJ, n, h, piece >> 6, piece & 63); }
    if (k < 14) return (const u32x4*)(AQKg + ((size_t)(n * 4 + h) * 512 + (k - 12) * 256 + ll) * 8);
    return (const u32x4*)(Ug + (size_t)(n * 4 + h) * 8192 + half * 4096 + (size_t)((k - 14) * 256 + ll) * 8);
}
constexpr int SCAN_XCH = 131584, SCAN_XCH_SLICE = 12288;
template <int ROLE>
__device__ __forceinline__ void scan_compute(LAS unsigned char* lds, bf16_t* ub  , int sp, int lane) {
    constexpr int NCH = S / 64;
    LAS unsigned char* xs = lds + SCAN_XCH + sp * SCAN_XCH_SLICE + lane * 16;
    LAS unsigned char* xv = xs + 8192;
    f32x16 St[2] = {};
    bf16x8 Sb[4][2];
#pragma unroll
    for (int mt = 0; mt < 4; ++mt) { Sb[mt][0] = (bf16x8){0, 0, 0, 0, 0, 0, 0, 0}; Sb[mt][1] = Sb[mt][0]; }
    __syncthreads();
#ifdef EXP_SCANSEC
    unsigned long long acc_s[4] = {0, 0, 0, 0}, tm_ = __builtin_amdgcn_s_memrealtime();
#define SEC(i) do { const unsigned long long t_ = __builtin_amdgcn_s_memrealtime(); acc_s[i] += t_ - tm_; tm_ = t_; } while (0)
#else
#define SEC(i)
#endif
#pragma unroll 1
    for (int n = 0; n < NCH; ++n) {
        const LAS unsigned char* stg = lds + (n & 1) * SCAN_STAGE + lane * 16;
        const LAS unsigned char* us = lds + (n & 1) * SCAN_STAGE + SCAN_U + (sp * 8 + ROLE * 4) * 512 + lane * 8;
        const float egl = *(const LAS float*)(lds + SCAN_EGL + (n & 1) * 4);
        f32x16 vn, o = {};
#pragma unroll
        for (int g = 0; g < 4; ++g) { const u32x2 w = *(const LAS u32x2*)(us + g * 512); vn[4 * g] = lo_bf(w.x); vn[4 * g + 1] = hi_bf(w.x); vn[4 * g + 2] = lo_bf(w.y); vn[4 * g + 3] = hi_bf(w.y); }
        if (n > 0) {
#pragma unroll
            for (int j = 0; j < 2; ++j) { Sb[2 * (1 - ROLE) + j][0] = *(const LAS bf16x8*)(xs + ((2 * (1 - ROLE) + j) * 2) * 1024); Sb[2 * (1 - ROLE) + j][1] = *(const LAS bf16x8*)(xs + ((2 * (1 - ROLE) + j) * 2 + 1) * 1024); }
        }
#define FR(f) (*(const LAS bf16x8*)(stg + (f) * 1024))
#define RD1(B, mt) do { const int f_ = (ROLE * 4 + (mt)) * 2; B[0] = FR(f_); B[1] = FR(f_ + 1); B[2] = FR(16 + f_); B[3] = FR(16 + f_ + 1); } while (0)
#define MM1(B, mt) do { vn = MFMA32(B[0], Sb[mt][0], vn); o = MFMA32(B[2], Sb[mt][0], o); vn = MFMA32(B[1], Sb[mt][1], vn); o = MFMA32(B[3], Sb[mt][1], o); } while (0)
        bf16x8 fa[4], fb[4];
        RD1(fa, 0); RD1(fb, 1); SBAR();
        MM1(fa, 0); SBAR(); RD1(fa, 2); SBAR();
        MM1(fb, 1); SBAR(); RD1(fb, 3); SBAR();
        MM1(fa, 2); SBAR();
        bf16x8 kd[2][4];
#pragma unroll
        for (int j = 0; j < 2; ++j)
#pragma unroll
            for (int q = 0; q < 4; ++q) kd[j][q] = FR(32 + ((2 * ROLE + j) * 2) * 2 + q);
        SBAR(); MM1(fb, 3); SBAR();
#pragma unroll
        for (int j = 0; j < 2; ++j)
#pragma unroll
            for (int r = 0; r < 16; ++r) St[j][r] *= egl;
        bf16x8 Vb[2][2];
        Vb[ROLE][0] = pack_step(vn, 0); Vb[ROLE][1] = pack_step(vn, 1);
        *(LAS bf16x8*)(xv + (ROLE * 2) * 1024) = Vb[ROLE][0]; *(LAS bf16x8*)(xv + (ROLE * 2 + 1) * 1024) = Vb[ROLE][1];
        bf16x8 aq[4];
        if (ROLE == 0) { aq[0] = FR(48); aq[1] = FR(49); } else { aq[0] = FR(52); aq[1] = FR(53); aq[2] = FR(54); aq[3] = FR(55); }
        SEC(0);
        __syncthreads();
        SEC(1);
        Vb[1 - ROLE][0] = *(const LAS bf16x8*)(xv + ((1 - ROLE) * 2) * 1024); Vb[1 - ROLE][1] = *(const LAS bf16x8*)(xv + ((1 - ROLE) * 2 + 1) * 1024);
#pragma unroll
        for (int ctp = 0; ctp < 2; ++ctp)
#pragma unroll
            for (int s = 0; s < 2; ++s) {
                St[0] = MFMA32(kd[0][ctp * 2 + s], Vb[ctp][s], St[0]); St[1] = MFMA32(kd[1][ctp * 2 + s], Vb[ctp][s], St[1]);
                if (ROLE == 1) o = MFMA32(aq[ctp * 2 + s], Vb[ctp][s], o); else if (ctp == 0) o = MFMA32(aq[s], Vb[0][s], o);
            }
        { bf16_t* uc = ub + (size_t)n * (4 * 8192);
#pragma unroll
          for (int g = 0; g < 4; ++g) { u32x2 w; w.x = cvtpk(o[4 * g], o[4 * g + 1]); w.y = cvtpk(o[4 * g + 2], o[4 * g + 3]); *(u32x2*)(uc + g * 256) = w; } }
#pragma unroll
        for (int j = 0; j < 2; ++j) { Sb[2 * ROLE + j][0] = pack_step(St[j], 0); Sb[2 * ROLE + j][1] = pack_step(St[j], 1);
            *(LAS bf16x8*)(xs + ((2 * ROLE + j) * 2) * 1024) = Sb[2 * ROLE + j][0]; *(LAS bf16x8*)(xs + ((2 * ROLE + j) * 2 + 1) * 1024) = Sb[2 * ROLE + j][1]; }
#undef FR
#undef RD1
#undef MM1
        SEC(2);
        __syncthreads();
        SEC(3);
    }
#ifdef EXP_SCANSEC
    { const unsigned long long t1_ = __builtin_amdgcn_s_memrealtime(); while (__builtin_amdgcn_s_memrealtime() - t1_ < 4 * acc_s[EXP_SCANSEC]) __builtin_amdgcn_s_sleep(8); }
#endif
#undef SEC
}
__device__ __forceinline__ void scan_wg(const Params& p, int h, int half, LAS unsigned char* lds) {
    const int tid = tidx(), lane = tid & 63, wid = __builtin_amdgcn_readfirstlane(tid >> 6);
    const bf16_t* PROJ = (const bf16_t*)(p.ws + WS_PROJ); const bf16_t* AQKg = (const bf16_t*)(p.ws + WS_AQK); bf16_t* Ug = (bf16_t*)(p.ws + WS_U); const float* EGL = (const float*)(p.ws + WS_MISC + MISC_EGL);
    constexpr int NCH = S / 64;
    __syncthreads();
    if (wid >= 4) {
        const int ll = tid - 256; u32x4 sa[SCAN_NP], sb[SCAN_NP]; float ea, eb;
        const char* pf0 = (const char*)(PROJ + (size_t)(ll >> 4) * NP + C_BQKV + h * 128 + (ll & 15) * 8); const char* pa0 = (const char*)(AQKg + ((size_t)h * 512 + ll) * 8); const char* pu0 = (const char*)(Ug + (size_t)h * 8192 + half * 4096 + (size_t)ll * 8);
#define LD_H0(R, n_) do { const char* pf_ = pf0 + (size_t)(n_) * (64 * NP * 2); SBAR(); _Pragma("unroll") for (int k = 0; k < 8; ++k) R[k] = *(const u32x4*)(pf_ + (size_t)(k & 3) * (16 * NP * 2) + (k >> 2) * 1024); SBAR(); } while (0)
#define LD_H1(R, E, n_) do { E = EGL[(n_) * 4 + h]; const char* pf_ = pf0 + (size_t)(n_) * (64 * NP * 2); const char* pa_ = pa0 + (size_t)(n_) * (4 * 512 * 16); const char* pu_ = pu0 + (size_t)(n_) * (4 * 8192 * 2); SBAR(); \
        _Pragma("unroll") for (int k = 8; k < 12; ++k) R[k] = *(const u32x4*)(pf_ + (size_t)(k & 3) * (16 * NP * 2) + (k >> 2) * 1024); SBAR(); \
        R[12] = *(const u32x4*)pa_; R[13] = *(const u32x4*)(pa_ + 4096); R[14] = *(const u32x4*)pu_; R[15] = *(const u32x4*)(pu_ + 4096); SBAR(); } while (0)
#define WR_H0(R, n_) do { _Pragma("unroll") for (int k = 0; k < 8; ++k) *(LAS u32x4*)(lds + ((n_) & 1) * SCAN_STAGE + (k * 256 + ll) * 16) = R[k]; } while (0)
#define WR_H1(R, E, n_) do { *(LAS float*)(lds + SCAN_EGL + ((n_) & 1) * 4) = E; _Pragma("unroll") for (int k = 8; k < SCAN_NP; ++k) *(LAS u32x4*)(lds + ((n_) & 1) * SCAN_STAGE + (k * 256 + ll) * 16) = R[k]; } while (0)
#define LSTEP(R, E, n_) do { WR_H0(R, (n_) + 1); if ((n_) + 3 < NCH) LD_H0(R, (n_) + 3); __syncthreads(); WR_H1(R, E, (n_) + 1); if ((n_) + 3 < NCH) LD_H1(R, E, (n_) + 3); __syncthreads(); } while (0)
        LD_H0(sa, 0); LD_H1(sa, ea, 0); WR_H0(sa, 0); WR_H1(sa, ea, 0); LD_H0(sa, 1); LD_H1(sa, ea, 1); LD_H0(sb, 2); LD_H1(sb, eb, 2);
        __syncthreads();
#pragma unroll 1
        for (int n = 0; n < NCH - 2; n += 2) { LSTEP(sa, ea, n); LSTEP(sb, eb, n + 1); }
        WR_H0(sa, NCH - 1); __syncthreads(); WR_H1(sa, ea, NCH - 1); __syncthreads();
        __syncthreads(); __syncthreads();
#undef LSTEP
#undef LD_H0
#undef LD_H1
#undef WR_H0
#undef WR_H1
    } else {
        const int sp = wid >> 1, role = wid & 1, sl = 2 * half + sp;
        bf16_t* ub = Ug + (size_t)h * 8192 + (size_t)(sl * 8 + role * 4) * 256 + lane * 4;
        if (role == 0) scan_compute<0>(lds, ub, sp, lane); else scan_compute<1>(lds, ub, sp, lane);
    }
}
}
typedef __attribute__((address_space(1))) unsigned gu32;
#define XB_TMO      128
#define XB_XCNT(j)  (256  + 64 * (j))
#define XB_XSUB(j)  (1280 + 64 * (j))
#define XB_XGEN(j)  (2304 + 64 * (j))
#define XB_TOP      3328
#define XB_TOPGEN   3392
#define XCD_BAR_WORDS 3456
#define XB_SPIN_CAP (1u << 18)

__device__ __forceinline__ unsigned xb_ld(unsigned* p)              { return __hip_atomic_load(p, __ATOMIC_RELAXED, __HIP_MEMORY_SCOPE_AGENT); }
__device__ __forceinline__ unsigned xb_add(unsigned* p, unsigned v) { return __hip_atomic_fetch_add(p, v, __ATOMIC_RELAXED, __HIP_MEMORY_SCOPE_AGENT); }
__device__ __forceinline__ unsigned xb_xcc_id() { return (unsigned)__builtin_amdgcn_s_getreg((3 << 11) | 20) & 0xFu; }
#define XB_SPIN(cond, bar) do { unsigned _sp = 0; while (cond) { __builtin_amdgcn_s_sleep(1); \
    if ((++_sp & 255u) == 0u) { if (xb_ld(&(bar)[XB_TMO])) break; if (_sp > XB_SPIN_CAP) { atomicAdd(&(bar)[XB_TMO], 1u); break; } } } } while (0)

struct XcdBarrier {
    unsigned* bar; unsigned x;
    volatile LAS unsigned* st;
};

__device__ __forceinline__ XcdBarrier xcd_barrier_post(unsigned* bar, volatile LAS unsigned* st) {
    XcdBarrier b; b.bar = bar; b.x = xb_xcc_id(); b.st = st;
    if (tidx() == 0) (void)xb_add(&bar[XB_XCNT(b.x)], 1u);
    return b;
}
__device__ __forceinline__ void xcd_barrier_complete(unsigned* bar, unsigned x, unsigned& nloc, unsigned& nx) {
    const unsigned G = gridDim.x * gridDim.y * gridDim.z;
    unsigned sum, cnt, mine, sp = 0u;
    for (;;) {
        sum = 0u; cnt = 0u; mine = 0u;
#pragma unroll
        for (unsigned j = 0; j < 16; ++j) { const unsigned c = xb_ld(&bar[XB_XCNT(j)]); sum += c; cnt += (c > 0u) ? 1u : 0u; mine = (j == x) ? c : mine; }
        if (sum == G) break;
        __builtin_amdgcn_s_sleep(1);
        if ((++sp & 255u) == 0u) { if (xb_ld(&bar[XB_TMO])) break; if (sp > XB_SPIN_CAP) { atomicAdd(&bar[XB_TMO], 1u); break; } }
    }
    nloc = mine > 0u ? mine : 1u; nx = cnt > 0u ? cnt : 1u;
}

__device__ __forceinline__ void xcd_barrier(const XcdBarrier& b) {
    asm volatile("s_waitcnt vmcnt(0)" ::: "memory");
    __syncthreads();
    if (tidx() == 0) {
        unsigned* bar = b.bar;
        __builtin_amdgcn_s_waitcnt(0);
        unsigned nloc = b.st[0], nx = b.st[1];
        if (nloc == 0u) { xcd_barrier_complete(bar, b.x, nloc, nx); b.st[0] = nloc; b.st[1] = nx; }
        const unsigned old = xb_add(&bar[XB_XSUB(b.x)], 1u);
        const unsigned gen = old / nloc;
        if (old + 1u == (gen + 1u) * nloc) {
            __builtin_amdgcn_fence(__ATOMIC_RELEASE, "agent");
            asm volatile("s_waitcnt vmcnt(0)" ::: "memory");
            const unsigned og = xb_add(&bar[XB_TOP], 1u);
            const unsigned tg = og / nx;
            if (og + 1u == (tg + 1u) * nx) xb_add(&bar[XB_TOPGEN], 1u);
            else XB_SPIN(xb_ld(&bar[XB_TOPGEN]) == tg, bar);
            __builtin_amdgcn_fence(__ATOMIC_ACQUIRE, "agent");
            xb_add(&bar[XB_XGEN(b.x)], 1u);
            asm volatile("s_waitcnt vmcnt(0)" ::: "memory");
        } else {
            XB_SPIN(xb_ld(&bar[XB_XGEN(b.x)]) == gen, bar);
            __builtin_amdgcn_fence(__ATOMIC_ACQUIRE, "agent");
            asm volatile("s_waitcnt vmcnt(0)" ::: "memory");
        }
    }
    __syncthreads();
}


constexpr int N_PHASES = 2 + 7 * DEPTH;
constexpr int SCAN_WGS = 8;
constexpr float QSCALE = 0.07216878364870322f * LOG2E;

__device__ __forceinline__ void sub_barrier(unsigned* ctr, unsigned expected, bool arrive) {
    asm volatile("s_waitcnt vmcnt(0)" ::: "memory"); __syncthreads();
    if (tidx() == 0) {
        if (arrive) { __builtin_amdgcn_fence(__ATOMIC_RELEASE, "agent"); asm volatile("s_waitcnt vmcnt(0)" ::: "memory"); (void)__hip_atomic_fetch_add(ctr, 1u, __ATOMIC_RELAXED, __HIP_MEMORY_SCOPE_AGENT); }
        unsigned sp = 0; while (__hip_atomic_load(ctr, __ATOMIC_RELAXED, __HIP_MEMORY_SCOPE_AGENT) < expected) { __builtin_amdgcn_s_sleep(2); if (++sp > (1u << 22)) break; }
        __builtin_amdgcn_fence(__ATOMIC_ACQUIRE, "agent"); asm volatile("s_waitcnt vmcnt(0)" ::: "memory");
    }
    __syncthreads();
}
__device__ __forceinline__ void sub_arrive(unsigned* ctr) {
    asm volatile("s_waitcnt vmcnt(0)" ::: "memory"); __syncthreads();
    if (tidx() == 0) { __builtin_amdgcn_fence(__ATOMIC_RELEASE, "agent"); asm volatile("s_waitcnt vmcnt(0)" ::: "memory"); (void)__hip_atomic_fetch_add(ctr, 1u, __ATOMIC_RELAXED, __HIP_MEMORY_SCOPE_AGENT); }
}
template <int KIND> __device__ __forceinline__ void run_kind(const Params& p_, int l, LAS unsigned char* lds) {
    Params p = p_;
    { unsigned long long w_ = (unsigned long long)p.ws; asm volatile("" : "+s"(w_)); p.ws = (unsigned char*)(__attribute__((address_space(1))) unsigned char*)w_; }
    const int tid = tidx(), lane = tid & 63, wid = __builtin_amdgcn_readfirstlane(tid >> 6);
    const int bid = bidx(), nblk = gridDim.x, gw = bid * 8 + wid, ngw = nblk * 8, gtid = bid * NT_THREADS + tid, gn = nblk * NT_THREADS;
    bf16_t* PROJ = (bf16_t*)(p.ws + WS_PROJ);
    if constexpr (KIND == 0) {
        job_win(p, 0, gw, ngw, lds, wid, lane); job_wout(p, 0, gw, ngw, lds, wid, lane); job_wmem(p, gw, ngw, lds, wid, lane);
        job_wq(p, bid, nblk, gtid, gn, lds); job_wuv(p, gtid, gn); job_rope(p, gtid, gn); job_btab(p, gtid, gn); job_memn(p, gw, ngw, lane);
        job_norm_rows(p, 0, gw, ngw, lane);
    } else if constexpr (KIND == 2) {
        { pg8::Gemm g{(const bf16_t*)(p.ws + WS_H), (const bf16_t*)(p.ws + WS_WIN), S, NP, DM, DM};
          pg8::StaticOrder so; so.init(S, NP, nblk, bid);
          pg8::EpiStore E{PROJ, NP, (bf16_t*)(p.ws + WS_HALO)};
          pg8::gemm_phase<pg8::EpiStore, pg8::StaticOrder, true, true>(lds, g, so, E); }
        if (l == 0) {
            for (int ll = 0; ll < 2; ++ll) {
                pg8::Gemm g{(const bf16_t*)(p.ws + WS_MEMN) + (size_t)ll * MEML * DM, (const bf16_t*)(p.ws + WS_WMEM) + (size_t)ll * DM * DM, MEML, DM, DM, DM};
                pg8::StaticOrder so; so.init(MEML, DM, nblk, (bid + 8 - 4 * ll) % nblk);
                pg8::EpiStore E{(bf16_t*)(p.ws + WS_MEMKV) + (size_t)ll * MEML * DM, DM, nullptr};
                pg8::gemm_phase<pg8::EpiStore, pg8::StaticOrder, true, true>(lds, g, so, E);
            }
        }
    } else if constexpr (KIND == 3) {
        for (int it = bid; it < 1024; it += nblk) gdn::prep_item(p, l, it >> 2, it & 3, lds);
    } else if constexpr (KIND == 5) {
        unsigned* rdy = (unsigned*)(p.ws + WS_CTL) + 64 * (9 + l);
        const bool is_scan = (bid & ~8) < 4;
#ifdef EXP_SPINSCAN
        if (is_scan) { const unsigned long long t0_ = __builtin_amdgcn_s_memrealtime(); gdn::scan_wg(p, bid & 3, bid >> 3, lds); const unsigned long long t1_ = __builtin_amdgcn_s_memrealtime();
            while (__builtin_amdgcn_s_memrealtime() - t1_ < 4 * (t1_ - t0_)) __builtin_amdgcn_s_sleep(8); }
#else
        if (is_scan) gdn::scan_wg(p, bid & 3, bid >> 3, lds);
#endif
        else { const int vb = bid < 8 ? bid - 4 : bid - 8, nb = nblk - SCAN_WGS;
#ifdef EXP_SPINPART
            unsigned long long tp_ = __builtin_amdgcn_s_memrealtime();
#endif
#ifdef EXP_SPINPRE
            const unsigned long long t0_ = __builtin_amdgcn_s_memrealtime();
#endif
            { pg8::Gemm g{PROJ + C_CQ, (const bf16_t*)(p.ws + WS_WQ) + (size_t)l * 768 * 256, S, 768, 256, NP};
              pg8::StaticOrder so; so.init(S, 768, nb, vb);
              pg8::EpiStore E{(bf16_t*)(p.ws + WS_QABS), 768, nullptr};
              pg8::gemm_phase<pg8::EpiStore, pg8::StaticOrder, true, true>(lds, g, so, E); }
#ifdef EXP_SPINPART
#define SPART(i) { __syncthreads(); const unsigned long long tn_ = __builtin_amdgcn_s_memrealtime(); if (EXP_SPINPART == (i)) { while (__builtin_amdgcn_s_memrealtime() - tn_ < 4 * (tn_ - tp_)) __builtin_amdgcn_s_sleep(8); } tp_ = __builtin_amdgcn_s_memrealtime(); }
#else
#define SPART(i)
#endif
            SPART(1)
            job_mla_rows(p, l, vb * 8 + wid, nb * 8, lane);
            sub_arrive(rdy);
            SPART(2)
            att::run_mixers(lds, (unsigned*)(p.ws + WS_CTL) + 64 * (11 + l), PROJ, p.pos, p.sinks + l * 8, (const float*)(p.ws + WS_MISC + MISC_BTAB), (const bf16_t*)(p.ws + WS_MEMKV) + (size_t)l * MEML * DM);
            __syncthreads();
            SPART(3)

#ifdef EXP_SPINPRE
            { const unsigned long long t1_ = __builtin_amdgcn_s_memrealtime(); while (__builtin_amdgcn_s_memrealtime() - t1_ < 4 * (t1_ - t0_)) __builtin_amdgcn_s_sleep(8); }
#endif
        }
        sub_barrier(rdy, (unsigned)(nblk - SCAN_WGS), false);
#ifdef EXP_SPINMLA
        const unsigned long long tq0_ = __builtin_amdgcn_s_memrealtime();
#endif
        mla::run_queue(lds, (unsigned*)(p.ws + WS_CTL) + 64 * (1 + l), (const bf16_t*)(p.ws + WS_QABS), (const bf16_t*)(p.ws + WS_KVLAT), PROJ, (const bf16_t*)(p.ws + WS_WUV) + (size_t)l * 512 * 512, (const float*)(p.ws + WS_MISC + MISC_RSQ), (const float*)(p.ws + WS_COS), (const float*)(p.ws + WS_SIN), QSCALE);
        if (l == 0) { __syncthreads(); const int t2_ = tidx(), w2_ = __builtin_amdgcn_readfirstlane(t2_ >> 6); job_win(p, 1, bidx() * 8 + w2_, (int)gridDim.x * 8, lds, w2_, t2_ & 63); }
#ifdef EXP_SPINMLA
        if (!is_scan) { const unsigned long long tq1_ = __builtin_amdgcn_s_memrealtime(); while (__builtin_amdgcn_s_memrealtime() - tq1_ < 4 * (tq1_ - tq0_)) __builtin_amdgcn_s_sleep(8); }
#endif
    } else if constexpr (KIND == 6) {
        job_gdn_final(p, l, gw, ngw, lane, wid, lds);
    } else if constexpr (KIND == 7) {
        pg8::Gemm g{PROJ + C_Z, (const bf16_t*)(p.ws + WS_WOUT), S, DM, MIXW, NP};
        pg8::StaticOrder so; so.init(S, DM, nblk, bid);
        pg8::EpiStore E{(bf16_t*)(p.ws + WS_Y), DM, nullptr};
        pg8::gemm_phase<pg8::EpiStore, pg8::StaticOrder, true, true>(lds, g, so, E);
    } else {
        job_norm_rows(p, l == 0 ? 1 : 2, gw, ngw, lane);
        if (l == 0) job_wout(p, 1, gw, ngw, lds, wid, lane);
    }
}
template <int KIND> __global__ void __launch_bounds__(NT_THREADS, 2) mk_kind(Params p, int l) {
    extern __shared__ __attribute__((aligned(16))) unsigned char lds_raw[];
    run_kind<KIND>(p, l, (LAS unsigned char*)lds_raw);
}

#ifndef MK_LAUNCHES_PER_PHASE
#define MK_LAUNCHES_PER_PHASE 0
#endif
#if !MK_LAUNCHES_PER_PHASE
#ifdef EXP_SPINKIND
#define SPIN_T0(K) unsigned long long t0_s = 0; if ((K) == EXP_SPINKIND) t0_s = __builtin_amdgcn_s_memrealtime();
#define SPIN_T1(K) if ((K) == EXP_SPINKIND) { const unsigned long long t1_s = __builtin_amdgcn_s_memrealtime(), d_s = t1_s - t0_s; while (__builtin_amdgcn_s_memrealtime() - t1_s < 4 * d_s) __builtin_amdgcn_s_sleep(8); }
#else
#define SPIN_T0(K)
#define SPIN_T1(K)
#endif
#ifdef EXP_DUPKINDS
#define DUP_PH(K, L) if ((EXP_DUPKINDS >> (K)) & 1) { GRID_BAR(); run_kind<K>(p, L, lds); }
#else
#define DUP_PH(K, L)
#endif
#define GRID_BAR() do { unsigned long long wi_ = (unsigned long long)p.ws; asm volatile("" : "+s"(wi_)); unsigned char* w_ = (unsigned char*)(__attribute__((address_space(1))) unsigned char*)wi_; XcdBarrier b_; b_.bar = (unsigned*)(w_ + WS_CTL) + 4096; b_.x = xb_xcc_id(); b_.st = (volatile LAS unsigned*)(lds + LDS_BYTES - 16); xcd_barrier(b_); } while (0)
#define PHASE(K, L, LAST) do { SPIN_T0(K) run_kind<K>(p, L, lds); DUP_PH(K, L) if (!(LAST)) GRID_BAR(); SPIN_T1(K) } while (0)
__global__ void __launch_bounds__(NT_THREADS, 2) mk_fwd(Params p) {
    extern __shared__ __attribute__((aligned(16))) unsigned char lds_raw[];
    LAS unsigned char* lds = (LAS unsigned char*)lds_raw;
    cg::grid_group grid = cg::this_grid();
    volatile LAS unsigned* bst = (volatile LAS unsigned*)(lds + LDS_BYTES - 16);
    if (tidx() < 4) bst[tidx()] = 0u;
    __syncthreads();
    (void)xcd_barrier_post((unsigned*)(p.ws + WS_CTL) + 4096, bst);
    if (p.ph_hi == 0x7fffffff) grid.sync();
    PHASE(0, 0, false);
#pragma unroll 1
    for (int l = 0; l < DEPTH; ++l) {
        PHASE(2, l, false); PHASE(3, l, false); PHASE(5, l, false);
        PHASE(6, l, false); PHASE(7, l, false); PHASE(8, l, l + 1 == DEPTH);
    }
}
#endif

#ifndef MK_LAUNCHES_PER_PHASE
#define MK_LAUNCHES_PER_PHASE 0
#endif
extern "C" void kernel_launch(void* const* d_in, const int* in_sizes, int n_in, void* d_out, int out_size, void* d_ws, size_t ws_size, hipStream_t stream) {
    static int grid = 0;
    if (grid == 0) {
        if (n_in != 19 || in_sizes[0] != S * DM || out_size != S * DM || ws_size < WS_END) { fprintf(stderr, "kernel_launch: unexpected shapes (n_in %d, in0 %d, out %d, ws %zu)\n", n_in, n_in > 0 ? in_sizes[0] : -1, out_size, ws_size); grid = -1; return; }
        int dev = 0, cus = 0, per_cu = 0;
        (void)hipGetDevice(&dev); (void)hipDeviceGetAttribute(&cus, hipDeviceAttributeMultiprocessorCount, dev);
#if !MK_LAUNCHES_PER_PHASE
        if (hipFuncSetAttribute((const void*)mk_fwd, hipFuncAttributeMaxDynamicSharedMemorySize, LDS_BYTES) != hipSuccess) { fprintf(stderr, "kernel_launch: hipFuncSetAttribute failed\n"); grid = -1; return; }
        if (hipOccupancyMaxActiveBlocksPerMultiprocessor(&per_cu, (const void*)mk_fwd, NT_THREADS, LDS_BYTES) != hipSuccess || per_cu < 1) { fprintf(stderr, "kernel_launch: occupancy query gave %d\n", per_cu); per_cu = 1; }
#else
#define SA(K) (void)hipFuncSetAttribute((const void*)mk_kind<K>, hipFuncAttributeMaxDynamicSharedMemorySize, LDS_BYTES)
        SA(0); SA(2); SA(3); SA(5); SA(6); SA(7); SA(8);
#undef SA
#endif
        (void)hipGetLastError();
        if (cus <= 0) cus = 256;
        grid = cus;
        fprintf(stderr, "kernel_launch: cus %d per_cu %d grid %d\n", cus, per_cu, grid);
    }
    if (grid < 0) return;
    Params p{};
    p.x = (const float*)d_in[0]; p.mem = (const float*)d_in[1]; p.pos = (const int*)d_in[2]; p.rel_bias = (const float*)d_in[3];
    p.norm_pre = (const float*)d_in[4]; p.norm_post = (const float*)d_in[5]; p.w_in = (const float*)d_in[6]; p.sinks = (const float*)d_in[7];
    p.conv_w = (const float*)d_in[8]; p.a_log = (const float*)d_in[9]; p.dt_bias = (const float*)d_in[10]; p.gdn_norm = (const float*)d_in[11];
    p.q_norm = (const float*)d_in[12]; p.kv_norm = (const float*)d_in[13]; p.w_uq = (const float*)d_in[14]; p.w_ukv = (const float*)d_in[15];
    p.mem_norm = (const float*)d_in[16]; p.w_mem = (const float*)d_in[17]; p.w_out = (const float*)d_in[18];
    p.out = (float*)d_out; p.ws = (unsigned char*)d_ws;
    if (hipMemsetAsync((char*)d_ws + WS_CTL, 0, 65536, stream) != hipSuccess) { fprintf(stderr, "kernel_launch: hipMemsetAsync failed\n"); return; }
#if MK_LAUNCHES_PER_PHASE
    p.ph_lo = 0; p.ph_hi = 0;
#define LK(K, L) hipLaunchKernelGGL(mk_kind<K>, dim3(grid), dim3(NT_THREADS), LDS_BYTES, stream, p, L)
    LK(0, 0);
    for (int l = 0; l < DEPTH; ++l) { LK(2, l); LK(3, l); LK(5, l); LK(6, l); LK(7, l); LK(8, l); }
#undef LK
#else
    p.ph_lo = 0; p.ph_hi = N_PHASES;
    void* args[] = {&p};
    hipError_t e = hipLaunchCooperativeKernel((const void*)mk_fwd, dim3(grid), dim3(NT_THREADS), args, LDS_BYTES, stream);
    if (e != hipSuccess) fprintf(stderr, "kernel_launch: cooperative launch failed: %s (grid %d)\n", hipGetErrorString(e), grid);
#endif
}
```

```cpp
#include <hip/hip_runtime.h>
#include <hip/hip_cooperative_groups.h>
#include <cstdint>
#include <cstdio>
namespace cg = cooperative_groups;

#define LAS __attribute__((address_space(3)))
typedef unsigned short bf16_t;
typedef short bf16x8 __attribute__((ext_vector_type(8)));
typedef short s16x4 __attribute__((ext_vector_type(4)));
typedef float f32x2 __attribute__((ext_vector_type(2)));
typedef float f32x4 __attribute__((ext_vector_type(4)));
typedef float f32x16 __attribute__((ext_vector_type(16)));
typedef unsigned u32x2 __attribute__((ext_vector_type(2)));
typedef unsigned u32x4 __attribute__((ext_vector_type(4)));
typedef __bf16 bf16x2_t __attribute__((ext_vector_type(2)));

constexpr int S = 16384, DM = 1024, MEML = 256, NP = 5376, DEPTH = 2, DIN = 5320, MIXW = 2048;
constexpr int C_Z = 0, C_AQ = 2048, C_AK = 2560, C_AV = 2688, C_DQ = 2816, C_BQKV = 3328, C_CQ = 4864, C_CKV = 5120, C_KR = 5248, C_BA = 5312, C_BB = 5316;
constexpr int C_OLAT = 2048;
constexpr float RMS_EPS = 1e-6f;
constexpr float LOG2E = 1.4426950408889634f;
constexpr int NT_THREADS = 512;

constexpr size_t MiB = 1u << 20;
constexpr size_t WS_CTL = 0, WS_COS = 1 * MiB, WS_SIN = 3 * MiB, WS_MEMKV = 5 * MiB, WS_MISC = 6 * MiB, WS_MEMN = 7 * MiB;
constexpr size_t WS_WIN = 8 * MiB, WS_WOUT = 19 * MiB, WS_WMEM = 23 * MiB, WS_WQ = 27 * MiB, WS_WUV = 28 * MiB, WS_HALO = 29 * MiB;
constexpr size_t WS_AQK = 32 * MiB, WS_U = 40 * MiB, WS_H = 56 * MiB, WS_PROJ = 88 * MiB, WS_END = 256 * MiB;
constexpr size_t WS_QABS = WS_H, WS_KVLAT = WS_H + 24 * MiB, WS_Y = WS_H;
constexpr size_t MISC_BTAB = 0, MISC_RSQ = 8192, MISC_EGL = 8192 + 65536;

constexpr int LDS_BYTES = 163840;

struct Params {
    const float* x; const float* mem; const int* pos; const float* rel_bias;
    const float* norm_pre; const float* norm_post; const float* w_in; const float* sinks;
    const float* conv_w; const float* a_log; const float* dt_bias; const float* gdn_norm;
    const float* q_norm; const float* kv_norm; const float* w_uq; const float* w_ukv;
    const float* mem_norm; const float* w_mem; const float* w_out;
    float* out; unsigned char* ws;
    int ph_lo, ph_hi;
};

__device__ __forceinline__ int tidx() { int t = threadIdx.x; asm volatile("" : "+v"(t)); return t; }
__device__ __forceinline__ int bidx() { int b = blockIdx.x; asm volatile("" : "+s"(b)); return b; }
__device__ __forceinline__ float bf2f(bf16_t v) { return __uint_as_float((unsigned)v << 16); }
__device__ __forceinline__ unsigned cvtpk(float lo, float hi) { f32x2 v = {lo, hi}; bf16x2_t b = __builtin_convertvector(v, bf16x2_t); return __builtin_bit_cast(unsigned, b); }
__device__ __forceinline__ bf16_t f2bf(float f) { return (bf16_t)(cvtpk(f, 0.f) & 0xffffu); }
__device__ __forceinline__ float lo_bf(unsigned w) { return __uint_as_float(w << 16); }
__device__ __forceinline__ float hi_bf(unsigned w) { return __uint_as_float(w & 0xffff0000u); }
__device__ __forceinline__ float silu_f(float v) { return v / (1.f + __expf(-v)); }
#define DPP_ROR(x, n) __builtin_amdgcn_update_dpp(0, (x), 0x120 + (n), 0xf, 0xf, false)
__device__ __forceinline__ float ror16_f(float v, int n) { const int x = __float_as_int(v); int r; switch (n) { case 1: r = DPP_ROR(x, 1); break; case 2: r = DPP_ROR(x, 2); break; case 4: r = DPP_ROR(x, 4); break; default: r = DPP_ROR(x, 8); break; } return __int_as_float(r); }
__device__ __forceinline__ unsigned xor8_u(unsigned v) { return (unsigned)DPP_ROR((int)v, 8); }
__device__ __forceinline__ float row16_sum(float v) { v += ror16_f(v, 1); v += ror16_f(v, 2); v += ror16_f(v, 4); v += ror16_f(v, 8); return v; }
__device__ __forceinline__ float wave_sum(float v) {
    v = row16_sum(v);
    v += __int_as_float(__builtin_amdgcn_ds_swizzle(__float_as_int(v), 0x401F));
    return __int_as_float(__builtin_amdgcn_readlane(__float_as_int(v), 0)) + __int_as_float(__builtin_amdgcn_readlane(__float_as_int(v), 32));
}
__device__ __forceinline__ int crow(int r, int hi) { return (r & 3) + 8 * (r >> 2) + 4 * hi; }
#define MFMA32(a, b, c) __builtin_amdgcn_mfma_f32_32x32x16_bf16((a), (b), (c), 0, 0, 0)
#define SBAR() __builtin_amdgcn_sched_barrier(0)
#define LDS_WAIT() asm volatile("s_waitcnt lgkmcnt(0)" ::: "memory")
__device__ __forceinline__ bf16x8 pack8(const float* v) { u32x4 w = {cvtpk(v[0], v[1]), cvtpk(v[2], v[3]), cvtpk(v[4], v[5]), cvtpk(v[6], v[7])}; return __builtin_bit_cast(bf16x8, w); }
__device__ __forceinline__ bf16x8 pack_step(const f32x16& x, int s) {
    u32x4 w = {cvtpk(x[8 * s + 0], x[8 * s + 1]), cvtpk(x[8 * s + 2], x[8 * s + 3]), cvtpk(x[8 * s + 4], x[8 * s + 5]), cvtpk(x[8 * s + 6], x[8 * s + 7])};
    return __builtin_bit_cast(bf16x8, w);
}

__device__ __forceinline__ int win_src(int n) {
    if (n < 512) return 768 + n;
    if (n < 1024) return 2824 + (n - 512);
    if (n < 1536) return 3784 + (n - 1024);
    if (n < 2048) return 4808 + (n - 1536);
    if (n < 2560) return n - 2048;
    if (n < 2688) return 512 + (n - 2560);
    if (n < 2816) return 640 + (n - 2688);
    if (n < 3328) return 4296 + (n - 2816);
    if (n < 4864) return 1280 + (n - 3328);
    if (n < 5120) return 3336 + (n - 4864);
    if (n < 5248) return 3592 + (n - 5120);
    if (n < 5312) return 3720 + (n - 5248);
    if (n < 5316) return 2816 + (n - 5312);
    if (n < 5320) return 2820 + (n - 5316);
    return -1;
}

__device__ __forceinline__ int t5_bucket(int n) {
    if (n < 16) return n < 0 ? 0 : n;
    if (n >= 128) return 31;
    const float v = __logf((float)n * 0.0625f) * (16.0f / 2.0794415416798357f);
    int b = 16 + (int)v; return b > 31 ? 31 : b;
}
__device__ __forceinline__ float inv_freq(int i) {
    const float t[32] = {1.000000000e+00f, 7.498942018e-01f, 5.623413324e-01f, 4.216965139e-01f, 3.162277639e-01f, 2.371373922e-01f, 1.778279394e-01f, 1.333521456e-01f,
                         1.000000015e-01f, 7.498941571e-02f, 5.623412877e-02f, 4.216964915e-02f, 3.162277862e-02f, 2.371373586e-02f, 1.778279431e-02f, 1.333521493e-02f,
                         9.999999776e-03f, 7.498942316e-03f, 5.623413250e-03f, 4.216964822e-03f, 3.162277862e-03f, 2.371373819e-03f, 1.778279431e-03f, 1.333521446e-03f,
                         1.000000047e-03f, 7.498941850e-04f, 5.623413017e-04f, 4.216965463e-04f, 3.162277862e-04f, 2.371373848e-04f, 1.778279402e-04f, 1.333521504e-04f};
    return t[i];
}
namespace pg8 {
#define PG8_LAS __attribute__((address_space(3)))
constexpr int BM = 256, BK = 64, HALF = 128, HTB = HALF * BK * 2  , STAGE_BYTES = 8 * HTB, NXCD = 8, WGM = 8;
__host__ __device__ __forceinline__ int lds_byte(int r, int c) { const int st = (r >> 4) * 2 + (c >> 5), rr = r & 15, cc = c & 31, ob = rr * 64 + cc * 2; return st * 1024 + (ob ^ (((ob >> 9) & 1) << 5)); }
__host__ __device__ __forceinline__ void stage_rc(int b, int& R, int& C) { const int st = b / 1024, sb = b % 1024, swz = sb ^ (((sb >> 9) & 1) << 5); R = (st >> 1) * 16 + swz / 64; C = (st & 1) * 32 + (swz % 64) / 2; }
__host__ __device__ __forceinline__ int perm32(int rho) { const int n = rho >> 4, i = rho & 15; return 8 * (i >> 2) + 4 * n + (i & 3); }
struct Unit { int pm, pn; };
struct Gemm { const bf16_t* A; const bf16_t* Bt; int M, N, K, lda; };
struct StaticOrder {
    int nM, nN, nwg, G, c;
    __device__ void init(int M, int N, int G_, int c_) { nM = M / BM; nN = N / BM; nwg = nM * nN; G = G_; c = c_; }
    __device__ bool next(int i, Unit& u) const {
        const long L = (long)i * G + c; if (L >= nwg) return false;
        int wgid = (int)L; { const int q = nwg / NXCD, r = nwg % NXCD, xcd = wgid % NXCD, off = wgid / NXCD; wgid = (xcd < r ? xcd * (q + 1) : r * (q + 1) + (xcd - r) * q) + off; }
        const int nig = WGM * nN, gid = wgid / nig, fm = gid * WGM, gsz = (nM - fm) < WGM ? (nM - fm) : WGM;
        u.pm = fm + ((wgid % nig) % gsz); u.pn = (wgid % nig) / gsz; return true;
    }
    __device__ __forceinline__ void a_ready(const Unit&) const {}
    __device__ __forceinline__ void done(const Unit&) const {}
};
struct EpiStore {
    static constexpr bool PERM = true, AFTER_DRAIN = false;
    bf16_t* O; int ldc; bf16_t* halo;
    __device__ __forceinline__ void operator()(const f32x4 (&acc)[2][2][4][2], const Unit& u, int wr, int wc, int fr, int fq) const {
        const int row0 = u.pm * BM + wr * 64 + fr, col0 = u.pn * BM + wc * 32 + 8 * fq;
        const bool hz = halo != nullptr && col0 >= C_BQKV && col0 < C_BQKV + 1536;
#pragma unroll
        for (int ai = 0; ai < 2; ++ai)
#pragma unroll
            for (int m = 0; m < 4; ++m) { const int row = row0 + ai * HALF + m * 16; bf16_t* rowp = O + (size_t)row * ldc + col0;
#pragma unroll
                for (int bj = 0; bj < 2; ++bj) { const f32x4 v0 = acc[ai][bj][m][0], v1 = acc[ai][bj][m][1];
                    u32x4 w; w.x = cvtpk(v0[0], v0[1]); w.y = cvtpk(v0[2], v0[3]); w.z = cvtpk(v1[0], v1[1]); w.w = cvtpk(v1[2], v1[3]);
                    *(u32x4*)(rowp + bj * HALF) = w;
                    if (m == 3 && hz && fr >= 13) *(u32x4*)(halo + ((size_t)(row >> 6) * 3 + (fr - 13)) * 1536 + (col0 + bj * HALF - C_BQKV)) = w; } }
    }
};
struct EpiGate {
    static constexpr bool PERM = true, AFTER_DRAIN = false;
    bf16_t* G; int ldc;
    __device__ __forceinline__ void operator()(const f32x4 (&acc)[2][2][4][2], const Unit& u, int wr, int wc, int fr, int fq) const {
        const int row0 = u.pm * BM + wr * 64 + fr, col0 = u.pn * BM + wc * 32 + 8 * fq;
#pragma unroll
        for (int ai = 0; ai < 2; ++ai)
#pragma unroll
            for (int m = 0; m < 4; ++m) { bf16_t* rowp = G + (size_t)(row0 + ai * HALF + m * 16) * ldc + col0;
#pragma unroll
                for (int bj = 0; bj < 2; ++bj) { const f32x4 v0 = acc[ai][bj][m][0], v1 = acc[ai][bj][m][1];
                    const u32x4 z = *(const u32x4*)(rowp + bj * HALF);
                    u32x4 w; w.x = cvtpk(v0[0] * silu_f(lo_bf(z.x)), v0[1] * silu_f(hi_bf(z.x))); w.y = cvtpk(v0[2] * silu_f(lo_bf(z.y)), v0[3] * silu_f(hi_bf(z.y)));
                    w.z = cvtpk(v1[0] * silu_f(lo_bf(z.z)), v1[1] * silu_f(hi_bf(z.z))); w.w = cvtpk(v1[2] * silu_f(lo_bf(z.w)), v1[3] * silu_f(hi_bf(z.w)));
                    *(u32x4*)(rowp + bj * HALF) = w; } }
    }
};
template <class Epi, class Sched, bool ALIGN_EPI = false, bool SP2 = false>
__device__ __forceinline__ void gemm_phase(PG8_LAS unsigned char* lds, const Gemm g, const Sched& S, const Epi& E) {
    const int tid = tidx(), wid = __builtin_amdgcn_readfirstlane(tid >> 6), lane = tid & 63, wr = wid >> 2, wc = wid & 3, fr = lane & 15, fq = lane >> 4;
    const int K = g.K, nt = K / BK;
    unsigned voffA[2], voffB[2];
#pragma unroll
    for (int i = 0; i < 2; ++i) { int R, C; stage_rc(tid * 16 + i * 8192, R, C); const int Rb = Epi::PERM ? ((R & ~31) + perm32(R & 31)) : R;
        voffA[i] = (unsigned)(R * g.lda + C) * 2u; voffB[i] = (unsigned)(Rb * K + C) * 2u; }
    const size_t kstep = (size_t)(BK * 2);
    const size_t hstepA = (size_t)HALF * g.lda * 2, hstepB = (size_t)HALF * K * 2;
    const size_t tstepA = 2 * hstepA, tstepB = 2 * hstepB;
    const unsigned ldsw = (unsigned)wid * 1024u;
    const int aoff = lds_byte(wr * 64 + fr, fq * 8), boff = lds_byte(wc * 32 + fr, fq * 8);
#define PG8_SA(b, h) (((b) * 2 + (h)) * HTB)
#define PG8_SB(b, h) ((4 + (b) * 2 + (h)) * HTB)
#define PG8_STAGE(bufoff, gbase, voff) do { _Pragma("unroll") for (int _i = 0; _i < 2; ++_i) \
        __builtin_amdgcn_global_load_lds((const unsigned*)((const char*)(gbase) + (voff)[_i]), (PG8_LAS unsigned*)(lds + (bufoff) + ldsw + _i * 8192), 16, 0, 0); } while (0)
#define PG8_LDA(dst, b, h) do { _Pragma("unroll") for (int m = 0; m < 4; ++m) _Pragma("unroll") for (int k = 0; k < 2; ++k) dst[m][k] = *(const PG8_LAS bf16x8*)(lds + PG8_SA(b, h) + aoff + m * 2048 + k * 1024); } while (0)
#define PG8_LDB(dst, b, h) do { _Pragma("unroll") for (int n = 0; n < 2; ++n) _Pragma("unroll") for (int k = 0; k < 2; ++k) dst[n][k] = *(const PG8_LAS bf16x8*)(lds + PG8_SB(b, h) + boff + n * 2048 + k * 1024); } while (0)
#define PG8_MMA(ai, bj, At, Bt) do { __builtin_amdgcn_s_setprio(1); _Pragma("unroll") for (int m = 0; m < 4; ++m) _Pragma("unroll") for (int n = 0; n < 2; ++n) _Pragma("unroll") for (int k = 0; k < 2; ++k) \
        acc[ai][bj][m][n] = __builtin_amdgcn_mfma_f32_16x16x32_bf16(Bt[n][k], At[m][k], acc[ai][bj][m][n], 0, 0, 0); __builtin_amdgcn_s_setprio(0); } while (0)
#define PG8_WAIT_V(n) asm volatile("s_waitcnt vmcnt(" #n ")" ::: "memory")
#define PG8_WAIT_L(n) asm volatile("s_waitcnt lgkmcnt(" #n ")" ::: "memory")
#define PG8_BAR __builtin_amdgcn_s_barrier()
#define PG8_SCHED __builtin_amdgcn_sched_barrier(0)
    Unit cur, nxt; int ui = 0;
    if (!S.next(0, cur)) return;
    f32x4 acc[2][2][4][2];
#pragma unroll
    for (int a = 0; a < 2; ++a)
#pragma unroll
        for (int b = 0; b < 2; ++b)
#pragma unroll
            for (int m = 0; m < 4; ++m)
#pragma unroll
                for (int n = 0; n < 2; ++n) acc[a][b][m][n] = (f32x4){0.f, 0.f, 0.f, 0.f};
    bf16x8 At[4][2], B0[2][2], B1[2][2];
    const char* cA = (const char*)g.A + (size_t)cur.pm * tstepA; const char* cB = (const char*)g.Bt + (size_t)cur.pn * tstepB;
    S.a_ready(cur);
    if constexpr (SP2) {
        PG8_STAGE(PG8_SB(0, 0), cB, voffB); PG8_STAGE(PG8_SB(0, 1), cB + hstepB, voffB); PG8_STAGE(PG8_SA(0, 0), cA, voffA); PG8_STAGE(PG8_SA(0, 1), cA + hstepA, voffA);
        if (wr == 1) PG8_BAR;
        PG8_WAIT_V(2); PG8_BAR;
        PG8_STAGE(PG8_SB(1, 0), cB + kstep, voffB); PG8_STAGE(PG8_SA(1, 0), cA + kstep, voffA); PG8_STAGE(PG8_SB(1, 1), cB + hstepB + kstep, voffB);
        PG8_WAIT_V(6); PG8_BAR;
    } else {
        PG8_STAGE(PG8_SB(0, 0), cB, voffB); PG8_STAGE(PG8_SA(0, 0), cA, voffA); PG8_STAGE(PG8_SB(0, 1), cB + hstepB, voffB); PG8_STAGE(PG8_SA(0, 1), cA + hstepA, voffA);
        if (wr == 1) PG8_BAR;
        PG8_WAIT_V(4); PG8_BAR;
        PG8_STAGE(PG8_SB(1, 0), cB + kstep, voffB); PG8_STAGE(PG8_SA(1, 0), cA + kstep, voffA); PG8_STAGE(PG8_SB(1, 1), cB + hstepB + kstep, voffB);
        PG8_WAIT_V(6); PG8_BAR;
    }
    for (;;) {
        const bool has_next = S.next(ui + 1, nxt);
        const char* nA = has_next ? (const char*)g.A + (size_t)nxt.pm * tstepA : cA; const char* nB = has_next ? (const char*)g.Bt + (size_t)nxt.pn * tstepB : cB;
        for (int t = 0; t < nt; t += 2) {
            const bool last = (t == nt - 2);
            const char* a1 = cA + (size_t)(t + 1) * kstep;
            const char* a2 = last ? nA : cA + (size_t)(t + 2) * kstep; const char* b2 = last ? nB : cB + (size_t)(t + 2) * kstep;
            const char* a3 = a2 + kstep; const char* b3 = b2 + kstep;
            if (last && has_next) S.a_ready(nxt);
            if constexpr (SP2) {
            PG8_LDB(B0, 0, 0); PG8_LDB(B1, 0, 1); PG8_SCHED; PG8_LDA(At, 0, 0); PG8_STAGE(PG8_SA(1, 1), a1 + hstepA, voffA);
            PG8_WAIT_V(8); PG8_WAIT_L(0); PG8_BAR; PG8_MMA(0, 0, At, B0); PG8_MMA(0, 1, At, B1); PG8_BAR; PG8_SCHED;
            PG8_LDA(At, 0, 1); PG8_STAGE(PG8_SB(0, 0), b2, voffB); PG8_STAGE(PG8_SB(0, 1), b2 + hstepB, voffB); PG8_STAGE(PG8_SA(0, 0), a2, voffA);
            PG8_WAIT_V(8); PG8_WAIT_L(0); PG8_BAR; PG8_MMA(1, 0, At, B0); PG8_MMA(1, 1, At, B1); PG8_BAR; PG8_SCHED;
            PG8_LDB(B0, 1, 0); PG8_LDB(B1, 1, 1); PG8_SCHED; PG8_LDA(At, 1, 0); PG8_STAGE(PG8_SA(0, 1), a2 + hstepA, voffA);
            PG8_WAIT_V(8); PG8_WAIT_L(0); PG8_BAR; PG8_MMA(0, 0, At, B0); PG8_MMA(0, 1, At, B1); PG8_BAR; PG8_SCHED;
            PG8_LDA(At, 1, 1); PG8_STAGE(PG8_SB(1, 0), b3, voffB); PG8_STAGE(PG8_SB(1, 1), b3 + hstepB, voffB); PG8_STAGE(PG8_SA(1, 0), a3, voffA);
            PG8_WAIT_V(8); PG8_WAIT_L(0); PG8_BAR; PG8_MMA(1, 0, At, B0); PG8_MMA(1, 1, At, B1); PG8_BAR; PG8_SCHED;
            } else {
            PG8_LDB(B0, 0, 0); PG8_SCHED; PG8_LDA(At, 0, 0); PG8_STAGE(PG8_SA(1, 1), a1 + hstepA, voffA);
            PG8_WAIT_L(8); PG8_BAR; PG8_WAIT_L(0); PG8_MMA(0, 0, At, B0); PG8_BAR; PG8_SCHED;
            PG8_LDB(B1, 0, 1); PG8_STAGE(PG8_SB(0, 0), b2, voffB);
            PG8_BAR; PG8_WAIT_L(0); PG8_MMA(0, 1, At, B1); PG8_BAR;
            PG8_LDA(At, 0, 1); PG8_STAGE(PG8_SA(0, 0), a2, voffA);
            PG8_BAR; PG8_WAIT_L(0); PG8_MMA(1, 0, At, B0); PG8_BAR; PG8_SCHED;
            PG8_STAGE(PG8_SB(0, 1), b2 + hstepB, voffB);
            PG8_WAIT_V(6); PG8_BAR; PG8_MMA(1, 1, At, B1); PG8_BAR;
            PG8_LDB(B0, 1, 0); PG8_SCHED; PG8_LDA(At, 1, 0); PG8_STAGE(PG8_SA(0, 1), a2 + hstepA, voffA);
            PG8_WAIT_L(8); PG8_BAR; PG8_WAIT_L(0); PG8_MMA(0, 0, At, B0); PG8_BAR; PG8_SCHED;
            PG8_LDB(B1, 1, 1); PG8_STAGE(PG8_SB(1, 0), b3, voffB);
            PG8_BAR; PG8_WAIT_L(0); PG8_MMA(0, 1, At, B1); PG8_BAR;
            PG8_LDA(At, 1, 1); PG8_STAGE(PG8_SA(1, 0), a3, voffA);
            PG8_BAR; PG8_WAIT_L(0); PG8_MMA(1, 0, At, B0); PG8_BAR; PG8_SCHED;
            PG8_STAGE(PG8_SB(1, 1), b3 + hstepB, voffB);
            PG8_WAIT_V(6); PG8_BAR; PG8_MMA(1, 1, At, B1); PG8_BAR;
            }
        }
        if constexpr (ALIGN_EPI) { if (wr == 0) PG8_BAR; }
        if constexpr (!Epi::AFTER_DRAIN) { E(acc, cur, wr, wc, fr, fq); S.done(cur); }
        if (!has_next) break;
#pragma unroll
        for (int a = 0; a < 2; ++a)
#pragma unroll
            for (int b = 0; b < 2; ++b)
#pragma unroll
                for (int m = 0; m < 4; ++m)
#pragma unroll
                    for (int n = 0; n < 2; ++n) acc[a][b][m][n] = (f32x4){0.f, 0.f, 0.f, 0.f};
        cur = nxt; cA = nA; cB = nB; ++ui;
        if constexpr (ALIGN_EPI) { if (wr == 1) PG8_BAR; }
    }
    PG8_WAIT_V(0);
    if constexpr (!ALIGN_EPI) { if (wr == 0) PG8_BAR; }
    PG8_BAR;
    if constexpr (Epi::AFTER_DRAIN) { E.fused(acc, cur, wr, wc, fr, fq, lds, wid, lane); S.done(cur); }
#undef PG8_SA
#undef PG8_SB
#undef PG8_STAGE
#undef PG8_LDA
#undef PG8_LDB
#undef PG8_MMA
#undef PG8_WAIT_V
#undef PG8_WAIT_L
#undef PG8_BAR
#undef PG8_SCHED
}
}
namespace att {
constexpr int KVBLK = 64;
constexpr int STG = 32768, L_WS = 65536, L_POSK = 67584, L_BTAB = 68096, L_UNIT = 72256, L_OST = 73728, OST_WAVE = 8704;
template <int DV> __device__ __forceinline__ int v_st(int k, int c) { const int kk = (k & ~0xC) | ((k & 4) << 1) | ((k & 8) >> 1); return ((kk >> 3) * (DV / 32) + (c >> 5)) * 512 + ((kk & 7) * 32 + (c & 31)) * 2; }
__device__ __forceinline__ int v_rd_base(int lane) { return ((lane & 3) << 3) | (((lane >> 2) & 3) << 6) | (((lane >> 4) & 1) << 5) | (((lane >> 5) & 1) << 8); }
__device__ __forceinline__ int koff(int row, int colB, int RB) { return row * RB + (colB ^ ((row & 7) << 4)); }

template <int DQK, int DV, int MODE>
__device__ __forceinline__ void attn_core(LAS unsigned char* lds, const bf16_t* qrow, const bf16_t* Kg, int ldk, const bf16_t* Vg, int ldv, int t_lo, int t_hi, float c2,
                                          int qidx, int head, const int* pos, float& m_reg, float& l_reg, f32x16 (&o)[DV / 32]) {
    constexpr int ND = DQK / 16, NV = DV / 32, RB = DQK * 2, NKC = (64 * (DQK / 8)) / NT_THREADS, NVC = (64 * (DV / 8)) / NT_THREADS, KB = 64 * RB;
    const int tid = tidx(), lane = tid & 63, r32 = lane & 31, hi = lane >> 5, wid = __builtin_amdgcn_readfirstlane(tid >> 6);
    bf16x8 qr[ND];
#pragma unroll
    for (int d0 = 0; d0 < ND; ++d0) qr[d0] = *(const bf16x8*)(qrow + d0 * 16 + hi * 8);
    LAS float* al_l = (LAS float*)(lds + L_WS) + wid * 64;
    LAS int* posk = (LAS int*)(lds + L_POSK); LAS float* btab = (LAS float*)(lds + L_BTAB);
    const unsigned vb0 = (unsigned)(uintptr_t)lds + (unsigned)KB + (unsigned)v_rd_base(lane);
    int posq = 0; if (MODE == 1) posq = pos[qidx];
    unsigned kdst[NKC], ksrc[NKC], vdst[NVC], vsrc[NVC];
#pragma unroll
    for (int i = 0; i < NKC; ++i) { const int c = tid + NT_THREADS * i, row = c / (DQK / 8), ch = c % (DQK / 8); kdst[i] = koff(row, ch * 16, RB); ksrc[i] = row * ldk + ch * 8; }
#pragma unroll
    for (int i = 0; i < NVC; ++i) { const int c = tid + NT_THREADS * i, row = c / (DV / 8), ch = c % (DV / 8); vdst[i] = KB + v_st<DV>(row, ch * 8); vsrc[i] = row * ldv + ch * 8; }
    u32x4 ks[NKC], vs[NVC]; int pkn = 0;
#define LOAD_TILE(t_) do { const size_t kb_ = (size_t)(t_) * KVBLK; _Pragma("unroll") for (int i = 0; i < NKC; ++i) ks[i] = *(const u32x4*)(Kg + kb_ * ldk + ksrc[i]); \
        _Pragma("unroll") for (int i = 0; i < NVC; ++i) vs[i] = *(const u32x4*)(Vg + kb_ * ldv + vsrc[i]); if (MODE == 1 && tid < 64) pkn = pos[(t_) * KVBLK + tid]; } while (0)
#define WRITE_TILE(st_) do { _Pragma("unroll") for (int i = 0; i < NKC; ++i) *(LAS u32x4*)(lds + (st_) * STG + kdst[i]) = ks[i]; \
        _Pragma("unroll") for (int i = 0; i < NVC; ++i) *(LAS u32x4*)(lds + (st_) * STG + vdst[i]) = vs[i]; if (MODE == 1 && tid < 64) posk[(st_) * 64 + tid] = pkn; } while (0)
    LOAD_TILE(t_lo); WRITE_TILE(0);
    __syncthreads();
#pragma unroll 1
    for (int t = t_lo; t < t_hi; ++t) {
        const int st = (t - t_lo) & 1, kbase = t * KVBLK;
        if (t + 1 < t_hi) LOAD_TILE(t + 1);
        const LAS unsigned char* K_lds = lds + st * STG;
        f32x16 p0 = {}, p1 = {};
#pragma unroll
        for (int d0 = 0; d0 < ND; ++d0) {
            const bf16x8 a0 = *(const LAS bf16x8*)(K_lds + koff(r32, (d0 * 16 + hi * 8) * 2, RB));
            const bf16x8 a1 = *(const LAS bf16x8*)(K_lds + koff(32 + r32, (d0 * 16 + hi * 8) * 2, RB));
            p0 = MFMA32(a0, qr[d0], p0); p1 = MFMA32(a1, qr[d0], p1);
        }
        if (MODE == 1) {
            typedef int i32x4_ __attribute__((ext_vector_type(4)));
            const LAS int* pk = posk + st * 64 + 4 * hi; const LAS float* bt = btab + head * 130;
            int dd[32]; float bb[32];
#pragma unroll
            for (int g = 0; g < 4; ++g) { const i32x4_ a = *(const LAS i32x4_*)(pk + 8 * g), b = *(const LAS i32x4_*)(pk + 32 + 8 * g);
#pragma unroll
                for (int e = 0; e < 4; ++e) { dd[4 * g + e] = posq - a[e]; dd[16 + 4 * g + e] = posq - b[e]; } }
#pragma unroll
            for (int r = 0; r < 32; ++r) { int dc = dd[r] < 0 ? 0 : dd[r]; dc = dc > 128 ? 128 : dc; bb[r] = bt[dc]; }
#pragma unroll
            for (int r = 0; r < 16; ++r) { const int kk = kbase + crow(r, hi);
                const float v0 = fmaf(p0[r], c2, bb[r]), v1 = fmaf(p1[r], c2, bb[16 + r]);
                p0[r] = ((unsigned)(qidx - kk) < 128u) ? v0 : -__builtin_inff(); p1[r] = ((unsigned)(qidx - kk - 32) < 128u) ? v1 : -__builtin_inff(); }
        } else {
#pragma unroll
            for (int r = 0; r < 16; ++r) { p0[r] *= c2; p1[r] *= c2; }
        }
        float pmax = p0[0];
#pragma unroll
        for (int r = 1; r < 16; ++r) pmax = fmaxf(pmax, p0[r]);
#pragma unroll
        for (int r = 0; r < 16; ++r) pmax = fmaxf(pmax, p1[r]);
        { auto rr = __builtin_amdgcn_permlane32_swap(__float_as_uint(pmax), __float_as_uint(pmax), false, false); pmax = fmaxf(__uint_as_float(rr[0]), __uint_as_float(rr[1])); }
        const float mn = fmaxf(m_reg, pmax); const float alpha = __builtin_amdgcn_exp2f(m_reg - mn); m_reg = mn;
        float ps = 0.f;
#pragma unroll
        for (int r = 0; r < 16; ++r) { p0[r] = __builtin_amdgcn_exp2f(p0[r] - mn); ps += p0[r]; }
#pragma unroll
        for (int r = 0; r < 16; ++r) { p1[r] = __builtin_amdgcn_exp2f(p1[r] - mn); ps += p1[r]; }
        { auto rr = __builtin_amdgcn_permlane32_swap(__float_as_uint(ps), __float_as_uint(ps), false, false); ps = __uint_as_float(rr[0]) + __uint_as_float(rr[1]); }
        l_reg = l_reg * alpha + ps;
        if (__any(alpha < 1.f)) {
            if (hi == 0) al_l[r32] = alpha;
            LDS_WAIT();
#pragma unroll
            for (int g = 0; g < 4; ++g) { const f32x4 a4 = *(const LAS f32x4*)(al_l + 8 * g + 4 * hi);
#pragma unroll
                for (int d = 0; d < NV; ++d) { o[d][4 * g + 0] *= a4[0]; o[d][4 * g + 1] *= a4[1]; o[d][4 * g + 2] *= a4[2]; o[d][4 * g + 3] *= a4[3]; } }
        }
        bf16x8 pa0, pa1, pa2, pa3;
#define PK4(P, B_, OUT) do { const unsigned a0_ = cvtpk(P[B_ + 0], P[B_ + 1]), a1_ = cvtpk(P[B_ + 2], P[B_ + 3]), b0_ = cvtpk(P[B_ + 4], P[B_ + 5]), b1_ = cvtpk(P[B_ + 6], P[B_ + 7]); \
        auto r0_ = __builtin_amdgcn_permlane32_swap(a0_, b0_, false, false); auto r1_ = __builtin_amdgcn_permlane32_swap(a1_, b1_, false, false); \
        u32x4 w_ = {r0_[0], r1_[0], r0_[1], r1_[1]}; OUT = __builtin_bit_cast(bf16x8, w_); } while (0)
        PK4(p0, 0, pa0); PK4(p0, 8, pa1); PK4(p1, 0, pa2); PK4(p1, 8, pa3);
#undef PK4
        const unsigned vba = vb0 + (unsigned)(st * STG);
#define TRRD(dst, off) asm volatile("ds_read_b64_tr_b16 %0, %1 offset:%2" : "=&v"(dst) : "v"(vba), "i"(off) : "memory")
#define PV_D0(d0) do { s16x4 l0, l1, l2, l3, h0, h1, h2, h3; constexpr int KS_ = NV * 1024, HF_ = NV * 512, b_ = (d0) * 512; \
        TRRD(l0, b_); TRRD(h0, b_ + HF_); TRRD(l1, b_ + KS_); TRRD(h1, b_ + KS_ + HF_); TRRD(l2, b_ + 2 * KS_); TRRD(h2, b_ + 2 * KS_ + HF_); TRRD(l3, b_ + 3 * KS_); TRRD(h3, b_ + 3 * KS_ + HF_); \
        asm volatile("s_waitcnt lgkmcnt(0)" ::: "memory"); SBAR(); \
        o[d0] = MFMA32(pa0, ((bf16x8){l0[0], l0[1], l0[2], l0[3], h0[0], h0[1], h0[2], h0[3]}), o[d0]); \
        o[d0] = MFMA32(pa1, ((bf16x8){l1[0], l1[1], l1[2], l1[3], h1[0], h1[1], h1[2], h1[3]}), o[d0]); \
        o[d0] = MFMA32(pa2, ((bf16x8){l2[0], l2[1], l2[2], l2[3], h2[0], h2[1], h2[2], h2[3]}), o[d0]); \
        o[d0] = MFMA32(pa3, ((bf16x8){l3[0], l3[1], l3[2], l3[3], h3[0], h3[1], h3[2], h3[3]}), o[d0]); } while (0)
        PV_D0(0); PV_D0(1);
        if constexpr (NV == 4) { PV_D0(2); PV_D0(3); }
#undef PV_D0
#undef TRRD
        if (t + 1 < t_hi) WRITE_TILE(st ^ 1);
        __syncthreads();
    }
#undef LOAD_TILE
#undef WRITE_TILE
}
template <int DV>
__device__ __forceinline__ void gated_store(LAS unsigned char* lds, float l_reg, const f32x16 (&o)[DV / 32], bf16_t* zp0) {
    constexpr int NV = DV / 32, OP = DV + 8, CPR = DV / 8;
    const int tid = tidx(), lane = tid & 63, r32 = lane & 31, hi = lane >> 5, wid = __builtin_amdgcn_readfirstlane(tid >> 6);
    LAS float* li_l = (LAS float*)(lds + L_WS) + wid * 64; LAS bf16_t* ost = (LAS bf16_t*)(lds + L_OST + wid * OST_WAVE);
    asm volatile("s_waitcnt lgkmcnt(0)" ::: "memory");
    if (hi == 0) li_l[r32] = l_reg;
    asm volatile("s_waitcnt lgkmcnt(0)" ::: "memory");
#pragma unroll
    for (int g = 0; g < 4; ++g) { const f32x4 a4 = *(const LAS f32x4*)(li_l + 8 * g + 4 * hi);
#pragma unroll
        for (int e = 0; e < 4; ++e) { const float rl = 1.f / a4[e]; const int row = 8 * g + 4 * hi + e;
#pragma unroll
            for (int d0 = 0; d0 < NV; ++d0) ost[row * OP + d0 * 32 + r32] = f2bf(o[d0][4 * g + e] * rl); } }
    asm volatile("s_waitcnt lgkmcnt(0)" ::: "memory");
#pragma unroll
    for (int i = 0; i < (32 * CPR) / 64; ++i) { const int id = lane + 64 * i, row = id / CPR, dc = id % CPR;
        const u32x4 v = *(const LAS u32x4*)(ost + row * OP + dc * 8); bf16_t* zp = zp0 + (size_t)row * NP + dc * 8; const u32x4 z = *(const u32x4*)zp;
        u32x4 w; w.x = cvtpk(lo_bf(v.x) * silu_f(lo_bf(z.x)), hi_bf(v.x) * silu_f(hi_bf(z.x))); w.y = cvtpk(lo_bf(v.y) * silu_f(lo_bf(z.y)), hi_bf(v.y) * silu_f(hi_bf(z.y)));
        w.z = cvtpk(lo_bf(v.z) * silu_f(lo_bf(z.z)), hi_bf(v.z) * silu_f(hi_bf(z.z))); w.w = cvtpk(lo_bf(v.w) * silu_f(lo_bf(z.w)), hi_bf(v.w) * silu_f(hi_bf(z.w)));
        *(u32x4*)zp = w; }
}
__device__ __forceinline__ void swa_unit(LAS unsigned char* lds, int qb, int hk, bf16_t* PROJ, const int* pos, const float* sinks  ) {
    const int tid = tidx(), lane = tid & 63, r32 = lane & 31, wid = __builtin_amdgcn_readfirstlane(tid >> 6);
    const int head = hk * 4 + (wid >> 1), q0 = qb * 64 + (wid & 1) * 32;
    const float sink = sinks[head] * LOG2E;
    float m = sink, l = 1.f; f32x16 o[2] = {};
    int t_lo = (qb * 64 - 128) / 64; if (t_lo < 0) t_lo = 0;
#ifdef EXP_DUPSWA
    attn_core<64, 64, 1>(lds, PROJ + (size_t)(q0 + r32) * NP + C_AQ + head * 64, PROJ + C_AK + hk * 64, NP, PROJ + C_AV + hk * 64, NP, t_lo, qb + 1, 0.125f * LOG2E, q0 + r32, head, pos, m, l, o);
    m = sink; l = 1.f; o[0] = (f32x16){}; o[1] = (f32x16){}; __syncthreads();
#endif
    attn_core<64, 64, 1>(lds, PROJ + (size_t)(q0 + r32) * NP + C_AQ + head * 64, PROJ + C_AK + hk * 64, NP, PROJ + C_AV + hk * 64, NP, t_lo, qb + 1, 0.125f * LOG2E, q0 + r32, head, pos, m, l, o);
    gated_store<64>(lds, l, o, PROJ + (size_t)q0 * NP + C_Z + head * 64);
}
__device__ __forceinline__ void cross_unit(LAS unsigned char* lds, int qb, int h, bf16_t* PROJ, const bf16_t* MEMKV  ) {
    const int tid = tidx(), lane = tid & 63, r32 = lane & 31, wid = __builtin_amdgcn_readfirstlane(tid >> 6);
    const int q0 = qb * 256 + wid * 32;
    float m = -1e30f, l = 0.f; f32x16 o[4] = {};
#ifdef EXP_DUPCROSS
    attn_core<128, 128, 2>(lds, PROJ + (size_t)(q0 + r32) * NP + C_DQ + h * 128, MEMKV + h * 128, 1024, MEMKV + 512 + h * 128, 1024, 0, 4, 0.08838834764831845f * LOG2E, q0 + r32, 0, nullptr, m, l, o);
    m = -1e30f; l = 0.f; o[0] = (f32x16){}; o[1] = (f32x16){}; o[2] = (f32x16){}; o[3] = (f32x16){}; __syncthreads();
#endif
    attn_core<128, 128, 2>(lds, PROJ + (size_t)(q0 + r32) * NP + C_DQ + h * 128, MEMKV + h * 128, 1024, MEMKV + 512 + h * 128, 1024, 0, 4, 0.08838834764831845f * LOG2E, q0 + r32, 0, nullptr, m, l, o);
    gated_store<128>(lds, l, o, PROJ + (size_t)q0 * NP + C_Z + 1536 + h * 128);
}
__device__ __forceinline__ void run_mixers(LAS unsigned char* lds, unsigned* ctr, bf16_t* PROJ, const int* pos, const float* sinks, const float* btab_g, const bf16_t* MEMKV) {
    LAS int* ub = (LAS int*)(lds + L_UNIT);
    __syncthreads();
    for (int i = tidx(); i < 129 * 8; i += NT_THREADS) ((LAS float*)(lds + L_BTAB))[(i & 7) * 130 + (i >> 3)] = btab_g[i];
    for (;;) {
        __syncthreads();
        if (tidx() == 0) *ub = (int)atomicAdd(ctr, 1u);
        __syncthreads();
        const int u = *ub;
        if (u >= 768) break;
        if (u < 256) cross_unit(lds, u >> 2, u & 3, PROJ, MEMKV); else swa_unit(lds, (u - 256) >> 1, (u - 256) & 1, PROJ, pos, sinks);
    }
}
}
namespace mla {
constexpr int ST_BYTES = 49152  , R_OFF = 32768, L_SCR = 147456  , L_UNIT = 149504, L_OLT = 67584  , L_OUT = 102400  ;
__device__ __forceinline__ unsigned off_a(unsigned row, unsigned ch) { return 2048u * (row >> 3) + 512u * (ch >> 2) + 64u * (row & 7) + 16u * ((ch & 3) ^ ((row >> 2) & 3)); }
__device__ __forceinline__ unsigned off_r(unsigned row, unsigned ch) { return 1024u * (row >> 3) + 512u * (ch >> 2) + 64u * (row & 7) + 16u * ((ch & 3) ^ ((row >> 2) & 3)); }

#ifdef EXP_MLASEC
#define MSEC(i) do { const unsigned long long t_ = __builtin_amdgcn_s_memrealtime(); macc[i] += t_ - mtm; mtm = t_; } while (0)
#define MSEC_ARGS , unsigned long long (&macc)[8], unsigned long long& mtm
#define MSEC_PASS , macc, mtm
#else
#define MSEC(i)
#define MSEC_ARGS
#define MSEC_PASS
#endif
template <int VAR, bool SAFE> __device__ __forceinline__ bool unit(LAS unsigned char* lds, int qb, int h, const bf16_t* QABS, const bf16_t* KVLAT, bf16_t* PROJ, const bf16_t* WUV, const float* rsq, const float* cosT, const float* sinT, float qscale MSEC_ARGS) {
    const int tid = tidx(), lane = tid & 63, r32 = lane & 31, hi = lane >> 5, wid = __builtin_amdgcn_readfirstlane(tid >> 6), kg = wid >> 2, g = wid & 3;
    const int q0 = qb * 128, qloc = 32 * g + r32, qidx = q0 + qloc;
    bf16x8 qr[12];
    { const bf16_t* qrow = QABS + (size_t)qidx * 768 + h * 192;
#pragma unroll
      for (int d0 = 0; d0 < 12; ++d0) qr[d0] = *(const bf16x8*)(qrow + d0 * 16 + hi * 8);
      const float sc = rsq[qidx] * qscale;
#pragma unroll
      for (int d0 = 0; d0 < 12; ++d0) { const u32x4 w = __builtin_bit_cast(u32x4, qr[d0]);
          float v[8] = {lo_bf(w.x) * sc, hi_bf(w.x) * sc, lo_bf(w.y) * sc, hi_bf(w.y) * sc, lo_bf(w.z) * sc, hi_bf(w.z) * sc, lo_bf(w.w) * sc, hi_bf(w.w) * sc};
          if (d0 >= 8) { const int i0 = (d0 - 8) * 8 + hi * 4; const f32x4 c = *(const f32x4*)(cosT + (size_t)qidx * 32 + i0), s = *(const f32x4*)(sinT + (size_t)qidx * 32 + i0);
#pragma unroll
              for (int jj = 0; jj < 4; ++jj) { const float t1 = v[2 * jj], t2 = v[2 * jj + 1]; v[2 * jj] = t1 * c[jj] - t2 * s[jj]; v[2 * jj + 1] = t1 * s[jj] + t2 * c[jj]; }
              SBAR(); }
          qr[d0] = pack8(v); } }
    SBAR();
    unsigned goff[6];
#pragma unroll
    for (int i = 0; i < 6; ++i) { const unsigned o_ = (unsigned)(wid * 6 + i) * 1024u + lane * 16u; unsigned key, cc;
        if (o_ < (unsigned)R_OFF) { const unsigned r = o_ & 2047u, k7 = (r & 511u) >> 6, x = (r & 63u) >> 4; key = (o_ >> 11) * 8u + k7; cc = (r >> 9) * 4u + (x ^ ((key >> 2) & 3u)); }
        else { const unsigned o2 = o_ - R_OFF, r = o2 & 1023u, k7 = (r & 511u) >> 6, x = (r & 63u) >> 4; key = (o2 >> 10) * 8u + k7; cc = 16u + (r >> 9) * 4u + (x ^ ((key >> 2) & 3u)); }
        goff[i] = (key * 192u + cc * 8u) * 2u; }
#define STAGE_TILE(t_, SB) do { const char* src_ = (const char*)KVLAT + (size_t)(t_) * (128 * 192 * 2); const unsigned la_ = (unsigned)(uintptr_t)lds + (SB) + wid * 6144; \
        _Pragma("unroll") for (int i = 0; i < 6; ++i) asm volatile("s_mov_b32 m0, %0\n\ts_nop 0\n\tglobal_load_lds_dwordx4 %1, %2" :: "s"(la_ + i * 1024), "v"(goff[i]), "s"(src_) : "memory", "m0"); } while (0)
    STAGE_TILE(0, 0);
    if (qb >= 1) STAGE_TILE(1, ST_BYTES);
    const unsigned y = (r32 >> 2) & 3, rowpart = 64u * (r32 & 7);
    const unsigned nb_e = 2048u * (8 * kg + (r32 >> 3)) + rowpart + 16u * ((unsigned)hi ^ y), nb_o = 2048u * (8 * kg + (r32 >> 3)) + rowpart + 16u * ((2u + hi) ^ y);
    const unsigned rb_e = R_OFF + 1024u * (8 * kg + (r32 >> 3)) + rowpart + 16u * ((unsigned)hi ^ y), rb_o = R_OFF + 1024u * (8 * kg + (r32 >> 3)) + rowpart + 16u * ((2u + hi) ^ y);
    const unsigned blk = (lane >> 4) & 1, q_ = (lane & 15) >> 2, p_ = lane & 3, xc = 2u * blk + (p_ >> 1);
    const unsigned tbo0 = 2048u * (8 * kg) + 64u * (4u * hi + q_) + 16u * (xc ^ (unsigned)hi) + 8u * (p_ & 1), tbo1 = 2048u * (8 * kg + 1) + 64u * (4u * hi + q_) + 16u * (xc ^ (2u + hi)) + 8u * (p_ & 1);
    LAS float* scr = (LAS float*)(lds + L_SCR) + wid * 64;
    float m_reg = -1e30f, l_reg = 0.f; f32x16 o[4] = {};
    bf16x8 paX0, paX1, paY0 = {}, paY1 = {};
    f32x16 pA, pB;
#define KADDR(s, hf) ((s) < 8 ? ((((s) & 1) ? no_ : ne_) + 512 * ((s) >> 1) + 8192 * (hf)) : ((((s) & 1) ? ro_ : re_) + 512 * (((s) - 8) >> 1) + 4096 * (hf)))
#define KRD1(dst, s, hf) dst = *(const LAS bf16x8*)KADDR(s, hf)
#define VRD1(L, H, d0, ka) do { L = __builtin_amdgcn_ds_read_tr16_b64_v4i16((LAS s16x4*)(t0a_ + 4096 * (ka) + 512 * (d0))); H = __builtin_amdgcn_ds_read_tr16_b64_v4i16((LAS s16x4*)(t1a_ + 4096 * (ka) + 512 * (d0))); } while (0)
#define VFR(L, H) ((bf16x8){L[0], L[1], L[2], L[3], H[0], H[1], H[2], H[3]})
#define QBASES(SB) const LAS unsigned char* ne_ = lds + (SB) + nb_e; const LAS unsigned char* no_ = lds + (SB) + nb_o; const LAS unsigned char* re_ = lds + (SB) + rb_e; const LAS unsigned char* ro_ = lds + (SB) + rb_o
#define PBASES(SB) LAS unsigned char* t0a_ = lds + (SB) + tbo0; LAS unsigned char* t1a_ = lds + (SB) + tbo1
#define QKQ_SERIAL(PN, SB, hf) do { QBASES(SB); PN = (f32x16){}; _Pragma("unroll") for (int s_ = 0; s_ < 12; ++s_) { bf16x8 k_; KRD1(k_, s_, hf); PN = MFMA32(k_, qr[s_], PN); } } while (0)
#define PVQ_SERIAL(SB, hf, PA0, PA1) do { PBASES(SB); _Pragma("unroll") for (int j_ = 0; j_ < 8; ++j_) { s16x4 l_, h_; VRD1(l_, h_, j_ >> 1, 2 * (hf) + (j_ & 1)); o[j_ >> 1] = MFMA32((j_ & 1) ? PA1 : PA0, VFR(l_, h_), o[j_ >> 1]); } } while (0)
#define ROWMAX16(P, out) do { float a_ = fmaxf(fmaxf(P[0], P[1]), P[2]), b_ = fmaxf(fmaxf(P[3], P[4]), P[5]), c_ = fmaxf(fmaxf(P[6], P[7]), P[8]), d_ = fmaxf(fmaxf(P[9], P[10]), P[11]), e_ = fmaxf(fmaxf(P[12], P[13]), P[14]); \
        a_ = fmaxf(fmaxf(a_, b_), P[15]); c_ = fmaxf(fmaxf(c_, d_), e_); out = fmaxf(a_, c_); } while (0)
#define HALVES_MAX(v) do { auto rr = __builtin_amdgcn_permlane32_swap(__float_as_uint(v), __float_as_uint(v), false, false); v = fmaxf(__uint_as_float(rr[0]), __uint_as_float(rr[1])); } while (0)
#define RESCALE_O(alpha_) do { if (hi == 0) scr[r32] = (alpha_); LDS_WAIT(); \
            _Pragma("unroll") for (int gg = 0; gg < 4; ++gg) { const f32x4 a4 = *(const LAS f32x4*)(scr + 8 * gg + 4 * hi); \
                _Pragma("unroll") for (int d = 0; d < 4; ++d) { o[d][4 * gg + 0] *= a4[0]; o[d][4 * gg + 1] *= a4[1]; o[d][4 * gg + 2] *= a4[2]; o[d][4 * gg + 3] *= a4[3]; } } } while (0)
#define DIAG_MASK() do { const int t2_ = tidx(); int ql_ = 32 * ((t2_ >> 6) & 3) + (t2_ & 31) - 64 * (t2_ >> 8) - 4 * ((t2_ >> 5) & 1); asm volatile("" : "+v"(ql_)); \
        _Pragma("unroll") for (int r = 0; r < 16; ++r) { const int kc_ = (r & 3) + 8 * (r >> 2); if (kc_ > ql_) pA[r] = -__builtin_inff(); if (kc_ + 32 > ql_) pB[r] = -__builtin_inff(); } } while (0)
    asm volatile("s_waitcnt vmcnt(0)" ::: "memory");
    __syncthreads();
    MSEC(0);
    if constexpr (!SAFE) {
#define SMC(i, PC, PE0, PE1) do { if ((i) < 16) { const float e_ = __builtin_amdgcn_exp2f(PC[i]); \
            if (((i) & 3) == 0) l0_ += e_; else if (((i) & 3) == 1) l1_ += e_; else if (((i) & 3) == 2) l2_ += e_; else l3_ += e_; \
            if (((i) & 1) == 0) ev_ = e_; else { const unsigned c_ = cvtpk(ev_, e_); if (((i) >> 1 & 3) == 0) c0_ = c_; else if (((i) >> 1 & 3) == 1) c1_ = c_; else if (((i) >> 1 & 3) == 2) c2_ = c_; else c3_ = c_; } \
            if ((i) == 7) { u32x4 w_ = {c0_, c1_, c2_, c3_}; PE0 = __builtin_bit_cast(bf16x8, w_); } if ((i) == 15) { u32x4 w_ = {c0_, c1_, c2_, c3_}; PE1 = __builtin_bit_cast(bf16x8, w_); } } } while (0)
#define SLOT_ISQ(i) (((i) < 16) ? (((i) & 1) == 0) : true)
#define SLOT_QS(i) (((i) < 16) ? ((i) >> 1) : ((i) - 8))
#define SLOT_PJ(i) ((i) >> 1)
#define RD_SLOT(i, HQ, HP) do { if ((i) < 20) { if (SLOT_ISQ(i)) { if (SLOT_QS(i) % 3 == 0) KRD1(kf0, SLOT_QS(i), HQ); else if (SLOT_QS(i) % 3 == 1) KRD1(kf1, SLOT_QS(i), HQ); else KRD1(kf2, SLOT_QS(i), HQ); } \
        else { if (SLOT_PJ(i) & 1) VRD1(vl1, vh1, SLOT_PJ(i) >> 1, 2 * (HP) + 1); else VRD1(vl0, vh0, SLOT_PJ(i) >> 1, 2 * (HP)); } } } while (0)
#define MM_SLOT(i, PN, PA0, PA1) do { if (SLOT_ISQ(i)) { if (SLOT_QS(i) % 3 == 0) PN = MFMA32(kf0, qr[SLOT_QS(i)], PN); else if (SLOT_QS(i) % 3 == 1) PN = MFMA32(kf1, qr[SLOT_QS(i)], PN); else PN = MFMA32(kf2, qr[SLOT_QS(i)], PN); } \
        else { if (SLOT_PJ(i) & 1) o[(SLOT_PJ(i) >> 1) & 3] = MFMA32(PA1, VFR(vl1, vh1), o[(SLOT_PJ(i) >> 1) & 3]); else o[(SLOT_PJ(i) >> 1) & 3] = MFMA32(PA0, VFR(vl0, vh0), o[(SLOT_PJ(i) >> 1) & 3]); } } while (0)
#define SLOT(i, PN, HQ, HP, PA0, PA1, PC, PE0, PE1) do { MM_SLOT(i, PN, PA0, PA1); RD_SLOT((i) + 2, HQ, HP); if (!(VAR & 2)) SMC(i, PC, PE0, PE1); SBAR(); } while (0)
#define ITER(PN, SBQ, HQ, SBP, HP, PA0, PA1, PC, PE0, PE1) do { QBASES(SBQ); PBASES(SBP); bf16x8 kf0, kf1, kf2; s16x4 vl0, vh0, vl1, vh1; float ev_ = 0.f; unsigned c0_ = 0, c1_ = 0, c2_ = 0, c3_ = 0; \
        PN = (f32x16){}; RD_SLOT(0, HQ, HP); RD_SLOT(1, HQ, HP); SBAR(); \
        SLOT(0, PN, HQ, HP, PA0, PA1, PC, PE0, PE1); SLOT(1, PN, HQ, HP, PA0, PA1, PC, PE0, PE1); SLOT(2, PN, HQ, HP, PA0, PA1, PC, PE0, PE1); SLOT(3, PN, HQ, HP, PA0, PA1, PC, PE0, PE1); \
        SLOT(4, PN, HQ, HP, PA0, PA1, PC, PE0, PE1); SLOT(5, PN, HQ, HP, PA0, PA1, PC, PE0, PE1); SLOT(6, PN, HQ, HP, PA0, PA1, PC, PE0, PE1); SLOT(7, PN, HQ, HP, PA0, PA1, PC, PE0, PE1); \
        SLOT(8, PN, HQ, HP, PA0, PA1, PC, PE0, PE1); SLOT(9, PN, HQ, HP, PA0, PA1, PC, PE0, PE1); SLOT(10, PN, HQ, HP, PA0, PA1, PC, PE0, PE1); SLOT(11, PN, HQ, HP, PA0, PA1, PC, PE0, PE1); \
        SLOT(12, PN, HQ, HP, PA0, PA1, PC, PE0, PE1); SLOT(13, PN, HQ, HP, PA0, PA1, PC, PE0, PE1); SLOT(14, PN, HQ, HP, PA0, PA1, PC, PE0, PE1); SLOT(15, PN, HQ, HP, PA0, PA1, PC, PE0, PE1); \
        SLOT(16, PN, HQ, HP, PA0, PA1, PC, PE0, PE1); SLOT(17, PN, HQ, HP, PA0, PA1, PC, PE0, PE1); SLOT(18, PN, HQ, HP, PA0, PA1, PC, PE0, PE1); SLOT(19, PN, HQ, HP, PA0, PA1, PC, PE0, PE1); } while (0)
    float l0_ = 0.f, l1_ = 0.f, l2_ = 0.f, l3_ = 0.f;
    unsigned s_prev = 2 * ST_BYTES, s_cur = 0, s_next = ST_BYTES;
    QKQ_SERIAL(pA, s_cur, 0);
#pragma unroll 1
    for (int t = 0; t < qb; ++t) {
        { const unsigned sp_ = t ? s_prev : s_cur; ITER(pB, s_cur, 1, sp_, 1, paY0, paY1, pA, paX0, paX1); }
        asm volatile("s_waitcnt vmcnt(0)" ::: "memory");
        if (!(VAR & 16)) __syncthreads();
        if (t + 2 <= qb && !(VAR & 8)) STAGE_TILE(t + 2, s_prev);
        ITER(pA, s_next, 0, s_cur, 0, paX0, paX1, pB, paY0, paY1);
        { const unsigned tmp_ = s_prev; s_prev = s_cur; s_cur = s_next; s_next = tmp_; }
    }
    if (qb > 0) PVQ_SERIAL(s_prev, 1, paY0, paY1);
    QKQ_SERIAL(pB, s_cur, 1);
    DIAG_MASK();
#pragma unroll
    for (int r = 0; r < 16; ++r) { pA[r] = __builtin_amdgcn_exp2f(pA[r]); pB[r] = __builtin_amdgcn_exp2f(pB[r]); l0_ += pA[r]; l1_ += pB[r]; }
    paX0 = pack_step(pA, 0); paX1 = pack_step(pA, 1); paY0 = pack_step(pB, 0); paY1 = pack_step(pB, 1);
    PVQ_SERIAL(s_cur, 0, paX0, paX1);
    PVQ_SERIAL(s_cur, 1, paY0, paY1);
    l_reg = (l0_ + l1_) + (l2_ + l3_); m_reg = 0.f;
#undef SMC
#undef SLOT_ISQ
#undef SLOT_QS
#undef SLOT_PJ
#undef RD_SLOT
#undef MM_SLOT
#undef SLOT
#undef ITER
    } else {
#pragma unroll 1
    for (int t = 0; t <= qb; ++t) {
        __syncthreads();
        STAGE_TILE(t, 0);
        asm volatile("s_waitcnt vmcnt(0)" ::: "memory");
        __syncthreads();
        QKQ_SERIAL(pA, 0, 0); QKQ_SERIAL(pB, 0, 1);
        if (t == qb) DIAG_MASK();
        float pm_, pm2_; ROWMAX16(pA, pm_); ROWMAX16(pB, pm2_); pm_ = fmaxf(pm_, pm2_); HALVES_MAX(pm_);
        const float mn_ = fmaxf(m_reg, pm_), al_ = __builtin_amdgcn_exp2f(m_reg - mn_); m_reg = mn_; float ps_ = 0.f;
#pragma unroll
        for (int r = 0; r < 16; ++r) { pA[r] = __builtin_amdgcn_exp2f(pA[r] - mn_); pB[r] = __builtin_amdgcn_exp2f(pB[r] - mn_); ps_ += pA[r] + pB[r]; }
        l_reg = l_reg * al_ + ps_;
        if (__any(al_ < 1.f)) RESCALE_O(al_);
        paX0 = pack_step(pA, 0); paX1 = pack_step(pA, 1); paY0 = pack_step(pB, 0); paY1 = pack_step(pB, 1);
        PVQ_SERIAL(0, 0, paX0, paX1);
        PVQ_SERIAL(0, 1, paY0, paY1);
    }
    }
    { auto rr = __builtin_amdgcn_permlane32_swap(__float_as_uint(l_reg), __float_as_uint(l_reg), false, false); l_reg = __uint_as_float(rr[0]) + __uint_as_float(rr[1]); }
    if (!(l_reg > 0.f)) m_reg = -1e30f;
    if (tidx() == 0) *(LAS int*)(lds + L_UNIT + 8) = 0;
    __syncthreads();
#undef KADDR
#undef KRD1
#undef VRD1
#undef VFR
#undef QBASES
#undef PBASES
#undef QKQ_SERIAL
#undef PVQ_SERIAL
#undef ROWMAX16
#undef HALVES_MAX
#undef RESCALE_O
#undef DIAG_MASK
    if (VAR != 0) { asm volatile("" :: "v"(o[0]), "v"(o[1]), "v"(o[2]), "v"(o[3]), "v"(m_reg), "v"(l_reg)); return false; }
#undef STAGE_TILE
    const int tid_e = tidx(), lane_e = tid_e & 63; const int wid_e = __builtin_amdgcn_readfirstlane(tid_e >> 6);
#define lane lane_e
#define r32 (lane_e & 31)
#define hi (lane_e >> 5)
#define kg (wid_e >> 2)
#define g (wid_e & 3)
    LAS float* scr_e = (LAS float*)(lds + L_SCR) + wid_e * 64;
#define scr scr_e
    LAS float* xo = (LAS float*)lds + g * 4096;
    LAS float* xm = (LAS float*)(lds + 65536) + g * 128;
    if (kg == 1) {
#pragma unroll
        for (int d0 = 0; d0 < 4; ++d0)
#pragma unroll
            for (int r = 0; r < 16; ++r) xo[(d0 * 16 + r) * 64 + lane] = o[d0][r];
        xm[lane] = m_reg; xm[64 + lane] = l_reg;
    }
    __syncthreads();
    float fA = 0.f, fB = 0.f, li = 0.f;
    if (kg == 0) {
        const float mB = xm[lane], lB = xm[64 + lane];
        const float m = fmaxf(m_reg, mB); fA = __builtin_amdgcn_exp2f(m_reg - m); fB = __builtin_amdgcn_exp2f(mB - m); const float ls = l_reg * fA + lB * fB; li = 1.f / ls;
#ifdef EXP_FORCE_SAFE
        if (!SAFE) *(LAS int*)(lds + L_UNIT + 8) = 1;
#else
        if (!SAFE && !(ls > 7.9e-31f && ls < 1.2e30f)) *(LAS int*)(lds + L_UNIT + 8) = 1;
#endif
    }
    if constexpr (!SAFE) { __syncthreads(); if (*(LAS int*)(lds + L_UNIT + 8)) { __syncthreads(); return true; } }
    if (kg == 0) {
        if (hi == 0) { scr[r32] = fA * li; scr[32 + r32] = fB * li; }
        LDS_WAIT();
        float sA[16], sB[16];
#pragma unroll
        for (int gg = 0; gg < 4; ++gg) { const f32x4 a4 = *(const LAS f32x4*)(scr + 8 * gg + 4 * hi), b4 = *(const LAS f32x4*)(scr + 32 + 8 * gg + 4 * hi);
            sA[4 * gg] = a4[0]; sA[4 * gg + 1] = a4[1]; sA[4 * gg + 2] = a4[2]; sA[4 * gg + 3] = a4[3]; sB[4 * gg] = b4[0]; sB[4 * gg + 1] = b4[1]; sB[4 * gg + 2] = b4[2]; sB[4 * gg + 3] = b4[3]; }
        LAS bf16_t* olt = (LAS bf16_t*)(lds + L_OLT + g * 8704); LAS bf16_t* ot = (LAS bf16_t*)(lds + L_OUT + g * 8704);
#pragma unroll
        for (int d0 = 0; d0 < 4; ++d0) {
#pragma unroll
            for (int r = 0; r < 16; ++r) olt[crow(r, hi) * 136 + d0 * 32 + r32] = f2bf(o[d0][r] * sA[r] + xo[(d0 * 16 + r) * 64 + lane] * sB[r]);
            SBAR(); }
        LDS_WAIT();
        bf16x8 af[8];
#pragma unroll
        for (int ks = 0; ks < 8; ++ks) af[ks] = *(const LAS bf16x8*)(olt + r32 * 136 + 16 * ks + 8 * hi);
        f32x16 y[4] = {};
        const bf16_t* wb = WUV + (size_t)(h * 128 + r32) * 512 + h * 128 + 8 * hi;
#pragma unroll
        for (int c = 0; c < 4; ++c)
#pragma unroll
            for (int ks = 0; ks < 8; ++ks) y[c] = MFMA32(af[ks], *(const bf16x8*)(wb + (size_t)(32 * c) * 512 + 16 * ks), y[c]);
#pragma unroll
        for (int r = 0; r < 16; ++r)
#pragma unroll
            for (int c = 0; c < 4; ++c) ot[crow(r, hi) * 136 + 32 * c + r32] = f2bf(y[c][r]);
        LDS_WAIT();
        bf16_t* zp0 = PROJ + (size_t)(q0 + 32 * g) * NP + C_Z + 1024 + h * 128;
#pragma unroll
        for (int i = 0; i < 8; ++i) { const int id = lane + 64 * i, row = id >> 4, dc = id & 15;
            const u32x4 v = *(const LAS u32x4*)(ot + row * 136 + dc * 8); bf16_t* zp = zp0 + (size_t)row * NP + dc * 8; const u32x4 z = *(const u32x4*)zp;
            u32x4 w; w.x = cvtpk(lo_bf(v.x) * silu_f(lo_bf(z.x)), hi_bf(v.x) * silu_f(hi_bf(z.x))); w.y = cvtpk(lo_bf(v.y) * silu_f(lo_bf(z.y)), hi_bf(v.y) * silu_f(hi_bf(z.y)));
            w.z = cvtpk(lo_bf(v.z) * silu_f(lo_bf(z.z)), hi_bf(v.z) * silu_f(hi_bf(z.z))); w.w = cvtpk(lo_bf(v.w) * silu_f(lo_bf(z.w)), hi_bf(v.w) * silu_f(hi_bf(z.w)));
            *(u32x4*)zp = w; }
    }
    __syncthreads();
    MSEC(6);
#undef lane
#undef r32
#undef hi
#undef kg
#undef g
#undef scr
    return false;
}
__device__ __forceinline__ void run_queue(LAS unsigned char* lds, unsigned* ctr, const bf16_t* QABS, const bf16_t* KVLAT, bf16_t* PROJ, const bf16_t* WUV, const float* rsq, const float* cosT, const float* sinT, float qscale) {
    LAS int* ub = (LAS int*)(lds + L_UNIT);
#ifdef EXP_MLASEC
    unsigned long long macc[8] = {0, 0, 0, 0, 0, 0, 0, 0}, mtm = __builtin_amdgcn_s_memrealtime();
#endif
    for (;;) {
        __syncthreads();
        if (tidx() == 0) *ub = (int)atomicAdd(ctr, 1u);
        __syncthreads();
        const int u = *ub;
        if (u >= 512) break;
        MSEC(7);
        if (unit<0, false>(lds, 127 - (u >> 2), u & 3, QABS, KVLAT, PROJ, WUV, rsq, cosT, sinT, qscale MSEC_PASS)) (void)unit<0, true>(lds, 127 - (u >> 2), u & 3, QABS, KVLAT, PROJ, WUV, rsq, cosT, sinT, qscale MSEC_PASS);
    }
#ifdef EXP_MLAVAR
    for (;;) {
        __syncthreads();
        if (tidx() == 0) *ub = (int)atomicAdd(ctr + 32, 1u);
        __syncthreads();
        const int u = *ub;
        if (u >= 512) break;
        (void)unit<EXP_MLAVAR, false>(lds, 127 - (u >> 2), u & 3, QABS, KVLAT, PROJ, WUV, rsq, cosT, sinT, qscale MSEC_PASS);
    }
#endif
#ifdef EXP_MLASEC
    { const unsigned long long t1_ = __builtin_amdgcn_s_memrealtime(); while (__builtin_amdgcn_s_memrealtime() - t1_ < 4 * macc[EXP_MLASEC]) __builtin_amdgcn_s_sleep(8); }
#endif
}
}
template <class Map>
__device__ __forceinline__ void transpose_tile(const float* W, int ldw, bf16_t* WT, int K, int n0, int k0, LAS float* tile, Map map, int lane) {
    { const int src = map(n0 + lane); float v[64];
#pragma unroll
      for (int k = 0; k < 64; ++k) v[k] = src >= 0 ? W[(size_t)(k0 + k) * ldw + src] : 0.f;
#pragma unroll
      for (int k = 0; k < 64; ++k) tile[k * 65 + lane] = v[k]; }
    LDS_WAIT();
    { const int kc = (lane & 7) * 8;
#pragma unroll
      for (int i = 0; i < 8; ++i) { const int n = (lane >> 3) + 8 * i; float v[8];
#pragma unroll
          for (int j = 0; j < 8; ++j) v[j] = tile[(kc + j) * 65 + n];
          u32x4 w = {cvtpk(v[0], v[1]), cvtpk(v[2], v[3]), cvtpk(v[4], v[5]), cvtpk(v[6], v[7])};
          *(u32x4*)(WT + (size_t)(n0 + n) * K + k0 + kc) = w; } }
    LDS_WAIT();
}
struct MapWin { __device__ int operator()(int n) const { return win_src(n); } };
struct MapId { __device__ int operator()(int n) const { return n; } };

__device__ __forceinline__ void job_win(const Params& p, int l, int gw, int ngw, LAS unsigned char* lds, int wid, int lane) {
    bf16_t* WT = (bf16_t*)(p.ws + WS_WIN); const float* W = p.w_in + (size_t)l * DM * DIN; LAS float* tile = (LAS float*)(lds + wid * 16640);
    for (int t = gw; t < (NP / 64) * (DM / 64); t += ngw) transpose_tile(W, DIN, WT, DM, (t / (DM / 64)) * 64, (t % (DM / 64)) * 64, tile, MapWin(), lane);
}
__device__ __forceinline__ void job_wout(const Params& p, int l, int gw, int ngw, LAS unsigned char* lds, int wid, int lane) {
    bf16_t* WT = (bf16_t*)(p.ws + WS_WOUT); const float* W = p.w_out + (size_t)l * MIXW * DM; LAS float* tile = (LAS float*)(lds + wid * 16640);
    for (int t = gw; t < (DM / 64) * (MIXW / 64); t += ngw) transpose_tile(W, DM, WT, MIXW, (t / (MIXW / 64)) * 64, (t % (MIXW / 64)) * 64, tile, MapId(), lane);
}
__device__ __forceinline__ void job_wmem(const Params& p, int gw, int ngw, LAS unsigned char* lds, int wid, int lane) {
    LAS float* tile = (LAS float*)(lds + wid * 16640);
    for (int t = gw; t < 2 * 16 * 16; t += ngw) { const int l = t >> 8, r = t & 255;
        transpose_tile(p.w_mem + (size_t)l * DM * DM, DM, (bf16_t*)(p.ws + WS_WMEM) + (size_t)l * DM * DM, DM, (r >> 4) * 64, (r & 15) * 64, tile, MapId(), lane); }
}
__device__ __forceinline__ void job_wq(const Params& p, int bid, int nblk, int gtid, int gn, LAS unsigned char* lds) {
    const int tid = tidx(); LAS float* At = (LAS float*)lds; LAS float* Bt = At + 64 * 129;
    for (int it = bid; it < 2 * 4 * 4 * 2; it += nblk) { const int l = it >> 5, h = (it >> 3) & 3, kt = (it >> 1) & 3, ct = it & 1;
        const float* uq = p.w_uq + (size_t)l * 256 * 768 + (size_t)(kt * 64) * 768 + h * 192; const float* ukv = p.w_ukv + (size_t)l * 128 * 1024 + (size_t)(ct * 64) * 1024 + h * 256;
        __syncthreads();
#pragma unroll
        for (int i = 0; i < 16; ++i) { const int e = tid + NT_THREADS * i, r = e >> 7, j = e & 127; At[r * 129 + j] = uq[(size_t)r * 768 + j]; Bt[r * 129 + j] = ukv[(size_t)r * 1024 + j]; }
        __syncthreads();
        const int kk = tid & 63, c0 = (tid >> 6) * 8; float acc[8] = {0.f, 0.f, 0.f, 0.f, 0.f, 0.f, 0.f, 0.f};
#pragma unroll 4
        for (int j = 0; j < 128; ++j) { const float a = At[kk * 129 + j];
#pragma unroll
            for (int e = 0; e < 8; ++e) acc[e] = fmaf(a, Bt[(c0 + e) * 129 + j], acc[e]); }
        const int k = kt * 64 + kk; const float g = p.q_norm[l * 256 + k]; bf16_t* wq = (bf16_t*)(p.ws + WS_WQ) + (size_t)l * 768 * 256;
#pragma unroll
        for (int e = 0; e < 8; ++e) wq[(size_t)(h * 192 + ct * 64 + c0 + e) * 256 + k] = f2bf(acc[e] * g);
    }
    for (int idx = gtid; idx < 2 * 4 * 64 * 256; idx += gn) {
        const int l = idx >> 16, r = idx & 65535, h = r >> 14, w = (r >> 8) & 63, k = r & 255, i = w >> 1, which = w & 1;
        ((bf16_t*)(p.ws + WS_WQ))[(size_t)l * 768 * 256 + (size_t)(h * 192 + 128 + w) * 256 + k] = f2bf(p.w_uq[(size_t)l * 256 * 768 + (size_t)k * 768 + h * 192 + 128 + i + 32 * which] * p.q_norm[l * 256 + k]);
    }
}
__device__ __forceinline__ void job_wuv(const Params& p, int gtid, int gn) {
    for (int idx = gtid; idx < 2 * 512 * 512; idx += gn) {
        const int l = idx / (512 * 512), r = idx % (512 * 512), n = r / 512, k = r % 512, h = n >> 7;
        const float v = (k >> 7) == h ? p.w_ukv[(size_t)l * 128 * 1024 + (size_t)(k & 127) * 1024 + h * 256 + 128 + (n & 127)] : 0.f;
        ((bf16_t*)(p.ws + WS_WUV))[idx] = f2bf(v);
    }
}
__device__ __forceinline__ void job_rope(const Params& p, int gtid, int gn) {
    float* cosT = (float*)(p.ws + WS_COS); float* sinT = (float*)(p.ws + WS_SIN);
    for (int idx = gtid; idx < S * 32; idx += gn) {
        const int s = idx >> 5, i = idx & 31;
        const float angf = (float)p.pos[s] * inv_freq(i);
        const double a = (double)angf; const double kq = __builtin_rint(a * 0.63661977236758134308);
        const double x = (a - kq * 1.5707963267948966192) - kq * 6.123233995736766036e-17;
        const double x2 = x * x;
        const double sn = x * (1.0 + x2 * (-1.0 / 6 + x2 * (1.0 / 120 + x2 * (-1.0 / 5040 + x2 * (1.0 / 362880 + x2 * (-1.0 / 39916800 + x2 * (1.0 / 6227020800.0)))))));
        const double cs = 1.0 + x2 * (-0.5 + x2 * (1.0 / 24 + x2 * (-1.0 / 720 + x2 * (1.0 / 40320 + x2 * (-1.0 / 3628800 + x2 * (1.0 / 479001600.0 + x2 * (-1.0 / 87178291200.0)))))));
        const int q = ((int)kq) & 3;
        const double c = (q == 0) ? cs : (q == 1) ? -sn : (q == 2) ? -cs : sn;
        const double sv = (q == 0) ? sn : (q == 1) ? cs : (q == 2) ? -sn : -cs;
        cosT[idx] = (float)c; sinT[idx] = (float)sv;
    }
}
__device__ __forceinline__ void job_btab(const Params& p, int gtid, int gn) {
    float* bt = (float*)(p.ws + WS_MISC + MISC_BTAB);
    for (int idx = gtid; idx < 129 * 8; idx += gn) { const int d = idx >> 3, h = idx & 7; bt[idx] = p.rel_bias[t5_bucket(d) * 8 + h] * LOG2E; }
}
__device__ __forceinline__ void rms_row_to_bf16(const float* xrow, const float* gain, bf16_t* orow, int lane) {
    f32x4 v[4]; float ss = 0.f;
#pragma unroll
    for (int j = 0; j < 4; ++j) { v[j] = *(const f32x4*)(xrow + 256 * j + 4 * lane); ss += (v[j].x * v[j].x + v[j].y * v[j].y) + (v[j].z * v[j].z + v[j].w * v[j].w); }
    const float rs = rsqrtf(wave_sum(ss) * (1.f / DM) + RMS_EPS);
#pragma unroll
    for (int j = 0; j < 4; ++j) { const f32x4 g = *(const f32x4*)(gain + 256 * j + 4 * lane);
        u32x2 w; w.x = cvtpk(v[j].x * rs * g.x, v[j].y * rs * g.y); w.y = cvtpk(v[j].z * rs * g.z, v[j].w * rs * g.w);
        *(u32x2*)(orow + 256 * j + 4 * lane) = w; }
}
__device__ __forceinline__ void job_memn(const Params& p, int gw, int ngw, int lane) {
    for (int r = gw; r < 2 * MEML; r += ngw) { const int l = r >> 8, m = r & 255;
        rms_row_to_bf16(p.mem + (size_t)m * DM, p.mem_norm + l * DM, (bf16_t*)(p.ws + WS_MEMN) + ((size_t)l * MEML + m) * DM, lane); }
}
__device__ __forceinline__ void job_norm_rows(const Params& p, int mode, int gw, int ngw, int lane) {
    bf16_t* H = (bf16_t*)(p.ws + WS_H); const bf16_t* Y = (const bf16_t*)(p.ws + WS_Y);
    for (int row = gw; row < S; row += ngw) {
        if (mode == 0) { rms_row_to_bf16(p.x + (size_t)row * DM, p.norm_pre, H + (size_t)row * DM, lane); continue; }
        const float* xin = (mode == 1 ? p.x : p.out) + (size_t)row * DM; const float* gpost = p.norm_post + (mode == 1 ? 0 : DM);
        float y[16]; float ss = 0.f;
#pragma unroll
        for (int j = 0; j < 4; ++j) { const u32x2 w = *(const u32x2*)(Y + (size_t)row * DM + 256 * j + 4 * lane);
            y[4 * j] = lo_bf(w.x); y[4 * j + 1] = hi_bf(w.x); y[4 * j + 2] = lo_bf(w.y); y[4 * j + 3] = hi_bf(w.y);
            ss += (y[4 * j] * y[4 * j] + y[4 * j + 1] * y[4 * j + 1]) + (y[4 * j + 2] * y[4 * j + 2] + y[4 * j + 3] * y[4 * j + 3]); }
        const float rs = rsqrtf(wave_sum(ss) * (1.f / DM) + RMS_EPS);
        f32x4 x1[4]; float s2 = 0.f;
#pragma unroll
        for (int j = 0; j < 4; ++j) { const f32x4 xv = *(const f32x4*)(xin + 256 * j + 4 * lane); const f32x4 g = *(const f32x4*)(gpost + 256 * j + 4 * lane);
            x1[j].x = xv.x + y[4 * j] * rs * g.x; x1[j].y = xv.y + y[4 * j + 1] * rs * g.y; x1[j].z = xv.z + y[4 * j + 2] * rs * g.z; x1[j].w = xv.w + y[4 * j + 3] * rs * g.w;
            *(f32x4*)(p.out + (size_t)row * DM + 256 * j + 4 * lane) = x1[j];
            s2 += (x1[j].x * x1[j].x + x1[j].y * x1[j].y) + (x1[j].z * x1[j].z + x1[j].w * x1[j].w); }
        if (mode == 1) { const float r2 = rsqrtf(wave_sum(s2) * (1.f / DM) + RMS_EPS); const float* gpre = p.norm_pre + DM;
#pragma unroll
            for (int j = 0; j < 4; ++j) { const f32x4 g = *(const f32x4*)(gpre + 256 * j + 4 * lane);
                u32x2 w; w.x = cvtpk(x1[j].x * r2 * g.x, x1[j].y * r2 * g.y); w.y = cvtpk(x1[j].z * r2 * g.z, x1[j].w * r2 * g.w);
                *(u32x2*)(H + (size_t)row * DM + 256 * j + 4 * lane) = w; } }
    }
}
__device__ __forceinline__ void job_mla_rows(const Params& p, int l, int gw, int ngw, int lane) {
    const bf16_t* PROJ = (const bf16_t*)(p.ws + WS_PROJ); bf16_t* KV = (bf16_t*)(p.ws + WS_KVLAT); float* RSQ = (float*)(p.ws + WS_MISC + MISC_RSQ);
    const float* cosT = (const float*)(p.ws + WS_COS); const float* sinT = (const float*)(p.ws + WS_SIN);
    const int rs_ = lane >> 4, j = lane & 15;
    for (int row = gw * 4 + rs_; row < S; row += ngw * 4) {
        const bf16_t* pr = PROJ + (size_t)row * NP;
        const u32x4 q0 = *(const u32x4*)(pr + C_CQ + j * 16), q1 = *(const u32x4*)(pr + C_CQ + j * 16 + 8), kv = *(const u32x4*)(pr + C_CKV + j * 8); const u32x2 kr = *(const u32x2*)(pr + C_KR + j * 4);
        f32x4 cs = {0.f, 0.f, 0.f, 0.f}, sn = {0.f, 0.f, 0.f, 0.f}; if (j < 8) { cs = *(const f32x4*)(cosT + (size_t)row * 32 + 4 * j); sn = *(const f32x4*)(sinT + (size_t)row * 32 + 4 * j); }
        float sq = 0.f, sk = 0.f;
        { const unsigned w[8] = {q0.x, q0.y, q0.z, q0.w, q1.x, q1.y, q1.z, q1.w};
#pragma unroll
          for (int e = 0; e < 8; ++e) { const float a = lo_bf(w[e]), b = hi_bf(w[e]); sq += a * a + b * b; } }
        float kvf[8] = {lo_bf(kv.x), hi_bf(kv.x), lo_bf(kv.y), hi_bf(kv.y), lo_bf(kv.z), hi_bf(kv.z), lo_bf(kv.w), hi_bf(kv.w)};
#pragma unroll
        for (int e = 0; e < 8; ++e) sk += kvf[e] * kvf[e];
        sq = row16_sum(sq); sk = row16_sum(sk);
        if (j == 0) RSQ[row] = rsqrtf(sq * (1.f / 256.f) + RMS_EPS);
        { const float rs = rsqrtf(sk * (1.f / 128.f) + RMS_EPS); const float* g = p.kv_norm + l * 128 + j * 8; const f32x4 g0 = *(const f32x4*)g, g1 = *(const f32x4*)(g + 4);
          u32x4 w; w.x = cvtpk(kvf[0] * rs * g0[0], kvf[1] * rs * g0[1]); w.y = cvtpk(kvf[2] * rs * g0[2], kvf[3] * rs * g0[3]); w.z = cvtpk(kvf[4] * rs * g1[0], kvf[5] * rs * g1[1]); w.w = cvtpk(kvf[6] * rs * g1[2], kvf[7] * rs * g1[3]);
          *(u32x4*)(KV + (size_t)row * 192 + j * 8) = w; }
        { const unsigned px = xor8_u(kr.x), py = xor8_u(kr.y);
          if (j < 8) { const float t1[4] = {lo_bf(kr.x), hi_bf(kr.x), lo_bf(kr.y), hi_bf(kr.y)}, t2[4] = {lo_bf(px), hi_bf(px), lo_bf(py), hi_bf(py)};
              u32x4 w; w.x = cvtpk(t1[0] * cs[0] - t2[0] * sn[0], t1[0] * sn[0] + t2[0] * cs[0]); w.y = cvtpk(t1[1] * cs[1] - t2[1] * sn[1], t1[1] * sn[1] + t2[1] * cs[1]);
              w.z = cvtpk(t1[2] * cs[2] - t2[2] * sn[2], t1[2] * sn[2] + t2[2] * cs[2]); w.w = cvtpk(t1[3] * cs[3] - t2[3] * sn[3], t1[3] * sn[3] + t2[3] * cs[3]);
              *(u32x4*)(KV + (size_t)row * 192 + 128 + 8 * j) = w; } }
    }
}
__device__ __forceinline__ void job_gdn_final(const Params& p, int l, int gw, int ngw, int lane, int wid, LAS unsigned char* lds) {
    bf16_t* PROJ = (bf16_t*)(p.ws + WS_PROJ); const bf16_t* U = (const bf16_t*)(p.ws + WS_U);
    LAS bf16_t* T = (LAS bf16_t*)(lds + wid * 17408);
    for (int it2 = gw; it2 < 2048; it2 += ngw) {
        const int it = it2 >> 1, ct = it2 & 1, n = it >> 2, h = it & 3; const bf16_t* ut = U + (size_t)it * 8192 + lane * 4;
#pragma unroll 4
        for (int jj = 0; jj < 16; ++jj) { const int j = 8 * (jj >> 2) + 4 * ct + (jj & 3); const u32x2 w = *(const u32x2*)(ut + j * 256);
            const int g = j & 3, sl = j >> 3, dv = 32 * sl + (lane & 31), c0 = 32 * ct + 8 * g + 4 * (lane >> 5);
            T[(c0 + 0) * 136 + dv] = (bf16_t)(w.x & 0xffffu); T[(c0 + 1) * 136 + dv] = (bf16_t)(w.x >> 16); T[(c0 + 2) * 136 + dv] = (bf16_t)(w.y & 0xffffu); T[(c0 + 3) * 136 + dv] = (bf16_t)(w.y >> 16); }
        LDS_WAIT();
#pragma unroll 2
        for (int i = 0; i < 8; ++i) { const int id = lane + 64 * i, c = 32 * ct + (id >> 4), dc = id & 15;
            const u32x4 v = *(const LAS u32x4*)(T + c * 136 + dc * 8);
            float x[8] = {lo_bf(v.x), hi_bf(v.x), lo_bf(v.y), hi_bf(v.y), lo_bf(v.z), hi_bf(v.z), lo_bf(v.w), hi_bf(v.w)};
            float ss = 0.f;
#pragma unroll
            for (int e = 0; e < 8; ++e) ss += x[e] * x[e];
            ss = row16_sum(ss);
            const float rs = rsqrtf(ss * (1.f / 128.f) + RMS_EPS);
            const float* gn = p.gdn_norm + l * 128 + dc * 8; const f32x4 g0 = *(const f32x4*)gn, g1 = *(const f32x4*)(gn + 4);
            bf16_t* zp = PROJ + (size_t)(n * 64 + c) * NP + C_Z + 512 + h * 128 + dc * 8; const u32x4 z = *(const u32x4*)zp;
            u32x4 o; o.x = cvtpk(x[0] * rs * g0[0] * silu_f(lo_bf(z.x)), x[1] * rs * g0[1] * silu_f(hi_bf(z.x))); o.y = cvtpk(x[2] * rs * g0[2] * silu_f(lo_bf(z.y)), x[3] * rs * g0[3] * silu_f(hi_bf(z.y)));
            o.z = cvtpk(x[4] * rs * g1[0] * silu_f(lo_bf(z.z)), x[5] * rs * g1[1] * silu_f(hi_bf(z.z))); o.w = cvtpk(x[6] * rs * g1[2] * silu_f(lo_bf(z.w)), x[7] * rs * g1[3] * silu_f(hi_bf(z.w)));
            *(u32x4*)zp = o; }
        LDS_WAIT();
    }
}
namespace gdn {
constexpr int L_QH = 0, L_KH = 17408, L_KBGT = 34816, L_KHDT = 53248, L_VBT = 71680, L_LF = 90112, L_TF = 107520, L_MB = 124928, L_GV = 129280, L_END = 130560;
constexpr int QP = 136, TP = 72, LP = 68;
__device__ __forceinline__ bf16_t* frag_ptr(bf16_t* PROJ, int n, int h, int f, int lane) {
    const int seg = 4 * f + (lane >> 4), part = seg >> 6, row = seg & 63;
    return PROJ + (size_t)(n * 64 + row) * NP + C_BQKV + part * 512 + h * 128 + (lane & 15) * 8;
}
__device__ __forceinline__ bf16x8 pack8f(const LAS float* q) { const f32x4 a = *(const LAS f32x4*)q, b = *(const LAS f32x4*)(q + 4); u32x4 w = {cvtpk(a[0], a[1]), cvtpk(a[2], a[3]), cvtpk(b[0], b[1]), cvtpk(b[2], b[3])}; return __builtin_bit_cast(bf16x8, w); }
__device__ __forceinline__ void prep_item(const Params& p, int l, int n, int h, LAS unsigned char* lds) {
    const int tid = tidx(), lane = tid & 63, r32 = lane & 31, hi = lane >> 5, wid = __builtin_amdgcn_readfirstlane(tid >> 6);
    bf16_t* PROJ = (bf16_t*)(p.ws + WS_PROJ); const bf16_t* HALO = (const bf16_t*)(p.ws + WS_HALO);
    bf16_t* AQKg = (bf16_t*)(p.ws + WS_AQK); bf16_t* Ug = (bf16_t*)(p.ws + WS_U); float* EGL = (float*)(p.ws + WS_MISC + MISC_EGL);
    LAS bf16_t* QH = (LAS bf16_t*)(lds + L_QH); LAS bf16_t* KH = (LAS bf16_t*)(lds + L_KH); LAS bf16_t* KBGT = (LAS bf16_t*)(lds + L_KBGT);
    LAS bf16_t* KHDT = (LAS bf16_t*)(lds + L_KHDT); LAS bf16_t* VBT = (LAS bf16_t*)(lds + L_VBT); LAS float* LF = (LAS float*)(lds + L_LF);
    LAS float* TF = (LAS float*)(lds + L_TF); LAS float* MB = (LAS float*)(lds + L_MB); LAS float* GC = (LAS float*)(lds + L_GV); LAS float* BETA = GC + 64; LAS float* EGC = GC + 128; LAS float* EGD = GC + 192;
    const int t0 = n * 64;
    const int g16 = tid & 15, row0 = tid >> 4;
#define S2_LOAD(part, XA, XB, WA, WB) do { const int cb_ = (part) * 512 + h * 128 + g16 * 8; \
        _Pragma("unroll") for (int j = 0; j < 4; ++j) { const int ta_ = t0 + row0 - 3 + j; XA[j] = (u32x4){0u, 0u, 0u, 0u}; \
            if (ta_ >= t0) XA[j] = *(const u32x4*)(PROJ + (size_t)ta_ * NP + C_BQKV + cb_); else if (n > 0) XA[j] = *(const u32x4*)(HALO + ((size_t)(n - 1) * 3 + (ta_ - (t0 - 3))) * 1536 + cb_); \
            XB[j] = *(const u32x4*)(PROJ + (size_t)(t0 + row0 + 29 + j) * NP + C_BQKV + cb_); \
            const float* cw_ = p.conv_w + ((size_t)l * 4 + j) * 1536 + cb_; WA[j] = *(const f32x4*)cw_; WB[j] = *(const f32x4*)(cw_ + 4); } } while (0)
    u32x4 xa[4], xb[4]; f32x4 wa[4], wb[4];
    S2_LOAD(0, xa, xb, wa, wb);
    __syncthreads();
    if (wid == 0) {
        const bf16_t* pr = PROJ + (size_t)(t0 + lane) * NP;
        const float xa_ = bf2f(pr[C_BA + h]) + p.dt_bias[l * 4 + h], xb_ = bf2f(pr[C_BB + h]);
        const float e = __expf(xa_); const float sp = xa_ > 20.f ? xa_ : (e < 1e-3f ? e * (1.f - e * (0.5f - e * (1.f / 3.f))) : logf(1.f + e));
        float gc = -__expf(p.a_log[l * 4 + h]) * sp;
#pragma unroll
        for (int o = 1; o < 64; o <<= 1) { const float t_ = __int_as_float(__builtin_amdgcn_ds_bpermute((lane - o) << 2, __float_as_int(gc))); if (lane >= o) gc += t_; }
        const float gl = __int_as_float(__builtin_amdgcn_readlane(__float_as_int(gc), 63));
        GC[lane] = gc; BETA[lane] = 1.f / (1.f + __expf(-xb_)); EGC[lane] = __expf(gc); EGD[lane] = __expf(gl - gc);
        if (lane == 0) EGL[n * 4 + h] = __expf(gl);
    }
    __syncthreads();
#define TSW(dk, j) ((dk) * 64 + (((((j) >> 3) ^ (((dk) >> 3) & 7)) << 3) | ((j) & 7)))
#define S2_ITEM(part, X, W0, W1, row) do { float a[8] = {0.f, 0.f, 0.f, 0.f, 0.f, 0.f, 0.f, 0.f}; \
        _Pragma("unroll") for (int j = 0; j < 4; ++j) { a[0] = fmaf(W0[j][0], lo_bf(X[j].x), a[0]); a[1] = fmaf(W0[j][1], hi_bf(X[j].x), a[1]); a[2] = fmaf(W0[j][2], lo_bf(X[j].y), a[2]); a[3] = fmaf(W0[j][3], hi_bf(X[j].y), a[3]); \
            a[4] = fmaf(W1[j][0], lo_bf(X[j].z), a[4]); a[5] = fmaf(W1[j][1], hi_bf(X[j].z), a[5]); a[6] = fmaf(W1[j][2], lo_bf(X[j].w), a[6]); a[7] = fmaf(W1[j][3], hi_bf(X[j].w), a[7]); } \
        float ss = 0.f; _Pragma("unroll") for (int e = 0; e < 8; ++e) { a[e] = silu_f(a[e]); ss += a[e] * a[e]; } \
        ss = row16_sum(ss); const float rn = rsqrtf(ss + 1e-6f); \
        if ((part) == 0) { const float sc = rn * 0.08838834764831845f; _Pragma("unroll") for (int e = 0; e < 8; ++e) a[e] *= sc; *(LAS bf16x8*)(QH + (row) * QP + g16 * 8) = pack8(a); } \
        else if ((part) == 1) { _Pragma("unroll") for (int e = 0; e < 8; ++e) a[e] *= rn; *(LAS bf16x8*)(KH + (row) * QP + g16 * 8) = pack8(a); const float s1 = BETA[row] * EGC[row], s2 = EGD[row]; \
            _Pragma("unroll") for (int e = 0; e < 8; ++e) { KBGT[TSW(g16 * 8 + e, row)] = f2bf(a[e] * s1); KHDT[TSW(g16 * 8 + e, row)] = f2bf(a[e] * s2); } } \
        else { const float b = BETA[row]; _Pragma("unroll") for (int e = 0; e < 8; ++e) VBT[TSW(g16 * 8 + e, row)] = f2bf(a[e] * b); } } while (0)
#ifdef EXP_DUPS2
#pragma unroll 1
    for (int rep_ = 0; rep_ < 2; ++rep_)
#endif
    { u32x4 ya[4], yb[4]; f32x4 va[4], vb[4];
      S2_LOAD(1, ya, yb, va, vb);
      S2_ITEM(0, xa, wa, wb, row0); S2_ITEM(0, xb, wa, wb, row0 + 32);
      S2_LOAD(2, xa, xb, wa, wb);
      S2_ITEM(1, ya, va, vb, row0); S2_ITEM(1, yb, va, vb, row0 + 32);
      S2_ITEM(2, xa, wa, wb, row0); S2_ITEM(2, xb, wa, wb, row0 + 32); }
#undef S2_LOAD
#undef S2_ITEM
    __syncthreads();
    if (wid < 3) { const int it = wid > 0, jt = wid > 1; f32x16 acc = {};
#pragma unroll
        for (int ks = 0; ks < 8; ++ks) { const bf16x8 a = *(const LAS bf16x8*)(KH + (32 * it + r32) * QP + 16 * ks + 8 * hi), b = *(const LAS bf16x8*)(KH + (32 * jt + r32) * QP + 16 * ks + 8 * hi);
            acc = MFMA32(a, b, acc); }
        const int j = 32 * jt + r32; const float gj = GC[j];
#pragma unroll
        for (int r = 0; r < 16; ++r) { const int i = 32 * it + crow(r, hi); LF[i * LP + j] = i > j ? BETA[i] * __expf(GC[i] - gj) * acc[r] : 0.f; }
    } else if (wid < 6) { const int w = wid - 3, ctp = w > 1, ct = w > 0; f32x16 acc = {};
#pragma unroll
        for (int ks = 0; ks < 8; ++ks) { const bf16x8 a = *(const LAS bf16x8*)(KH + (32 * ctp + r32) * QP + 16 * ks + 8 * hi), b = *(const LAS bf16x8*)(QH + (32 * ct + r32) * QP + 16 * ks + 8 * hi);
            acc = MFMA32(a, b, acc); }
        const int c = 32 * ct + r32; const float gcq = GC[c];
#pragma unroll
        for (int r = 0; r < 16; ++r) { const int cp = 32 * ctp + crow(r, hi); acc[r] = c >= cp ? acc[r] * __expf(gcq - GC[cp]) : 0.f; }
        bf16_t* dst = AQKg + (((size_t)(n * 4 + h) * 8 + (ct * 2 + ctp) * 2) * 64 + lane) * 8;
        *(bf16x8*)dst = pack_step(acc, 0); *(bf16x8*)(dst + 512) = pack_step(acc, 1);
    } else { const int w = wid - 6;
        if (w == 0) { const bf16x8 z = {0, 0, 0, 0, 0, 0, 0, 0}; bf16_t* dst = AQKg + (((size_t)(n * 4 + h) * 8 + 2) * 64 + lane) * 8; *(bf16x8*)dst = z; *(bf16x8*)(dst + 512) = z; }
#pragma unroll
        for (int ff = 0; ff < 8; ++ff) { const int f = w * 8 + ff, s = f & 1, mt = (f >> 1) & 3, ct = f >> 3, c = 32 * ct + r32, d0 = 32 * mt + 16 * s + 4 * hi; const float eg = EGC[c];
            const u32x2 lo = *(const LAS u32x2*)(QH + c * QP + d0), hw = *(const LAS u32x2*)(QH + c * QP + d0 + 8);
            u32x4 o; o.x = cvtpk(lo_bf(lo.x) * eg, hi_bf(lo.x) * eg); o.y = cvtpk(lo_bf(lo.y) * eg, hi_bf(lo.y) * eg); o.z = cvtpk(lo_bf(hw.x) * eg, hi_bf(hw.x) * eg); o.w = cvtpk(lo_bf(hw.y) * eg, hi_bf(hw.y) * eg);
            *(u32x4*)frag_ptr(PROJ, n, h, 16 + f, lane) = o; }
    }
    __syncthreads();
    if (wid == 0) {
#ifdef EXP_DUPS4
#pragma unroll 1
      for (int rep_ = 0; rep_ < 2; ++rep_)
#endif
      {
        unsigned lfb = (unsigned)(uintptr_t)LF, tfb = (unsigned)(uintptr_t)TF, mbb = (unsigned)(uintptr_t)MB; asm volatile("" : "+v"(lfb), "+v"(tfb), "+v"(mbb));
        const LAS float* LFv = (const LAS float*)(uintptr_t)lfb; LAS float* TFv = (LAS float*)(uintptr_t)tfb; LAS float* MBv = (LAS float*)(uintptr_t)mbb;
        { const int b = lane >> 4, c = lane & 15; const LAS float* Lb = LFv + (16 * b) * LP + 16 * b; LAS float* Tb = TFv + (16 * b) * LP + 16 * b + c; float t[16];
#pragma unroll
          for (int i = 0; i < 16; ++i) { float a0 = (c == i) ? 1.f : 0.f, a1 = 0.f;
#pragma unroll
              for (int q = 0; 4 * q < i; ++q) { const f32x4 lv = *(const LAS f32x4*)(Lb + i * LP + 4 * q);
#pragma unroll
                  for (int e = 0; e < 4; ++e) if (4 * q + e < i) { if (e & 1) a1 = fmaf(-lv[e], t[4 * q + e], a1); else a0 = fmaf(-lv[e], t[4 * q + e], a0); } }
              t[i] = a0 + a1; Tb[i * LP] = t[i]; } }
        const int r16 = lane & 15, k4 = lane >> 4;
#define BLK(P, b_, a_) ((P) + (16 * (b_)) * LP + 16 * (a_))
#define MM16(acc, X, Y) do { _Pragma("unroll") for (int ks = 0; ks < 4; ++ks) acc = __builtin_amdgcn_mfma_f32_16x16x4f32((X)[r16 * LP + 4 * ks + k4], (Y)[(4 * ks + k4) * LP + r16], acc, 0, 0, 0); } while (0)
#define ST16(Z, acc, sg) do { _Pragma("unroll") for (int r = 0; r < 4; ++r) (Z)[(4 * k4 + r) * LP + r16] = (sg) * acc[r]; } while (0)
#define TBLK(b_, a_, SUM) do { f32x4 m_ = {0.f, 0.f, 0.f, 0.f}; SUM; ST16(MBv, m_, 1.f); f32x4 t_ = {0.f, 0.f, 0.f, 0.f}; MM16(t_, BLK(TFv, b_, b_), MBv); ST16(BLK(TFv, b_, a_), t_, -1.f); } while (0)
        TBLK(1, 0, MM16(m_, BLK(LFv, 1, 0), BLK(TFv, 0, 0)));
        TBLK(2, 1, MM16(m_, BLK(LFv, 2, 1), BLK(TFv, 1, 1)));
        TBLK(3, 2, MM16(m_, BLK(LFv, 3, 2), BLK(TFv, 2, 2)));
        TBLK(2, 0, MM16(m_, BLK(LFv, 2, 0), BLK(TFv, 0, 0)); MM16(m_, BLK(LFv, 2, 1), BLK(TFv, 1, 0)));
        TBLK(3, 1, MM16(m_, BLK(LFv, 3, 1), BLK(TFv, 1, 1)); MM16(m_, BLK(LFv, 3, 2), BLK(TFv, 2, 1)));
        TBLK(3, 0, MM16(m_, BLK(LFv, 3, 0), BLK(TFv, 0, 0)); MM16(m_, BLK(LFv, 3, 1), BLK(TFv, 1, 0)); MM16(m_, BLK(LFv, 3, 2), BLK(TFv, 2, 0)));
#undef BLK
#undef MM16
#undef ST16
#undef TBLK
      }
    } else {
        if (wid == 1) {
#pragma unroll
            for (int i = 0; i < 24; ++i) { const int id = lane + 64 * i, blk = id >> 8, rr = (id >> 4) & 15, cc = id & 15;
                const int b = blk < 3 ? 0 : (blk < 5 ? 1 : 2), a = blk < 3 ? blk + 1 : (blk < 5 ? blk - 1 : 3);
                TF[(16 * b + rr) * LP + 16 * a + cc] = 0.f; }
        }
        for (int f = wid - 1; f < 16; f += 7) { const int s = f & 1, ctp = (f >> 1) & 1, mt = f >> 2, dk = 32 * mt + r32, c0 = 32 * ctp + 16 * s + 4 * hi;
            const u32x2 lo = *(const LAS u32x2*)(KHDT + TSW(dk, c0)), hw = *(const LAS u32x2*)(KHDT + TSW(dk, c0 + 8));
            u32x4 o = {lo.x, lo.y, hw.x, hw.y}; *(u32x4*)frag_ptr(PROJ, n, h, 32 + f, lane) = o; }
    }
    __syncthreads();
    { const int mt = wid >> 1, ct = wid & 1; f32x16 acc = {};
#pragma unroll
      for (int ks = 0; ks < 4; ++ks) { const bf16x8 a = *(const LAS bf16x8*)(KBGT + TSW(32 * mt + r32, 16 * ks + 8 * hi)), b = pack8f(TF + (32 * ct + r32) * LP + 16 * ks + 8 * hi);
          acc = MFMA32(a, b, acc); }
#pragma unroll
      for (int r = 0; r < 16; ++r) acc[r] = -acc[r];
      *(bf16x8*)frag_ptr(PROJ, n, h, (ct * 4 + mt) * 2, lane) = pack_step(acc, 0); *(bf16x8*)frag_ptr(PROJ, n, h, (ct * 4 + mt) * 2 + 1, lane) = pack_step(acc, 1); }
    { const int ct = wid >> 2, dt = wid & 3; f32x16 acc = {};
#pragma unroll
      for (int ks = 0; ks < 4; ++ks) { const bf16x8 a = pack8f(TF + (32 * ct + r32) * LP + 16 * ks + 8 * hi), b = *(const LAS bf16x8*)(VBT + TSW(32 * dt + r32, 16 * ks + 8 * hi));
          acc = MFMA32(a, b, acc); }
      bf16_t* up = Ug + (size_t)(n * 4 + h) * 8192 + (size_t)((dt * 2 + ct) * 4) * 256 + lane * 4;
#pragma unroll
      for (int g = 0; g < 4; ++g) { u32x2 w; w.x = cvtpk(acc[4 * g], acc[4 * g + 1]); w.y = cvtpk(acc[4 * g + 2], acc[4 * g + 3]); *(u32x2*)(up + g * 256) = w; } }
}
constexpr int SCAN_STAGE = 65536, SCAN_U = 57344, SCAN_EGL = 131072, SCAN_NP = 16;
__device__ __forceinline__ const u32x4* scan_src(const bf16_t* PROJ, const bf16_t* AQKg, const bf16_t* Ug, int n, int h, int half, int k, int ll) {
    if (k < 12) { const int piece = k * 256 + ll; return (const u32x4*)frag_ptr((bf16_t*)PROJ, n, h, piece >> 6, piece & 63); }
    if (k < 14) return (const u32x4*)(AQKg + ((size_t)(n * 4 + h) * 512 + (k - 12) * 256 + ll) * 8);
    return (const u32x4*)(Ug + (size_t)(n * 4 + h) * 8192 + half * 4096 + (size_t)((k - 14) * 256 + ll) * 8);
}
constexpr int SCAN_XCH = 131584, SCAN_XCH_SLICE = 12288;
template <int ROLE>
__device__ __forceinline__ void scan_compute(LAS unsigned char* lds, bf16_t* ub  , int sp, int lane) {
    constexpr int NCH = S / 64;
    LAS unsigned char* xs = lds + SCAN_XCH + sp * SCAN_XCH_SLICE + lane * 16;
    LAS unsigned char* xv = xs + 8192;
    f32x16 St[2] = {};
    bf16x8 Sb[4][2];
#pragma unroll
    for (int mt = 0; mt < 4; ++mt) { Sb[mt][0] = (bf16x8){0, 0, 0, 0, 0, 0, 0, 0}; Sb[mt][1] = Sb[mt][0]; }
    __syncthreads();
#ifdef EXP_SCANSEC
    unsigned long long acc_s[4] = {0, 0, 0, 0}, tm_ = __builtin_amdgcn_s_memrealtime();
#define SEC(i) do { const unsigned long long t_ = __builtin_amdgcn_s_memrealtime(); acc_s[i] += t_ - tm_; tm_ = t_; } while (0)
#else
#define SEC(i)
#endif
#pragma unroll 1
    for (int n = 0; n < NCH; ++n) {
        const LAS unsigned char* stg = lds + (n & 1) * SCAN_STAGE + lane * 16;
        const LAS unsigned char* us = lds + (n & 1) * SCAN_STAGE + SCAN_U + (sp * 8 + ROLE * 4) * 512 + lane * 8;
        const float egl = *(const LAS float*)(lds + SCAN_EGL + (n & 1) * 4);
        f32x16 vn, o = {};
#pragma unroll
        for (int g = 0; g < 4; ++g) { const u32x2 w = *(const LAS u32x2*)(us + g * 512); vn[4 * g] = lo_bf(w.x); vn[4 * g + 1] = hi_bf(w.x); vn[4 * g + 2] = lo_bf(w.y); vn[4 * g + 3] = hi_bf(w.y); }
        if (n > 0) {
#pragma unroll
            for (int j = 0; j < 2; ++j) { Sb[2 * (1 - ROLE) + j][0] = *(const LAS bf16x8*)(xs + ((2 * (1 - ROLE) + j) * 2) * 1024); Sb[2 * (1 - ROLE) + j][1] = *(const LAS bf16x8*)(xs + ((2 * (1 - ROLE) + j) * 2 + 1) * 1024); }
        }
#define FR(f) (*(const LAS bf16x8*)(stg + (f) * 1024))
#define RD1(B, mt) do { const int f_ = (ROLE * 4 + (mt)) * 2; B[0] = FR(f_); B[1] = FR(f_ + 1); B[2] = FR(16 + f_); B[3] = FR(16 + f_ + 1); } while (0)
#define MM1(B, mt) do { vn = MFMA32(B[0], Sb[mt][0], vn); o = MFMA32(B[2], Sb[mt][0], o); vn = MFMA32(B[1], Sb[mt][1], vn); o = MFMA32(B[3], Sb[mt][1], o); } while (0)
        bf16x8 fa[4], fb[4];
        RD1(fa, 0); RD1(fb, 1); SBAR();
        MM1(fa, 0); SBAR(); RD1(fa, 2); SBAR();
        MM1(fb, 1); SBAR(); RD1(fb, 3); SBAR();
        MM1(fa, 2); SBAR();
        bf16x8 kd[2][4];
#pragma unroll
        for (int j = 0; j < 2; ++j)
#pragma unroll
            for (int q = 0; q < 4; ++q) kd[j][q] = FR(32 + ((2 * ROLE + j) * 2) * 2 + q);
        SBAR(); MM1(fb, 3); SBAR();
#pragma unroll
        for (int j = 0; j < 2; ++j)
#pragma unroll
            for (int r = 0; r < 16; ++r) St[j][r] *= egl;
        bf16x8 Vb[2][2];
        Vb[ROLE][0] = pack_step(vn, 0); Vb[ROLE][1] = pack_step(vn, 1);
        *(LAS bf16x8*)(xv + (ROLE * 2) * 1024) = Vb[ROLE][0]; *(LAS bf16x8*)(xv + (ROLE * 2 + 1) * 1024) = Vb[ROLE][1];
        bf16x8 aq[4];
        if (ROLE == 0) { aq[0] = FR(48); aq[1] = FR(49); } else { aq[0] = FR(52); aq[1] = FR(53); aq[2] = FR(54); aq[3] = FR(55); }
        SEC(0);
        __syncthreads();
        SEC(1);
        Vb[1 - ROLE][0] = *(const LAS bf16x8*)(xv + ((1 - ROLE) * 2) * 1024); Vb[1 - ROLE][1] = *(const LAS bf16x8*)(xv + ((1 - ROLE) * 2 + 1) * 1024);
#pragma unroll
        for (int ctp = 0; ctp < 2; ++ctp)
#pragma unroll
            for (int s = 0; s < 2; ++s) {
                St[0] = MFMA32(kd[0][ctp * 2 + s], Vb[ctp][s], St[0]); St[1] = MFMA32(kd[1][ctp * 2 + s], Vb[ctp][s], St[1]);
                if (ROLE == 1) o = MFMA32(aq[ctp * 2 + s], Vb[ctp][s], o); else if (ctp == 0) o = MFMA32(aq[s], Vb[0][s], o);
            }
        { bf16_t* uc = ub + (size_t)n * (4 * 8192);
#pragma unroll
          for (int g = 0; g < 4; ++g) { u32x2 w; w.x = cvtpk(o[4 * g], o[4 * g + 1]); w.y = cvtpk(o[4 * g + 2], o[4 * g + 3]); *(u32x2*)(uc + g * 256) = w; } }
#pragma unroll
        for (int j = 0; j < 2; ++j) { Sb[2 * ROLE + j][0] = pack_step(St[j], 0); Sb[2 * ROLE + j][1] = pack_step(St[j], 1);
            *(LAS bf16x8*)(xs + ((2 * ROLE + j) * 2) * 1024) = Sb[2 * ROLE + j][0]; *(LAS bf16x8*)(xs + ((2 * ROLE + j) * 2 + 1) * 1024) = Sb[2 * ROLE + j][1]; }
#undef FR
#undef RD1
#undef MM1
        SEC(2);
        __syncthreads();
        SEC(3);
    }
#ifdef EXP_SCANSEC
    { const unsigned long long t1_ = __builtin_amdgcn_s_memrealtime(); while (__builtin_amdgcn_s_memrealtime() - t1_ < 4 * acc_s[EXP_SCANSEC]) __builtin_amdgcn_s_sleep(8); }
#endif
#undef SEC
}
__device__ __forceinline__ void scan_wg(const Params& p, int h, int half, LAS unsigned char* lds, unsigned* prep_cnt, int nprep) {
    const int tid = tidx(), lane = tid & 63, wid = __builtin_amdgcn_readfirstlane(tid >> 6);
    const bf16_t* PROJ = (const bf16_t*)(p.ws + WS_PROJ); const bf16_t* AQKg = (const bf16_t*)(p.ws + WS_AQK); bf16_t* Ug = (bf16_t*)(p.ws + WS_U); const float* EGL = (const float*)(p.ws + WS_MISC + MISC_EGL);
    constexpr int NCH = S / 64;
    __syncthreads();
    if (wid >= 4) {
        const int ll = tid - 256; u32x4 sa[SCAN_NP], sb[SCAN_NP]; float ea, eb;
        const char* pf0 = (const char*)(PROJ + (size_t)(ll >> 4) * NP + C_BQKV + h * 128 + (ll & 15) * 8); const char* pa0 = (const char*)(AQKg + ((size_t)h * 512 + ll) * 8); const char* pu0 = (const char*)(Ug + (size_t)h * 8192 + half * 4096 + (size_t)ll * 8);
#define LD_H0(R, n_) do { const char* pf_ = pf0 + (size_t)(n_) * (64 * NP * 2); SBAR(); _Pragma("unroll") for (int k = 0; k < 8; ++k) R[k] = *(const u32x4*)(pf_ + (size_t)(k & 3) * (16 * NP * 2) + (k >> 2) * 1024); SBAR(); } while (0)
#define LD_H1(R, E, n_) do { E = EGL[(n_) * 4 + h]; const char* pf_ = pf0 + (size_t)(n_) * (64 * NP * 2); const char* pa_ = pa0 + (size_t)(n_) * (4 * 512 * 16); const char* pu_ = pu0 + (size_t)(n_) * (4 * 8192 * 2); SBAR(); \
        _Pragma("unroll") for (int k = 8; k < 12; ++k) R[k] = *(const u32x4*)(pf_ + (size_t)(k & 3) * (16 * NP * 2) + (k >> 2) * 1024); SBAR(); \
        R[12] = *(const u32x4*)pa_; R[13] = *(const u32x4*)(pa_ + 4096); R[14] = *(const u32x4*)pu_; R[15] = *(const u32x4*)(pu_ + 4096); SBAR(); } while (0)
#define WR_H0(R, n_) do { _Pragma("unroll") for (int k = 0; k < 8; ++k) *(LAS u32x4*)(lds + ((n_) & 1) * SCAN_STAGE + (k * 256 + ll) * 16) = R[k]; } while (0)
#define WR_H1(R, E, n_) do { *(LAS float*)(lds + SCAN_EGL + ((n_) & 1) * 4) = E; _Pragma("unroll") for (int k = 8; k < SCAN_NP; ++k) *(LAS u32x4*)(lds + ((n_) & 1) * SCAN_STAGE + (k * 256 + ll) * 16) = R[k]; } while (0)
#define LSTEP(R, E, n_) do { WR_H0(R, (n_) + 1); if ((n_) + 3 < NCH) LD_H0(R, (n_) + 3); __syncthreads(); WR_H1(R, E, (n_) + 1); if ((n_) + 3 < NCH) LD_H1(R, E, (n_) + 3); __syncthreads(); } while (0)
#define WAIT_GROUP(g_) do { unsigned sp_ = 0; while (__hip_atomic_load(prep_cnt + (g_), __ATOMIC_RELAXED, __HIP_MEMORY_SCOPE_AGENT) < (unsigned)nprep) { __builtin_amdgcn_s_sleep(4); if (++sp_ > (1u << 22)) break; } \
        __builtin_amdgcn_fence(__ATOMIC_ACQUIRE, "agent"); } while (0)
        const int n_first = (nprep >> 2) & ~1;
        WAIT_GROUP(0);
        LD_H0(sa, 0); LD_H1(sa, ea, 0); WR_H0(sa, 0); WR_H1(sa, ea, 0); LD_H0(sa, 1); LD_H1(sa, ea, 1); LD_H0(sb, 2); LD_H1(sb, eb, 2);
        __syncthreads();
#pragma unroll 1
        for (int n = 0; n < NCH - 2; n += 2) { if (n + 4 == n_first) WAIT_GROUP(1); LSTEP(sa, ea, n); LSTEP(sb, eb, n + 1); }
        WR_H0(sa, NCH - 1); __syncthreads(); WR_H1(sa, ea, NCH - 1); __syncthreads();
        __syncthreads(); __syncthreads();
#undef LSTEP
#undef WAIT_GROUP
#undef LD_H0
#undef LD_H1
#undef WR_H0
#undef WR_H1
    } else {
        const int sp = wid >> 1, role = wid & 1, sl = 2 * half + sp;
        bf16_t* ub = Ug + (size_t)h * 8192 + (size_t)(sl * 8 + role * 4) * 256 + lane * 4;
        if (role == 0) scan_compute<0>(lds, ub, sp, lane); else scan_compute<1>(lds, ub, sp, lane);
    }
}
}
typedef __attribute__((address_space(1))) unsigned gu32;
#define XB_TMO      128
#define XB_XCNT(j)  (256  + 64 * (j))
#define XB_XSUB(j)  (1280 + 64 * (j))
#define XB_XGEN(j)  (2304 + 64 * (j))
#define XB_TOP      3328
#define XB_TOPGEN   3392
#define XCD_BAR_WORDS 3456
#define XB_SPIN_CAP (1u << 18)

__device__ __forceinline__ unsigned xb_ld(unsigned* p)              { return __hip_atomic_load(p, __ATOMIC_RELAXED, __HIP_MEMORY_SCOPE_AGENT); }
__device__ __forceinline__ unsigned xb_add(unsigned* p, unsigned v) { return __hip_atomic_fetch_add(p, v, __ATOMIC_RELAXED, __HIP_MEMORY_SCOPE_AGENT); }
__device__ __forceinline__ unsigned xb_xcc_id() { return (unsigned)__builtin_amdgcn_s_getreg((3 << 11) | 20) & 0xFu; }
#define XB_SPIN(cond, bar) do { unsigned _sp = 0; while (cond) { __builtin_amdgcn_s_sleep(1); \
    if ((++_sp & 255u) == 0u) { if (xb_ld(&(bar)[XB_TMO])) break; if (_sp > XB_SPIN_CAP) { atomicAdd(&(bar)[XB_TMO], 1u); break; } } } } while (0)

struct XcdBarrier {
    unsigned* bar; unsigned x;
    volatile LAS unsigned* st;
};

__device__ __forceinline__ XcdBarrier xcd_barrier_post(unsigned* bar, volatile LAS unsigned* st) {
    XcdBarrier b; b.bar = bar; b.x = xb_xcc_id(); b.st = st;
    if (tidx() == 0) (void)xb_add(&bar[XB_XCNT(b.x)], 1u);
    return b;
}
__device__ __forceinline__ void xcd_barrier_complete(unsigned* bar, unsigned x, unsigned& nloc, unsigned& nx) {
    const unsigned G = gridDim.x * gridDim.y * gridDim.z;
    unsigned sum, cnt, mine, sp = 0u;
    for (;;) {
        sum = 0u; cnt = 0u; mine = 0u;
#pragma unroll
        for (unsigned j = 0; j < 16; ++j) { const unsigned c = xb_ld(&bar[XB_XCNT(j)]); sum += c; cnt += (c > 0u) ? 1u : 0u; mine = (j == x) ? c : mine; }
        if (sum == G) break;
        __builtin_amdgcn_s_sleep(1);
        if ((++sp & 255u) == 0u) { if (xb_ld(&bar[XB_TMO])) break; if (sp > XB_SPIN_CAP) { atomicAdd(&bar[XB_TMO], 1u); break; } }
    }
    nloc = mine > 0u ? mine : 1u; nx = cnt > 0u ? cnt : 1u;
}

__device__ __forceinline__ void xcd_barrier(const XcdBarrier& b) {
    asm volatile("s_waitcnt vmcnt(0)" ::: "memory");
    __syncthreads();
    if (tidx() == 0) {
        unsigned* bar = b.bar;
        __builtin_amdgcn_s_waitcnt(0);
        unsigned nloc = b.st[0], nx = b.st[1];
        if (nloc == 0u) { xcd_barrier_complete(bar, b.x, nloc, nx); b.st[0] = nloc; b.st[1] = nx; }
        const unsigned old = xb_add(&bar[XB_XSUB(b.x)], 1u);
        const unsigned gen = old / nloc;
        if (old + 1u == (gen + 1u) * nloc) {
            __builtin_amdgcn_fence(__ATOMIC_RELEASE, "agent");
            asm volatile("s_waitcnt vmcnt(0)" ::: "memory");
            const unsigned og = xb_add(&bar[XB_TOP], 1u);
            const unsigned tg = og / nx;
            if (og + 1u == (tg + 1u) * nx) xb_add(&bar[XB_TOPGEN], 1u);
            else XB_SPIN(xb_ld(&bar[XB_TOPGEN]) == tg, bar);
            __builtin_amdgcn_fence(__ATOMIC_ACQUIRE, "agent");
            xb_add(&bar[XB_XGEN(b.x)], 1u);
            asm volatile("s_waitcnt vmcnt(0)" ::: "memory");
        } else {
            XB_SPIN(xb_ld(&bar[XB_XGEN(b.x)]) == gen, bar);
            __builtin_amdgcn_fence(__ATOMIC_ACQUIRE, "agent");
            asm volatile("s_waitcnt vmcnt(0)" ::: "memory");
        }
    }
    __syncthreads();
}


constexpr int N_PHASES = 2 + 7 * DEPTH;
constexpr int SCAN_WGS = 8;
constexpr float QSCALE = 0.07216878364870322f * LOG2E;

__device__ __forceinline__ void sub_barrier(unsigned* ctr, unsigned expected, bool arrive) {
    asm volatile("s_waitcnt vmcnt(0)" ::: "memory"); __syncthreads();
    if (tidx() == 0) {
        if (arrive) { __builtin_amdgcn_fence(__ATOMIC_RELEASE, "agent"); asm volatile("s_waitcnt vmcnt(0)" ::: "memory"); (void)__hip_atomic_fetch_add(ctr, 1u, __ATOMIC_RELAXED, __HIP_MEMORY_SCOPE_AGENT); }
        unsigned sp = 0; while (__hip_atomic_load(ctr, __ATOMIC_RELAXED, __HIP_MEMORY_SCOPE_AGENT) < expected) { __builtin_amdgcn_s_sleep(2); if (++sp > (1u << 22)) break; }
        __builtin_amdgcn_fence(__ATOMIC_ACQUIRE, "agent"); asm volatile("s_waitcnt vmcnt(0)" ::: "memory");
    }
    __syncthreads();
}
__device__ __forceinline__ void sub_arrive(unsigned* ctr) {
    asm volatile("s_waitcnt vmcnt(0)" ::: "memory"); __syncthreads();
    if (tidx() == 0) { __builtin_amdgcn_fence(__ATOMIC_RELEASE, "agent"); asm volatile("s_waitcnt vmcnt(0)" ::: "memory"); (void)__hip_atomic_fetch_add(ctr, 1u, __ATOMIC_RELAXED, __HIP_MEMORY_SCOPE_AGENT); }
}
template <int KIND> __device__ __forceinline__ void run_kind(const Params& p_, int l, LAS unsigned char* lds) {
    Params p = p_;
    { unsigned long long w_ = (unsigned long long)p.ws; asm volatile("" : "+s"(w_)); p.ws = (unsigned char*)(__attribute__((address_space(1))) unsigned char*)w_; }
    const int tid = tidx(), lane = tid & 63, wid = __builtin_amdgcn_readfirstlane(tid >> 6);
    const int bid = bidx(), nblk = gridDim.x, gw = bid * 8 + wid, ngw = nblk * 8, gtid = bid * NT_THREADS + tid, gn = nblk * NT_THREADS;
    bf16_t* PROJ = (bf16_t*)(p.ws + WS_PROJ);
    if constexpr (KIND == 0) {
        job_win(p, 0, gw, ngw, lds, wid, lane); job_wout(p, 0, gw, ngw, lds, wid, lane); job_wmem(p, gw, ngw, lds, wid, lane);
        job_wq(p, bid, nblk, gtid, gn, lds); job_wuv(p, gtid, gn); job_rope(p, gtid, gn); job_btab(p, gtid, gn); job_memn(p, gw, ngw, lane);
        job_norm_rows(p, 0, gw, ngw, lane);
    } else if constexpr (KIND == 2) {
        { pg8::Gemm g{(const bf16_t*)(p.ws + WS_H), (const bf16_t*)(p.ws + WS_WIN), S, NP, DM, DM};
          pg8::StaticOrder so; so.init(S, NP, nblk, bid);
          pg8::EpiStore E{PROJ, NP, (bf16_t*)(p.ws + WS_HALO)};
          pg8::gemm_phase<pg8::EpiStore, pg8::StaticOrder, true, true>(lds, g, so, E); }
        if (l == 0) {
            for (int ll = 0; ll < 2; ++ll) {
                pg8::Gemm g{(const bf16_t*)(p.ws + WS_MEMN) + (size_t)ll * MEML * DM, (const bf16_t*)(p.ws + WS_WMEM) + (size_t)ll * DM * DM, MEML, DM, DM, DM};
                pg8::StaticOrder so; so.init(MEML, DM, nblk, (bid + 8 - 4 * ll) % nblk);
                pg8::EpiStore E{(bf16_t*)(p.ws + WS_MEMKV) + (size_t)ll * MEML * DM, DM, nullptr};
                pg8::gemm_phase<pg8::EpiStore, pg8::StaticOrder, true, true>(lds, g, so, E);
            }
        }
    } else if constexpr (KIND == 3) {
        (void)lds;
    } else if constexpr (KIND == 5) {
        unsigned* rdy = (unsigned*)(p.ws + WS_CTL) + 64 * (9 + l);
        const bool is_scan = (bid & ~8) < 4;
        unsigned* prep_cnt = (unsigned*)(p.ws + WS_CTL) + 64 * (13 + l);
#ifdef EXP_SPINSCAN
        if (is_scan) { const unsigned long long t0_ = __builtin_amdgcn_s_memrealtime(); gdn::scan_wg(p, bid & 3, bid >> 3, lds, prep_cnt, nblk - SCAN_WGS); const unsigned long long t1_ = __builtin_amdgcn_s_memrealtime();
            while (__builtin_amdgcn_s_memrealtime() - t1_ < 4 * (t1_ - t0_)) __builtin_amdgcn_s_sleep(8); }
#else
        if (is_scan) gdn::scan_wg(p, bid & 3, bid >> 3, lds, prep_cnt, nblk - SCAN_WGS);
#endif
        else { const int vb = bid < 8 ? bid - 4 : bid - 8, nb = nblk - SCAN_WGS;
            for (int it = vb; it < 1024; it += nb) { gdn::prep_item(p, l, it >> 2, it & 3, lds);
                if (it == vb || it + nb >= 1024) {
                    asm volatile("s_waitcnt vmcnt(0)" ::: "memory"); __syncthreads();
                    if (tidx() == 0) { __builtin_amdgcn_fence(__ATOMIC_RELEASE, "agent"); asm volatile("s_waitcnt vmcnt(0)" ::: "memory"); (void)__hip_atomic_fetch_add(prep_cnt + (it == vb ? 0 : 1), 1u, __ATOMIC_RELAXED, __HIP_MEMORY_SCOPE_AGENT); } } }
#ifdef EXP_SPINPART
            unsigned long long tp_ = __builtin_amdgcn_s_memrealtime();
#endif
#ifdef EXP_SPINPRE
            const unsigned long long t0_ = __builtin_amdgcn_s_memrealtime();
#endif
            { pg8::Gemm g{PROJ + C_CQ, (const bf16_t*)(p.ws + WS_WQ) + (size_t)l * 768 * 256, S, 768, 256, NP};
              pg8::StaticOrder so; so.init(S, 768, nb, vb);
              pg8::EpiStore E{(bf16_t*)(p.ws + WS_QABS), 768, nullptr};
              pg8::gemm_phase<pg8::EpiStore, pg8::StaticOrder, true, true>(lds, g, so, E); }
#ifdef EXP_SPINPART
#define SPART(i) { __syncthreads(); const unsigned long long tn_ = __builtin_amdgcn_s_memrealtime(); if (EXP_SPINPART == (i)) { while (__builtin_amdgcn_s_memrealtime() - tn_ < 4 * (tn_ - tp_)) __builtin_amdgcn_s_sleep(8); } tp_ = __builtin_amdgcn_s_memrealtime(); }
#else
#define SPART(i)
#endif
            SPART(1)
            job_mla_rows(p, l, vb * 8 + wid, nb * 8, lane);
            sub_arrive(rdy);
            SPART(2)
            att::run_mixers(lds, (unsigned*)(p.ws + WS_CTL) + 64 * (11 + l), PROJ, p.pos, p.sinks + l * 8, (const float*)(p.ws + WS_MISC + MISC_BTAB), (const bf16_t*)(p.ws + WS_MEMKV) + (size_t)l * MEML * DM);
            __syncthreads();
            SPART(3)

#ifdef EXP_SPINPRE
            { const unsigned long long t1_ = __builtin_amdgcn_s_memrealtime(); while (__builtin_amdgcn_s_memrealtime() - t1_ < 4 * (t1_ - t0_)) __builtin_amdgcn_s_sleep(8); }
#endif
        }
        sub_barrier(rdy, (unsigned)(nblk - SCAN_WGS), false);
#ifdef EXP_SPINMLA
        const unsigned long long tq0_ = __builtin_amdgcn_s_memrealtime();
#endif
        mla::run_queue(lds, (unsigned*)(p.ws + WS_CTL) + 64 * (1 + l), (const bf16_t*)(p.ws + WS_QABS), (const bf16_t*)(p.ws + WS_KVLAT), PROJ, (const bf16_t*)(p.ws + WS_WUV) + (size_t)l * 512 * 512, (const float*)(p.ws + WS_MISC + MISC_RSQ), (const float*)(p.ws + WS_COS), (const float*)(p.ws + WS_SIN), QSCALE);
        if (l == 0) { __syncthreads(); const int t2_ = tidx(), w2_ = __builtin_amdgcn_readfirstlane(t2_ >> 6); job_win(p, 1, bidx() * 8 + w2_, (int)gridDim.x * 8, lds, w2_, t2_ & 63); }
#ifdef EXP_SPINMLA
        if (!is_scan) { const unsigned long long tq1_ = __builtin_amdgcn_s_memrealtime(); while (__builtin_amdgcn_s_memrealtime() - tq1_ < 4 * (tq1_ - tq0_)) __builtin_amdgcn_s_sleep(8); }
#endif
    } else if constexpr (KIND == 6) {
        job_gdn_final(p, l, gw, ngw, lane, wid, lds);
    } else if constexpr (KIND == 7) {
        pg8::Gemm g{PROJ + C_Z, (const bf16_t*)(p.ws + WS_WOUT), S, DM, MIXW, NP};
        pg8::StaticOrder so; so.init(S, DM, nblk, bid);
        pg8::EpiStore E{(bf16_t*)(p.ws + WS_Y), DM, nullptr};
        pg8::gemm_phase<pg8::EpiStore, pg8::StaticOrder, true, true>(lds, g, so, E);
    } else {
        job_norm_rows(p, l == 0 ? 1 : 2, gw, ngw, lane);
        if (l == 0) job_wout(p, 1, gw, ngw, lds, wid, lane);
    }
}
template <int KIND> __global__ void __launch_bounds__(NT_THREADS, 2) mk_kind(Params p, int l) {
    extern __shared__ __attribute__((aligned(16))) unsigned char lds_raw[];
    run_kind<KIND>(p, l, (LAS unsigned char*)lds_raw);
}

#ifndef MK_LAUNCHES_PER_PHASE
#define MK_LAUNCHES_PER_PHASE 0
#endif
#if !MK_LAUNCHES_PER_PHASE
#ifdef EXP_SPINKIND
#define SPIN_T0(K) unsigned long long t0_s = 0; if ((K) == EXP_SPINKIND) t0_s = __builtin_amdgcn_s_memrealtime();
#define SPIN_T1(K) if ((K) == EXP_SPINKIND) { const unsigned long long t1_s = __builtin_amdgcn_s_memrealtime(), d_s = t1_s - t0_s; while (__builtin_amdgcn_s_memrealtime() - t1_s < 4 * d_s) __builtin_amdgcn_s_sleep(8); }
#else
#define SPIN_T0(K)
#define SPIN_T1(K)
#endif
#ifdef EXP_DUPKINDS
#define DUP_PH(K, L) if ((EXP_DUPKINDS >> (K)) & 1) { GRID_BAR(); run_kind<K>(p, L, lds); }
#else
#define DUP_PH(K, L)
#endif
#define GRID_BAR() do { unsigned long long wi_ = (unsigned long long)p.ws; asm volatile("" : "+s"(wi_)); unsigned char* w_ = (unsigned char*)(__attribute__((address_space(1))) unsigned char*)wi_; XcdBarrier b_; b_.bar = (unsigned*)(w_ + WS_CTL) + 4096; b_.x = xb_xcc_id(); b_.st = (volatile LAS unsigned*)(lds + LDS_BYTES - 16); xcd_barrier(b_); } while (0)
#define PHASE(K, L, LAST) do { SPIN_T0(K) run_kind<K>(p, L, lds); DUP_PH(K, L) if (!(LAST)) GRID_BAR(); SPIN_T1(K) } while (0)
__global__ void __launch_bounds__(NT_THREADS, 2) mk_fwd(Params p) {
    extern __shared__ __attribute__((aligned(16))) unsigned char lds_raw[];
    LAS unsigned char* lds = (LAS unsigned char*)lds_raw;
    cg::grid_group grid = cg::this_grid();
    volatile LAS unsigned* bst = (volatile LAS unsigned*)(lds + LDS_BYTES - 16);
    if (tidx() < 4) bst[tidx()] = 0u;
    __syncthreads();
    (void)xcd_barrier_post((unsigned*)(p.ws + WS_CTL) + 4096, bst);
    if (p.ph_hi == 0x7fffffff) grid.sync();
    PHASE(0, 0, false);
#pragma unroll 1
    for (int l = 0; l < DEPTH; ++l) {
        PHASE(2, l, false); PHASE(5, l, false);
        PHASE(6, l, false); PHASE(7, l, false); PHASE(8, l, l + 1 == DEPTH);
    }
}
#endif

#ifndef MK_LAUNCHES_PER_PHASE
#define MK_LAUNCHES_PER_PHASE 0
#endif
extern "C" void kernel_launch(void* const* d_in, const int* in_sizes, int n_in, void* d_out, int out_size, void* d_ws, size_t ws_size, hipStream_t stream) {
    static int grid = 0;
    if (grid == 0) {
        if (n_in != 19 || in_sizes[0] != S * DM || out_size != S * DM || ws_size < WS_END) { fprintf(stderr, "kernel_launch: unexpected shapes (n_in %d, in0 %d, out %d, ws %zu)\n", n_in, n_in > 0 ? in_sizes[0] : -1, out_size, ws_size); grid = -1; return; }
        int dev = 0, cus = 0, per_cu = 0;
        (void)hipGetDevice(&dev); (void)hipDeviceGetAttribute(&cus, hipDeviceAttributeMultiprocessorCount, dev);
#if !MK_LAUNCHES_PER_PHASE
        if (hipFuncSetAttribute((const void*)mk_fwd, hipFuncAttributeMaxDynamicSharedMemorySize, LDS_BYTES) != hipSuccess) { fprintf(stderr, "kernel_launch: hipFuncSetAttribute failed\n"); grid = -1; return; }
        if (hipOccupancyMaxActiveBlocksPerMultiprocessor(&per_cu, (const void*)mk_fwd, NT_THREADS, LDS_BYTES) != hipSuccess || per_cu < 1) { fprintf(stderr, "kernel_launch: occupancy query gave %d\n", per_cu); per_cu = 1; }
#else
#define SA(K) (void)hipFuncSetAttribute((const void*)mk_kind<K>, hipFuncAttributeMaxDynamicSharedMemorySize, LDS_BYTES)
        SA(0); SA(2); SA(3); SA(5); SA(6); SA(7); SA(8);
#undef SA
#endif
        (void)hipGetLastError();
        if (cus <= 0) cus = 256;
        grid = cus;
        fprintf(stderr, "kernel_launch: cus %d per_cu %d grid %d\n", cus, per_cu, grid);
    }
    if (grid < 0) return;
    Params p{};
    p.x = (const float*)d_in[0]; p.mem = (const float*)d_in[1]; p.pos = (const int*)d_in[2]; p.rel_bias = (const float*)d_in[3];
    p.norm_pre = (const float*)d_in[4]; p.norm_post = (const float*)d_in[5]; p.w_in = (const float*)d_in[6]; p.sinks = (const float*)d_in[7];
    p.conv_w = (const float*)d_in[8]; p.a_log = (const float*)d_in[9]; p.dt_bias = (const float*)d_in[10]; p.gdn_norm = (const float*)d_in[11];
    p.q_norm = (const float*)d_in[12]; p.kv_norm = (const float*)d_in[13]; p.w_uq = (const float*)d_in[14]; p.w_ukv = (const float*)d_in[15];
    p.mem_norm = (const float*)d_in[16]; p.w_mem = (const float*)d_in[17]; p.w_out = (const float*)d_in[18];
    p.out = (float*)d_out; p.ws = (unsigned char*)d_ws;
    if (hipMemsetAsync((char*)d_ws + WS_CTL, 0, 65536, stream) != hipSuccess) { fprintf(stderr, "kernel_launch: hipMemsetAsync failed\n"); return; }
#if MK_LAUNCHES_PER_PHASE
    p.ph_lo = 0; p.ph_hi = 0;
#define LK(K, L) hipLaunchKernelGGL(mk_kind<K>, dim3(grid), dim3(NT_THREADS), LDS_BYTES, stream, p, L)
    LK(0, 0);
    for (int l = 0; l < DEPTH; ++l) { LK(2, l); LK(5, l); LK(6, l); LK(7, l); LK(8, l); }
#undef LK
#else
    p.ph_lo = 0; p.ph_hi = N_PHASES;
    void* args[] = {&p};
    hipError_t e = hipLaunchCooperativeKernel((const void*)mk_fwd, dim3(grid), dim3(NT_THREADS), args, LDS_BYTES, stream);
    if (e != hipSuccess) fprintf(stderr, "kernel_launch: cooperative launch failed: %s (grid %d)\n", hipGetErrorString(e), grid);
#endif
}
```
